# Optimizing an MI355X kernel written in HIP

```python
import math
import jax, jax.numpy as jnp
from jax import lax
import numpy as np

D_MODEL = 1024
BATCH = 32
SEQ = 256
DEPTH = 2
DEC_BATCH = 2
DEC_SEQ = 1024
PAST_LEN = 512

GRID_W = 64
HEAD_DIM = 64
D_RWKV = 384
H_RWKV = D_RWKV // HEAD_DIM
D_DIFF = 384
H_DIFF = D_DIFF // HEAD_DIM
D_QK = HEAD_DIM // 2
D_FNET = D_MODEL - D_RWKV - D_DIFF
FNET_GROUPS = 4
FNET_GROUP_DIM = D_FNET // FNET_GROUPS
LORA_W = 32
LORA_A = 32
LORA_G = 64
N_RWKV_IN = 3 * D_RWKV + 2 * LORA_W + 2 * LORA_A + LORA_G
N_DIFF_IN = 3 * D_DIFF
D_IN = N_RWKV_IN + N_DIFF_IN + D_FNET
RWKV_SPLITS = (D_RWKV, 2 * D_RWKV, 3 * D_RWKV, 3 * D_RWKV + 2 * LORA_W, 3 * D_RWKV + 2 * LORA_W + 2 * LORA_A)
D_FF = ((8 * D_MODEL + 3 * 256 - 1) // (3 * 256)) * 256
ROPE_PAIRS = D_QK // 4
ROPE_BASE = 10000.0
Q_BLOCK = 128
RMS_EPS = 1e-6
GN_EPS = 64e-5
SUBLN_EPS = 1e-5
DECAY_SCALE = math.exp(-0.5)

kernel_name = 'hybrid_rwkv7_diffattn_fnet_dit_step'

F32 = jnp.float32


def rmsnorm(x, g, eps=RMS_EPS):
    xf = x.astype(F32)
    y = xf * lax.rsqrt(jnp.mean(xf * xf, axis=-1, keepdims=True) + eps)
    return (y * g.astype(F32)).astype(x.dtype)


def modulation(cond, w_mod, b_mod):
    m = jax.nn.silu(cond) @ w_mod + b_mod
    return jnp.split(m[:, None, :], 6, axis=-1)


def token_shift(x, mu):
    prev = jnp.pad(x[:, :-1], ((0, 0), (1, 0), (0, 0)))
    nxt = jnp.pad(x[:, 1:], ((0, 0), (0, 1), (0, 0)))
    return x + mu[0] * (prev - x) + mu[1] * (nxt - x)


def wkv_scan(s0, r, w, k, v, kk, a, reverse):
    def step(S, inp):
        r_t, w_t, k_t, v_t, kk_t, a_t = inp
        sa = jnp.einsum('bhvk,bhk->bhv', S, -kk_t)
        S = S * w_t[:, :, None, :] + sa[..., None] * (kk_t * a_t)[:, :, None, :] + v_t[..., None] * k_t[:, :, None, :]
        return S, jnp.einsum('bhvk,bhk->bhv', S, r_t)
    xs = tuple(jnp.moveaxis(t, 1, 0) for t in (r, w, k, v, kk, a))
    S, ys = lax.scan(step, s0, xs, reverse=reverse)
    return S, jnp.moveaxis(ys, 0, 1)


def rwkv_time_mix(u, s0, p, l):
    B, T, _ = u.shape
    u = token_shift(u.astype(F32), p['shift_mu'][l])
    r, k, v, wd, ad, gd = jnp.split(u, RWKV_SPLITS, axis=-1)
    wd = wd.reshape(B, T, 2, LORA_W)
    ad = ad.reshape(B, T, 2, LORA_A)
    w = jnp.exp(-DECAY_SCALE * jax.nn.sigmoid(p['decay_w0'][l] + jnp.einsum('btdr,drc->btdc', jnp.tanh(wd), p['decay_up'][l])))
    a = jax.nn.sigmoid(p['iclr_a0'][l] + jnp.einsum('btdr,drc->btdc', ad, p['iclr_up'][l]))
    g = jax.nn.sigmoid(gd) @ p['gate_up'][l]
    heads = lambda t: t.reshape(B, T, H_RWKV, HEAD_DIM)
    kk = heads(k * p['k_k'][l])
    kk = kk / jnp.maximum(jnp.sqrt(jnp.sum(kk * kk, axis=-1, keepdims=True)), 1e-12)
    k_dir = k[:, :, None, :] * (1.0 + (a - 1.0) * p['k_a'][l])
    rh, vh = heads(r), heads(v)
    k_f, k_b = heads(k_dir[:, :, 0]), heads(k_dir[:, :, 1])
    S_f, y_f = wkv_scan(s0[:, 0], rh, heads(w[:, :, 0]), k_f, vh, kk, heads(a[:, :, 0]), False)
    S_b, y_b = wkv_scan(s0[:, 1], rh, heads(w[:, :, 1]), k_b, vh, kk, heads(a[:, :, 1]), True)
    y = y_f + y_b
    mu = jnp.mean(y, axis=-1, keepdims=True)
    var = jnp.mean(jnp.square(y - mu), axis=-1, keepdims=True)
    y = ((y - mu) * lax.rsqrt(var + GN_EPS)).reshape(B, T, D_RWKV) * p['lnx_g'][l] + p['lnx_b'][l]
    bonus = jnp.sum(rh * (k_f + k_b) * p['r_k'][l], axis=-1, keepdims=True) * vh
    out = (y + bonus.reshape(B, T, D_RWKV)) * g
    return out, jnp.stack([S_f, S_b], axis=1)


def axial_rope(T):
    rows = T // GRID_W
    row = jnp.repeat(jnp.arange(rows), GRID_W).astype(F32)
    col = jnp.tile(jnp.arange(GRID_W), rows).astype(F32)
    inv = 1.0 / (ROPE_BASE ** (jnp.arange(ROPE_PAIRS, dtype=F32) / ROPE_PAIRS))
    ang = jnp.stack([row[:, None] * inv, col[:, None] * inv], axis=1)
    return jnp.cos(ang), jnp.sin(ang)


def apply_rope(x, cos, sin):
    xs = x.astype(F32).reshape(*x.shape[:-1], 2, 2, ROPE_PAIRS)
    x1, x2 = xs[..., 0, :], xs[..., 1, :]
    c, s = cos[:, None, None], sin[:, None, None]
    out = jnp.stack([x1 * c - x2 * s, x2 * c + x1 * s], axis=-2)
    return out.reshape(x.shape).astype(x.dtype)


def diff_attention(q, k, v, lam_params, lam_init, subln_g):
    B, Tq, H = q.shape[:3]
    lp = lam_params.astype(F32)
    lam = jnp.exp(jnp.sum(lp[0] * lp[1])) - jnp.exp(jnp.sum(lp[2] * lp[3])) + lam_init
    kf, vf = k.astype(F32), v.astype(F32)
    qb = jnp.moveaxis((q.astype(F32) * D_QK ** -0.5).reshape(B, Tq // Q_BLOCK, Q_BLOCK, H, 2, D_QK), 1, 0)

    def block(q_blk):
        pr = jax.nn.softmax(jnp.einsum('bqhmd,bkhmd->bhmqk', q_blk, kf), axis=-1)
        return jnp.einsum('bhqk,bkhd->bqhd', pr[:, :, 0] - lam * pr[:, :, 1], vf)

    o = jnp.moveaxis(lax.map(block, qb), 0, 1).reshape(B, Tq, H, HEAD_DIM)
    o = o * lax.rsqrt(jnp.mean(o * o, axis=-1, keepdims=True) + SUBLN_EPS) * subln_g * (1.0 - lam_init)
    return o.reshape(B, Tq, H * HEAD_DIM)


def fourier_mix(u):
    B, T, _ = u.shape
    f = jnp.fft.fft2(u.astype(F32).reshape(B, T, FNET_GROUPS, FNET_GROUP_DIM), axes=(1, 3), norm='ortho').real
    return f.reshape(B, T, D_FNET)


def mixer_sublayer(h, p, l, s0, ctx_k, ctx_v, rope):
    B, T, _ = h.shape
    u_rwkv, u_diff, u_fnet = jnp.split(h @ p['w_in'][l], [N_RWKV_IN, N_RWKV_IN + N_DIFF_IN], axis=-1)
    y_rwkv, s_new = rwkv_time_mix(u_rwkv, s0, p, l)
    q, k, v = jnp.split(u_diff, 3, axis=-1)
    q = q.reshape(B, T, H_DIFF, 2, D_QK)
    k = k.reshape(B, T, H_DIFF, 2, D_QK)
    v = v.reshape(B, T, H_DIFF, HEAD_DIM)
    if rope is None:
        keys, vals = k, v
    else:
        q = apply_rope(q, *rope)
        k = apply_rope(k, *rope)
        keys = jnp.concatenate([ctx_k.astype(k.dtype), k], axis=1)
        vals = jnp.concatenate([ctx_v.astype(v.dtype), v], axis=1)
    lam_init = 0.8 - 0.6 * math.exp(-0.3 * l)
    y_diff = diff_attention(q, keys, vals, p['diff_lambda'][l], lam_init, p['subln_g'][l])
    y_fnet = fourier_mix(u_fnet)
    y = jnp.concatenate([y_rwkv, y_diff, y_fnet], axis=-1).astype(h.dtype) @ p['w_out'][l]
    return y, s_new, k, v


def swiglu(h, w_in, w_out):
    gt, up = jnp.split(h @ w_in, 2, axis=-1)
    return (jax.nn.silu(gt) * up) @ w_out


def trunk_layer(x, cond, p, l, s0, ctx_k, ctx_v, rope):
    sh1, sc1, g1, sh2, sc2, g2 = modulation(cond, p['w_mod'][l], p['b_mod'][l])
    h = rmsnorm(x, p['norm1_g'][l]) * (1 + sc1) + sh1
    y, s_new, k, v = mixer_sublayer(h, p, l, s0, ctx_k, ctx_v, rope)
    x = x + g1 * y
    h = rmsnorm(x, p['norm2_g'][l]) * (1 + sc2) + sh2
    x = x + g2 * swiglu(h, p['w_ffn_in'][l], p['w_ffn_out'][l])
    return x, s_new, k, v


def setup_inputs(seed: int = 0) -> dict:
    key = jax.random.key(seed)
    ks = iter(jax.random.split(key, 40))
    nrm = lambda shape, s: jax.random.normal(next(ks), shape, F32) * s
    L = DEPTH
    return {
        'x_prompt': nrm((BATCH, SEQ, D_MODEL), 1.0),
        'x_sample': nrm((DEC_BATCH, DEC_SEQ, D_MODEL), 1.0),
        'c': nrm((DEC_BATCH, D_MODEL), 1.0),
        'state_rwkv': nrm((DEC_BATCH, L, 2, H_RWKV, HEAD_DIM, HEAD_DIM), 0.5),
        'cache_diff_k': nrm((DEC_BATCH, L, PAST_LEN, H_DIFF, 2, D_QK), 1.0),
        'cache_diff_v': nrm((DEC_BATCH, L, PAST_LEN, H_DIFF, HEAD_DIM), 1.0),
        'c_ctx': nrm((D_MODEL,), 1.0),
        'norm1_g': 1.0 + nrm((L, D_MODEL), 0.02),
        'norm2_g': 1.0 + nrm((L, D_MODEL), 0.02),
        'final_norm_g': 1.0 + nrm((D_MODEL,), 0.02),
        'w_mod': nrm((L, D_MODEL, 6 * D_MODEL), 0.5 * D_MODEL ** -0.5),
        'b_mod': nrm((L, 6 * D_MODEL), 0.02),
        'w_in': nrm((L, D_MODEL, D_IN), D_MODEL ** -0.5),
        'w_out': nrm((L, D_MODEL, D_MODEL), D_MODEL ** -0.5),
        'shift_mu': jax.random.uniform(next(ks), (L, 2, N_RWKV_IN), F32, 0.0, 0.4),
        'decay_w0': nrm((L, 2, D_RWKV), 1.0),
        'decay_up': nrm((L, 2, LORA_W, D_RWKV), 0.1 * LORA_W ** -0.5),
        'iclr_a0': nrm((L, 2, D_RWKV), 0.5),
        'iclr_up': nrm((L, 2, LORA_A, D_RWKV), 0.1 * LORA_A ** -0.5),
        'gate_up': nrm((L, LORA_G, D_RWKV), LORA_G ** -0.5),
        'k_k': 1.0 + nrm((L, D_RWKV), 0.1),
        'k_a': 1.0 + nrm((L, D_RWKV), 0.1),
        'r_k': nrm((L, H_RWKV, HEAD_DIM), 0.1),
        'lnx_g': 1.0 + nrm((L, D_RWKV), 0.02),
        'lnx_b': nrm((L, D_RWKV), 0.02),
        'diff_lambda': nrm((L, 4, D_QK), 0.1),
        'subln_g': 1.0 + nrm((L, HEAD_DIM), 0.02),
        'w_ffn_in': nrm((L, D_MODEL, 2 * D_FF), D_MODEL ** -0.5),
        'w_ffn_out': nrm((L, D_FF, D_MODEL), D_FF ** -0.5),
    }


def reference(x_prompt, x_sample, c, state_rwkv, cache_diff_k, cache_diff_v, c_ctx, norm1_g, norm2_g, final_norm_g,
              w_mod, b_mod, w_in, w_out, shift_mu, decay_w0, decay_up, iclr_a0, iclr_up, gate_up, k_k, k_a, r_k,
              lnx_g, lnx_b, diff_lambda, subln_g, w_ffn_in, w_ffn_out):
    p = dict(norm1_g=norm1_g, norm2_g=norm2_g, w_mod=w_mod, b_mod=b_mod, w_in=w_in, w_out=w_out,
             shift_mu=shift_mu, decay_w0=decay_w0, decay_up=decay_up, iclr_a0=iclr_a0, iclr_up=iclr_up,
             gate_up=gate_up, k_k=k_k, k_a=k_a, r_k=r_k, lnx_g=lnx_g, lnx_b=lnx_b, diff_lambda=diff_lambda,
             subln_g=subln_g, w_ffn_in=w_ffn_in, w_ffn_out=w_ffn_out)

    xp = x_prompt
    s_zero = jnp.zeros((x_prompt.shape[0], 2, H_RWKV, HEAD_DIM, HEAD_DIM), F32)
    states, ks, vs = [], [], []
    for l in range(DEPTH):
        xp, s_new, k, v = trunk_layer(xp, c_ctx[None, :], p, l, s_zero, None, None, None)
        states.append(s_new)
        ks.append(k)
        vs.append(v)
    y_prompt = rmsnorm(xp, final_norm_g)
    new_state_rwkv = jnp.stack(states, axis=1)
    new_cache_diff_k = jnp.stack(ks, axis=1)
    new_cache_diff_v = jnp.stack(vs, axis=1)

    rope = axial_rope(x_sample.shape[1])
    xs = x_sample
    for l in range(DEPTH):
        xs, _, _, _ = trunk_layer(xs, c, p, l, state_rwkv[:, l].astype(F32), cache_diff_k[:, l], cache_diff_v[:, l], rope)
    y_sample = rmsnorm(xs, final_norm_g)
    return (y_prompt, y_sample, new_state_rwkv, new_cache_diff_k, new_cache_diff_v)
```

```cpp
#include <hip/hip_runtime.h>
#include <stdint.h>

typedef unsigned short bf16_t;

#define D_MODEL 1024
#define NTOK 10240
#define NPTOK 8192
#define TP 256
#define TS 1024
#define NSEQ 34
#define NH 6
#define N1 3072
#define C_DIFF 0
#define C_FNET 1152
#define C_RWKV 1664
#define C_END 3008
#define N_RWKV 1344
#define D_FF 2816
#define D_IN 2752

#define OUT_YP 0
#define OUT_YS 8388608
#define OUT_ST 10485760
#define OUT_CK 13631488
#define OUT_CV 19922944

#define OPS_REC 1792
#define OPS_TOK (6 * OPS_REC)

#define WS_WIN   ((size_t)0)
#define WS_WOUT  (WS_WIN + (size_t)2 * N1 * 1024 * 2)
#define WS_WF1   (WS_WOUT + (size_t)2 * 1024 * 1024 * 2)
#define WS_WF2   (WS_WF1 + (size_t)2 * 5632 * 1024 * 2)
#define WS_H     (WS_WF2 + (size_t)2 * 1024 * 2816 * 2)
#define WS_UD    (WS_H + (size_t)NTOK * 1024 * 2)
#define WS_ZF    (WS_UD + (size_t)NTOK * 1152 * 2)
#define WS_UR    (WS_ZF + (size_t)NTOK * 512 * 2)
#define WS_OPS   (WS_UR + (size_t)2 * NTOK * 384 * 4)
#define WS_MOD   (WS_OPS + (size_t)NTOK * OPS_TOK)
#define WS_TAB   (WS_MOD + (size_t)2 * 3 * 6144 * 4)
#define WS_END   (WS_TAB + (size_t)1024 * 8)

struct P {
    const float *x_prompt, *x_sample, *c, *state_rwkv, *cache_k, *cache_v, *c_ctx, *norm1_g, *norm2_g, *final_g;
    const float *w_mod, *b_mod, *w_in, *w_out, *shift_mu, *decay_w0, *decay_up, *iclr_a0, *iclr_up, *gate_up;
    const float *k_k, *k_a, *r_k, *lnx_g, *lnx_b, *diff_lambda, *subln_g, *w_ffn_in, *w_ffn_out;
    float* out;
    unsigned char* ws;
};

__device__ __forceinline__ bf16_t f2bf(float f) { unsigned u = __builtin_bit_cast(unsigned, f); return (bf16_t)((u + 0x7fffu + ((u >> 16) & 1u)) >> 16); }
__device__ __forceinline__ float bf2f(bf16_t b) { return __builtin_bit_cast(float, ((unsigned)b) << 16); }
__device__ __forceinline__ float sigmoidf_(float x) { return 1.f / (1.f + __expf(-x)); }
__device__ __forceinline__ float wave_sum(float v) {
#pragma unroll
    for (int o = 1; o < 64; o <<= 1) v += __shfl_xor(v, o);
    return v;
}
__device__ __forceinline__ int tok_cls(int tok) { return tok < NPTOK ? 0 : 1 + ((tok - NPTOK) >> 10); }
__device__ __forceinline__ const float* xin_row(const P& p, int tok) { return tok < NPTOK ? p.x_prompt + (size_t)tok * 1024 : p.x_sample + (size_t)(tok - NPTOK) * 1024; }
__device__ __forceinline__ float* X_row(const P& p, int tok) { return p.out + (size_t)tok * 1024; }
__device__ __forceinline__ const float* mod_vec(const P& p, int l, int cls, int which) { return (const float*)(p.ws + WS_MOD) + ((size_t)(l * 3 + cls) * 6144 + which * 1024); }
__device__ __forceinline__ void seq_info(int s, int& start, int& T) { if (s < 32) { start = s * TP; T = TP; } else { start = NPTOK + (s - 32) * TS; T = TS; } }
__device__ __forceinline__ void tok_info(int tok, int& s, int& t, int& T, int& start) {
    if (tok < NPTOK) { s = tok >> 8; t = tok & 255; T = TP; start = s * TP; } else { int r = tok - NPTOK; s = 32 + (r >> 10); t = r & 1023; T = TS; start = NPTOK + ((r >> 10) << 10); }
}

#define P0_MOD 192
#define P0_TILES_L 3136
__device__ void ph_prep0(const P& p, float* sm) {
    const int tid = threadIdx.x;
    const int nitems = P0_MOD + 2 * P0_TILES_L + 1;
    for (int item = blockIdx.x; item < nitems; item += gridDim.x) {
        __syncthreads();
        if (item < P0_MOD) {
            const int l = item / 96, cg = item % 96, col = cg * 64 + (tid & 63), ks = tid >> 6;
            const float* W = p.w_mod + (size_t)l * 1024 * 6144;
            float a0 = 0.f, a1 = 0.f, a2 = 0.f;
            for (int k = ks * 128; k < ks * 128 + 128; ++k) {
                const float w = W[(size_t)k * 6144 + col];
                float c0 = p.c_ctx[k], c1 = p.c[k], c2 = p.c[1024 + k];
                c0 = c0 * sigmoidf_(c0); c1 = c1 * sigmoidf_(c1); c2 = c2 * sigmoidf_(c2);
                a0 += c0 * w; a1 += c1 * w; a2 += c2 * w;
            }
            sm[(ks * 3 + 0) * 64 + (tid & 63)] = a0; sm[(ks * 3 + 1) * 64 + (tid & 63)] = a1; sm[(ks * 3 + 2) * 64 + (tid & 63)] = a2;
            __syncthreads();
            if (tid < 192) {
                const int cls = tid >> 6, cc = tid & 63; float s = 0.f;
                for (int k = 0; k < 8; ++k) s += sm[(k * 3 + cls) * 64 + cc];
                const int colo = cg * 64 + cc;
                ((float*)(p.ws + WS_MOD))[(size_t)(l * 3 + cls) * 6144 + colo] = s + p.b_mod[(size_t)l * 6144 + colo];
            }
        } else if (item < P0_MOD + 2 * P0_TILES_L) {
            int it = item - P0_MOD; const int l = it / P0_TILES_L; it %= P0_TILES_L;
            const float* src; int srcN, K, ntile, ktile, mode = 0, scol = 0; bf16_t* dst; int n0;
            if (it < 768) { ntile = it / 16; ktile = it % 16; K = 1024; srcN = D_IN; src = p.w_in + (size_t)l * 1024 * D_IN; dst = (bf16_t*)(p.ws + WS_WIN) + (size_t)l * N1 * 1024;
                n0 = ntile * 64;
                if (n0 < C_FNET) { scol = 1344 + n0; } else if (n0 < C_RWKV) { mode = 1 + ((n0 - C_FNET) / 64) % 2; scol = 2496 + ((n0 - C_FNET) / 128) * 64; } else if (n0 < C_END) { scol = n0 - C_RWKV; } else mode = 3; }
            else if (it < 1024) { it -= 768; ntile = it / 16; ktile = it % 16; K = 1024; srcN = 1024; src = p.w_out + (size_t)l * 1024 * 1024; dst = (bf16_t*)(p.ws + WS_WOUT) + (size_t)l * 1024 * 1024; n0 = ntile * 64; scol = n0; }
            else if (it < 2432) { it -= 1024; ntile = it / 16; ktile = it % 16; K = 1024; srcN = 5632; src = p.w_ffn_in + (size_t)l * 1024 * 5632; dst = (bf16_t*)(p.ws + WS_WF1) + (size_t)l * 5632 * 1024; n0 = ntile * 64;
                const int pn = ntile >> 2, sub = ntile & 3; scol = (sub < 2) ? (128 * pn + 64 * sub) : (2816 + 128 * pn + 64 * (sub - 2)); }
            else { it -= 2432; ntile = it / 44; ktile = it % 44; K = 2816; srcN = 1024; src = p.w_ffn_out + (size_t)l * 2816 * 1024; dst = (bf16_t*)(p.ws + WS_WF2) + (size_t)l * 1024 * 2816; n0 = ntile * 64; scol = n0; }
            const int k0 = ktile * 64;
            float* tile = sm;
            float* cs = sm + 64 * 65;
            if (mode != 3) {
#pragma unroll
                for (int i = 0; i < 8; ++i) { const int k = i * 8 + (tid >> 6), n = tid & 63; tile[k * 65 + n] = src[(size_t)(k0 + k) * srcN + scol + n]; }
            }
            if (tid < 64) { cs[tid] = cospif((float)tid / 32.f); cs[64 + tid] = sinpif((float)tid / 32.f); }
            __syncthreads();
            const int n = tid >> 3, k8 = (tid & 7) * 8;
            float v[8];
            if (mode == 0) {
#pragma unroll
                for (int j = 0; j < 8; ++j) v[j] = tile[(k8 + j) * 65 + n];
            } else if (mode == 3) {
#pragma unroll
                for (int j = 0; j < 8; ++j) v[j] = 0.f;
            } else {
#pragma unroll
                for (int j = 0; j < 8; ++j) v[j] = 0.f;
                for (int cc = 0; cc < 64; ++cc) {
                    const int idx = (n * cc) & 63;
                    const float tr = (mode == 1) ? cs[idx] * 0.125f : -cs[64 + idx] * 0.125f;
#pragma unroll
                    for (int j = 0; j < 8; ++j) v[j] += tile[(k8 + j) * 65 + cc] * tr;
                }
            }
            uint4 o;
            o.x = (unsigned)f2bf(v[0]) | ((unsigned)f2bf(v[1]) << 16); o.y = (unsigned)f2bf(v[2]) | ((unsigned)f2bf(v[3]) << 16);
            o.z = (unsigned)f2bf(v[4]) | ((unsigned)f2bf(v[5]) << 16); o.w = (unsigned)f2bf(v[6]) | ((unsigned)f2bf(v[7]) << 16);
            *(uint4*)(dst + (size_t)(n0 + n) * K + k0 + k8) = o;
        } else {
            float2* tab = (float2*)(p.ws + WS_TAB);
            for (int k = tid; k < 1024; k += blockDim.x) tab[k] = make_float2(cospif((float)k / 512.f), sinpif((float)k / 512.f));
        }
    }
}

__device__ void ph_norm(const P& p, int l, int which) {
    const int lane = threadIdx.x & 63, wv = threadIdx.x >> 6, nw = blockDim.x >> 6;
    for (int row = blockIdx.x * nw + wv; row < NTOK; row += gridDim.x * nw) {
        const float* xr = (which == 0 && l == 0) ? xin_row(p, row) : X_row(p, row);
        float4 x[4]; float ss = 0.f;
#pragma unroll
        for (int i = 0; i < 4; ++i) { x[i] = *(const float4*)(xr + i * 256 + lane * 4); ss += x[i].x * x[i].x + x[i].y * x[i].y + x[i].z * x[i].z + x[i].w * x[i].w; }
        ss = wave_sum(ss);
        const float rstd = rsqrtf(ss * (1.f / 1024.f) + 1e-6f);
        if (which == 2) {
            float* o = p.out + (size_t)row * 1024;
#pragma unroll
            for (int i = 0; i < 4; ++i) { const float4 g = *(const float4*)(p.final_g + i * 256 + lane * 4);
                float4 y; y.x = x[i].x * rstd * g.x; y.y = x[i].y * rstd * g.y; y.z = x[i].z * rstd * g.z; y.w = x[i].w * rstd * g.w;
                *(float4*)(o + i * 256 + lane * 4) = y; }
        } else {
            const int cls = tok_cls(row);
            const float* g = (which == 0 ? p.norm1_g : p.norm2_g) + (size_t)l * 1024;
            const float* sh = mod_vec(p, l, cls, which == 0 ? 0 : 3);
            const float* sc = mod_vec(p, l, cls, which == 0 ? 1 : 4);
            bf16_t* h = (bf16_t*)(p.ws + WS_H) + (size_t)row * 1024;
#pragma unroll
            for (int i = 0; i < 4; ++i) { const int c = i * 256 + lane * 4;
                const float4 gg = *(const float4*)(g + c), s1 = *(const float4*)(sc + c), s0 = *(const float4*)(sh + c);
                const float y0 = x[i].x * rstd * gg.x * (1.f + s1.x) + s0.x, y1 = x[i].y * rstd * gg.y * (1.f + s1.y) + s0.y;
                const float y2 = x[i].z * rstd * gg.z * (1.f + s1.z) + s0.z, y3 = x[i].w * rstd * gg.w * (1.f + s1.w) + s0.w;
                uint2 o; o.x = (unsigned)f2bf(y0) | ((unsigned)f2bf(y1) << 16); o.y = (unsigned)f2bf(y2) | ((unsigned)f2bf(y3) << 16);
                *(uint2*)(h + c) = o; }
        }
    }
}

struct EpiG1 {
    int l;
    __device__ __forceinline__ void operator()(const P& p, int row, int col, const float* v) const {
        if (col < C_FNET) {
            bf16_t* o = (bf16_t*)(p.ws + WS_UD) + (size_t)row * 1152 + col;
            uint2 w; w.x = (unsigned)f2bf(v[0]) | ((unsigned)f2bf(v[1]) << 16); w.y = (unsigned)f2bf(v[2]) | ((unsigned)f2bf(v[3]) << 16);
            *(uint2*)o = w;
            if (row < NPTOK && col >= 384) {
                const int b = row >> 8, t = row & 255;
                float* dst = p.out + (col < 768 ? OUT_CK : OUT_CV) + ((size_t)(b * 2 + l) * 256 + t) * 384 + (col < 768 ? col - 384 : col - 768);
                *(float4*)dst = make_float4(v[0], v[1], v[2], v[3]);
            }
        } else if (col < C_RWKV) {
            bf16_t* o = (bf16_t*)(p.ws + WS_ZF) + (size_t)row * 512 + (col - C_FNET);
            uint2 w; w.x = (unsigned)f2bf(v[0]) | ((unsigned)f2bf(v[1]) << 16); w.y = (unsigned)f2bf(v[2]) | ((unsigned)f2bf(v[3]) << 16);
            *(uint2*)o = w;
        } else if (col < C_END) {
            bf16_t* o = (bf16_t*)(p.ws + WS_UR) + (size_t)row * N_RWKV + (col - C_RWKV);
            uint2 w; w.x = (unsigned)f2bf(v[0]) | ((unsigned)f2bf(v[1]) << 16); w.y = (unsigned)f2bf(v[2]) | ((unsigned)f2bf(v[3]) << 16);
            *(uint2*)o = w;
        }
    }
};
struct EpiRes {
    int l, which;
    __device__ __forceinline__ void operator()(const P& p, int row, int col, const float* v) const {
        const float* g = mod_vec(p, l, tok_cls(row), which) + col;
        const float* xo = (which == 2 && l == 0) ? xin_row(p, row) + col : X_row(p, row) + col;
        const float4 x = *(const float4*)xo; const float4 gg = *(const float4*)g;
        *(float4*)(X_row(p, row) + col) = make_float4(x.x + gg.x * v[0], x.y + gg.y * v[1], x.z + gg.z * v[2], x.w + gg.w * v[3]);
    }
};

template <bool PAIR, class Epi>
__device__ void ph_gemm_naive(const P& p, const bf16_t* A, const bf16_t* Bt, int M, int N, int K, const Epi& epi, float* sm) {
    float* As = sm;
    float* Bs = sm + 128 * 33;
    const int tid = threadIdx.x, ty = tid >> 4, tx = tid & 15;
    const int nMt = M / 128, nNt = PAIR ? (N / 256) * 4 : N / 64;
    for (int tile = blockIdx.x; tile < nMt * nNt; tile += gridDim.x) {
        const int mt = tile / nNt, nt = tile % nNt, m0 = mt * 128;
        int c0; if (PAIR) { c0 = (nt >> 2) * 256 + (nt & 3) * 32; } else c0 = nt * 64;
        float acc[4][4];
#pragma unroll
        for (int i = 0; i < 4; ++i)
#pragma unroll
            for (int j = 0; j < 4; ++j) acc[i][j] = 0.f;
        for (int k0 = 0; k0 < K; k0 += 32) {
            __syncthreads();
            { const int r = tid >> 2, c8 = (tid & 3) * 8; const uint4 u = *(const uint4*)(A + (size_t)(m0 + r) * K + k0 + c8);
              const unsigned w[4] = {u.x, u.y, u.z, u.w};
#pragma unroll
              for (int j = 0; j < 4; ++j) { As[r * 33 + c8 + 2 * j] = bf2f((bf16_t)(w[j] & 0xffff)); As[r * 33 + c8 + 2 * j + 1] = bf2f((bf16_t)(w[j] >> 16)); } }
            if (tid < 256) { const int r = tid >> 2, c8 = (tid & 3) * 8; int brow; if (PAIR) brow = (r < 32) ? c0 + r : c0 + 128 + (r - 32); else brow = c0 + r;
              const uint4 u = *(const uint4*)(Bt + (size_t)brow * K + k0 + c8);
              const unsigned w[4] = {u.x, u.y, u.z, u.w};
#pragma unroll
              for (int j = 0; j < 4; ++j) { Bs[r * 33 + c8 + 2 * j] = bf2f((bf16_t)(w[j] & 0xffff)); Bs[r * 33 + c8 + 2 * j + 1] = bf2f((bf16_t)(w[j] >> 16)); } }
            __syncthreads();
#pragma unroll 8
            for (int kk = 0; kk < 32; ++kk) {
                float a[4], b[4];
#pragma unroll
                for (int i = 0; i < 4; ++i) a[i] = As[(ty * 4 + i) * 33 + kk];
                if (PAIR) { b[0] = Bs[(tx * 2) * 33 + kk]; b[1] = Bs[(tx * 2 + 1) * 33 + kk]; b[2] = Bs[(32 + tx * 2) * 33 + kk]; b[3] = Bs[(32 + tx * 2 + 1) * 33 + kk]; }
                else {
#pragma unroll
                    for (int j = 0; j < 4; ++j) b[j] = Bs[(tx * 4 + j) * 33 + kk]; }
#pragma unroll
                for (int i = 0; i < 4; ++i)
#pragma unroll
                    for (int j = 0; j < 4; ++j) acc[i][j] += a[i] * b[j];
            }
        }
#pragma unroll
        for (int i = 0; i < 4; ++i) {
            const int row = m0 + ty * 4 + i;
            if (PAIR) {
                const int j0 = (nt >> 2) * 128 + (nt & 3) * 32 + tx * 2;
                const float g0 = acc[i][0], g1 = acc[i][1], u0 = acc[i][2], u1 = acc[i][3];
                const float h0 = g0 * sigmoidf_(g0) * u0, h1 = g1 * sigmoidf_(g1) * u1;
                bf16_t* o = (bf16_t*)(p.ws + WS_UR) + (size_t)row * D_FF + j0;
                *(unsigned*)o = (unsigned)f2bf(h0) | ((unsigned)f2bf(h1) << 16);
            } else {
                epi(p, row, c0 + tx * 4, acc[i]);
            }
        }
    }
}

__device__ void ph_prep(const P& p, int l, float* sm) {
    const int tid = threadIdx.x, lane = tid & 63, wv = tid >> 6;
    const bf16_t* UR = (const bf16_t*)(p.ws + WS_UR);
    float* lin = sm;
    const float* mu0 = p.shift_mu + (size_t)l * 2 * N_RWKV; const float* mu1 = mu0 + N_RWKV;
    for (int tile = blockIdx.x; tile < NTOK / 8; tile += gridDim.x) {
        __syncthreads();
        for (int e = tid; e < 8 * 192; e += blockDim.x) {
            const int tk = e / 192, j = e % 192, tok = tile * 8 + tk, col = 1152 + j;
            int s, t, T, st; tok_info(tok, s, t, T, st);
            const float xc = bf2f(UR[(size_t)tok * N_RWKV + col]);
            const float xp = t > 0 ? bf2f(UR[(size_t)(tok - 1) * N_RWKV + col]) : 0.f;
            const float xn = t < T - 1 ? bf2f(UR[(size_t)(tok + 1) * N_RWKV + col]) : 0.f;
            float x = xc + mu0[col] * (xp - xc) + mu1[col] * (xn - xc);
            if (j < 64) x = tanhf(x); else if (j >= 128) x = sigmoidf_(x);
            lin[tk * 192 + j] = x;
        }
        __syncthreads();
        if (tid < 384) {
            const int ch = tid, h = wv;
#pragma unroll 1
            for (int tk = 0; tk < 8; ++tk) {
                const int tok = tile * 8 + tk; int s, t, T, st; tok_info(tok, s, t, T, st);
                float rkv[3];
#pragma unroll
                for (int q = 0; q < 3; ++q) { const int col = q * 384 + ch;
                    const float xc = bf2f(UR[(size_t)tok * N_RWKV + col]);
                    const float xp = t > 0 ? bf2f(UR[(size_t)(tok - 1) * N_RWKV + col]) : 0.f;
                    const float xn = t < T - 1 ? bf2f(UR[(size_t)(tok + 1) * N_RWKV + col]) : 0.f;
                    rkv[q] = xc + mu0[col] * (xp - xc) + mu1[col] * (xn - xc); }
                float w[2], a[2];
#pragma unroll
                for (int d = 0; d < 2; ++d) {
                    float sw = p.decay_w0[(size_t)(l * 2 + d) * 384 + ch], sa = p.iclr_a0[(size_t)(l * 2 + d) * 384 + ch];
                    const float* du = p.decay_up + (size_t)((l * 2 + d) * 32) * 384 + ch; const float* iu = p.iclr_up + (size_t)((l * 2 + d) * 32) * 384 + ch;
#pragma unroll 4
                    for (int j = 0; j < 32; ++j) { sw += lin[tk * 192 + d * 32 + j] * du[(size_t)j * 384]; sa += lin[tk * 192 + 64 + d * 32 + j] * iu[(size_t)j * 384]; }
                    w[d] = __expf(-0.60653065971263342f * sigmoidf_(sw)); a[d] = sigmoidf_(sa);
                }
                float g = 0.f; { const float* gu = p.gate_up + (size_t)l * 64 * 384 + ch;
#pragma unroll 4
                    for (int j = 0; j < 64; ++j) g += lin[tk * 192 + 128 + j] * gu[(size_t)j * 384]; }
                const float kkr = rkv[1] * p.k_k[(size_t)l * 384 + ch];
                const float nrm = sqrtf(wave_sum(kkr * kkr));
                const float kk = kkr / fmaxf(nrm, 1e-12f);
                unsigned char* rec = p.ws + WS_OPS + (size_t)tok * OPS_TOK + (size_t)h * OPS_REC;
                float* rf = (float*)rec; bf16_t* rb = (bf16_t*)(rec + 1280);
                rf[lane] = -kk; rf[64 + lane] = w[0]; rf[128 + lane] = w[1]; rf[192 + lane] = a[0]; rf[256 + lane] = a[1];
                rb[lane] = f2bf(rkv[0]); rb[64 + lane] = f2bf(rkv[2]); rb[128 + lane] = f2bf(rkv[1]); rb[192 + lane] = f2bf(g);
            }
        }
    }
    bf16_t* UD = (bf16_t*)(p.ws + WS_UD);
    for (int e = blockIdx.x * blockDim.x + tid; e < 2048 * 384; e += gridDim.x * blockDim.x) {
        const int tk = e / 384, pi = e % 384;
        const int grp = pi >> 3, pr = pi & 7, col = grp * 16 + pr;
        const int axis = grp & 1;
        const int t = tk & 1023, pos = axis == 0 ? (t >> 6) : (t & 63);
        const float inv = __powf(10000.f, -(float)pr / 8.f);
        float sn, cs; __sincosf((float)pos * inv, &sn, &cs);
        bf16_t* ptr = UD + (size_t)(NPTOK + tk) * 1152 + col;
        const float x1 = bf2f(ptr[0]), x2 = bf2f(ptr[8]);
        ptr[0] = f2bf(x1 * cs - x2 * sn); ptr[8] = f2bf(x2 * cs + x1 * sn);
    }
}

#define SC_TC 16
__device__ void ph_scan(const P& p, int l, float* sm) {
    const int tid = threadIdx.x, dir = tid >> 8, ht = tid & 255, v = ht >> 2, q = ht & 3;
    float* ops = sm + dir * (SC_TC * 6 * 64);
    float* Yb = (float*)(p.ws + WS_UR);
    for (int job = blockIdx.x; job < NSEQ * NH; job += gridDim.x) {
        const int s = job / NH, h = job % NH; int start, T; seq_info(s, start, T);
        float S[16];
        if (s < 32) {
#pragma unroll
            for (int e = 0; e < 16; ++e) S[e] = 0.f;
        } else {
            const float* s0 = p.state_rwkv + ((((size_t)(s - 32) * 2 + l) * 2 + dir) * NH + h) * 4096 + v * 64 + q * 16;
#pragma unroll
            for (int e = 0; e < 16; ++e) S[e] = s0[e];
        }
        for (int c = 0; c < T / SC_TC; ++c) {
            __syncthreads();
#pragma unroll
            for (int rpt = 0; rpt < 4; ++rpt) {
                const int e = rpt * 256 + ht, i = e >> 6, ch = e & 63;
                const int st = c * SC_TC + i, t = dir == 0 ? st : T - 1 - st, tok = start + t;
                const unsigned char* rec = p.ws + WS_OPS + (size_t)tok * OPS_TOK + (size_t)h * OPS_REC;
                const float* rf = (const float*)rec; const bf16_t* rb = (const bf16_t*)(rec + 1280);
                const float nkk = rf[ch], w = rf[64 + dir * 64 + ch], a = rf[192 + dir * 64 + ch];
                const float r = bf2f(rb[ch]), vv = bf2f(rb[64 + ch]), k = bf2f(rb[128 + ch]);
                const float kd = k * (1.f + (a - 1.f) * p.k_a[(size_t)l * 384 + h * 64 + ch]);
                float* o = ops + i * 384;
                o[ch] = r; o[64 + ch] = nkk; o[128 + ch] = vv; o[192 + ch] = w; o[256 + ch] = kd; o[320 + ch] = -nkk * a;
            }
            __syncthreads();
            for (int i = 0; i < SC_TC; ++i) {
                const float* o = ops + i * 384;
                float sa = 0.f;
#pragma unroll
                for (int e = 0; e < 16; ++e) sa += S[e] * o[64 + q * 16 + e];
                sa += __shfl_xor(sa, 1); sa += __shfl_xor(sa, 2);
                const float vv = o[128 + v];
                float y = 0.f;
#pragma unroll
                for (int e = 0; e < 16; ++e) { const int k = q * 16 + e; S[e] = S[e] * o[192 + k] + sa * o[320 + k] + vv * o[256 + k]; y += S[e] * o[k]; }
                y += __shfl_xor(y, 1); y += __shfl_xor(y, 2);
                if (q == 0) { const int st = c * SC_TC + i, t = dir == 0 ? st : T - 1 - st; Yb[((size_t)dir * NTOK + start + t) * 384 + h * 64 + v] = y; }
            }
        }
        if (s < 32) {
            float* so = p.out + OUT_ST + ((((size_t)s * 2 + l) * 2 + dir) * NH + h) * 4096 + v * 64 + q * 16;
#pragma unroll
            for (int e = 0; e < 16; ++e) so[e] = S[e];
        }
    }
}

__device__ void ph_finalize(const P& p, int l) {
    const int lane = threadIdx.x & 63, wv = threadIdx.x >> 6, nw = blockDim.x >> 6;
    const float* Yb = (const float*)(p.ws + WS_UR);
    bf16_t* MIX = (bf16_t*)(p.ws + WS_H);
    for (int it = blockIdx.x * nw + wv; it < NTOK * NH; it += gridDim.x * nw) {
        const int tok = it / NH, h = it % NH, ch = h * 64 + lane;
        const float y = Yb[(size_t)tok * 384 + ch] + Yb[((size_t)NTOK + tok) * 384 + ch];
        const float mu = wave_sum(y) * (1.f / 64.f);
        const float dlt = y - mu;
        const float var = wave_sum(dlt * dlt) * (1.f / 64.f);
        const float yn = dlt * rsqrtf(var + 64e-5f) * p.lnx_g[(size_t)l * 384 + ch] + p.lnx_b[(size_t)l * 384 + ch];
        const unsigned char* rec = p.ws + WS_OPS + (size_t)tok * OPS_TOK + (size_t)h * OPS_REC;
        const float* rf = (const float*)rec; const bf16_t* rb = (const bf16_t*)(rec + 1280);
        const float a0 = rf[192 + lane], a1 = rf[256 + lane];
        const float r = bf2f(rb[lane]), vv = bf2f(rb[64 + lane]), k = bf2f(rb[128 + lane]), g = bf2f(rb[192 + lane]);
        const float ka = p.k_a[(size_t)l * 384 + ch];
        const float kf = k * (1.f + (a0 - 1.f) * ka), kb = k * (1.f + (a1 - 1.f) * ka);
        const float bs = wave_sum(r * (kf + kb) * p.r_k[(size_t)l * 384 + ch]);
        MIX[(size_t)tok * 1024 + ch] = f2bf((yn + bs * vv) * g);
    }
}

__device__ void ph_attn_naive(const P& p, int l) {
    const bf16_t* UD = (const bf16_t*)(p.ws + WS_UD);
    bf16_t* MIX = (bf16_t*)(p.ws + WS_H);
    const float lam_init = 0.8f - 0.6f * __expf(-0.3f * (float)l);
    float lam;
    {
        const float* lp = p.diff_lambda + (size_t)l * 128; float s01 = 0.f, s23 = 0.f;
        for (int d = 0; d < 32; ++d) { s01 += lp[d] * lp[32 + d]; s23 += lp[64 + d] * lp[96 + d]; }
        lam = __expf(s01) - __expf(s23) + lam_init;
    }
    const float scale = 0.17677669529663687f;
    for (int idx = blockIdx.x * blockDim.x + threadIdx.x; idx < NTOK * NH; idx += gridDim.x * blockDim.x) {
        int s, h, t, T, start;
        if (idx < NPTOK * NH) { const int sh = idx >> 8; t = idx & 255; s = sh / NH; h = sh % NH; T = TP; start = s * TP; }
        else { const int r = idx - NPTOK * NH; const int sh = r >> 10; t = r & 1023; s = 32 + sh / NH; h = sh % NH; T = TS; start = NPTOK + (s - 32) * TS; }
        const int tok = start + t;
        float q[64];
#pragma unroll
        for (int d = 0; d < 64; ++d) q[d] = bf2f(UD[(size_t)tok * 1152 + h * 64 + d]) * scale;
        const int nctx = (s >= 32) ? 512 : 0;
        const float* ck = (s >= 32) ? p.cache_k + (((size_t)(s - 32) * 2 + l) * 512) * 384 + h * 64 : nullptr;
        const float* cv = (s >= 32) ? p.cache_v + (((size_t)(s - 32) * 2 + l) * 512) * 384 + h * 64 : nullptr;
        float m0 = -1e30f, m1 = -1e30f;
        for (int j = 0; j < nctx + T; ++j) {
            float s0 = 0.f, s1 = 0.f;
            if (j < nctx) { const float* kp = ck + (size_t)j * 384;
#pragma unroll
                for (int d = 0; d < 32; ++d) { s0 += q[d] * kp[d]; s1 += q[32 + d] * kp[32 + d]; } }
            else { const bf16_t* kp = UD + (size_t)(start + j - nctx) * 1152 + 384 + h * 64;
#pragma unroll
                for (int d = 0; d < 32; ++d) { s0 += q[d] * bf2f(kp[d]); s1 += q[32 + d] * bf2f(kp[32 + d]); } }
            m0 = fmaxf(m0, s0); m1 = fmaxf(m1, s1);
        }
        float l0 = 0.f, l1 = 0.f;
        for (int j = 0; j < nctx + T; ++j) {
            float s0 = 0.f, s1 = 0.f;
            if (j < nctx) { const float* kp = ck + (size_t)j * 384;
#pragma unroll
                for (int d = 0; d < 32; ++d) { s0 += q[d] * kp[d]; s1 += q[32 + d] * kp[32 + d]; } }
            else { const bf16_t* kp = UD + (size_t)(start + j - nctx) * 1152 + 384 + h * 64;
#pragma unroll
                for (int d = 0; d < 32; ++d) { s0 += q[d] * bf2f(kp[d]); s1 += q[32 + d] * bf2f(kp[32 + d]); } }
            l0 += __expf(s0 - m0); l1 += __expf(s1 - m1);
        }
        const float il0 = 1.f / l0, il1 = lam / l1;
        float o[64];
#pragma unroll
        for (int d = 0; d < 64; ++d) o[d] = 0.f;
        for (int j = 0; j < nctx + T; ++j) {
            float s0 = 0.f, s1 = 0.f;
            if (j < nctx) { const float* kp = ck + (size_t)j * 384;
#pragma unroll
                for (int d = 0; d < 32; ++d) { s0 += q[d] * kp[d]; s1 += q[32 + d] * kp[32 + d]; }
                const float pw = __expf(s0 - m0) * il0 - __expf(s1 - m1) * il1; const float* vp = cv + (size_t)j * 384;
#pragma unroll
                for (int d = 0; d < 64; ++d) o[d] += pw * vp[d]; }
            else { const bf16_t* kp = UD + (size_t)(start + j - nctx) * 1152 + 384 + h * 64;
#pragma unroll
                for (int d = 0; d < 32; ++d) { s0 += q[d] * bf2f(kp[d]); s1 += q[32 + d] * bf2f(kp[32 + d]); }
                const float pw = __expf(s0 - m0) * il0 - __expf(s1 - m1) * il1; const bf16_t* vp = UD + (size_t)(start + j - nctx) * 1152 + 768 + h * 64;
#pragma unroll
                for (int d = 0; d < 64; ++d) o[d] += pw * bf2f(vp[d]); }
        }
        float ss = 0.f;
#pragma unroll
        for (int d = 0; d < 64; ++d) ss += o[d] * o[d];
        const float rs = rsqrtf(ss * (1.f / 64.f) + 1e-5f) * (1.f - lam_init);
#pragma unroll
        for (int d = 0; d < 64; ++d) MIX[(size_t)tok * 1024 + 384 + h * 64 + d] = f2bf(o[d] * rs * p.subln_g[(size_t)l * 64 + d]);
    }
}

__device__ void ph_fnet_naive(const P& p) {
    const bf16_t* ZF = (const bf16_t*)(p.ws + WS_ZF);
    const float2* tab = (const float2*)(p.ws + WS_TAB);
    bf16_t* MIX = (bf16_t*)(p.ws + WS_H);
    for (int idx = blockIdx.x * blockDim.x + threadIdx.x; idx < NTOK * 256; idx += gridDim.x * blockDim.x) {
        const int tok = idx >> 8, chn = idx & 255, g = chn >> 6, fc = chn & 63;
        int s, ft, T, start; tok_info(tok, s, ft, T, start);
        const int sh = (T == 256) ? 2 : 0;
        float acc = 0.f;
        for (int t = 0; t < T; ++t) {
            const float2 cs = tab[((ft * t) & (T - 1)) << sh];
            const bf16_t* z = ZF + (size_t)(start + t) * 512 + g * 128 + fc;
            acc += cs.x * bf2f(z[0]) + cs.y * bf2f(z[64]);
        }
        MIX[(size_t)tok * 1024 + 768 + chn] = f2bf(acc * rsqrtf((float)T));
    }
}

__global__ __launch_bounds__(512) void k_prep0(P p) { __shared__ float sm[64 * 65 + 128]; ph_prep0(p, sm); }
__global__ __launch_bounds__(512) void k_norm(P p, int l, int which) { ph_norm(p, l, which); }
__global__ __launch_bounds__(512) void k_g1(P p, int l) { __shared__ float sm[192 * 33]; EpiG1 e{l};
    ph_gemm_naive<false>(p, (const bf16_t*)(p.ws + WS_H), (const bf16_t*)(p.ws + WS_WIN) + (size_t)l * N1 * 1024, NTOK, N1, 1024, e, sm); }
__global__ __launch_bounds__(512) void k_prep(P p, int l) { __shared__ float sm[8 * 192]; ph_prep(p, l, sm); }
__global__ __launch_bounds__(512) void k_scan(P p, int l) { __shared__ float sm[2 * SC_TC * 6 * 64]; ph_scan(p, l, sm); }
__global__ __launch_bounds__(512) void k_attn(P p, int l) { ph_attn_naive(p, l); }
__global__ __launch_bounds__(512) void k_fnet(P p) { ph_fnet_naive(p); }
__global__ __launch_bounds__(512) void k_final(P p, int l) { ph_finalize(p, l); }
__global__ __launch_bounds__(512) void k_gout(P p, int l) { __shared__ float sm[192 * 33]; EpiRes e{l, 2};
    ph_gemm_naive<false>(p, (const bf16_t*)(p.ws + WS_H), (const bf16_t*)(p.ws + WS_WOUT) + (size_t)l * 1024 * 1024, NTOK, 1024, 1024, e, sm); }
__global__ __launch_bounds__(512) void k_ffn1(P p, int l) { __shared__ float sm[192 * 33]; EpiRes e{l, 5};
    ph_gemm_naive<true>(p, (const bf16_t*)(p.ws + WS_H), (const bf16_t*)(p.ws + WS_WF1) + (size_t)l * 5632 * 1024, NTOK, 5632, 1024, e, sm); }
__global__ __launch_bounds__(512) void k_ffn2(P p, int l) { __shared__ float sm[192 * 33]; EpiRes e{l, 5};
    ph_gemm_naive<false>(p, (const bf16_t*)(p.ws + WS_UR), (const bf16_t*)(p.ws + WS_WF2) + (size_t)l * 1024 * 2816, NTOK, 1024, 2816, e, sm); }

extern "C" void kernel_launch(void* const* d_in, const int* in_sizes, int n_in, void* d_out, int out_size, void* d_ws, size_t ws_size, hipStream_t stream) {
    if (n_in != 29 || ws_size < WS_END) return;
    P p{};
    const float** f = (const float**)&p;
    for (int i = 0; i < 29; ++i) f[i] = (const float*)d_in[i];
    p.out = (float*)d_out; p.ws = (unsigned char*)d_ws;
    const int G = 1024;
    k_prep0<<<G, 512, 0, stream>>>(p);
    for (int l = 0; l < 2; ++l) {
        k_norm<<<G, 512, 0, stream>>>(p, l, 0);
        k_g1<<<G, 512, 0, stream>>>(p, l);
        k_prep<<<G, 512, 0, stream>>>(p, l);
        k_scan<<<204, 512, 0, stream>>>(p, l);
        k_attn<<<G, 512, 0, stream>>>(p, l);
        k_fnet<<<G, 512, 0, stream>>>(p);
        k_final<<<G, 512, 0, stream>>>(p, l);
        k_gout<<<G, 512, 0, stream>>>(p, l);
        k_norm<<<G, 512, 0, stream>>>(p, l, 1);
        k_ffn1<<<G, 512, 0, stream>>>(p, l);
        k_ffn2<<<G, 512, 0, stream>>>(p, l);
    }
    k_norm<<<G, 512, 0, stream>>>(p, 0, 2);
}
```

```cpp
#include <hip/hip_runtime.h>
#include <stdint.h>
#include <stdio.h>
#ifndef ONE_LAUNCH
#define ONE_LAUNCH 1
#endif

typedef unsigned short bf16_t;

#define D_MODEL 1024
#define NTOK 10240
#define NPTOK 8192
#define TP 256
#define TS 1024
#define NSEQ 34
#define NH 6
#define N1 3072
#define C_DIFF 0
#define C_FNET 1152
#define C_RWKV 1664
#define C_END 3008
#define N_RWKV 1344
#define D_FF 2816
#define D_IN 2752

#define OUT_YP 0
#define OUT_YS 8388608
#define OUT_ST 10485760
#define OUT_CK 13631488
#define OUT_CV 19922944

#define OPS_REC 1792
#define OPS_TOK (6 * OPS_REC)

#define WS_WIN   ((size_t)0)
#define WS_WOUT  (WS_WIN + (size_t)2 * N1 * 1024 * 2)
#define WS_WF1   (WS_WOUT + (size_t)2 * 1024 * 1024 * 2)
#define WS_WF2   (WS_WF1 + (size_t)2 * 5632 * 1024 * 2)
#define WS_H     (WS_WF2 + (size_t)2 * 1024 * 2816 * 2)
#define WS_UD    (WS_H + (size_t)NTOK * 1024 * 2)
#define WS_ZF    (WS_UD + (size_t)NTOK * 1152 * 2)
#define WS_UR    (WS_ZF + (size_t)NTOK * 512 * 2)
#define WS_OPS   (WS_UR + (size_t)2 * NTOK * 384 * 4)
#define WS_MOD   (WS_OPS + (size_t)NTOK * OPS_TOK)
#define WS_TAB   (WS_MOD + (size_t)2 * 3 * 6144 * 4)
#define WS_CTL   (WS_TAB + (size_t)1024 * 8)
#define WS_ATT   (WS_CTL + (size_t)16384)
#define WS_END   (WS_ATT + (size_t)NTOK * 384 * 4)

struct P {
    const float *x_prompt, *x_sample, *c, *state_rwkv, *cache_k, *cache_v, *c_ctx, *norm1_g, *norm2_g, *final_g;
    const float *w_mod, *b_mod, *w_in, *w_out, *shift_mu, *decay_w0, *decay_up, *iclr_a0, *iclr_up, *gate_up;
    const float *k_k, *k_a, *r_k, *lnx_g, *lnx_b, *diff_lambda, *subln_g, *w_ffn_in, *w_ffn_out;
    float* out;
    unsigned char* ws;
};

__device__ __forceinline__ bf16_t f2bf(float f) { unsigned u = __builtin_bit_cast(unsigned, f); return (bf16_t)((u + 0x7fffu + ((u >> 16) & 1u)) >> 16); }
__device__ __forceinline__ float bf2f(bf16_t b) { return __builtin_bit_cast(float, ((unsigned)b) << 16); }
__device__ __forceinline__ float sigmoidf_(float x) { return 1.f / (1.f + __expf(-x)); }
__device__ __forceinline__ float wave_sum(float v) {
#pragma unroll
    for (int o = 1; o < 64; o <<= 1) v += __shfl_xor(v, o);
    return v;
}
__device__ __forceinline__ int otid() { int t = threadIdx.x; asm volatile("" : "+v"(t)); return t; }
__device__ __forceinline__ int tok_cls(int tok) { return tok < NPTOK ? 0 : 1 + ((tok - NPTOK) >> 10); }
__device__ __forceinline__ const float* xin_row(const P& p, int tok) { return tok < NPTOK ? p.x_prompt + (size_t)tok * 1024 : p.x_sample + (size_t)(tok - NPTOK) * 1024; }
__device__ __forceinline__ float* X_row(const P& p, int tok) { return p.out + (size_t)tok * 1024; }
__device__ __forceinline__ const float* mod_vec(const P& p, int l, int cls, int which) { return (const float*)(p.ws + WS_MOD) + ((size_t)(l * 3 + cls) * 6144 + which * 1024); }
__device__ __forceinline__ void seq_info(int s, int& start, int& T) { if (s < 32) { start = s * TP; T = TP; } else { start = NPTOK + (s - 32) * TS; T = TS; } }
__device__ __forceinline__ void tok_info(int tok, int& s, int& t, int& T, int& start) {
    if (tok < NPTOK) { s = tok >> 8; t = tok & 255; T = TP; start = s * TP; } else { int r = tok - NPTOK; s = 32 + (r >> 10); t = r & 1023; T = TS; start = NPTOK + ((r >> 10) << 10); }
}

#define P0_MOD 192
#define P0_TILES_L 3136
__device__ void ph_prep0(const P& p, float* sm) {
    const int tid = otid();
    const int nitems = P0_MOD + 2 * P0_TILES_L + 1;
    for (int item = blockIdx.x; item < nitems; item += gridDim.x) {
        __syncthreads();
        if (item < P0_MOD) {
            const int l = item / 96, cg = item % 96, col = cg * 64 + (tid & 63), ks = tid >> 6;
            const float* W = p.w_mod + (size_t)l * 1024 * 6144;
            float a0 = 0.f, a1 = 0.f, a2 = 0.f;
            for (int k = ks * 128; k < ks * 128 + 128; ++k) {
                const float w = W[(size_t)k * 6144 + col];
                float c0 = p.c_ctx[k], c1 = p.c[k], c2 = p.c[1024 + k];
                c0 = c0 * sigmoidf_(c0); c1 = c1 * sigmoidf_(c1); c2 = c2 * sigmoidf_(c2);
                a0 += c0 * w; a1 += c1 * w; a2 += c2 * w;
            }
            sm[(ks * 3 + 0) * 64 + (tid & 63)] = a0; sm[(ks * 3 + 1) * 64 + (tid & 63)] = a1; sm[(ks * 3 + 2) * 64 + (tid & 63)] = a2;
            __syncthreads();
            if (tid < 192) {
                const int cls = tid >> 6, cc = tid & 63; float s = 0.f;
                for (int k = 0; k < 8; ++k) s += sm[(k * 3 + cls) * 64 + cc];
                const int colo = cg * 64 + cc;
                ((float*)(p.ws + WS_MOD))[(size_t)(l * 3 + cls) * 6144 + colo] = s + p.b_mod[(size_t)l * 6144 + colo];
            }
        } else if (item < P0_MOD + 2 * P0_TILES_L) {
            int it = item - P0_MOD; const int l = it / P0_TILES_L; it %= P0_TILES_L;
            const float* src; int srcN, K, ntile, ktile, mode = 0, scol = 0; bf16_t* dst; int n0;
            if (it < 768) { ntile = it / 16; ktile = it % 16; K = 1024; srcN = D_IN; src = p.w_in + (size_t)l * 1024 * D_IN; dst = (bf16_t*)(p.ws + WS_WIN) + (size_t)l * N1 * 1024;
                n0 = ntile * 64;
                if (n0 < C_FNET) { scol = 1344 + n0; } else if (n0 < C_RWKV) { mode = 1 + ((n0 - C_FNET) / 64) % 2; scol = 2496 + ((n0 - C_FNET) / 128) * 64; } else if (n0 < C_END) { scol = n0 - C_RWKV; } else mode = 3; }
            else if (it < 1024) { it -= 768; ntile = it / 16; ktile = it % 16; K = 1024; srcN = 1024; src = p.w_out + (size_t)l * 1024 * 1024; dst = (bf16_t*)(p.ws + WS_WOUT) + (size_t)l * 1024 * 1024; n0 = ntile * 64; scol = n0; }
            else if (it < 2432) { it -= 1024; ntile = it / 16; ktile = it % 16; K = 1024; srcN = 5632; src = p.w_ffn_in + (size_t)l * 1024 * 5632; dst = (bf16_t*)(p.ws + WS_WF1) + (size_t)l * 5632 * 1024; n0 = ntile * 64;
                const int pn = ntile >> 2, sub = ntile & 3; scol = (sub < 2) ? (128 * pn + 64 * sub) : (2816 + 128 * pn + 64 * (sub - 2)); }
            else { it -= 2432; ntile = it / 44; ktile = it % 44; K = 2816; srcN = 1024; src = p.w_ffn_out + (size_t)l * 2816 * 1024; dst = (bf16_t*)(p.ws + WS_WF2) + (size_t)l * 1024 * 2816; n0 = ntile * 64; scol = n0; }
            const int k0 = ktile * 64;
            float* tile = sm;
            float* cs = sm + 64 * 65;
            if (mode != 3) {
#pragma unroll
                for (int i = 0; i < 8; ++i) { const int k = i * 8 + (tid >> 6), n = tid & 63; tile[k * 65 + n] = src[(size_t)(k0 + k) * srcN + scol + n]; }
            }
            if (tid < 64) { cs[tid] = cospif((float)tid / 32.f); cs[64 + tid] = sinpif((float)tid / 32.f); }
            __syncthreads();
            const int n = tid >> 3, k8 = (tid & 7) * 8;
            float v[8];
            if (mode == 0) {
#pragma unroll
                for (int j = 0; j < 8; ++j) v[j] = tile[(k8 + j) * 65 + n];
            } else if (mode == 3) {
#pragma unroll
                for (int j = 0; j < 8; ++j) v[j] = 0.f;
            } else {
#pragma unroll
                for (int j = 0; j < 8; ++j) v[j] = 0.f;
                for (int cc = 0; cc < 64; ++cc) {
                    const int idx = (n * cc) & 63;
                    const float tr = (mode == 1) ? cs[idx] * 0.125f : -cs[64 + idx] * 0.125f;
#pragma unroll
                    for (int j = 0; j < 8; ++j) v[j] += tile[(k8 + j) * 65 + cc] * tr;
                }
            }
            uint4 o;
            o.x = (unsigned)f2bf(v[0]) | ((unsigned)f2bf(v[1]) << 16); o.y = (unsigned)f2bf(v[2]) | ((unsigned)f2bf(v[3]) << 16);
            o.z = (unsigned)f2bf(v[4]) | ((unsigned)f2bf(v[5]) << 16); o.w = (unsigned)f2bf(v[6]) | ((unsigned)f2bf(v[7]) << 16);
            *(uint4*)(dst + (size_t)(n0 + n) * K + k0 + k8) = o;
        } else {
            float2* tab = (float2*)(p.ws + WS_TAB);
            for (int k = tid; k < 1024; k += blockDim.x) tab[k] = make_float2(cospif((float)k / 512.f), sinpif((float)k / 512.f));
        }
    }
}

__device__ void ph_norm(const P& p, int l, int which) {
    const int tid_ = otid(); const int lane = tid_ & 63, wv = tid_ >> 6, nw = blockDim.x >> 6;
    for (int row = blockIdx.x * nw + wv; row < NTOK; row += gridDim.x * nw) {
        const float* xr = (which == 0 && l == 0) ? xin_row(p, row) : X_row(p, row);
        float4 x[4]; float ss = 0.f;
#pragma unroll
        for (int i = 0; i < 4; ++i) { x[i] = *(const float4*)(xr + i * 256 + lane * 4); ss += x[i].x * x[i].x + x[i].y * x[i].y + x[i].z * x[i].z + x[i].w * x[i].w; }
        ss = wave_sum(ss);
        const float rstd = rsqrtf(ss * (1.f / 1024.f) + 1e-6f);
        if (which == 2) {
            float* o = p.out + (size_t)row * 1024;
#pragma unroll
            for (int i = 0; i < 4; ++i) { const float4 g = *(const float4*)(p.final_g + i * 256 + lane * 4);
                float4 y; y.x = x[i].x * rstd * g.x; y.y = x[i].y * rstd * g.y; y.z = x[i].z * rstd * g.z; y.w = x[i].w * rstd * g.w;
                *(float4*)(o + i * 256 + lane * 4) = y; }
        } else {
            const int cls = tok_cls(row);
            const float* g = (which == 0 ? p.norm1_g : p.norm2_g) + (size_t)l * 1024;
            const float* sh = mod_vec(p, l, cls, which == 0 ? 0 : 3);
            const float* sc = mod_vec(p, l, cls, which == 0 ? 1 : 4);
            bf16_t* h = (bf16_t*)(p.ws + WS_H) + (size_t)row * 1024;
#pragma unroll
            for (int i = 0; i < 4; ++i) { const int c = i * 256 + lane * 4;
                const float4 gg = *(const float4*)(g + c), s1 = *(const float4*)(sc + c), s0 = *(const float4*)(sh + c);
                const float y0 = x[i].x * rstd * gg.x * (1.f + s1.x) + s0.x, y1 = x[i].y * rstd * gg.y * (1.f + s1.y) + s0.y;
                const float y2 = x[i].z * rstd * gg.z * (1.f + s1.z) + s0.z, y3 = x[i].w * rstd * gg.w * (1.f + s1.w) + s0.w;
                uint2 o; o.x = (unsigned)f2bf(y0) | ((unsigned)f2bf(y1) << 16); o.y = (unsigned)f2bf(y2) | ((unsigned)f2bf(y3) << 16);
                *(uint2*)(h + c) = o; }
        }
    }
}

struct EpiG1 {
    int l;
    __device__ __forceinline__ void operator()(const P& p, int row, int col, const float* v) const {
        if (col < C_FNET) {
            bf16_t* o = (bf16_t*)(p.ws + WS_UD) + (size_t)row * 1152 + col;
            uint2 w; w.x = (unsigned)f2bf(v[0]) | ((unsigned)f2bf(v[1]) << 16); w.y = (unsigned)f2bf(v[2]) | ((unsigned)f2bf(v[3]) << 16);
            *(uint2*)o = w;
            if (row < NPTOK && col >= 384) {
                const int b = row >> 8, t = row & 255;
                float* dst = p.out + (col < 768 ? OUT_CK : OUT_CV) + ((size_t)(b * 2 + l) * 256 + t) * 384 + (col < 768 ? col - 384 : col - 768);
                *(float4*)dst = make_float4(v[0], v[1], v[2], v[3]);
            }
        } else if (col < C_RWKV) {
            bf16_t* o = (bf16_t*)(p.ws + WS_ZF) + (size_t)row * 512 + (col - C_FNET);
            uint2 w; w.x = (unsigned)f2bf(v[0]) | ((unsigned)f2bf(v[1]) << 16); w.y = (unsigned)f2bf(v[2]) | ((unsigned)f2bf(v[3]) << 16);
            *(uint2*)o = w;
        } else if (col < C_END) {
            bf16_t* o = (bf16_t*)(p.ws + WS_UR) + (size_t)row * N_RWKV + (col - C_RWKV);
            uint2 w; w.x = (unsigned)f2bf(v[0]) | ((unsigned)f2bf(v[1]) << 16); w.y = (unsigned)f2bf(v[2]) | ((unsigned)f2bf(v[3]) << 16);
            *(uint2*)o = w;
        }
    }
};
struct EpiRes {
    int l, which;
    __device__ __forceinline__ void operator()(const P& p, int row, int col, const float* v) const {
        const float* g = mod_vec(p, l, tok_cls(row), which) + col;
        const float* xo = (which == 2 && l == 0) ? xin_row(p, row) + col : X_row(p, row) + col;
        const float4 x = *(const float4*)xo; const float4 gg = *(const float4*)g;
        *(float4*)(X_row(p, row) + col) = make_float4(x.x + gg.x * v[0], x.y + gg.y * v[1], x.z + gg.z * v[2], x.w + gg.w * v[3]);
    }
};

__device__ void ph_prep(const P& p, int l, float* sm) {
    const int tid = otid(), lane = tid & 63, wv = tid >> 6;
    const bf16_t* UR = (const bf16_t*)(p.ws + WS_UR);
    float* lin = sm;
    const float* mu0 = p.shift_mu + (size_t)l * 2 * N_RWKV; const float* mu1 = mu0 + N_RWKV;
    for (int tile = blockIdx.x; tile < NTOK / 8; tile += gridDim.x) {
        __syncthreads();
        for (int e = tid; e < 8 * 192; e += blockDim.x) {
            const int tk = e / 192, j = e % 192, tok = tile * 8 + tk, col = 1152 + j;
            int s, t, T, st; tok_info(tok, s, t, T, st);
            const float xc = bf2f(UR[(size_t)tok * N_RWKV + col]);
            const float xp = t > 0 ? bf2f(UR[(size_t)(tok - 1) * N_RWKV + col]) : 0.f;
            const float xn = t < T - 1 ? bf2f(UR[(size_t)(tok + 1) * N_RWKV + col]) : 0.f;
            float x = xc + mu0[col] * (xp - xc) + mu1[col] * (xn - xc);
            if (j < 64) x = tanhf(x); else if (j >= 128) x = sigmoidf_(x);
            lin[tk * 192 + j] = x;
        }
        __syncthreads();
        if (tid < 384) {
            const int ch = tid, h = wv;
#pragma unroll 1
            for (int tk = 0; tk < 8; ++tk) {
                const int tok = tile * 8 + tk; int s, t, T, st; tok_info(tok, s, t, T, st);
                float rkv[3];
#pragma unroll
                for (int q = 0; q < 3; ++q) { const int col = q * 384 + ch;
                    const float xc = bf2f(UR[(size_t)tok * N_RWKV + col]);
                    const float xp = t > 0 ? bf2f(UR[(size_t)(tok - 1) * N_RWKV + col]) : 0.f;
                    const float xn = t < T - 1 ? bf2f(UR[(size_t)(tok + 1) * N_RWKV + col]) : 0.f;
                    rkv[q] = xc + mu0[col] * (xp - xc) + mu1[col] * (xn - xc); }
                float w[2], a[2];
#pragma unroll
                for (int d = 0; d < 2; ++d) {
                    float sw = p.decay_w0[(size_t)(l * 2 + d) * 384 + ch], sa = p.iclr_a0[(size_t)(l * 2 + d) * 384 + ch];
                    const float* du = p.decay_up + (size_t)((l * 2 + d) * 32) * 384 + ch; const float* iu = p.iclr_up + (size_t)((l * 2 + d) * 32) * 384 + ch;
#pragma unroll 4
                    for (int j = 0; j < 32; ++j) { sw += lin[tk * 192 + d * 32 + j] * du[(size_t)j * 384]; sa += lin[tk * 192 + 64 + d * 32 + j] * iu[(size_t)j * 384]; }
                    w[d] = __expf(-0.60653065971263342f * sigmoidf_(sw)); a[d] = sigmoidf_(sa);
                }
                float g = 0.f; { const float* gu = p.gate_up + (size_t)l * 64 * 384 + ch;
#pragma unroll 4
                    for (int j = 0; j < 64; ++j) g += lin[tk * 192 + 128 + j] * gu[(size_t)j * 384]; }
                const float kkr = rkv[1] * p.k_k[(size_t)l * 384 + ch];
                const float nrm = sqrtf(wave_sum(kkr * kkr));
                const float kk = kkr / fmaxf(nrm, 1e-12f);
                unsigned char* rec = p.ws + WS_OPS + (size_t)tok * OPS_TOK + (size_t)h * OPS_REC;
                float* rf = (float*)rec; bf16_t* rb = (bf16_t*)(rec + 1280);
                rf[lane] = -kk; rf[64 + lane] = w[0]; rf[128 + lane] = w[1]; rf[192 + lane] = a[0]; rf[256 + lane] = a[1];
                rb[lane] = f2bf(rkv[0]); rb[64 + lane] = f2bf(rkv[2]); rb[128 + lane] = f2bf(rkv[1]); rb[192 + lane] = f2bf(g);
            }
        }
    }
    bf16_t* UD = (bf16_t*)(p.ws + WS_UD);
    for (int e = blockIdx.x * blockDim.x + tid; e < 2048 * 384; e += gridDim.x * blockDim.x) {
        const int tk = e / 384, pi = e % 384;
        const int grp = pi >> 3, pr = pi & 7, col = grp * 16 + pr;
        const int axis = grp & 1;
        const int t = tk & 1023, pos = axis == 0 ? (t >> 6) : (t & 63);
        const float inv = __powf(10000.f, -(float)pr / 8.f);
        float sn, cs; __sincosf((float)pos * inv, &sn, &cs);
        bf16_t* ptr = UD + (size_t)(NPTOK + tk) * 1152 + col;
        const float x1 = bf2f(ptr[0]), x2 = bf2f(ptr[8]);
        ptr[0] = f2bf(x1 * cs - x2 * sn); ptr[8] = f2bf(x2 * cs + x1 * sn);
    }
}

#define SC_TC 16
__device__ void ph_scan(const P& p, int l, float* sm) {
    const int tid = otid(), dir = tid >> 8, ht = tid & 255, v = ht >> 2, q = ht & 3;
    float* ops = sm + dir * (SC_TC * 6 * 64);
    float* Yb = (float*)(p.ws + WS_UR);
    for (int job = blockIdx.x; job < NSEQ * NH; job += gridDim.x) {
        const int s = job / NH, h = job % NH; int start, T; seq_info(s, start, T);
        float S[16];
        if (s < 32) {
#pragma unroll
            for (int e = 0; e < 16; ++e) S[e] = 0.f;
        } else {
            const float* s0 = p.state_rwkv + ((((size_t)(s - 32) * 2 + l) * 2 + dir) * NH + h) * 4096 + v * 64 + q * 16;
#pragma unroll
            for (int e = 0; e < 16; ++e) S[e] = s0[e];
        }
        for (int c = 0; c < T / SC_TC; ++c) {
            __syncthreads();
#pragma unroll
            for (int rpt = 0; rpt < 4; ++rpt) {
                const int e = rpt * 256 + ht, i = e >> 6, ch = e & 63;
                const int st = c * SC_TC + i, t = dir == 0 ? st : T - 1 - st, tok = start + t;
                const unsigned char* rec = p.ws + WS_OPS + (size_t)tok * OPS_TOK + (size_t)h * OPS_REC;
                const float* rf = (const float*)rec; const bf16_t* rb = (const bf16_t*)(rec + 1280);
                const float nkk = rf[ch], w = rf[64 + dir * 64 + ch], a = rf[192 + dir * 64 + ch];
                const float r = bf2f(rb[ch]), vv = bf2f(rb[64 + ch]), k = bf2f(rb[128 + ch]);
                const float kd = k * (1.f + (a - 1.f) * p.k_a[(size_t)l * 384 + h * 64 + ch]);
                float* o = ops + i * 384;
                o[ch] = r; o[64 + ch] = nkk; o[128 + ch] = vv; o[192 + ch] = w; o[256 + ch] = kd; o[320 + ch] = -nkk * a;
            }
            __syncthreads();
            for (int i = 0; i < SC_TC; ++i) {
                const float* o = ops + i * 384;
                float sa = 0.f;
#pragma unroll
                for (int e = 0; e < 16; ++e) sa += S[e] * o[64 + q * 16 + e];
                sa += __shfl_xor(sa, 1); sa += __shfl_xor(sa, 2);
                const float vv = o[128 + v];
                float y = 0.f;
#pragma unroll
                for (int e = 0; e < 16; ++e) { const int k = q * 16 + e; S[e] = S[e] * o[192 + k] + sa * o[320 + k] + vv * o[256 + k]; y += S[e] * o[k]; }
                y += __shfl_xor(y, 1); y += __shfl_xor(y, 2);
                if (q == 0) { const int st = c * SC_TC + i, t = dir == 0 ? st : T - 1 - st; Yb[((size_t)dir * NTOK + start + t) * 384 + h * 64 + v] = y; }
            }
        }
        if (s < 32) {
            float* so = p.out + OUT_ST + ((((size_t)s * 2 + l) * 2 + dir) * NH + h) * 4096 + v * 64 + q * 16;
#pragma unroll
            for (int e = 0; e < 16; ++e) so[e] = S[e];
        }
    }
}

__device__ void ph_finalize(const P& p, int l) {
    const int tid_ = otid(); const int lane = tid_ & 63, wv = tid_ >> 6, nw = blockDim.x >> 6;
    const float* Yb = (const float*)(p.ws + WS_UR);
    bf16_t* MIX = (bf16_t*)(p.ws + WS_H);
    for (int it = blockIdx.x * nw + wv; it < NTOK * NH; it += gridDim.x * nw) {
        const int tok = it / NH, h = it % NH, ch = h * 64 + lane;
        const float y = Yb[(size_t)tok * 384 + ch] + Yb[((size_t)NTOK + tok) * 384 + ch];
        const float mu = wave_sum(y) * (1.f / 64.f);
        const float dlt = y - mu;
        const float var = wave_sum(dlt * dlt) * (1.f / 64.f);
        const float yn = dlt * rsqrtf(var + 64e-5f) * p.lnx_g[(size_t)l * 384 + ch] + p.lnx_b[(size_t)l * 384 + ch];
        const unsigned char* rec = p.ws + WS_OPS + (size_t)tok * OPS_TOK + (size_t)h * OPS_REC;
        const float* rf = (const float*)rec; const bf16_t* rb = (const bf16_t*)(rec + 1280);
        const float a0 = rf[192 + lane], a1 = rf[256 + lane];
        const float r = bf2f(rb[lane]), vv = bf2f(rb[64 + lane]), k = bf2f(rb[128 + lane]), g = bf2f(rb[192 + lane]);
        const float ka = p.k_a[(size_t)l * 384 + ch];
        const float kf = k * (1.f + (a0 - 1.f) * ka), kb = k * (1.f + (a1 - 1.f) * ka);
        const float bs = wave_sum(r * (kf + kb) * p.r_k[(size_t)l * 384 + ch]);
        MIX[(size_t)tok * 1024 + ch] = f2bf((yn + bs * vv) * g);
    }
}

#define AT_TMP(tok, h, d) (((float*)(p.ws + WS_ATT))[(size_t)(tok) * 384 + (h) * 64 + (d)])
__device__ void ph_attn_naive(const P& p, int l) {
    const bf16_t* UD = (const bf16_t*)(p.ws + WS_UD);
    bf16_t* MIX = (bf16_t*)(p.ws + WS_H);
    const float lam_init = 0.8f - 0.6f * __expf(-0.3f * (float)l);
    float lam;
    {
        const float* lp = p.diff_lambda + (size_t)l * 128; float s01 = 0.f, s23 = 0.f;
        for (int d = 0; d < 32; ++d) { s01 += lp[d] * lp[32 + d]; s23 += lp[64 + d] * lp[96 + d]; }
        lam = __expf(s01) - __expf(s23) + lam_init;
    }
    const float scale = 0.17677669529663687f;
    for (int idx = blockIdx.x * blockDim.x + otid(); idx < NTOK * NH; idx += gridDim.x * blockDim.x) {
        int s, h, t, T, start;
        if (idx < NPTOK * NH) { const int sh = idx >> 8; t = idx & 255; s = sh / NH; h = sh % NH; T = TP; start = s * TP; }
        else { const int r = idx - NPTOK * NH; const int sh = r >> 10; t = r & 1023; s = 32 + sh / NH; h = sh % NH; T = TS; start = NPTOK + (s - 32) * TS; }
        const int tok = start + t;
        float q[64];
#pragma unroll
        for (int d = 0; d < 64; ++d) q[d] = bf2f(UD[(size_t)tok * 1152 + h * 64 + d]) * scale;
        const int nctx = (s >= 32) ? 512 : 0;
        const float* ck = (s >= 32) ? p.cache_k + (((size_t)(s - 32) * 2 + l) * 512) * 384 + h * 64 : nullptr;
        const float* cv = (s >= 32) ? p.cache_v + (((size_t)(s - 32) * 2 + l) * 512) * 384 + h * 64 : nullptr;
        float m0 = -1e30f, m1 = -1e30f;
        for (int j = 0; j < nctx + T; ++j) {
            float s0 = 0.f, s1 = 0.f;
            if (j < nctx) { const float* kp = ck + (size_t)j * 384;
#pragma unroll
                for (int d = 0; d < 32; ++d) { s0 += q[d] * kp[d]; s1 += q[32 + d] * kp[32 + d]; } }
            else { const bf16_t* kp = UD + (size_t)(start + j - nctx) * 1152 + 384 + h * 64;
#pragma unroll
                for (int d = 0; d < 32; ++d) { s0 += q[d] * bf2f(kp[d]); s1 += q[32 + d] * bf2f(kp[32 + d]); } }
            m0 = fmaxf(m0, s0); m1 = fmaxf(m1, s1);
        }
        float l0 = 0.f, l1 = 0.f;
        for (int j = 0; j < nctx + T; ++j) {
            float s0 = 0.f, s1 = 0.f;
            if (j < nctx) { const float* kp = ck + (size_t)j * 384;
#pragma unroll
                for (int d = 0; d < 32; ++d) { s0 += q[d] * kp[d]; s1 += q[32 + d] * kp[32 + d]; } }
            else { const bf16_t* kp = UD + (size_t)(start + j - nctx) * 1152 + 384 + h * 64;
#pragma unroll
                for (int d = 0; d < 32; ++d) { s0 += q[d] * bf2f(kp[d]); s1 += q[32 + d] * bf2f(kp[32 + d]); } }
            l0 += __expf(s0 - m0); l1 += __expf(s1 - m1);
        }
        const float il0 = 1.f / l0, il1 = lam / l1;
        float ss = 0.f;
#pragma unroll 1
        for (int hf = 0; hf < 2; ++hf) {
            float o[32];
#pragma unroll
            for (int d = 0; d < 32; ++d) o[d] = 0.f;
            for (int j = 0; j < nctx + T; ++j) {
                float s0 = 0.f, s1 = 0.f;
                if (j < nctx) { const float* kp = ck + (size_t)j * 384;
#pragma unroll
                    for (int d = 0; d < 32; ++d) { s0 += q[d] * kp[d]; s1 += q[32 + d] * kp[32 + d]; }
                    const float pw = __expf(s0 - m0) * il0 - __expf(s1 - m1) * il1; const float* vp = cv + (size_t)j * 384 + hf * 32;
#pragma unroll
                    for (int d = 0; d < 32; ++d) o[d] += pw * vp[d]; }
                else { const bf16_t* kp = UD + (size_t)(start + j - nctx) * 1152 + 384 + h * 64;
#pragma unroll
                    for (int d = 0; d < 32; ++d) { s0 += q[d] * bf2f(kp[d]); s1 += q[32 + d] * bf2f(kp[32 + d]); }
                    const float pw = __expf(s0 - m0) * il0 - __expf(s1 - m1) * il1; const bf16_t* vp = UD + (size_t)(start + j - nctx) * 1152 + 768 + h * 64 + hf * 32;
#pragma unroll
                    for (int d = 0; d < 32; ++d) o[d] += pw * bf2f(vp[d]); }
            }
#pragma unroll
            for (int d = 0; d < 32; ++d) { ss += o[d] * o[d]; AT_TMP(tok, h, hf * 32 + d) = o[d]; }
        }
        const float rs = rsqrtf(ss * (1.f / 64.f) + 1e-5f) * (1.f - lam_init);
#pragma unroll 8
        for (int d = 0; d < 64; ++d) MIX[(size_t)tok * 1024 + 384 + h * 64 + d] = f2bf(AT_TMP(tok, h, d) * rs * p.subln_g[(size_t)l * 64 + d]);
    }
}
#undef AT_TMP

__device__ void ph_fnet_naive(const P& p) {
    const bf16_t* ZF = (const bf16_t*)(p.ws + WS_ZF);
    const float2* tab = (const float2*)(p.ws + WS_TAB);
    bf16_t* MIX = (bf16_t*)(p.ws + WS_H);
    for (int idx = blockIdx.x * blockDim.x + otid(); idx < NTOK * 256; idx += gridDim.x * blockDim.x) {
        const int tok = idx >> 8, chn = idx & 255, g = chn >> 6, fc = chn & 63;
        int s, ft, T, start; tok_info(tok, s, ft, T, start);
        const int sh = (T == 256) ? 2 : 0;
        float acc = 0.f;
        for (int t = 0; t < T; ++t) {
            const float2 cs = tab[((ft * t) & (T - 1)) << sh];
            const bf16_t* z = ZF + (size_t)(start + t) * 512 + g * 128 + fc;
            acc += cs.x * bf2f(z[0]) + cs.y * bf2f(z[64]);
        }
        MIX[(size_t)tok * 1024 + 768 + chn] = f2bf(acc * rsqrtf((float)T));
    }
}


#define LAS __attribute__((address_space(3)))
namespace pg8 {
typedef short bf16x8 __attribute__((ext_vector_type(8)));
typedef float f32x4 __attribute__((ext_vector_type(4)));
constexpr int BM = 256, BK = 64, HALF = 128, HTB = HALF * BK * 2, STAGE_BYTES = 8 * HTB, NXCD = 8, WGM = 8;
__host__ __device__ __forceinline__ int lds_byte(int r, int c) { const int st = (r >> 4) * 2 + (c >> 5), rr = r & 15, cc = c & 31, ob = rr * 64 + cc * 2; return st * 1024 + (ob ^ (((ob >> 9) & 1) << 5)); }
__host__ __device__ __forceinline__ void stage_rc(int b, int& R, int& C) { const int st = b / 1024, sb = b % 1024, swz = sb ^ (((sb >> 9) & 1) << 5); R = (st >> 1) * 16 + swz / 64; C = (st & 1) * 32 + (swz % 64) / 2; }
struct Unit { int pm, pn; };
struct Gemm { const bf16_t* A; const bf16_t* Bt; int M, N, K; };
struct StaticOrder {
    int nM, nN, nwg, G, c;
    __device__ void init(int M, int N, int G_, int c_) { nM = M / BM; nN = N / BM; nwg = nM * nN; G = G_; c = c_; }
    __device__ bool next(int i, Unit& u) const {
        const long L = (long)i * G + c; if (L >= nwg) return false;
        int wgid = (int)L; { const int q = nwg / NXCD, r = nwg % NXCD, xcd = wgid % NXCD, off = wgid / NXCD; wgid = (xcd < r ? xcd * (q + 1) : r * (q + 1) + (xcd - r) * q) + off; }
        const int nig = WGM * nN, gid = wgid / nig, fm = gid * WGM, gsz = (nM - fm) < WGM ? (nM - fm) : WGM;
        u.pm = fm + ((wgid % nig) % gsz); u.pn = (wgid % nig) / gsz; return true;
    }
};
template <class Epi>
__device__ __forceinline__ void gemm_phase(LAS unsigned char* lds, const Gemm g, const StaticOrder& S, const Epi& E) {
    int tid_ = threadIdx.x; asm volatile("" : "+v"(tid_));
    const int tid = tid_, wid = __builtin_amdgcn_readfirstlane(tid >> 6), lane = tid & 63, wr = wid >> 2, wc = wid & 3, fr = lane & 15, fq = lane >> 4;
    const int K = g.K, nt = K / BK;
    unsigned voffA[2], voffB[2];
#pragma unroll
    for (int i = 0; i < 2; ++i) { int R, C; stage_rc(tid * 16 + i * 8192, R, C); voffA[i] = (unsigned)(R * K + C) * 2u; voffB[i] = (unsigned)(R * K + C) * 2u; }
    const size_t kstep = (size_t)(BK * 2);
    const size_t hstep = (size_t)HALF * K * 2;
    const size_t tstep = 2 * hstep;
    const unsigned ldsw = (unsigned)wid * 1024u;
    const int aoff = lds_byte(wr * 64 + fr, fq * 8), boff = lds_byte(wc * 32 + fr, fq * 8);
#define PG8_SA(b, h) (((b) * 2 + (h)) * HTB)
#define PG8_SB(b, h) ((4 + (b) * 2 + (h)) * HTB)
#define PG8_STAGE(bufoff, gbase, voff) do { _Pragma("unroll") for (int _i = 0; _i < 2; ++_i) \
        __builtin_amdgcn_global_load_lds((const unsigned*)((const char*)(gbase) + (voff)[_i]), (LAS unsigned*)(lds + (bufoff) + ldsw + _i * 8192), 16, 0, 0); } while (0)
#define PG8_LDA(dst, b, h) do { _Pragma("unroll") for (int m = 0; m < 4; ++m) _Pragma("unroll") for (int k = 0; k < 2; ++k) dst[m][k] = *(const LAS bf16x8*)(lds + PG8_SA(b, h) + aoff + m * 2048 + k * 1024); } while (0)
#define PG8_LDB(dst, b, h) do { _Pragma("unroll") for (int n = 0; n < 2; ++n) _Pragma("unroll") for (int k = 0; k < 2; ++k) dst[n][k] = *(const LAS bf16x8*)(lds + PG8_SB(b, h) + boff + n * 2048 + k * 1024); } while (0)
#define PG8_MMA(ai, bj, At, Bt) do { __builtin_amdgcn_s_setprio(1); _Pragma("unroll") for (int m = 0; m < 4; ++m) _Pragma("unroll") for (int n = 0; n < 2; ++n) _Pragma("unroll") for (int k = 0; k < 2; ++k) \
        acc[ai][bj][m][n] = __builtin_amdgcn_mfma_f32_16x16x32_bf16(Bt[n][k], At[m][k], acc[ai][bj][m][n], 0, 0, 0); __builtin_amdgcn_s_setprio(0); } while (0)
#define PG8_WAIT_V(n) asm volatile("s_waitcnt vmcnt(" #n ")" ::: "memory")
#define PG8_WAIT_L(n) asm volatile("s_waitcnt lgkmcnt(" #n ")" ::: "memory")
#define PG8_BAR __builtin_amdgcn_s_barrier()
#define PG8_SCHED __builtin_amdgcn_sched_barrier(0)
    Unit cur, nxt; int ui = 0;
    if (!S.next(0, cur)) return;
    f32x4 acc[2][2][4][2];
#pragma unroll
    for (int a = 0; a < 2; ++a)
#pragma unroll
        for (int b = 0; b < 2; ++b)
#pragma unroll
            for (int m = 0; m < 4; ++m)
#pragma unroll
                for (int n = 0; n < 2; ++n) acc[a][b][m][n] = (f32x4){0.f, 0.f, 0.f, 0.f};
    bf16x8 At[4][2], B0[2][2], B1[2][2];
    const char* cA = (const char*)g.A + (size_t)cur.pm * tstep; const char* cB = (const char*)g.Bt + (size_t)cur.pn * tstep;
    PG8_STAGE(PG8_SB(0, 0), cB, voffB); PG8_STAGE(PG8_SA(0, 0), cA, voffA); PG8_STAGE(PG8_SB(0, 1), cB + hstep, voffB); PG8_STAGE(PG8_SA(0, 1), cA + hstep, voffA);
    if (wr == 1) PG8_BAR;
    PG8_WAIT_V(4); PG8_BAR;
    PG8_STAGE(PG8_SB(1, 0), cB + kstep, voffB); PG8_STAGE(PG8_SA(1, 0), cA + kstep, voffA); PG8_STAGE(PG8_SB(1, 1), cB + hstep + kstep, voffB);
    PG8_WAIT_V(6); PG8_BAR;
    for (;;) {
        const bool has_next = S.next(ui + 1, nxt);
        const char* nA = has_next ? (const char*)g.A + (size_t)nxt.pm * tstep : cA; const char* nB = has_next ? (const char*)g.Bt + (size_t)nxt.pn * tstep : cB;
        for (int t = 0; t < nt; t += 2) {
            const bool last = (t == nt - 2);
            const char* a1 = cA + (size_t)(t + 1) * kstep;
            const char* a2 = last ? nA : cA + (size_t)(t + 2) * kstep; const char* b2 = last ? nB : cB + (size_t)(t + 2) * kstep;
            const char* a3 = a2 + kstep; const char* b3 = b2 + kstep;
            PG8_LDB(B0, 0, 0); PG8_SCHED; PG8_LDA(At, 0, 0); PG8_STAGE(PG8_SA(1, 1), a1 + hstep, voffA);
            PG8_WAIT_L(8); PG8_BAR; PG8_WAIT_L(0); PG8_MMA(0, 0, At, B0); PG8_BAR; PG8_SCHED;
            PG8_LDB(B1, 0, 1); PG8_STAGE(PG8_SB(0, 0), b2, voffB);
            PG8_BAR; PG8_WAIT_L(0); PG8_MMA(0, 1, At, B1); PG8_BAR;
            PG8_LDA(At, 0, 1); PG8_STAGE(PG8_SA(0, 0), a2, voffA);
            PG8_BAR; PG8_WAIT_L(0); PG8_MMA(1, 0, At, B0); PG8_BAR; PG8_SCHED;
            PG8_STAGE(PG8_SB(0, 1), b2 + hstep, voffB);
            PG8_WAIT_V(6); PG8_BAR; PG8_MMA(1, 1, At, B1); PG8_BAR;
            PG8_LDB(B0, 1, 0); PG8_SCHED; PG8_LDA(At, 1, 0); PG8_STAGE(PG8_SA(0, 1), a2 + hstep, voffA);
            PG8_WAIT_L(8); PG8_BAR; PG8_WAIT_L(0); PG8_MMA(0, 0, At, B0); PG8_BAR; PG8_SCHED;
            PG8_LDB(B1, 1, 1); PG8_STAGE(PG8_SB(1, 0), b3, voffB);
            PG8_BAR; PG8_WAIT_L(0); PG8_MMA(0, 1, At, B1); PG8_BAR;
            PG8_LDA(At, 1, 1); PG8_STAGE(PG8_SA(1, 0), a3, voffA);
            PG8_BAR; PG8_WAIT_L(0); PG8_MMA(1, 0, At, B0); PG8_BAR; PG8_SCHED;
            PG8_STAGE(PG8_SB(1, 1), b3 + hstep, voffB);
            PG8_WAIT_V(6); PG8_BAR; PG8_MMA(1, 1, At, B1); PG8_BAR;
        }
        E(acc, cur, wr, wc, fr, fq);
        if (!has_next) break;
#pragma unroll
        for (int a = 0; a < 2; ++a)
#pragma unroll
            for (int b = 0; b < 2; ++b)
#pragma unroll
                for (int m = 0; m < 4; ++m)
#pragma unroll
                    for (int n = 0; n < 2; ++n) acc[a][b][m][n] = (f32x4){0.f, 0.f, 0.f, 0.f};
        cur = nxt; cA = nA; cB = nB; ++ui;
    }
    PG8_WAIT_V(0);
    if (wr == 0) PG8_BAR;
    PG8_BAR;
#undef PG8_SA
#undef PG8_SB
#undef PG8_STAGE
#undef PG8_LDA
#undef PG8_LDB
#undef PG8_MMA
#undef PG8_WAIT_V
#undef PG8_WAIT_L
#undef PG8_BAR
#undef PG8_SCHED
}
template <class F> struct EpiWrap {
    const P* p; F f;
    __device__ __forceinline__ void operator()(const f32x4 (&acc)[2][2][4][2], const Unit& u, int wr, int wc, int fr, int fq) const {
        const int row0 = u.pm * BM + wr * 64 + fr, col0 = u.pn * BM + wc * 32 + 4 * fq;
#pragma unroll
        for (int ai = 0; ai < 2; ++ai)
#pragma unroll
            for (int m = 0; m < 4; ++m)
#pragma unroll
                for (int bj = 0; bj < 2; ++bj)
#pragma unroll
                    for (int n = 0; n < 2; ++n) {
                        const f32x4 a = acc[ai][bj][m][n]; const float v[4] = {a[0], a[1], a[2], a[3]};
                        f(*p, row0 + ai * HALF + m * 16, col0 + bj * HALF + n * 16, v);
                    }
    }
};
struct EpiFfn1 {
    const P* p;
    __device__ __forceinline__ void operator()(const f32x4 (&acc)[2][2][4][2], const Unit& u, int wr, int wc, int fr, int fq) const {
        const int row0 = u.pm * BM + wr * 64 + fr, j0 = u.pn * 128 + wc * 32 + 4 * fq;
        bf16_t* HA = (bf16_t*)(p->ws + WS_UR);
#pragma unroll
        for (int ai = 0; ai < 2; ++ai)
#pragma unroll
            for (int m = 0; m < 4; ++m)
#pragma unroll
                for (int n = 0; n < 2; ++n) {
                    const f32x4 g = acc[ai][0][m][n], up = acc[ai][1][m][n]; float h[4];
#pragma unroll
                    for (int e = 0; e < 4; ++e) h[e] = g[e] * sigmoidf_(g[e]) * up[e];
                    uint2 w; w.x = (unsigned)f2bf(h[0]) | ((unsigned)f2bf(h[1]) << 16); w.y = (unsigned)f2bf(h[2]) | ((unsigned)f2bf(h[3]) << 16);
                    *(uint2*)(HA + (size_t)(row0 + ai * HALF + m * 16) * D_FF + j0 + n * 16) = w;
                }
    }
};
}

#define XB_TMO      128
#define XB_XCNT(j)  (256  + 64 * (j))
#define XB_XSUB(j)  (1280 + 64 * (j))
#define XB_XGEN(j)  (2304 + 64 * (j))
#define XB_TOP      3328
#define XB_TOPGEN   3392
#define XCD_BAR_WORDS 3456
#define XB_SPIN_CAP (1u << 22)
__device__ __forceinline__ unsigned xb_ld(unsigned* p)              { return __hip_atomic_load(p, __ATOMIC_RELAXED, __HIP_MEMORY_SCOPE_AGENT); }
__device__ __forceinline__ unsigned xb_add(unsigned* p, unsigned v) { return __hip_atomic_fetch_add(p, v, __ATOMIC_RELAXED, __HIP_MEMORY_SCOPE_AGENT); }
__device__ __forceinline__ unsigned xb_xcc_id() { return (unsigned)__builtin_amdgcn_s_getreg((3 << 11) | 20) & 0xFu; }
#define XB_SPIN(cond, bar) do { unsigned _sp = 0; while (cond) { __builtin_amdgcn_s_sleep(1); \
    if ((++_sp & 255u) == 0u) { if (xb_ld(&(bar)[XB_TMO])) break; if (_sp > XB_SPIN_CAP) { atomicAdd(&(bar)[XB_TMO], 1u); break; } } } } while (0)
struct XcdBarrier { unsigned* bar; unsigned x; volatile LAS unsigned* st; };
__device__ __forceinline__ XcdBarrier xcd_barrier_post(unsigned* bar, volatile LAS unsigned* st) {
    XcdBarrier b; b.bar = bar; b.x = xb_xcc_id(); b.st = st;
    if (threadIdx.x == 0) (void)xb_add(&bar[XB_XCNT(b.x)], 1u);
    return b;
}
__device__ __forceinline__ void xcd_barrier_complete(unsigned* bar, unsigned x, unsigned& nloc, unsigned& nx) {
    const unsigned G = gridDim.x * gridDim.y * gridDim.z;
    unsigned sum, cnt, mine, sp = 0u;
    for (;;) {
        sum = 0u; cnt = 0u; mine = 0u;
#pragma unroll
        for (unsigned j = 0; j < 16; ++j) { const unsigned c = xb_ld(&bar[XB_XCNT(j)]); sum += c; cnt += (c > 0u) ? 1u : 0u; mine = (j == x) ? c : mine; }
        if (sum == G) break;
        __builtin_amdgcn_s_sleep(1);
        if ((++sp & 255u) == 0u) { if (xb_ld(&bar[XB_TMO])) break; if (sp > XB_SPIN_CAP) { atomicAdd(&bar[XB_TMO], 1u); break; } }
    }
    nloc = mine > 0u ? mine : 1u; nx = cnt > 0u ? cnt : 1u;
}
__device__ __forceinline__ void xcd_barrier(const XcdBarrier& b) {
    asm volatile("s_waitcnt vmcnt(0)" ::: "memory");
    __syncthreads();
    if (threadIdx.x == 0) {
        unsigned* bar = b.bar;
        __builtin_amdgcn_s_waitcnt(0);
        unsigned nloc = b.st[0], nx = b.st[1];
        if (nloc == 0u) { xcd_barrier_complete(bar, b.x, nloc, nx); b.st[0] = nloc; b.st[1] = nx; }
        const unsigned old = xb_add(&bar[XB_XSUB(b.x)], 1u);
        const unsigned gen = old / nloc;
        if (old + 1u == (gen + 1u) * nloc) {
            __builtin_amdgcn_fence(__ATOMIC_RELEASE, "agent");
            asm volatile("s_waitcnt vmcnt(0)" ::: "memory");
            const unsigned og = xb_add(&bar[XB_TOP], 1u);
            const unsigned tg = og / nx;
            if (og + 1u == (tg + 1u) * nx) xb_add(&bar[XB_TOPGEN], 1u);
            else XB_SPIN(xb_ld(&bar[XB_TOPGEN]) == tg, bar);
            __builtin_amdgcn_fence(__ATOMIC_ACQUIRE, "agent");
            xb_add(&bar[XB_XGEN(b.x)], 1u);
            asm volatile("s_waitcnt vmcnt(0)" ::: "memory");
        } else {
            XB_SPIN(xb_ld(&bar[XB_XGEN(b.x)]) == gen, bar);
            __builtin_amdgcn_fence(__ATOMIC_ACQUIRE, "agent");
            asm volatile("s_waitcnt vmcnt(0)" ::: "memory");
        }
    }
    __syncthreads();
}

#define LDS_BYTES (pg8::STAGE_BYTES + 1024)
#define N_PHASES 20
struct Args { P p; int ph_lo, ph_hi; };
__global__ __launch_bounds__(512, 2) void mega(Args a) {
    extern __shared__ __attribute__((aligned(16))) unsigned char lds[];
    const P& p = a.p;
    LAS unsigned char* l3 = (LAS unsigned char*)lds;
    volatile LAS unsigned* misc = (volatile LAS unsigned*)(l3 + pg8::STAGE_BYTES);
    if (threadIdx.x < 16) misc[threadIdx.x] = 0u;
    __syncthreads();
    XcdBarrier bar = xcd_barrier_post((unsigned*)(p.ws + WS_CTL), misc);
    float* sm = (float*)lds;
    const int lo = a.ph_lo, hi = a.ph_hi;
#define IN(k) (lo <= (k) && (k) < hi)
#define SEAM(k) do { if (IN(k) && IN((k) + 1)) xcd_barrier(bar); } while (0)
    if (IN(0)) ph_prep0(p, sm);
    SEAM(0);
    for (int l = 0; l < 2; ++l) {
        const int b0 = 1 + 9 * l;
        if (IN(b0 + 0)) ph_norm(p, l, 0);
        SEAM(b0 + 0);
        if (IN(b0 + 1)) { pg8::Gemm g{(const bf16_t*)(p.ws + WS_H), (const bf16_t*)(p.ws + WS_WIN) + (size_t)l * N1 * 1024, NTOK, N1, 1024};
            pg8::StaticOrder S; S.init(NTOK, N1, gridDim.x, blockIdx.x); pg8::EpiWrap<EpiG1> E{&p, EpiG1{l}}; pg8::gemm_phase(l3, g, S, E); }
        SEAM(b0 + 1);
        if (IN(b0 + 2)) ph_prep(p, l, sm);
        SEAM(b0 + 2);
        if (IN(b0 + 3)) { ph_scan(p, l, sm); ph_attn_naive(p, l); ph_fnet_naive(p); }
        SEAM(b0 + 3);
        if (IN(b0 + 4)) ph_finalize(p, l);
        SEAM(b0 + 4);
        if (IN(b0 + 5)) { pg8::Gemm g{(const bf16_t*)(p.ws + WS_H), (const bf16_t*)(p.ws + WS_WOUT) + (size_t)l * 1024 * 1024, NTOK, 1024, 1024};
            pg8::StaticOrder S; S.init(NTOK, 1024, gridDim.x, blockIdx.x); pg8::EpiWrap<EpiRes> E{&p, EpiRes{l, 2}}; pg8::gemm_phase(l3, g, S, E); }
        SEAM(b0 + 5);
        if (IN(b0 + 6)) ph_norm(p, l, 1);
        SEAM(b0 + 6);
        if (IN(b0 + 7)) { pg8::Gemm g{(const bf16_t*)(p.ws + WS_H), (const bf16_t*)(p.ws + WS_WF1) + (size_t)l * 5632 * 1024, NTOK, 5632, 1024};
            pg8::StaticOrder S; S.init(NTOK, 5632, gridDim.x, blockIdx.x); pg8::EpiFfn1 E{&p}; pg8::gemm_phase(l3, g, S, E); }
        SEAM(b0 + 7);
        if (IN(b0 + 8)) { pg8::Gemm g{(const bf16_t*)(p.ws + WS_UR), (const bf16_t*)(p.ws + WS_WF2) + (size_t)l * 1024 * 2816, NTOK, 1024, 2816};
            pg8::StaticOrder S; S.init(NTOK, 1024, gridDim.x, blockIdx.x); pg8::EpiWrap<EpiRes> E{&p, EpiRes{l, 5}}; pg8::gemm_phase(l3, g, S, E); }
        SEAM(b0 + 8);
    }
    if (IN(19)) ph_norm(p, 0, 2);
#undef IN
#undef SEAM
}

extern "C" void kernel_launch(void* const* d_in, const int* in_sizes, int n_in, void* d_out, int out_size, void* d_ws, size_t ws_size, hipStream_t stream) {
    static int grid = 0;
    if (grid == 0) {
        if (n_in != 29 || ws_size < WS_END) { fprintf(stderr, "kernel_launch: bad n_in %d or ws_size %zu (need %zu)\n", n_in, ws_size, (size_t)WS_END); grid = -1; return; }
        int dev = 0, cus = 0, per_cu = 0;
        hipGetDevice(&dev); hipDeviceGetAttribute(&cus, hipDeviceAttributeMultiprocessorCount, dev);
        if (hipFuncSetAttribute((const void*)mega, hipFuncAttributeMaxDynamicSharedMemorySize, LDS_BYTES) != hipSuccess) { fprintf(stderr, "kernel_launch: hipFuncSetAttribute failed\n"); grid = -1; return; }
        if (hipOccupancyMaxActiveBlocksPerMultiprocessor(&per_cu, (const void*)mega, 512, LDS_BYTES) != hipSuccess || per_cu < 1) { fprintf(stderr, "kernel_launch: occupancy query says %d\n", per_cu); per_cu = 1; }
        (void)hipGetLastError();
        grid = cus;
    }
    if (grid < 0) return;
    hipMemsetAsync((unsigned char*)d_ws + WS_CTL, 0, 16384, stream);
    Args a{};
    const float** f = (const float**)&a.p;
    for (int i = 0; i < 29; ++i) f[i] = (const float*)d_in[i];
    a.p.out = (float*)d_out; a.p.ws = (unsigned char*)d_ws;
#if ONE_LAUNCH
    a.ph_lo = 0; a.ph_hi = N_PHASES;
    hipLaunchKernelGGL(mega, dim3(grid), dim3(512), LDS_BYTES, stream, a);
#else
    for (int ph = 0; ph < N_PHASES; ++ph) { a.ph_lo = ph; a.ph_hi = ph + 1; hipLaunchKernelGGL(mega, dim3(grid), dim3(512), LDS_BYTES, stream, a); }
#endif
}
```

```cpp
#include <hip/hip_runtime.h>
#include <stdint.h>
#include <stdio.h>
#ifndef ONE_LAUNCH
#define ONE_LAUNCH 1
#endif

typedef unsigned short bf16_t;

#define D_MODEL 1024
#define NTOK 10240
#define NPTOK 8192
#define TP 256
#define TS 1024
#define NSEQ 34
#define NH 6
#define N1 3072
#define C_DIFF 0
#define C_FNET 1152
#define C_RWKV 1664
#define C_END 3008
#define N_RWKV 1344
#define D_FF 2816
#define D_IN 2752

#define OUT_YP 0
#define OUT_YS 8388608
#define OUT_ST 10485760
#define OUT_CK 13631488
#define OUT_CV 19922944

#define OPS_REC 1792
#define OPS_TOK (6 * OPS_REC)

#define WS_WIN   ((size_t)0)
#define WS_WOUT  (WS_WIN + (size_t)2 * N1 * 1024 * 2)
#define WS_WF1   (WS_WOUT + (size_t)2 * 1024 * 1024 * 2)
#define WS_WF2   (WS_WF1 + (size_t)2 * 5632 * 1024 * 2)
#define WS_H     (WS_WF2 + (size_t)2 * 1024 * 2816 * 2)
#define WS_UD    (WS_H + (size_t)NTOK * 1024 * 2)
#define WS_ZF    (WS_UD + (size_t)NTOK * 1152 * 2)
#define WS_UR    (WS_ZF + (size_t)NTOK * 512 * 2)
#define WS_OPS   (WS_UR + (size_t)2 * NTOK * 384 * 4)
#define WS_MOD   (WS_OPS + (size_t)NTOK * OPS_TOK)
#define WS_L256  (WS_MOD + (size_t)2 * 3 * 6144 * 4)
#define WS_L1024 (WS_L256 + (size_t)256 * 512 * 2)
#define WS_CTL   (WS_L1024 + (size_t)1024 * 2048 * 2)
#define WS_END   (WS_CTL + (size_t)16384)
#define CTL_QUEUE 3584
static_assert(WS_END <= ((size_t)256 << 20), "workspace exceeds 256 MiB");

struct P {
    const float *x_prompt, *x_sample, *c, *state_rwkv, *cache_k, *cache_v, *c_ctx, *norm1_g, *norm2_g, *final_g;
    const float *w_mod, *b_mod, *w_in, *w_out, *shift_mu, *decay_w0, *decay_up, *iclr_a0, *iclr_up, *gate_up;
    const float *k_k, *k_a, *r_k, *lnx_g, *lnx_b, *diff_lambda, *subln_g, *w_ffn_in, *w_ffn_out;
    float* out;
    unsigned char* ws;
};

__device__ __forceinline__ bf16_t f2bf(float f) { unsigned u = __builtin_bit_cast(unsigned, f); return (bf16_t)((u + 0x7fffu + ((u >> 16) & 1u)) >> 16); }
__device__ __forceinline__ float bf2f(bf16_t b) { return __builtin_bit_cast(float, ((unsigned)b) << 16); }
__device__ __forceinline__ float sigmoidf_(float x) { return 1.f / (1.f + __expf(-x)); }
__device__ __forceinline__ float wave_sum(float v) {
#pragma unroll
    for (int o = 1; o < 64; o <<= 1) v += __shfl_xor(v, o);
    return v;
}
__device__ __forceinline__ int otid() { int t = threadIdx.x; asm volatile("" : "+v"(t)); return t; }
__device__ __forceinline__ int tok_cls(int tok) { return tok < NPTOK ? 0 : 1 + ((tok - NPTOK) >> 10); }
__device__ __forceinline__ const float* xin_row(const P& p, int tok) { return tok < NPTOK ? p.x_prompt + (size_t)tok * 1024 : p.x_sample + (size_t)(tok - NPTOK) * 1024; }
__device__ __forceinline__ float* X_row(const P& p, int tok) { return p.out + (size_t)tok * 1024; }
__device__ __forceinline__ const float* mod_vec(const P& p, int l, int cls, int which) { return (const float*)(p.ws + WS_MOD) + ((size_t)(l * 3 + cls) * 6144 + which * 1024); }
__device__ __forceinline__ void seq_info(int s, int& start, int& T) { if (s < 32) { start = s * TP; T = TP; } else { start = NPTOK + (s - 32) * TS; T = TS; } }
__device__ __forceinline__ void tok_info(int tok, int& s, int& t, int& T, int& start) {
    if (tok < NPTOK) { s = tok >> 8; t = tok & 255; T = TP; start = s * TP; } else { int r = tok - NPTOK; s = 32 + (r >> 10); t = r & 1023; T = TS; start = NPTOK + ((r >> 10) << 10); }
}

#define P0_MOD 192
#define P0_TILES_L 3136
__device__ void ph_prep0(const P& p, float* sm) {
    const int tid = otid();
    const int nitems = P0_MOD + 2 * P0_TILES_L + 1280;
    for (int item = blockIdx.x; item < nitems; item += gridDim.x) {
        __syncthreads();
        if (item < P0_MOD) {
            const int l = item / 96, cg = item % 96, col = cg * 64 + (tid & 63), ks = tid >> 6;
            const float* W = p.w_mod + (size_t)l * 1024 * 6144;
            float a0 = 0.f, a1 = 0.f, a2 = 0.f;
            for (int k = ks * 128; k < ks * 128 + 128; ++k) {
                const float w = W[(size_t)k * 6144 + col];
                float c0 = p.c_ctx[k], c1 = p.c[k], c2 = p.c[1024 + k];
                c0 = c0 * sigmoidf_(c0); c1 = c1 * sigmoidf_(c1); c2 = c2 * sigmoidf_(c2);
                a0 += c0 * w; a1 += c1 * w; a2 += c2 * w;
            }
            sm[(ks * 3 + 0) * 64 + (tid & 63)] = a0; sm[(ks * 3 + 1) * 64 + (tid & 63)] = a1; sm[(ks * 3 + 2) * 64 + (tid & 63)] = a2;
            __syncthreads();
            if (tid < 192) {
                const int cls = tid >> 6, cc = tid & 63; float s = 0.f;
                for (int k = 0; k < 8; ++k) s += sm[(k * 3 + cls) * 64 + cc];
                const int colo = cg * 64 + cc;
                ((float*)(p.ws + WS_MOD))[(size_t)(l * 3 + cls) * 6144 + colo] = s + p.b_mod[(size_t)l * 6144 + colo];
            }
        } else if (item < P0_MOD + 2 * P0_TILES_L) {
            int it = item - P0_MOD; const int l = it / P0_TILES_L; it %= P0_TILES_L;
            const float* src; int srcN, K, ntile, ktile, mode = 0, scol = 0; bf16_t* dst; int n0;
            if (it < 768) { ntile = it / 16; ktile = it % 16; K = 1024; srcN = D_IN; src = p.w_in + (size_t)l * 1024 * D_IN; dst = (bf16_t*)(p.ws + WS_WIN) + (size_t)l * N1 * 1024;
                n0 = ntile * 64;
                if (n0 < C_FNET) { scol = 1344 + n0; } else if (n0 < C_RWKV) { mode = 1 + ((n0 - C_FNET) / 64) % 2; scol = 2496 + ((n0 - C_FNET) / 128) * 64; } else if (n0 < C_END) { scol = n0 - C_RWKV; } else mode = 3; }
            else if (it < 1024) { it -= 768; ntile = it / 16; ktile = it % 16; K = 1024; srcN = 1024; src = p.w_out + (size_t)l * 1024 * 1024; dst = (bf16_t*)(p.ws + WS_WOUT) + (size_t)l * 1024 * 1024; n0 = ntile * 64; scol = n0; }
            else if (it < 2432) { it -= 1024; ntile = it / 16; ktile = it % 16; K = 1024; srcN = 5632; src = p.w_ffn_in + (size_t)l * 1024 * 5632; dst = (bf16_t*)(p.ws + WS_WF1) + (size_t)l * 5632 * 1024; n0 = ntile * 64;
                const int pn = ntile >> 2, sub = ntile & 3; scol = (sub < 2) ? (128 * pn + 64 * sub) : (2816 + 128 * pn + 64 * (sub - 2)); }
            else { it -= 2432; ntile = it / 44; ktile = it % 44; K = 2816; srcN = 1024; src = p.w_ffn_out + (size_t)l * 2816 * 1024; dst = (bf16_t*)(p.ws + WS_WF2) + (size_t)l * 1024 * 2816; n0 = ntile * 64; scol = n0; }
            const int k0 = ktile * 64;
            float* tile = sm;
            float* cs = sm + 64 * 65;
            if (mode != 3) {
#pragma unroll
                for (int i = 0; i < 8; ++i) { const int k = i * 8 + (tid >> 6), n = tid & 63; tile[k * 65 + n] = src[(size_t)(k0 + k) * srcN + scol + n]; }
            }
            if (tid < 64) { cs[tid] = cospif((float)tid / 32.f); cs[64 + tid] = sinpif((float)tid / 32.f); }
            __syncthreads();
            const int n = tid >> 3, k8 = (tid & 7) * 8;
            float v[8];
            if (mode == 0) {
#pragma unroll
                for (int j = 0; j < 8; ++j) v[j] = tile[(k8 + j) * 65 + n];
            } else if (mode == 3) {
#pragma unroll
                for (int j = 0; j < 8; ++j) v[j] = 0.f;
            } else {
#pragma unroll
                for (int j = 0; j < 8; ++j) v[j] = 0.f;
                for (int cc = 0; cc < 64; ++cc) {
                    const int idx = (n * cc) & 63;
                    const float tr = (mode == 1) ? cs[idx] * 0.125f : -cs[64 + idx] * 0.125f;
#pragma unroll
                    for (int j = 0; j < 8; ++j) v[j] += tile[(k8 + j) * 65 + cc] * tr;
                }
            }
            uint4 o;
            o.x = (unsigned)f2bf(v[0]) | ((unsigned)f2bf(v[1]) << 16); o.y = (unsigned)f2bf(v[2]) | ((unsigned)f2bf(v[3]) << 16);
            o.z = (unsigned)f2bf(v[4]) | ((unsigned)f2bf(v[5]) << 16); o.w = (unsigned)f2bf(v[6]) | ((unsigned)f2bf(v[7]) << 16);
            *(uint4*)(dst + (size_t)(n0 + n) * K + k0 + k8) = o;
        } else {
            const int r = item - (P0_MOD + 2 * P0_TILES_L);
            const int T = r < 256 ? 256 : 1024, ft = r < 256 ? r : r - 256;
            bf16_t* L = r < 256 ? (bf16_t*)(p.ws + WS_L256) + (size_t)ft * 512 : (bf16_t*)(p.ws + WS_L1024) + (size_t)ft * 2048;
            const float sc = r < 256 ? 0.0625f : 0.03125f;
            for (int k = tid; k < 2 * T; k += blockDim.x) {
                const int t = k & (T - 1), idx = (ft * t) & (T - 1);
                const float ang = (float)(2 * idx) / (float)T;
                L[k] = f2bf((k < T ? cospif(ang) : sinpif(ang)) * sc);
            }
        }
    }
}

__device__ void ph_norm(const P& p, int l, int which) {
    const int tid_ = otid(); const int lane = tid_ & 63, wv = tid_ >> 6, nw = blockDim.x >> 6;
    for (int row = blockIdx.x * nw + wv; row < NTOK; row += gridDim.x * nw) {
        const float* xr = (which == 0 && l == 0) ? xin_row(p, row) : X_row(p, row);
        float4 x[4]; float ss = 0.f;
#pragma unroll
        for (int i = 0; i < 4; ++i) { x[i] = *(const float4*)(xr + i * 256 + lane * 4); ss += x[i].x * x[i].x + x[i].y * x[i].y + x[i].z * x[i].z + x[i].w * x[i].w; }
        ss = wave_sum(ss);
        const float rstd = rsqrtf(ss * (1.f / 1024.f) + 1e-6f);
        if (which == 2) {
            float* o = p.out + (size_t)row * 1024;
#pragma unroll
            for (int i = 0; i < 4; ++i) { const float4 g = *(const float4*)(p.final_g + i * 256 + lane * 4);
                float4 y; y.x = x[i].x * rstd * g.x; y.y = x[i].y * rstd * g.y; y.z = x[i].z * rstd * g.z; y.w = x[i].w * rstd * g.w;
                *(float4*)(o + i * 256 + lane * 4) = y; }
        } else {
            const int cls = tok_cls(row);
            const float* g = (which == 0 ? p.norm1_g : p.norm2_g) + (size_t)l * 1024;
            const float* sh = mod_vec(p, l, cls, which == 0 ? 0 : 3);
            const float* sc = mod_vec(p, l, cls, which == 0 ? 1 : 4);
            bf16_t* h = (bf16_t*)(p.ws + WS_H) + (size_t)row * 1024;
#pragma unroll
            for (int i = 0; i < 4; ++i) { const int c = i * 256 + lane * 4;
                const float4 gg = *(const float4*)(g + c), s1 = *(const float4*)(sc + c), s0 = *(const float4*)(sh + c);
                const float y0 = x[i].x * rstd * gg.x * (1.f + s1.x) + s0.x, y1 = x[i].y * rstd * gg.y * (1.f + s1.y) + s0.y;
                const float y2 = x[i].z * rstd * gg.z * (1.f + s1.z) + s0.z, y3 = x[i].w * rstd * gg.w * (1.f + s1.w) + s0.w;
                uint2 o; o.x = (unsigned)f2bf(y0) | ((unsigned)f2bf(y1) << 16); o.y = (unsigned)f2bf(y2) | ((unsigned)f2bf(y3) << 16);
                *(uint2*)(h + c) = o; }
        }
    }
}

struct EpiG1 {
    int l;
    __device__ __forceinline__ void operator()(const P& p, int row, int col, const float* v) const {
        if (col < C_FNET) {
            bf16_t* o = (bf16_t*)(p.ws + WS_UD) + (size_t)row * 1152 + col;
            uint2 w; w.x = (unsigned)f2bf(v[0]) | ((unsigned)f2bf(v[1]) << 16); w.y = (unsigned)f2bf(v[2]) | ((unsigned)f2bf(v[3]) << 16);
            *(uint2*)o = w;
            if (row < NPTOK && col >= 384) {
                const int b = row >> 8, t = row & 255;
                float* dst = p.out + (col < 768 ? OUT_CK : OUT_CV) + ((size_t)(b * 2 + l) * 256 + t) * 384 + (col < 768 ? col - 384 : col - 768);
                *(float4*)dst = make_float4(v[0], v[1], v[2], v[3]);
            }
        } else if (col < C_RWKV) {
            const int cc = col - C_FNET, g = cc >> 7, half = (cc >> 6) & 1, fc = cc & 63;
            bf16_t* o;
            if (row < NPTOK) { const int sq = row >> 8, t = row & 255; o = (bf16_t*)(p.ws + WS_ZF) + ((size_t)(sq * 256 + g * 64 + fc) * 512 + half * 256 + t);
                o[0] = f2bf(v[0]); o[512] = f2bf(v[1]); o[1024] = f2bf(v[2]); o[1536] = f2bf(v[3]); }
            else { const int r = row - NPTOK, b = r >> 10, t = r & 1023; o = (bf16_t*)(p.ws + WS_ZF) + (size_t)8192 * 512 + ((size_t)(b * 256 + g * 64 + fc) * 2048 + half * 1024 + t);
                o[0] = f2bf(v[0]); o[2048] = f2bf(v[1]); o[4096] = f2bf(v[2]); o[6144] = f2bf(v[3]); }
        } else if (col < C_END) {
            bf16_t* o = (bf16_t*)(p.ws + WS_UR) + (size_t)row * N_RWKV + (col - C_RWKV);
            uint2 w; w.x = (unsigned)f2bf(v[0]) | ((unsigned)f2bf(v[1]) << 16); w.y = (unsigned)f2bf(v[2]) | ((unsigned)f2bf(v[3]) << 16);
            *(uint2*)o = w;
        }
    }
};
struct EpiRes {
    int l, which;
    __device__ __forceinline__ void operator()(const P& p, int row, int col, const float* v) const {
        const float* g = mod_vec(p, l, tok_cls(row), which) + col;
        const float* xo = (which == 2 && l == 0) ? xin_row(p, row) + col : X_row(p, row) + col;
        const float4 x = *(const float4*)xo; const float4 gg = *(const float4*)g;
        *(float4*)(X_row(p, row) + col) = make_float4(x.x + gg.x * v[0], x.y + gg.y * v[1], x.z + gg.z * v[2], x.w + gg.w * v[3]);
    }
};

__device__ void ph_prep(const P& p, int l, float* sm) {
    const int tid = otid(), lane = tid & 63, wv = tid >> 6;
    const bf16_t* UR = (const bf16_t*)(p.ws + WS_UR);
    float* lin = sm;
    const float* mu0 = p.shift_mu + (size_t)l * 2 * N_RWKV; const float* mu1 = mu0 + N_RWKV;
    for (int tile = blockIdx.x; tile < NTOK / 8; tile += gridDim.x) {
        __syncthreads();
        for (int e = tid; e < 8 * 192; e += blockDim.x) {
            const int tk = e / 192, j = e % 192, tok = tile * 8 + tk, col = 1152 + j;
            int s, t, T, st; tok_info(tok, s, t, T, st);
            const float xc = bf2f(UR[(size_t)tok * N_RWKV + col]);
            const float xp = t > 0 ? bf2f(UR[(size_t)(tok - 1) * N_RWKV + col]) : 0.f;
            const float xn = t < T - 1 ? bf2f(UR[(size_t)(tok + 1) * N_RWKV + col]) : 0.f;
            float x = xc + mu0[col] * (xp - xc) + mu1[col] * (xn - xc);
            if (j < 64) x = tanhf(x); else if (j >= 128) x = sigmoidf_(x);
            lin[tk * 192 + j] = x;
        }
        __syncthreads();
        if (tid < 384) {
            const int ch = tid, h = wv;
#pragma unroll 1
            for (int tk = 0; tk < 8; ++tk) {
                const int tok = tile * 8 + tk; int s, t, T, st; tok_info(tok, s, t, T, st);
                float rkv[3];
#pragma unroll
                for (int q = 0; q < 3; ++q) { const int col = q * 384 + ch;
                    const float xc = bf2f(UR[(size_t)tok * N_RWKV + col]);
                    const float xp = t > 0 ? bf2f(UR[(size_t)(tok - 1) * N_RWKV + col]) : 0.f;
                    const float xn = t < T - 1 ? bf2f(UR[(size_t)(tok + 1) * N_RWKV + col]) : 0.f;
                    rkv[q] = xc + mu0[col] * (xp - xc) + mu1[col] * (xn - xc); }
                float w[2], a[2];
#pragma unroll
                for (int d = 0; d < 2; ++d) {
                    float sw = p.decay_w0[(size_t)(l * 2 + d) * 384 + ch], sa = p.iclr_a0[(size_t)(l * 2 + d) * 384 + ch];
                    const float* du = p.decay_up + (size_t)((l * 2 + d) * 32) * 384 + ch; const float* iu = p.iclr_up + (size_t)((l * 2 + d) * 32) * 384 + ch;
#pragma unroll 4
                    for (int j = 0; j < 32; ++j) { sw += lin[tk * 192 + d * 32 + j] * du[(size_t)j * 384]; sa += lin[tk * 192 + 64 + d * 32 + j] * iu[(size_t)j * 384]; }
                    w[d] = __expf(-0.60653065971263342f * sigmoidf_(sw)); a[d] = sigmoidf_(sa);
                }
                float g = 0.f; { const float* gu = p.gate_up + (size_t)l * 64 * 384 + ch;
#pragma unroll 4
                    for (int j = 0; j < 64; ++j) g += lin[tk * 192 + 128 + j] * gu[(size_t)j * 384]; }
                const float kkr = rkv[1] * p.k_k[(size_t)l * 384 + ch];
                const float nrm = sqrtf(wave_sum(kkr * kkr));
                const float kk = kkr / fmaxf(nrm, 1e-12f);
                unsigned char* rec = p.ws + WS_OPS + (size_t)tok * OPS_TOK + (size_t)h * OPS_REC;
                float* rf = (float*)rec; bf16_t* rb = (bf16_t*)(rec + 1280);
                rf[lane] = -kk; rf[64 + lane] = w[0]; rf[128 + lane] = w[1]; rf[192 + lane] = a[0]; rf[256 + lane] = a[1];
                rb[lane] = f2bf(rkv[0]); rb[64 + lane] = f2bf(rkv[2]); rb[128 + lane] = f2bf(rkv[1]); rb[192 + lane] = f2bf(g);
            }
        }
    }
    bf16_t* UD = (bf16_t*)(p.ws + WS_UD);
    for (int e = blockIdx.x * blockDim.x + tid; e < 2048 * 384; e += gridDim.x * blockDim.x) {
        const int tk = e / 384, pi = e % 384;
        const int grp = pi >> 3, pr = pi & 7, col = grp * 16 + pr;
        const int axis = grp & 1;
        const int t = tk & 1023, pos = axis == 0 ? (t >> 6) : (t & 63);
        const float inv = __powf(10000.f, -(float)pr / 8.f);
        float sn, cs; __sincosf((float)pos * inv, &sn, &cs);
        bf16_t* ptr = UD + (size_t)(NPTOK + tk) * 1152 + col;
        const float x1 = bf2f(ptr[0]), x2 = bf2f(ptr[8]);
        ptr[0] = f2bf(x1 * cs - x2 * sn); ptr[8] = f2bf(x2 * cs + x1 * sn);
    }
}

#define SC_TC 16
__device__ void ph_scan_job(const P& p, int l, int job, float* sm) {
    const int tid = otid(), dir = tid >> 8, ht = tid & 255, v = ht >> 2, q = ht & 3;
    float* ops = sm + dir * (SC_TC * 6 * 64);
    float* Yb = (float*)(p.ws + WS_UR);
    {
        const int s = job / NH, h = job % NH; int start, T; seq_info(s, start, T);
        float S[16];
        if (s < 32) {
#pragma unroll
            for (int e = 0; e < 16; ++e) S[e] = 0.f;
        } else {
            const float* s0 = p.state_rwkv + ((((size_t)(s - 32) * 2 + l) * 2 + dir) * NH + h) * 4096 + v * 64 + q * 16;
#pragma unroll
            for (int e = 0; e < 16; ++e) S[e] = s0[e];
        }
        for (int c = 0; c < T / SC_TC; ++c) {
            __syncthreads();
#pragma unroll
            for (int rpt = 0; rpt < 4; ++rpt) {
                const int e = rpt * 256 + ht, i = e >> 6, ch = e & 63;
                const int st = c * SC_TC + i, t = dir == 0 ? st : T - 1 - st, tok = start + t;
                const unsigned char* rec = p.ws + WS_OPS + (size_t)tok * OPS_TOK + (size_t)h * OPS_REC;
                const float* rf = (const float*)rec; const bf16_t* rb = (const bf16_t*)(rec + 1280);
                const float nkk = rf[ch], w = rf[64 + dir * 64 + ch], a = rf[192 + dir * 64 + ch];
                const float r = bf2f(rb[ch]), vv = bf2f(rb[64 + ch]), k = bf2f(rb[128 + ch]);
                const float kd = k * (1.f + (a - 1.f) * p.k_a[(size_t)l * 384 + h * 64 + ch]);
                float* o = ops + i * 384;
                o[ch] = r; o[64 + ch] = nkk; o[128 + ch] = vv; o[192 + ch] = w; o[256 + ch] = kd; o[320 + ch] = -nkk * a;
            }
            __syncthreads();
            for (int i = 0; i < SC_TC; ++i) {
                const float* o = ops + i * 384;
                float sa = 0.f;
#pragma unroll
                for (int e = 0; e < 16; ++e) sa += S[e] * o[64 + q * 16 + e];
                sa += __shfl_xor(sa, 1); sa += __shfl_xor(sa, 2);
                const float vv = o[128 + v];
                float y = 0.f;
#pragma unroll
                for (int e = 0; e < 16; ++e) { const int k = q * 16 + e; S[e] = S[e] * o[192 + k] + sa * o[320 + k] + vv * o[256 + k]; y += S[e] * o[k]; }
                y += __shfl_xor(y, 1); y += __shfl_xor(y, 2);
                if (q == 0) { const int st = c * SC_TC + i, t = dir == 0 ? st : T - 1 - st; Yb[((size_t)dir * NTOK + start + t) * 384 + h * 64 + v] = y; }
            }
        }
        if (s < 32) {
            float* so = p.out + OUT_ST + ((((size_t)s * 2 + l) * 2 + dir) * NH + h) * 4096 + v * 64 + q * 16;
#pragma unroll
            for (int e = 0; e < 16; ++e) so[e] = S[e];
        }
    }
}

__device__ void ph_finalize(const P& p, int l) {
    const int tid_ = otid(); const int lane = tid_ & 63, wv = tid_ >> 6, nw = blockDim.x >> 6;
    const float* Yb = (const float*)(p.ws + WS_UR);
    bf16_t* MIX = (bf16_t*)(p.ws + WS_H);
    for (int it = blockIdx.x * nw + wv; it < NTOK * NH; it += gridDim.x * nw) {
        const int tok = it / NH, h = it % NH, ch = h * 64 + lane;
        const float y = Yb[(size_t)tok * 384 + ch] + Yb[((size_t)NTOK + tok) * 384 + ch];
        const float mu = wave_sum(y) * (1.f / 64.f);
        const float dlt = y - mu;
        const float var = wave_sum(dlt * dlt) * (1.f / 64.f);
        const float yn = dlt * rsqrtf(var + 64e-5f) * p.lnx_g[(size_t)l * 384 + ch] + p.lnx_b[(size_t)l * 384 + ch];
        const unsigned char* rec = p.ws + WS_OPS + (size_t)tok * OPS_TOK + (size_t)h * OPS_REC;
        const float* rf = (const float*)rec; const bf16_t* rb = (const bf16_t*)(rec + 1280);
        const float a0 = rf[192 + lane], a1 = rf[256 + lane];
        const float r = bf2f(rb[lane]), vv = bf2f(rb[64 + lane]), k = bf2f(rb[128 + lane]), g = bf2f(rb[192 + lane]);
        const float ka = p.k_a[(size_t)l * 384 + ch];
        const float kf = k * (1.f + (a0 - 1.f) * ka), kb = k * (1.f + (a1 - 1.f) * ka);
        const float bs = wave_sum(r * (kf + kb) * p.r_k[(size_t)l * 384 + ch]);
        MIX[(size_t)tok * 1024 + ch] = f2bf((yn + bs * vv) * g);
    }
}

#define LAS __attribute__((address_space(3)))
namespace pg8 {
typedef short bf16x8 __attribute__((ext_vector_type(8)));
typedef float f32x4 __attribute__((ext_vector_type(4)));
constexpr int BM = 256, BK = 64, HALF = 128, HTB = HALF * BK * 2, STAGE_BYTES = 8 * HTB, NXCD = 8, WGM = 8;
__host__ __device__ __forceinline__ int lds_byte(int r, int c) { const int st = (r >> 4) * 2 + (c >> 5), rr = r & 15, cc = c & 31, ob = rr * 64 + cc * 2; return st * 1024 + (ob ^ (((ob >> 9) & 1) << 5)); }
__host__ __device__ __forceinline__ void stage_rc(int b, int& R, int& C) { const int st = b / 1024, sb = b % 1024, swz = sb ^ (((sb >> 9) & 1) << 5); R = (st >> 1) * 16 + swz / 64; C = (st & 1) * 32 + (swz % 64) / 2; }
struct Unit { int pm, pn; };
struct Gemm { const bf16_t* A; const bf16_t* Bt; int M, N, K; };
struct StaticOrder {
    int nM, nN, nwg, G, c;
    __device__ void init(int M, int N, int G_, int c_) { nM = M / BM; nN = N / BM; nwg = nM * nN; G = G_; c = c_; }
    __device__ bool next(int i, Unit& u) const {
        const long L = (long)i * G + c; if (L >= nwg) return false;
        int wgid = (int)L; { const int q = nwg / NXCD, r = nwg % NXCD, xcd = wgid % NXCD, off = wgid / NXCD; wgid = (xcd < r ? xcd * (q + 1) : r * (q + 1) + (xcd - r) * q) + off; }
        const int nig = WGM * nN, gid = wgid / nig, fm = gid * WGM, gsz = (nM - fm) < WGM ? (nM - fm) : WGM;
        u.pm = fm + ((wgid % nig) % gsz); u.pn = (wgid % nig) / gsz; return true;
    }
};
template <class Epi, class Sched>
__device__ __forceinline__ void gemm_phase(LAS unsigned char* lds, const Gemm g, const Sched& S, const Epi& E) {
    int tid_ = threadIdx.x; asm volatile("" : "+v"(tid_));
    const int tid = tid_, wid = __builtin_amdgcn_readfirstlane(tid >> 6), lane = tid & 63, wr = wid >> 2, wc = wid & 3, fr = lane & 15, fq = lane >> 4;
    const int K = g.K, nt = K / BK;
    unsigned voffA[2], voffB[2];
#pragma unroll
    for (int i = 0; i < 2; ++i) { int R, C; stage_rc(tid * 16 + i * 8192, R, C); voffA[i] = (unsigned)(R * K + C) * 2u; voffB[i] = (unsigned)(R * K + C) * 2u; }
    const size_t kstep = (size_t)(BK * 2);
    const size_t hstep = (size_t)HALF * K * 2;
    const size_t tstep = 2 * hstep;
    const unsigned ldsw = (unsigned)wid * 1024u;
    const int aoff = lds_byte(wr * 64 + fr, fq * 8), boff = lds_byte(wc * 32 + fr, fq * 8);
#define PG8_SA(b, h) (((b) * 2 + (h)) * HTB)
#define PG8_SB(b, h) ((4 + (b) * 2 + (h)) * HTB)
#define PG8_STAGE(bufoff, gbase, voff) do { _Pragma("unroll") for (int _i = 0; _i < 2; ++_i) \
        __builtin_amdgcn_global_load_lds((const unsigned*)((const char*)(gbase) + (voff)[_i]), (LAS unsigned*)(lds + (bufoff) + ldsw + _i * 8192), 16, 0, 0); } while (0)
#define PG8_LDA(dst, b, h) do { _Pragma("unroll") for (int m = 0; m < 4; ++m) _Pragma("unroll") for (int k = 0; k < 2; ++k) dst[m][k] = *(const LAS bf16x8*)(lds + PG8_SA(b, h) + aoff + m * 2048 + k * 1024); } while (0)
#define PG8_LDB(dst, b, h) do { _Pragma("unroll") for (int n = 0; n < 2; ++n) _Pragma("unroll") for (int k = 0; k < 2; ++k) dst[n][k] = *(const LAS bf16x8*)(lds + PG8_SB(b, h) + boff + n * 2048 + k * 1024); } while (0)
#define PG8_MMA(ai, bj, At, Bt) do { __builtin_amdgcn_s_setprio(1); _Pragma("unroll") for (int m = 0; m < 4; ++m) _Pragma("unroll") for (int n = 0; n < 2; ++n) _Pragma("unroll") for (int k = 0; k < 2; ++k) \
        acc[ai][bj][m][n] = __builtin_amdgcn_mfma_f32_16x16x32_bf16(Bt[n][k], At[m][k], acc[ai][bj][m][n], 0, 0, 0); __builtin_amdgcn_s_setprio(0); } while (0)
#define PG8_WAIT_V(n) asm volatile("s_waitcnt vmcnt(" #n ")" ::: "memory")
#define PG8_WAIT_L(n) asm volatile("s_waitcnt lgkmcnt(" #n ")" ::: "memory")
#define PG8_BAR __builtin_amdgcn_s_barrier()
#define PG8_SCHED __builtin_amdgcn_sched_barrier(0)
    Unit cur, nxt; int ui = 0;
    if (!S.next(0, cur)) return;
    f32x4 acc[2][2][4][2];
#pragma unroll
    for (int a = 0; a < 2; ++a)
#pragma unroll
        for (int b = 0; b < 2; ++b)
#pragma unroll
            for (int m = 0; m < 4; ++m)
#pragma unroll
                for (int n = 0; n < 2; ++n) acc[a][b][m][n] = (f32x4){0.f, 0.f, 0.f, 0.f};
    bf16x8 At[4][2], B0[2][2], B1[2][2];
    const char* cA = (const char*)g.A + (size_t)cur.pm * tstep; const char* cB = (const char*)g.Bt + (size_t)cur.pn * tstep;
    PG8_STAGE(PG8_SB(0, 0), cB, voffB); PG8_STAGE(PG8_SA(0, 0), cA, voffA); PG8_STAGE(PG8_SB(0, 1), cB + hstep, voffB); PG8_STAGE(PG8_SA(0, 1), cA + hstep, voffA);
    if (wr == 1) PG8_BAR;
    PG8_WAIT_V(4); PG8_BAR;
    PG8_STAGE(PG8_SB(1, 0), cB + kstep, voffB); PG8_STAGE(PG8_SA(1, 0), cA + kstep, voffA); PG8_STAGE(PG8_SB(1, 1), cB + hstep + kstep, voffB);
    PG8_WAIT_V(6); PG8_BAR;
    for (;;) {
        const bool has_next = S.next(ui + 1, nxt);
        const char* nA = has_next ? (const char*)g.A + (size_t)nxt.pm * tstep : cA; const char* nB = has_next ? (const char*)g.Bt + (size_t)nxt.pn * tstep : cB;
        for (int t = 0; t < nt; t += 2) {
            const bool last = (t == nt - 2);
            const char* a1 = cA + (size_t)(t + 1) * kstep;
            const char* a2 = last ? nA : cA + (size_t)(t + 2) * kstep; const char* b2 = last ? nB : cB + (size_t)(t + 2) * kstep;
            const char* a3 = a2 + kstep; const char* b3 = b2 + kstep;
            PG8_LDB(B0, 0, 0); PG8_SCHED; PG8_LDA(At, 0, 0); PG8_STAGE(PG8_SA(1, 1), a1 + hstep, voffA);
            PG8_WAIT_L(8); PG8_BAR; PG8_WAIT_L(0); PG8_MMA(0, 0, At, B0); PG8_BAR; PG8_SCHED;
            PG8_LDB(B1, 0, 1); PG8_STAGE(PG8_SB(0, 0), b2, voffB);
            PG8_BAR; PG8_WAIT_L(0); PG8_MMA(0, 1, At, B1); PG8_BAR;
            PG8_LDA(At, 0, 1); PG8_STAGE(PG8_SA(0, 0), a2, voffA);
            PG8_BAR; PG8_WAIT_L(0); PG8_MMA(1, 0, At, B0); PG8_BAR; PG8_SCHED;
            PG8_STAGE(PG8_SB(0, 1), b2 + hstep, voffB);
            PG8_WAIT_V(6); PG8_BAR; PG8_MMA(1, 1, At, B1); PG8_BAR;
            PG8_LDB(B0, 1, 0); PG8_SCHED; PG8_LDA(At, 1, 0); PG8_STAGE(PG8_SA(0, 1), a2 + hstep, voffA);
            PG8_WAIT_L(8); PG8_BAR; PG8_WAIT_L(0); PG8_MMA(0, 0, At, B0); PG8_BAR; PG8_SCHED;
            PG8_LDB(B1, 1, 1); PG8_STAGE(PG8_SB(1, 0), b3, voffB);
            PG8_BAR; PG8_WAIT_L(0); PG8_MMA(0, 1, At, B1); PG8_BAR;
            PG8_LDA(At, 1, 1); PG8_STAGE(PG8_SA(1, 0), a3, voffA);
            PG8_BAR; PG8_WAIT_L(0); PG8_MMA(1, 0, At, B0); PG8_BAR; PG8_SCHED;
            PG8_STAGE(PG8_SB(1, 1), b3 + hstep, voffB);
            PG8_WAIT_V(6); PG8_BAR; PG8_MMA(1, 1, At, B1); PG8_BAR;
        }
        E(acc, cur, wr, wc, fr, fq);
        if (!has_next) break;
#pragma unroll
        for (int a = 0; a < 2; ++a)
#pragma unroll
            for (int b = 0; b < 2; ++b)
#pragma unroll
                for (int m = 0; m < 4; ++m)
#pragma unroll
                    for (int n = 0; n < 2; ++n) acc[a][b][m][n] = (f32x4){0.f, 0.f, 0.f, 0.f};
        cur = nxt; cA = nA; cB = nB; ++ui;
    }
    PG8_WAIT_V(0);
    if (wr == 0) PG8_BAR;
    PG8_BAR;
#undef PG8_SA
#undef PG8_SB
#undef PG8_STAGE
#undef PG8_LDA
#undef PG8_LDB
#undef PG8_MMA
#undef PG8_WAIT_V
#undef PG8_WAIT_L
#undef PG8_BAR
#undef PG8_SCHED
}
template <class F> struct EpiWrap {
    const P* p; F f;
    __device__ __forceinline__ void operator()(const f32x4 (&acc)[2][2][4][2], const Unit& u, int wr, int wc, int fr, int fq) const {
        const int row0 = u.pm * BM + wr * 64 + fr, col0 = u.pn * BM + wc * 32 + 4 * fq;
#pragma unroll
        for (int ai = 0; ai < 2; ++ai)
#pragma unroll
            for (int m = 0; m < 4; ++m)
#pragma unroll
                for (int bj = 0; bj < 2; ++bj)
#pragma unroll
                    for (int n = 0; n < 2; ++n) {
                        const f32x4 a = acc[ai][bj][m][n]; const float v[4] = {a[0], a[1], a[2], a[3]};
                        f(*p, row0 + ai * HALF + m * 16, col0 + bj * HALF + n * 16, v);
                    }
    }
};
struct EpiFfn1 {
    const P* p;
    __device__ __forceinline__ void operator()(const f32x4 (&acc)[2][2][4][2], const Unit& u, int wr, int wc, int fr, int fq) const {
        const int row0 = u.pm * BM + wr * 64 + fr, j0 = u.pn * 128 + wc * 32 + 4 * fq;
        bf16_t* HA = (bf16_t*)(p->ws + WS_UR);
#pragma unroll
        for (int ai = 0; ai < 2; ++ai)
#pragma unroll
            for (int m = 0; m < 4; ++m)
#pragma unroll
                for (int n = 0; n < 2; ++n) {
                    const f32x4 g = acc[ai][0][m][n], up = acc[ai][1][m][n]; float h[4];
#pragma unroll
                    for (int e = 0; e < 4; ++e) h[e] = g[e] * sigmoidf_(g[e]) * up[e];
                    uint2 w; w.x = (unsigned)f2bf(h[0]) | ((unsigned)f2bf(h[1]) << 16); w.y = (unsigned)f2bf(h[2]) | ((unsigned)f2bf(h[3]) << 16);
                    *(uint2*)(HA + (size_t)(row0 + ai * HALF + m * 16) * D_FF + j0 + n * 16) = w;
                }
    }
};
}


typedef short bf16x8_t __attribute__((ext_vector_type(8)));
typedef short bf16x4_t __attribute__((ext_vector_type(4)));
typedef float f32x16_t __attribute__((ext_vector_type(16)));
#define AT_KS_BYTES (256 * 72 * 2)
__device__ __forceinline__ unsigned pk_bf16(float lo, float hi) { return (unsigned)f2bf(lo) | ((unsigned)f2bf(hi) << 16); }
__device__ __forceinline__ void attn_stage(const P& p, int l, int s, int h, int start, int nctx, int chunk, bool withV, bf16_t* Ks, bf16_t* Vt, int tid) {
    const int key = tid >> 1, half = tid & 1, j = chunk * 256 + key;
    if (j < nctx) {
        const size_t base = (((size_t)(s - 32) * 2 + l) * 512 + j) * 384 + h * 64 + half * 32;
        const float4* kp = (const float4*)(p.cache_k + base);
#pragma unroll
        for (int i = 0; i < 4; ++i) { const float4 a = kp[2 * i], b = kp[2 * i + 1]; uint4 o; o.x = pk_bf16(a.x, a.y); o.y = pk_bf16(a.z, a.w); o.z = pk_bf16(b.x, b.y); o.w = pk_bf16(b.z, b.w);
            *(uint4*)(Ks + key * 72 + half * 32 + i * 8) = o; }
        if (withV) { const float4* vp = (const float4*)(p.cache_v + base);
#pragma unroll
            for (int i = 0; i < 8; ++i) { const float4 a = vp[i]; bf16_t* d = Vt + (half * 32 + i * 4) * 260 + key; d[0] = f2bf(a.x); d[260] = f2bf(a.y); d[520] = f2bf(a.z); d[780] = f2bf(a.w); } }
    } else {
        const bf16_t* UD = (const bf16_t*)(p.ws + WS_UD);
        const size_t base = (size_t)(start + j - nctx) * 1152 + h * 64 + half * 32;
        const uint4* kp = (const uint4*)(UD + base + 384);
#pragma unroll
        for (int i = 0; i < 4; ++i) *(uint4*)(Ks + key * 72 + half * 32 + i * 8) = kp[i];
        if (withV) { const uint4* vp = (const uint4*)(UD + base + 768);
#pragma unroll
            for (int i = 0; i < 4; ++i) { const uint4 u = vp[i]; const unsigned w[4] = {u.x, u.y, u.z, u.w}; bf16_t* d = Vt + (half * 32 + i * 8) * 260 + key;
#pragma unroll
                for (int e = 0; e < 4; ++e) { d[(2 * e) * 260] = (bf16_t)(w[e] & 0xffff); d[(2 * e + 1) * 260] = (bf16_t)(w[e] >> 16); } } }
    }
}
__device__ void attn_item(const P& p, int l, int item, unsigned char* lds, float lam, float lam_init) {
    const int tid = otid(), lane = tid & 63, wv = tid >> 6, n = lane & 31, hh = lane >> 5;
    int s, h, qb;
    if (item < 48) { s = 32 + item / 24; h = (item % 24) / 4; qb = item & 3; } else { const int r = item - 48; s = r / 6; h = r % 6; qb = 0; }
    int start, T; seq_info(s, start, T);
    const int nctx = s >= 32 ? 512 : 0, nchunks = (nctx + T) >> 8;
    bf16_t* Ks = (bf16_t*)lds; bf16_t* Vt = (bf16_t*)(lds + AT_KS_BYTES);
    const bf16_t* UD = (const bf16_t*)(p.ws + WS_UD);
    const int qtok = start + qb * 256 + wv * 32 + n;
    bf16x8_t Qf[2][2];
#pragma unroll
    for (int m = 0; m < 2; ++m)
#pragma unroll
        for (int si = 0; si < 2; ++si) Qf[m][si] = *(const bf16x8_t*)(UD + (size_t)qtok * 1152 + h * 64 + m * 32 + si * 16 + hh * 8);
    const float c = 0.17677669529663687f * 1.4426950408889634f;
    float m0 = -1e30f, m1 = -1e30f, l0 = 0.f, l1 = 0.f;
    for (int ch = 0; ch < nchunks; ++ch) {
        __syncthreads();
        attn_stage(p, l, s, h, start, nctx, ch, false, Ks, Vt, tid);
        __syncthreads();
#pragma unroll 1
        for (int kt = 0; kt < 8; ++kt) {
            f32x16_t S0 = {0,0,0,0,0,0,0,0,0,0,0,0,0,0,0,0}, S1 = S0;
#pragma unroll
            for (int si = 0; si < 2; ++si) {
                const bf16x8_t k0 = *(const bf16x8_t*)(Ks + (kt * 32 + n) * 72 + si * 16 + hh * 8);
                const bf16x8_t k1 = *(const bf16x8_t*)(Ks + (kt * 32 + n) * 72 + 32 + si * 16 + hh * 8);
                S0 = __builtin_amdgcn_mfma_f32_32x32x16_bf16(k0, Qf[0][si], S0, 0, 0, 0);
                S1 = __builtin_amdgcn_mfma_f32_32x32x16_bf16(k1, Qf[1][si], S1, 0, 0, 0);
            }
            float t0 = S0[0], t1 = S1[0];
#pragma unroll
            for (int r = 1; r < 16; ++r) { t0 = fmaxf(t0, S0[r]); t1 = fmaxf(t1, S1[r]); }
            const float n0 = fmaxf(m0, t0), n1 = fmaxf(m1, t1);
            float a0 = 0.f, a1 = 0.f;
#pragma unroll
            for (int r = 0; r < 16; ++r) { a0 += __builtin_amdgcn_exp2f((S0[r] - n0) * c); a1 += __builtin_amdgcn_exp2f((S1[r] - n1) * c); }
            l0 = l0 * __builtin_amdgcn_exp2f((m0 - n0) * c) + a0; l1 = l1 * __builtin_amdgcn_exp2f((m1 - n1) * c) + a1;
            m0 = n0; m1 = n1;
        }
    }
    {
        const float mo0 = __shfl_xor(m0, 32), lo0 = __shfl_xor(l0, 32), mo1 = __shfl_xor(m1, 32), lo1 = __shfl_xor(l1, 32);
        const float M0 = fmaxf(m0, mo0), M1 = fmaxf(m1, mo1);
        l0 = l0 * __builtin_amdgcn_exp2f((m0 - M0) * c) + lo0 * __builtin_amdgcn_exp2f((mo0 - M0) * c);
        l1 = l1 * __builtin_amdgcn_exp2f((m1 - M1) * c) + lo1 * __builtin_amdgcn_exp2f((mo1 - M1) * c);
        m0 = M0; m1 = M1;
    }
    const float i0 = 1.f / l0, i1 = lam / l1;
    f32x16_t O0 = {0,0,0,0,0,0,0,0,0,0,0,0,0,0,0,0}, O1 = O0;
    for (int ch = 0; ch < nchunks; ++ch) {
        __syncthreads();
        attn_stage(p, l, s, h, start, nctx, ch, true, Ks, Vt, tid);
        __syncthreads();
#pragma unroll 1
        for (int kt = 0; kt < 8; ++kt) {
            f32x16_t S0 = {0,0,0,0,0,0,0,0,0,0,0,0,0,0,0,0}, S1 = S0;
#pragma unroll
            for (int si = 0; si < 2; ++si) {
                const bf16x8_t k0 = *(const bf16x8_t*)(Ks + (kt * 32 + n) * 72 + si * 16 + hh * 8);
                const bf16x8_t k1 = *(const bf16x8_t*)(Ks + (kt * 32 + n) * 72 + 32 + si * 16 + hh * 8);
                S0 = __builtin_amdgcn_mfma_f32_32x32x16_bf16(k0, Qf[0][si], S0, 0, 0, 0);
                S1 = __builtin_amdgcn_mfma_f32_32x32x16_bf16(k1, Qf[1][si], S1, 0, 0, 0);
            }
            float pw[16];
#pragma unroll
            for (int r = 0; r < 16; ++r) pw[r] = __builtin_amdgcn_exp2f((S0[r] - m0) * c) * i0 - __builtin_amdgcn_exp2f((S1[r] - m1) * c) * i1;
#pragma unroll
            for (int si = 0; si < 2; ++si) {
                union { unsigned u[4]; bf16x8_t v; } pf;
#pragma unroll
                for (int e = 0; e < 4; ++e) pf.u[e] = pk_bf16(pw[8 * si + 2 * e], pw[8 * si + 2 * e + 1]);
                union { bf16x4_t h2[2]; bf16x8_t v; } va, vb;
                const bf16_t* v0 = Vt + n * 260 + kt * 32 + si * 16 + hh * 4;
                va.h2[0] = *(const bf16x4_t*)v0; va.h2[1] = *(const bf16x4_t*)(v0 + 8);
                vb.h2[0] = *(const bf16x4_t*)(v0 + 32 * 260); vb.h2[1] = *(const bf16x4_t*)(v0 + 32 * 260 + 8);
                O0 = __builtin_amdgcn_mfma_f32_32x32x16_bf16(va.v, pf.v, O0, 0, 0, 0);
                O1 = __builtin_amdgcn_mfma_f32_32x32x16_bf16(vb.v, pf.v, O1, 0, 0, 0);
            }
        }
    }
    float ss = 0.f;
#pragma unroll
    for (int r = 0; r < 16; ++r) ss += O0[r] * O0[r] + O1[r] * O1[r];
    ss += __shfl_xor(ss, 32);
    const float rs = rsqrtf(ss * (1.f / 64.f) + 1e-5f) * (1.f - lam_init);
    bf16_t* mo = (bf16_t*)(p.ws + WS_H) + (size_t)qtok * 1024 + 384 + h * 64;
    const float* sg = p.subln_g + (size_t)l * 64;
#pragma unroll
    for (int g = 0; g < 4; ++g) {
        const int vd = 8 * g + 4 * hh;
        uint2 w0, w1;
        w0.x = pk_bf16(O0[4 * g] * rs * sg[vd], O0[4 * g + 1] * rs * sg[vd + 1]); w0.y = pk_bf16(O0[4 * g + 2] * rs * sg[vd + 2], O0[4 * g + 3] * rs * sg[vd + 3]);
        w1.x = pk_bf16(O1[4 * g] * rs * sg[32 + vd], O1[4 * g + 1] * rs * sg[32 + vd + 1]); w1.y = pk_bf16(O1[4 * g + 2] * rs * sg[32 + vd + 2], O1[4 * g + 3] * rs * sg[32 + vd + 3]);
        *(uint2*)(mo + vd) = w0; *(uint2*)(mo + 32 + vd) = w1;
    }
}

struct EpiFnet {
    int samp;
    __device__ __forceinline__ void operator()(const P& p, int row, int col, const float* v) const {
        const int sq = col >> 8, ch = col & 255;
        const int tok = samp ? NPTOK + sq * 1024 + row : sq * 256 + row;
        uint2 w; w.x = pk_bf16(v[0], v[1]); w.y = pk_bf16(v[2], v[3]);
        *(uint2*)((bf16_t*)(p.ws + WS_H) + (size_t)tok * 1024 + 768 + ch) = w;
    }
};
struct OneUnit { int pm, pn; __device__ bool next(int i, pg8::Unit& u) const { if (i) return false; u.pm = pm; u.pn = pn; return true; } };

#define MX_ITEMS 484
template <class GemmFn>
__device__ void ph_mixer(const P& p, int l, unsigned char* lds, volatile LAS unsigned* slot, GemmFn gemm_one) {
    const float lam_init = 0.8f - 0.6f * __expf(-0.3f * (float)l);
    float lam;
    { const float* lp = p.diff_lambda + (size_t)l * 128; float s01 = 0.f, s23 = 0.f;
      for (int d = 0; d < 32; ++d) { s01 += lp[d] * lp[32 + d]; s23 += lp[64 + d] * lp[96 + d]; }
      lam = __expf(s01) - __expf(s23) + lam_init; }
    unsigned* ctr = (unsigned*)(p.ws + WS_CTL) + CTL_QUEUE + 64 * l;
    for (;;) {
        __syncthreads();
        if (threadIdx.x == 0) *slot = atomicAdd(ctr, 1u);
        __syncthreads();
        const int item = (int)*slot;
        if (item >= MX_ITEMS) break;
        if (item < 12) ph_scan_job(p, l, 32 * NH + item, (float*)lds);
        else if (item < 20) gemm_one(1, (item - 12) >> 1, (item - 12) & 1);
        else if (item < 212) ph_scan_job(p, l, item - 20, (float*)lds);
        else if (item < 260) attn_item(p, l, item - 212, lds, lam, lam_init);
        else if (item < 292) gemm_one(0, 0, item - 260);
        else attn_item(p, l, 48 + item - 292, lds, lam, lam_init);
    }
}

#define XB_TMO      128
#define XB_XCNT(j)  (256  + 64 * (j))
#define XB_XSUB(j)  (1280 + 64 * (j))
#define XB_XGEN(j)  (2304 + 64 * (j))
#define XB_TOP      3328
#define XB_TOPGEN   3392
#define XCD_BAR_WORDS 3456
#define XB_SPIN_CAP (1u << 22)
__device__ __forceinline__ unsigned xb_ld(unsigned* p)              { return __hip_atomic_load(p, __ATOMIC_RELAXED, __HIP_MEMORY_SCOPE_AGENT); }
__device__ __forceinline__ unsigned xb_add(unsigned* p, unsigned v) { return __hip_atomic_fetch_add(p, v, __ATOMIC_RELAXED, __HIP_MEMORY_SCOPE_AGENT); }
__device__ __forceinline__ unsigned xb_xcc_id() { return (unsigned)__builtin_amdgcn_s_getreg((3 << 11) | 20) & 0xFu; }
#define XB_SPIN(cond, bar) do { unsigned _sp = 0; while (cond) { __builtin_amdgcn_s_sleep(1); \
    if ((++_sp & 255u) == 0u) { if (xb_ld(&(bar)[XB_TMO])) break; if (_sp > XB_SPIN_CAP) { atomicAdd(&(bar)[XB_TMO], 1u); break; } } } } while (0)
struct XcdBarrier { unsigned* bar; unsigned x; volatile LAS unsigned* st; };
__device__ __forceinline__ XcdBarrier xcd_barrier_post(unsigned* bar, volatile LAS unsigned* st) {
    XcdBarrier b; b.bar = bar; b.x = xb_xcc_id(); b.st = st;
    if (threadIdx.x == 0) (void)xb_add(&bar[XB_XCNT(b.x)], 1u);
    return b;
}
__device__ __forceinline__ void xcd_barrier_complete(unsigned* bar, unsigned x, unsigned& nloc, unsigned& nx) {
    const unsigned G = gridDim.x * gridDim.y * gridDim.z;
    unsigned sum, cnt, mine, sp = 0u;
    for (;;) {
        sum = 0u; cnt = 0u; mine = 0u;
#pragma unroll
        for (unsigned j = 0; j < 16; ++j) { const unsigned c = xb_ld(&bar[XB_XCNT(j)]); sum += c; cnt += (c > 0u) ? 1u : 0u; mine = (j == x) ? c : mine; }
        if (sum == G) break;
        __builtin_amdgcn_s_sleep(1);
        if ((++sp & 255u) == 0u) { if (xb_ld(&bar[XB_TMO])) break; if (sp > XB_SPIN_CAP) { atomicAdd(&bar[XB_TMO], 1u); break; } }
    }
    nloc = mine > 0u ? mine : 1u; nx = cnt > 0u ? cnt : 1u;
}
__device__ __forceinline__ void xcd_barrier(const XcdBarrier& b) {
    asm volatile("s_waitcnt vmcnt(0)" ::: "memory");
    __syncthreads();
    if (threadIdx.x == 0) {
        unsigned* bar = b.bar;
        __builtin_amdgcn_s_waitcnt(0);
        unsigned nloc = b.st[0], nx = b.st[1];
        if (nloc == 0u) { xcd_barrier_complete(bar, b.x, nloc, nx); b.st[0] = nloc; b.st[1] = nx; }
        const unsigned old = xb_add(&bar[XB_XSUB(b.x)], 1u);
        const unsigned gen = old / nloc;
        if (old + 1u == (gen + 1u) * nloc) {
            __builtin_amdgcn_fence(__ATOMIC_RELEASE, "agent");
            asm volatile("s_waitcnt vmcnt(0)" ::: "memory");
            const unsigned og = xb_add(&bar[XB_TOP], 1u);
            const unsigned tg = og / nx;
            if (og + 1u == (tg + 1u) * nx) xb_add(&bar[XB_TOPGEN], 1u);
            else XB_SPIN(xb_ld(&bar[XB_TOPGEN]) == tg, bar);
            __builtin_amdgcn_fence(__ATOMIC_ACQUIRE, "agent");
            xb_add(&bar[XB_XGEN(b.x)], 1u);
            asm volatile("s_waitcnt vmcnt(0)" ::: "memory");
        } else {
            XB_SPIN(xb_ld(&bar[XB_XGEN(b.x)]) == gen, bar);
            __builtin_amdgcn_fence(__ATOMIC_ACQUIRE, "agent");
            asm volatile("s_waitcnt vmcnt(0)" ::: "memory");
        }
    }
    __syncthreads();
}

#define LDS_BYTES (pg8::STAGE_BYTES + 1024)
#define N_PHASES 20
struct Args { P p; int ph_lo, ph_hi; };
__global__ __launch_bounds__(512, 2) void mega(Args a) {
    extern __shared__ __attribute__((aligned(16))) unsigned char lds[];
    const P& p = a.p;
    LAS unsigned char* l3 = (LAS unsigned char*)lds;
    volatile LAS unsigned* misc = (volatile LAS unsigned*)(l3 + pg8::STAGE_BYTES);
    if (threadIdx.x < 16) misc[threadIdx.x] = 0u;
    __syncthreads();
    XcdBarrier bar = xcd_barrier_post((unsigned*)(p.ws + WS_CTL), misc);
    float* sm = (float*)lds;
    const int lo = a.ph_lo, hi = a.ph_hi;
#define IN(k) (lo <= (k) && (k) < hi)
#define SEAM(k) do { if (IN(k) && IN((k) + 1)) xcd_barrier(bar); } while (0)
    if (IN(0)) ph_prep0(p, sm);
    SEAM(0);
    for (int l = 0; l < 2; ++l) {
        const int b0 = 1 + 9 * l;
        if (IN(b0 + 0)) ph_norm(p, l, 0);
        SEAM(b0 + 0);
        if (IN(b0 + 1)) { pg8::Gemm g{(const bf16_t*)(p.ws + WS_H), (const bf16_t*)(p.ws + WS_WIN) + (size_t)l * N1 * 1024, NTOK, N1, 1024};
            pg8::StaticOrder S; S.init(NTOK, N1, gridDim.x, blockIdx.x); pg8::EpiWrap<EpiG1> E{&p, EpiG1{l}}; pg8::gemm_phase(l3, g, S, E); }
        SEAM(b0 + 1);
        if (IN(b0 + 2)) ph_prep(p, l, sm);
        SEAM(b0 + 2);
        if (IN(b0 + 3)) {
            auto gemm_one = [&](int samp, int pm, int pn) {
                pg8::Gemm g{samp ? (const bf16_t*)(p.ws + WS_L1024) : (const bf16_t*)(p.ws + WS_L256), samp ? (const bf16_t*)(p.ws + WS_ZF) + (size_t)8192 * 512 : (const bf16_t*)(p.ws + WS_ZF),
                            samp ? 1024 : 256, samp ? 512 : 8192, samp ? 2048 : 512};
                OneUnit S{pm, pn}; pg8::EpiWrap<EpiFnet> E{&p, EpiFnet{samp}}; pg8::gemm_phase(l3, g, S, E); };
            ph_mixer(p, l, lds, misc + 4, gemm_one);
        }
        SEAM(b0 + 3);
        if (IN(b0 + 4)) ph_finalize(p, l);
        SEAM(b0 + 4);
        if (IN(b0 + 5)) { pg8::Gemm g{(const bf16_t*)(p.ws + WS_H), (const bf16_t*)(p.ws + WS_WOUT) + (size_t)l * 1024 * 1024, NTOK, 1024, 1024};
            pg8::StaticOrder S; S.init(NTOK, 1024, gridDim.x, blockIdx.x); pg8::EpiWrap<EpiRes> E{&p, EpiRes{l, 2}}; pg8::gemm_phase(l3, g, S, E); }
        SEAM(b0 + 5);
        if (IN(b0 + 6)) ph_norm(p, l, 1);
        SEAM(b0 + 6);
        if (IN(b0 + 7)) { pg8::Gemm g{(const bf16_t*)(p.ws + WS_H), (const bf16_t*)(p.ws + WS_WF1) + (size_t)l * 5632 * 1024, NTOK, 5632, 1024};
            pg8::StaticOrder S; S.init(NTOK, 5632, gridDim.x, blockIdx.x); pg8::EpiFfn1 E{&p}; pg8::gemm_phase(l3, g, S, E); }
        SEAM(b0 + 7);
        if (IN(b0 + 8)) { pg8::Gemm g{(const bf16_t*)(p.ws + WS_UR), (const bf16_t*)(p.ws + WS_WF2) + (size_t)l * 1024 * 2816, NTOK, 1024, 2816};
            pg8::StaticOrder S; S.init(NTOK, 1024, gridDim.x, blockIdx.x); pg8::EpiWrap<EpiRes> E{&p, EpiRes{l, 5}}; pg8::gemm_phase(l3, g, S, E); }
        SEAM(b0 + 8);
    }
    if (IN(19)) ph_norm(p, 0, 2);
#undef IN
#undef SEAM
}

extern "C" void kernel_launch(void* const* d_in, const int* in_sizes, int n_in, void* d_out, int out_size, void* d_ws, size_t ws_size, hipStream_t stream) {
    static int grid = 0;
    if (grid == 0) {
        if (n_in != 29 || ws_size < WS_END) { fprintf(stderr, "kernel_launch: bad n_in %d or ws_size %zu (need %zu)\n", n_in, ws_size, (size_t)WS_END); grid = -1; return; }
        int dev = 0, cus = 0, per_cu = 0;
        hipGetDevice(&dev); hipDeviceGetAttribute(&cus, hipDeviceAttributeMultiprocessorCount, dev);
        if (hipFuncSetAttribute((const void*)mega, hipFuncAttributeMaxDynamicSharedMemorySize, LDS_BYTES) != hipSuccess) { fprintf(stderr, "kernel_launch: hipFuncSetAttribute failed\n"); grid = -1; return; }
        if (hipOccupancyMaxActiveBlocksPerMultiprocessor(&per_cu, (const void*)mega, 512, LDS_BYTES) != hipSuccess || per_cu < 1) { fprintf(stderr, "kernel_launch: occupancy query says %d\n", per_cu); per_cu = 1; }
        (void)hipGetLastError();
        grid = cus;
    }
    if (grid < 0) return;
    hipMemsetAsync((unsigned char*)d_ws + WS_CTL, 0, 16384, stream);
    Args a{};
    const float** f = (const float**)&a.p;
    for (int i = 0; i < 29; ++i) f[i] = (const float*)d_in[i];
    a.p.out = (float*)d_out; a.p.ws = (unsigned char*)d_ws;
#if ONE_LAUNCH
    a.ph_lo = 0; a.ph_hi = N_PHASES;
    hipLaunchKernelGGL(mega, dim3(grid), dim3(512), LDS_BYTES, stream, a);
#else
    for (int ph = 0; ph < N_PHASES; ++ph) { a.ph_lo = ph; a.ph_hi = ph + 1; hipLaunchKernelGGL(mega, dim3(grid), dim3(512), LDS_BYTES, stream, a); }
#endif
}
```

```cpp
#include <hip/hip_runtime.h>
#include <stdint.h>
#include <stdio.h>
#ifndef ONE_LAUNCH
#define ONE_LAUNCH 1
#endif
#ifndef PROBE_ID
#define PROBE_ID 0
#endif

typedef unsigned short bf16_t;

#define D_MODEL 1024
#define NTOK 10240
#define NPTOK 8192
#define TP 256
#define TS 1024
#define NSEQ 34
#define NH 6
#define N1 3072
#define C_DIFF 0
#define C_FNET 1152
#define C_RWKV 1664
#define C_END 3008
#define N_RWKV 1344
#define D_FF 2816
#define D_IN 2752

#define OUT_YP 0
#define OUT_YS 8388608
#define OUT_ST 10485760
#define OUT_CK 13631488
#define OUT_CV 19922944

#define OPS_REC 1792
#define OPS_TOK (6 * OPS_REC)

#define WS_WIN   ((size_t)0)
#define WS_WOUT  (WS_WIN + (size_t)2 * N1 * 1024 * 2)
#define WS_WF1   (WS_WOUT + (size_t)2 * 1024 * 1024 * 2)
#define WS_WF2   (WS_WF1 + (size_t)2 * 5632 * 1024 * 2)
#define WS_H     (WS_WF2 + (size_t)2 * 1024 * 2816 * 2)
#define WS_UD    (WS_H + (size_t)NTOK * 1024 * 2)
#define WS_ZF    (WS_UD + (size_t)NTOK * 1152 * 2)
#define WS_UR    (WS_ZF + (size_t)NTOK * 512 * 2)
#define WS_OPS   (WS_UR + (size_t)2 * NTOK * 384 * 4)
#define WS_MOD   (WS_OPS + (size_t)NTOK * OPS_TOK)
#define WS_L256  (WS_MOD + (size_t)2 * 3 * 6144 * 4)
#define WS_L1024 (WS_L256 + (size_t)256 * 512 * 2)
#define WS_CTL   (WS_L1024 + (size_t)1024 * 2048 * 2)
#define WS_ZS    (WS_CTL + (size_t)16384)
#define WS_SS    (WS_ZS + (size_t)2 * 2048 * 384 * 4)
#define WS_WLT   (WS_SS + (size_t)24 * 3 * 4096 * 4)
#define WLT_L    73728
#define WS_END   (WS_WLT + (size_t)2 * WLT_L * 2)
#define CTL_QUEUE 3584
static_assert(WS_END <= ((size_t)256 << 20), "workspace exceeds 256 MiB");

struct P {
    const float *x_prompt, *x_sample, *c, *state_rwkv, *cache_k, *cache_v, *c_ctx, *norm1_g, *norm2_g, *final_g;
    const float *w_mod, *b_mod, *w_in, *w_out, *shift_mu, *decay_w0, *decay_up, *iclr_a0, *iclr_up, *gate_up;
    const float *k_k, *k_a, *r_k, *lnx_g, *lnx_b, *diff_lambda, *subln_g, *w_ffn_in, *w_ffn_out;
    float* out;
    unsigned char* ws;
};

__device__ __forceinline__ bf16_t f2bf(float f) { unsigned u = __builtin_bit_cast(unsigned, f); return (bf16_t)((u + 0x7fffu + ((u >> 16) & 1u)) >> 16); }
__device__ __forceinline__ float bf2f(bf16_t b) { return __builtin_bit_cast(float, ((unsigned)b) << 16); }
__device__ __forceinline__ float sigmoidf_(float x) { return 1.f / (1.f + __expf(-x)); }
__device__ __forceinline__ float wave_sum(float v) {
#pragma unroll
    for (int o = 1; o < 64; o <<= 1) v += __shfl_xor(v, o);
    return v;
}
__device__ __forceinline__ int otid() { int t = threadIdx.x; asm volatile("" : "+v"(t)); return t; }
__device__ __forceinline__ int tok_cls(int tok) { return tok < NPTOK ? 0 : 1 + ((tok - NPTOK) >> 10); }
__device__ __forceinline__ const float* xin_row(const P& p, int tok) { return tok < NPTOK ? p.x_prompt + (size_t)tok * 1024 : p.x_sample + (size_t)(tok - NPTOK) * 1024; }
__device__ __forceinline__ float* X_row(const P& p, int tok) { return p.out + (size_t)tok * 1024; }
__device__ __forceinline__ const float* mod_vec(const P& p, int l, int cls, int which) { return (const float*)(p.ws + WS_MOD) + ((size_t)(l * 3 + cls) * 6144 + which * 1024); }
__device__ __forceinline__ void seq_info(int s, int& start, int& T) { if (s < 32) { start = s * TP; T = TP; } else { start = NPTOK + (s - 32) * TS; T = TS; } }
__device__ __forceinline__ void tok_info(int tok, int& s, int& t, int& T, int& start) {
    if (tok < NPTOK) { s = tok >> 8; t = tok & 255; T = TP; start = s * TP; } else { int r = tok - NPTOK; s = 32 + (r >> 10); t = r & 1023; T = TS; start = NPTOK + ((r >> 10) << 10); }
}

#define P0_MOD 192
#define P0_TILES_L 3136
struct P0Tile { const float* src; bf16_t* dst; int srcN, K, n0, k0, mode, scol; };
__device__ __forceinline__ P0Tile p0_decode(const P& p, int it) {
    P0Tile t; const int l = it / P0_TILES_L; it %= P0_TILES_L; int ntile, ktile; t.mode = 0; t.scol = 0;
    if (it < 768) { ntile = it / 16; ktile = it % 16; t.K = 1024; t.srcN = D_IN; t.src = p.w_in + (size_t)l * 1024 * D_IN; t.dst = (bf16_t*)(p.ws + WS_WIN) + (size_t)l * N1 * 1024;
        t.n0 = ntile * 64;
        if (t.n0 < C_FNET) { t.scol = 1344 + t.n0; } else if (t.n0 < C_RWKV) { t.mode = 1 + ((t.n0 - C_FNET) / 64) % 2; t.scol = 2496 + ((t.n0 - C_FNET) / 128) * 64; } else if (t.n0 < C_END) { t.scol = t.n0 - C_RWKV; } else t.mode = 3; }
    else if (it < 1024) { it -= 768; ntile = it / 16; ktile = it % 16; t.K = 1024; t.srcN = 1024; t.src = p.w_out + (size_t)l * 1024 * 1024; t.dst = (bf16_t*)(p.ws + WS_WOUT) + (size_t)l * 1024 * 1024; t.n0 = ntile * 64; t.scol = t.n0; }
    else if (it < 2432) { it -= 1024; ntile = it / 16; ktile = it % 16; t.K = 1024; t.srcN = 5632; t.src = p.w_ffn_in + (size_t)l * 1024 * 5632; t.dst = (bf16_t*)(p.ws + WS_WF1) + (size_t)l * 5632 * 1024; t.n0 = ntile * 64;
        const int pn = ntile >> 2, sub = ntile & 3; t.scol = (sub < 2) ? (128 * pn + 64 * sub) : (2816 + 128 * pn + 64 * (sub - 2)); }
    else { it -= 2432; ntile = it / 44; ktile = it % 44; t.K = 2816; t.srcN = 1024; t.src = p.w_ffn_out + (size_t)l * 2816 * 1024; t.dst = (bf16_t*)(p.ws + WS_WF2) + (size_t)l * 1024 * 2816; t.n0 = ntile * 64; t.scol = t.n0; }
    t.k0 = ktile * 64;
    return t;
}
#define P0_TGROUPS 1568
__device__ __forceinline__ void ph_prep0(const P& p, float* sm) {
    const int tid = otid();
    const int nitems = P0_MOD + P0_TGROUPS + 1280 + 10;
    for (int item = blockIdx.x; item < nitems; item += gridDim.x) {
        __syncthreads();
        if (item < P0_MOD) {
            const int l = item / 96, cg = item % 96, col = cg * 64 + (tid & 63), ks = tid >> 6;
            const float* W = p.w_mod + (size_t)l * 1024 * 6144;
            float* sl = sm + 2048;
            for (int e = tid; e < 3072; e += blockDim.x) { const int cls = e >> 10, k = e & 1023; const float c = cls == 0 ? p.c_ctx[k] : p.c[(cls - 1) * 1024 + k]; sl[e] = c * sigmoidf_(c); }
            __syncthreads();
            float a0 = 0.f, a1 = 0.f, a2 = 0.f;
#pragma unroll 8
            for (int k = ks * 128; k < ks * 128 + 128; ++k) {
                const float w = W[(size_t)k * 6144 + col];
                a0 += sl[k] * w; a1 += sl[1024 + k] * w; a2 += sl[2048 + k] * w;
            }
            sm[(ks * 3 + 0) * 64 + (tid & 63)] = a0; sm[(ks * 3 + 1) * 64 + (tid & 63)] = a1; sm[(ks * 3 + 2) * 64 + (tid & 63)] = a2;
            __syncthreads();
            if (tid < 192) {
                const int cls = tid >> 6, cc = tid & 63; float s = 0.f;
                for (int k = 0; k < 8; ++k) s += sm[(k * 3 + cls) * 64 + cc];
                const int colo = cg * 64 + cc;
                ((float*)(p.ws + WS_MOD))[(size_t)(l * 3 + cls) * 6144 + colo] = s + p.b_mod[(size_t)l * 6144 + colo];
            }
        } else if (item < P0_MOD + P0_TGROUPS) {
            const int it0 = (item - P0_MOD) * 4;
            float* cs = sm + 4 * 64 * 65;
            if (tid < 64) { cs[tid] = cospif((float)tid / 32.f); cs[64 + tid] = sinpif((float)tid / 32.f); }
#pragma unroll
            for (int u = 0; u < 4; ++u) {
                const P0Tile t = p0_decode(p, it0 + u); float* tile = sm + u * 64 * 65;
                if (t.mode != 3) {
#pragma unroll
                    for (int i = 0; i < 8; ++i) { const int k = i * 8 + (tid >> 6), n = tid & 63; tile[k * 65 + n] = t.src[(size_t)(t.k0 + k) * t.srcN + t.scol + n]; }
                }
            }
            __syncthreads();
#pragma unroll 1
            for (int u = 0; u < 4; ++u) {
                const P0Tile t = p0_decode(p, it0 + u); const float* tile = sm + u * 64 * 65;
                const int n = tid >> 3, k8 = (tid & 7) * 8;
                float v[8];
                if (t.mode == 0) {
#pragma unroll
                    for (int j = 0; j < 8; ++j) v[j] = tile[(k8 + j) * 65 + n];
                } else if (t.mode == 3) {
#pragma unroll
                    for (int j = 0; j < 8; ++j) v[j] = 0.f;
                } else {
#pragma unroll
                    for (int j = 0; j < 8; ++j) v[j] = 0.f;
                    for (int cc = 0; cc < 64; ++cc) {
                        const int idx = (n * cc) & 63;
                        const float tr = (t.mode == 1) ? cs[idx] * 0.125f : -cs[64 + idx] * 0.125f;
#pragma unroll
                        for (int j = 0; j < 8; ++j) v[j] += tile[(k8 + j) * 65 + cc] * tr;
                    }
                }
                uint4 o;
                o.x = (unsigned)f2bf(v[0]) | ((unsigned)f2bf(v[1]) << 16); o.y = (unsigned)f2bf(v[2]) | ((unsigned)f2bf(v[3]) << 16);
                o.z = (unsigned)f2bf(v[4]) | ((unsigned)f2bf(v[5]) << 16); o.w = (unsigned)f2bf(v[6]) | ((unsigned)f2bf(v[7]) << 16);
                *(uint4*)(t.dst + (size_t)(t.n0 + n) * t.K + t.k0 + k8) = o;
            }
        } else if (item >= P0_MOD + P0_TGROUPS + 1280) {
            const int it = item - (P0_MOD + P0_TGROUPS + 1280), l = it / 5, kind = it % 5, K = kind == 4 ? 64 : 32;
            const float* src = kind == 4 ? p.gate_up + (size_t)l * 64 * 384 : ((kind >> 1) ? p.iclr_up : p.decay_up) + (size_t)((l * 2 + (kind & 1)) * 32) * 384;
            bf16_t* dst = (bf16_t*)(p.ws + WS_WLT) + (size_t)l * WLT_L + kind * 12288;
            for (int e = tid; e < 384 * K; e += blockDim.x) { const int n = e % 384, k = e / 384; dst[n * K + k] = f2bf(src[(size_t)k * 384 + n]); }
        } else {
            const int r = item - (P0_MOD + P0_TGROUPS);
            const int T = r < 256 ? 256 : 1024, ft = r < 256 ? r : r - 256;
            bf16_t* L = r < 256 ? (bf16_t*)(p.ws + WS_L256) + (size_t)ft * 512 : (bf16_t*)(p.ws + WS_L1024) + (size_t)ft * 2048;
            const float sc = r < 256 ? 0.0625f : 0.03125f;
            for (int k = tid; k < 2 * T; k += blockDim.x) {
                const int t = k & (T - 1), idx = (ft * t) & (T - 1);
                const float ang = (float)(2 * idx) / (float)T;
                L[k] = f2bf((k < T ? cospif(ang) : sinpif(ang)) * sc);
            }
        }
    }
}

__device__ __forceinline__ void ph_norm(const P& p, int l, int which) {
    const int tid_ = otid(); const int lane = tid_ & 63, wv = tid_ >> 6, nw = blockDim.x >> 6;
    for (int row = blockIdx.x * nw + wv; row < NTOK; row += gridDim.x * nw) {
        const float* xr = (which == 0 && l == 0) ? xin_row(p, row) : X_row(p, row);
        float4 x[4]; float ss = 0.f;
#pragma unroll
        for (int i = 0; i < 4; ++i) { x[i] = *(const float4*)(xr + i * 256 + lane * 4); ss += x[i].x * x[i].x + x[i].y * x[i].y + x[i].z * x[i].z + x[i].w * x[i].w; }
        ss = wave_sum(ss);
        const float rstd = rsqrtf(ss * (1.f / 1024.f) + 1e-6f);
        if (which == 2) {
            float* o = p.out + (size_t)row * 1024;
#pragma unroll
            for (int i = 0; i < 4; ++i) { const float4 g = *(const float4*)(p.final_g + i * 256 + lane * 4);
                float4 y; y.x = x[i].x * rstd * g.x; y.y = x[i].y * rstd * g.y; y.z = x[i].z * rstd * g.z; y.w = x[i].w * rstd * g.w;
                *(float4*)(o + i * 256 + lane * 4) = y; }
        } else {
            const int cls = tok_cls(row);
            const float* g = (which == 0 ? p.norm1_g : p.norm2_g) + (size_t)l * 1024;
            const float* sh = mod_vec(p, l, cls, which == 0 ? 0 : 3);
            const float* sc = mod_vec(p, l, cls, which == 0 ? 1 : 4);
            bf16_t* h = (bf16_t*)(p.ws + WS_H) + (size_t)row * 1024;
#pragma unroll
            for (int i = 0; i < 4; ++i) { const int c = i * 256 + lane * 4;
                const float4 gg = *(const float4*)(g + c), s1 = *(const float4*)(sc + c), s0 = *(const float4*)(sh + c);
                const float y0 = x[i].x * rstd * gg.x * (1.f + s1.x) + s0.x, y1 = x[i].y * rstd * gg.y * (1.f + s1.y) + s0.y;
                const float y2 = x[i].z * rstd * gg.z * (1.f + s1.z) + s0.z, y3 = x[i].w * rstd * gg.w * (1.f + s1.w) + s0.w;
                uint2 o; o.x = (unsigned)f2bf(y0) | ((unsigned)f2bf(y1) << 16); o.y = (unsigned)f2bf(y2) | ((unsigned)f2bf(y3) << 16);
                *(uint2*)(h + c) = o; }
        }
    }
}

struct EpiG1 {
    int l;
    __device__ __forceinline__ void operator()(const P& p, int row, int col, const float* v) const {
        if (col < C_FNET) {
            bf16_t* o = (bf16_t*)(p.ws + WS_UD) + (size_t)row * 1152 + col;
            uint2 w; w.x = (unsigned)f2bf(v[0]) | ((unsigned)f2bf(v[1]) << 16); w.y = (unsigned)f2bf(v[2]) | ((unsigned)f2bf(v[3]) << 16);
            *(uint2*)o = w;
            if (row < NPTOK && col >= 384) {
                const int b = row >> 8, t = row & 255;
                float* dst = p.out + (col < 768 ? OUT_CK : OUT_CV) + ((size_t)(b * 2 + l) * 256 + t) * 384 + (col < 768 ? col - 384 : col - 768);
                *(float4*)dst = make_float4(v[0], v[1], v[2], v[3]);
            }
        } else if (col < C_RWKV) {
            const int cc = col - C_FNET, g = cc >> 7, half = (cc >> 6) & 1, fc = cc & 63;
            bf16_t* o;
            if (row < NPTOK) { const int sq = row >> 8, t = row & 255; o = (bf16_t*)(p.ws + WS_ZF) + ((size_t)(sq * 256 + g * 64 + fc) * 512 + half * 256 + t);
                o[0] = f2bf(v[0]); o[512] = f2bf(v[1]); o[1024] = f2bf(v[2]); o[1536] = f2bf(v[3]); }
            else { const int r = row - NPTOK, b = r >> 10, t = r & 1023; o = (bf16_t*)(p.ws + WS_ZF) + (size_t)8192 * 512 + ((size_t)(b * 256 + g * 64 + fc) * 2048 + half * 1024 + t);
                o[0] = f2bf(v[0]); o[2048] = f2bf(v[1]); o[4096] = f2bf(v[2]); o[6144] = f2bf(v[3]); }
        } else if (col < C_END) {
            bf16_t* o = (bf16_t*)(p.ws + WS_UR) + (size_t)row * N_RWKV + (col - C_RWKV);
            uint2 w; w.x = (unsigned)f2bf(v[0]) | ((unsigned)f2bf(v[1]) << 16); w.y = (unsigned)f2bf(v[2]) | ((unsigned)f2bf(v[3]) << 16);
            *(uint2*)o = w;
        }
    }
};
struct EpiRes {
    int l, which;
    __device__ __forceinline__ void operator()(const P& p, int row, int col, const float* v) const {
        const float* g = mod_vec(p, l, tok_cls(row), which) + col;
        const float* xo = (which == 2 && l == 0) ? xin_row(p, row) + col : X_row(p, row) + col;
        const float4 x = *(const float4*)xo; const float4 gg = *(const float4*)g;
        *(float4*)(X_row(p, row) + col) = make_float4(x.x + gg.x * v[0], x.y + gg.y * v[1], x.z + gg.z * v[2], x.w + gg.w * v[3]);
    }
};

#define PR_TT 40
#define PR_LS 200
typedef short bf16x8p __attribute__((ext_vector_type(8)));
typedef float f32x4p __attribute__((ext_vector_type(4)));
__device__ __forceinline__ void ph_prep(const P& p, int l, float* sm) {
    const int tid = otid(), lane = tid & 63, wv = tid >> 6;
    const bf16_t* UR = (const bf16_t*)(p.ws + WS_UR);
    bf16_t* linb = (bf16_t*)sm;
    const float* mu0 = p.shift_mu + (size_t)l * 2 * N_RWKV; const float* mu1 = mu0 + N_RWKV;
#if PROBE_ID
    unsigned long long* tsp = (unsigned long long*)(p.ws + WS_CTL + 15360) + 32;
#define PSTAMP(i) do { __syncthreads(); if (blockIdx.x == 0 && tid == 0 && l == 0) tsp[i] = __builtin_amdgcn_s_memrealtime(); } while (0)
#else
#define PSTAMP(i)
#endif
    PSTAMP(0);
    for (int tile = blockIdx.x; tile < NTOK / PR_TT; tile += gridDim.x) {
        const int tok0 = tile * PR_TT;
        __syncthreads();
        for (int e = tid; e < 48 * 192; e += blockDim.x) {
            const int tk = e / 192, j = e % 192, tok = tok0 + tk, col = 1152 + j;
            float x = 0.f;
            if (tk < PR_TT) {
                int s, t, T, st; tok_info(tok, s, t, T, st);
                const float xc = bf2f(UR[(size_t)tok * N_RWKV + col]);
                const float xp = t > 0 ? bf2f(UR[(size_t)(tok - 1) * N_RWKV + col]) : 0.f;
                const float xn = t < T - 1 ? bf2f(UR[(size_t)(tok + 1) * N_RWKV + col]) : 0.f;
                x = xc + mu0[col] * (xp - xc) + mu1[col] * (xn - xc);
                if (j < 64) x = tanhf(x); else if (j >= 128) x = sigmoidf_(x);
            }
            linb[tk * PR_LS + j] = f2bf(x);
        }
        __syncthreads();
        PSTAMP(1);
        {
            const int n = lane & 15, kg = lane >> 4;
            const bf16_t* WLT = (const bf16_t*)(p.ws + WS_WLT) + (size_t)l * WLT_L;
#pragma unroll 1
            for (int combo = wv; combo < 120; combo += 8) {
                const int kind = combo / 24, nt = combo % 24, ch = nt * 16 + n, h = ch >> 6, cl = ch & 63;
                const int K = kind == 4 ? 64 : 32, loff = kind == 4 ? 128 : (kind >> 1) * 64 + (kind & 1) * 32;
                const bf16_t* wrow = WLT + kind * 12288 + (size_t)ch * K + 8 * kg;
                const bf16x8p b0 = *(const bf16x8p*)wrow;
                bf16x8p b1 = b0; if (kind == 4) b1 = *(const bf16x8p*)(wrow + 32);
                float bias = 0.f;
                if (kind < 4) bias = ((kind >> 1) ? p.iclr_a0 : p.decay_w0)[(size_t)(l * 2 + (kind & 1)) * 384 + ch];
#pragma unroll
                for (int mt = 0; mt < 3; ++mt) {
                    f32x4p acc = {bias, bias, bias, bias};
                    const bf16x8p a0 = *(const bf16x8p*)(linb + (mt * 16 + n) * PR_LS + loff + 8 * kg);
                    acc = __builtin_amdgcn_mfma_f32_16x16x32_bf16(a0, b0, acc, 0, 0, 0);
                    if (kind == 4) { const bf16x8p a1 = *(const bf16x8p*)(linb + (mt * 16 + n) * PR_LS + loff + 32 + 8 * kg); acc = __builtin_amdgcn_mfma_f32_16x16x32_bf16(a1, b1, acc, 0, 0, 0); }
#pragma unroll
                    for (int r = 0; r < 4; ++r) {
                        const int tk = mt * 16 + kg * 4 + r;
                        if (tk < PR_TT) {
                            unsigned char* rec = p.ws + WS_OPS + (size_t)(tok0 + tk) * OPS_TOK + (size_t)h * OPS_REC;
                            if (kind == 4) ((bf16_t*)(rec + 1280))[192 + cl] = f2bf(acc[r]);
                            else { const float sg = sigmoidf_(acc[r]); ((float*)rec)[64 + (kind >> 1) * 128 + (kind & 1) * 64 + cl] = (kind >> 1) ? sg : __expf(-0.60653065971263342f * sg); }
                        }
                    }
                }
            }
        }
#if PROBE_ID
        if (blockIdx.x == 0 && tid == 0 && l == 0) tsp[2] = __builtin_amdgcn_s_memrealtime();
#endif
        if (tid < 384) {
            const int ch = tid, h = wv;
            unsigned char* rec0 = p.ws + WS_OPS + (size_t)tok0 * OPS_TOK + (size_t)h * OPS_REC;
            const float kkw = p.k_k[(size_t)l * 384 + ch];
            float m0c[3], m1c[3];
#pragma unroll
            for (int q = 0; q < 3; ++q) { m0c[q] = mu0[q * 384 + ch]; m1c[q] = mu1[q * 384 + ch]; }
#pragma unroll 8
            for (int tk = 0; tk < PR_TT; ++tk) {
                const int tok = tok0 + tk; int s, t, T, st; tok_info(tok, s, t, T, st);
                float rkv[3];
#pragma unroll
                for (int q = 0; q < 3; ++q) { const int col = q * 384 + ch;
                    const float xc = bf2f(UR[(size_t)tok * N_RWKV + col]);
                    const float xp = t > 0 ? bf2f(UR[(size_t)(tok - 1) * N_RWKV + col]) : 0.f;
                    const float xn = t < T - 1 ? bf2f(UR[(size_t)(tok + 1) * N_RWKV + col]) : 0.f;
                    rkv[q] = xc + m0c[q] * (xp - xc) + m1c[q] * (xn - xc); }
                const float kkr = rkv[1] * kkw;
                const float nrm = sqrtf(wave_sum(kkr * kkr));
                const float kk = kkr / fmaxf(nrm, 1e-12f);
                unsigned char* rec = rec0 + (size_t)tk * OPS_TOK;
                ((float*)rec)[lane] = -kk;
                bf16_t* rb = (bf16_t*)(rec + 1280);
                rb[lane] = f2bf(rkv[0]); rb[64 + lane] = f2bf(rkv[2]); rb[128 + lane] = f2bf(rkv[1]);
            }
        }
    }
    PSTAMP(3);
    bf16_t* UD = (bf16_t*)(p.ws + WS_UD);
    for (int e = blockIdx.x * blockDim.x + tid; e < 2048 * 384; e += gridDim.x * blockDim.x) {
        const int tk = e / 384, pi = e % 384;
        const int grp = pi >> 3, pr = pi & 7, col = grp * 16 + pr;
        const int axis = grp & 1;
        const int t = tk & 1023, pos = axis == 0 ? (t >> 6) : (t & 63);
        const float inv = __powf(10000.f, -(float)pr / 8.f);
        float sn, cs; __sincosf((float)pos * inv, &sn, &cs);
        bf16_t* ptr = UD + (size_t)(NPTOK + tk) * 1152 + col;
        const float x1 = bf2f(ptr[0]), x2 = bf2f(ptr[8]);
        ptr[0] = f2bf(x1 * cs - x2 * sn); ptr[8] = f2bf(x2 * cs + x1 * sn);
    }
    PSTAMP(4);
}

#define SC_TC 16
typedef float f32x2 __attribute__((ext_vector_type(2)));
template <int CTRL> __device__ __forceinline__ float dpp_add(float x) {
    return x + __builtin_bit_cast(float, __builtin_amdgcn_update_dpp(0, __builtin_bit_cast(int, x), CTRL, 0xf, 0xf, false));
}
__device__ __forceinline__ float reduce8(float x) { x = dpp_add<0xB1>(x); x = dpp_add<0x4E>(x); x = dpp_add<0x141>(x); return x; }
struct ScanStage { float nkk[4], w[4], a[4]; bf16_t r[4], v[4], k[4]; };
__device__ __forceinline__ void scan_load(const P& p, int h, int dir, int T, int start, int st_base, int ht, ScanStage& g) {
#pragma unroll
    for (int rpt = 0; rpt < 4; ++rpt) {
        const int e = rpt * 256 + ht, i = e >> 6, ch = e & 63;
        const int st = st_base + i, t = dir == 0 ? st : T - 1 - st, tok = start + t;
        const unsigned char* rec = p.ws + WS_OPS + (size_t)tok * OPS_TOK + (size_t)h * OPS_REC;
        const float* rf = (const float*)rec; const bf16_t* rb = (const bf16_t*)(rec + 1280);
        g.nkk[rpt] = rf[ch]; g.w[rpt] = rf[64 + dir * 64 + ch]; g.a[rpt] = rf[192 + dir * 64 + ch];
        g.r[rpt] = rb[ch]; g.v[rpt] = rb[64 + ch]; g.k[rpt] = rb[128 + ch];
    }
}
__device__ __forceinline__ void scan_store(const ScanStage& g, float ka, float vmul, int ht, float* ops) {
#pragma unroll
    for (int rpt = 0; rpt < 4; ++rpt) {
        const int e = rpt * 256 + ht, i = e >> 6, ch = e & 63;
        float* o = ops + i * 384;
        const float k = bf2f(g.k[rpt]);
        o[ch] = bf2f(g.r[rpt]); o[64 + ch] = g.nkk[rpt]; o[128 + ch] = bf2f(g.v[rpt]) * vmul; o[192 + ch] = g.w[rpt];
        o[256 + ch] = k * (1.f + (g.a[rpt] - 1.f) * ka); o[320 + ch] = -g.nkk[rpt] * g.a[rpt];
    }
}
struct StepOps { float4 r0, r1, nk0, nk1, w0, w1, kd0, kd1, ka0, ka1; float2 v; };
__device__ __forceinline__ void step_load(const float* o, int kq, int rp, StepOps& x) {
    x.r0 = *(const float4*)(o + kq * 8); x.r1 = *(const float4*)(o + kq * 8 + 4);
    x.nk0 = *(const float4*)(o + 64 + kq * 8); x.nk1 = *(const float4*)(o + 64 + kq * 8 + 4);
    x.w0 = *(const float4*)(o + 192 + kq * 8); x.w1 = *(const float4*)(o + 192 + kq * 8 + 4);
    x.kd0 = *(const float4*)(o + 256 + kq * 8); x.kd1 = *(const float4*)(o + 256 + kq * 8 + 4);
    x.ka0 = *(const float4*)(o + 320 + kq * 8); x.ka1 = *(const float4*)(o + 320 + kq * 8 + 4);
    x.v = *(const float2*)(o + 128 + 2 * rp);
}
#define F2LO(q) ((f32x2){(q).x, (q).y})
#define F2HI(q) ((f32x2){(q).z, (q).w})
__device__ __forceinline__ void step_compute(f32x2 (&S)[2][4], const StepOps& x, float (&yo)[2]) {
    const f32x2 nk[4] = {F2LO(x.nk0), F2HI(x.nk0), F2LO(x.nk1), F2HI(x.nk1)}, w[4] = {F2LO(x.w0), F2HI(x.w0), F2LO(x.w1), F2HI(x.w1)};
    const f32x2 kd[4] = {F2LO(x.kd0), F2HI(x.kd0), F2LO(x.kd1), F2HI(x.kd1)}, kk[4] = {F2LO(x.ka0), F2HI(x.ka0), F2LO(x.ka1), F2HI(x.ka1)};
    const f32x2 rr[4] = {F2LO(x.r0), F2HI(x.r0), F2LO(x.r1), F2HI(x.r1)};
    const float vv[2] = {x.v.x, x.v.y};
#pragma unroll
    for (int r = 0; r < 2; ++r) {
        f32x2 t = S[r][0] * nk[0]; t += S[r][1] * nk[1]; t += S[r][2] * nk[2]; t += S[r][3] * nk[3];
        const float sa = reduce8(t.x + t.y);
        const f32x2 sa2 = (f32x2){sa, sa}, v2b = (f32x2){vv[r], vv[r]};
        f32x2 y = (f32x2){0.f, 0.f};
#pragma unroll
        for (int e = 0; e < 4; ++e) { S[r][e] = S[r][e] * w[e] + v2b * kd[e] + sa2 * kk[e]; y += S[r][e] * rr[e]; }
        yo[r] = reduce8(y.x + y.y);
    }
}
__device__ __forceinline__ void ph_scan_job(const P& p, int l, int s, int h, int mode, int pdir, int seg, int st0, int nsteps, float* sm) {
    const int tid = otid(), half = tid >> 8, ht = tid & 255, kq = ht & 7, rp = ht >> 3;
    const int dir = mode == 0 ? half : pdir, kind = mode == 0 ? 0 : 1 + half;
    int start, T; seq_info(s, start, T);
    f32x2 S[2][4];
#pragma unroll
    for (int r = 0; r < 2; ++r)
#pragma unroll
        for (int e = 0; e < 4; ++e) S[r][e] = (f32x2){0.f, 0.f};
    if (kind == 0 && s >= 32) {
        const float* s0 = p.state_rwkv + ((((size_t)(s - 32) * 2 + l) * 2 + dir) * NH + h) * 4096 + (2 * rp) * 64 + kq * 8;
#pragma unroll
        for (int r = 0; r < 2; ++r)
#pragma unroll
            for (int e = 0; e < 4; ++e) S[r][e] = *(const f32x2*)(s0 + r * 64 + 2 * e);
    } else if (kind == 1) {
#pragma unroll
        for (int r = 0; r < 2; ++r)
#pragma unroll
            for (int e = 0; e < 4; ++e) { const int row = 2 * rp + r, k = 8 * kq + 2 * e; S[r][e] = (f32x2){row == k ? 1.f : 0.f, row == k + 1 ? 1.f : 0.f}; }
    }
    const float vmul = kind == 1 ? 0.f : 1.f;
    float* ybase = kind == 1 ? (float*)(p.ws + WS_ZS) + ((ptrdiff_t)dir * 2048 - (ptrdiff_t)NPTOK) * 384 : (float*)(p.ws + WS_UR) + (size_t)dir * NTOK * 384;
    ybase += h * 64 + 2 * rp;
    const float ka = p.k_a[(size_t)l * 384 + h * 64 + (ht & 63)];
    const int nc = nsteps / SC_TC;
    ScanStage g;
    __syncthreads();
    scan_load(p, h, dir, T, start, st0, ht, g);
    scan_store(g, ka, vmul, ht, sm + half * (SC_TC * 384));
    __syncthreads();
    for (int c = 0; c < nc; ++c) {
        const float* ops = sm + ((c & 1) * 2 + half) * (SC_TC * 384);
        if (c + 1 < nc) scan_load(p, h, dir, T, start, st0 + (c + 1) * SC_TC, ht, g);
        StepOps A, B;
        step_load(ops, kq, rp, A);
#pragma unroll 1
        for (int i = 0; i < SC_TC; i += 2) {
            float yo[2];
            step_load(ops + (i + 1) * 384, kq, rp, B);
            step_compute(S, A, yo);
            if (kq == 0) { const int st = st0 + c * SC_TC + i, t = dir == 0 ? st : T - 1 - st; *(float2*)(ybase + (size_t)(start + t) * 384) = make_float2(yo[0], yo[1]); }
            if (i + 2 < SC_TC) step_load(ops + (i + 2) * 384, kq, rp, A);
            step_compute(S, B, yo);
            if (kq == 0) { const int st = st0 + c * SC_TC + i + 1, t = dir == 0 ? st : T - 1 - st; *(float2*)(ybase + (size_t)(start + t) * 384) = make_float2(yo[0], yo[1]); }
        }
        if (c + 1 < nc) scan_store(g, ka, vmul, ht, sm + (((c + 1) & 1) * 2 + half) * (SC_TC * 384));
        __syncthreads();
    }
    float* so = nullptr;
    if (mode == 0) so = s < 32 ? p.out + OUT_ST + ((((size_t)s * 2 + l) * 2 + dir) * NH + h) * 4096
                              : (float*)(p.ws + WS_SS) + ((size_t)(((s - 32) * NH + h) * 2 + dir) * 3 + 0) * 4096;
    else if (seg == 1) so = (float*)(p.ws + WS_SS) + ((size_t)(((s - 32) * NH + h) * 2 + dir) * 3 + kind) * 4096;
    if (so) {
        so += (2 * rp) * 64 + kq * 8;
#pragma unroll
        for (int r = 0; r < 2; ++r)
#pragma unroll
            for (int e = 0; e < 4; ++e) *(f32x2*)(so + r * 64 + 2 * e) = S[r][e];
    }
}

#define SEG0_LEN 352
#define SEGX_LEN 336
__device__ __forceinline__ void ph_fixup(const P& p, float* sm) {
    const int tid = otid(), lane = tid & 63, wv = tid >> 6;
    for (int item4 = blockIdx.x; item4 < 192; item4 += gridDim.x) {
        const int item = item4 >> 2, qtr = item4 & 3;
        const int b = item / 24, h = (item % 24) >> 2, dir = (item >> 1) & 1, seg = 1 + (item & 1);
        const float* E0 = (const float*)(p.ws + WS_SS) + (size_t)(((b * NH + h) * 2 + dir) * 3) * 4096; const float* P1 = E0 + 4096; const float* Q1 = E0 + 8192;
        __syncthreads();
        { const int v = tid >> 3, kg = tid & 7;
          float acc[8];
          if (seg == 1) {
#pragma unroll
              for (int j = 0; j < 8; ++j) acc[j] = E0[v * 64 + kg * 8 + j];
          } else {
#pragma unroll
              for (int j = 0; j < 8; ++j) acc[j] = Q1[v * 64 + kg * 8 + j];
#pragma unroll 8
              for (int i = 0; i < 64; ++i) { const float e = E0[v * 64 + i]; const float4 pa = *(const float4*)(P1 + i * 64 + kg * 8), pb = *(const float4*)(P1 + i * 64 + kg * 8 + 4);
                  acc[0] += e * pa.x; acc[1] += e * pa.y; acc[2] += e * pa.z; acc[3] += e * pa.w; acc[4] += e * pb.x; acc[5] += e * pb.y; acc[6] += e * pb.z; acc[7] += e * pb.w; }
          }
#pragma unroll
          for (int j = 0; j < 8; ++j) sm[v * 65 + kg * 8 + j] = acc[j]; }
        __syncthreads();
        float Srow[64];
#pragma unroll
        for (int i = 0; i < 64; ++i) Srow[i] = sm[lane * 65 + i];
        const int st0 = (seg == 1 ? SEG0_LEN : SEG0_LEN + SEGX_LEN) + qtr * (SEGX_LEN / 4);
        const float* Zb = (const float*)(p.ws + WS_ZS) + (size_t)dir * 2048 * 384; float* Yb = (float*)(p.ws + WS_UR) + (size_t)dir * NTOK * 384;
#pragma unroll 1
        for (int q = wv * 4; q < SEGX_LEN / 4; q += 32) {
            int zi[4]; float yv[4]; float* yp[4]; bool ok[4];
#pragma unroll
            for (int u = 0; u < 4; ++u) {
                ok[u] = (q + u) < SEGX_LEN / 4;
                const int st = st0 + (ok[u] ? q + u : 0), t = dir ? 1023 - st : st, stok = b * 1024 + t;
                zi[u] = __builtin_bit_cast(int, Zb[(size_t)stok * 384 + h * 64 + lane]);
                yp[u] = Yb + (size_t)(NPTOK + stok) * 384 + h * 64 + lane; yv[u] = *yp[u];
            }
#pragma unroll
            for (int i = 0; i < 64; ++i)
#pragma unroll
                for (int u = 0; u < 4; ++u) yv[u] += Srow[i] * __builtin_bit_cast(float, __builtin_amdgcn_readlane(zi[u], i));
#pragma unroll
            for (int u = 0; u < 4; ++u) if (ok[u]) *yp[u] = yv[u];
        }
    }
}

__device__ __forceinline__ void ph_finalize(const P& p, int l) {
    const int tid_ = otid(); const int lane = tid_ & 63, wv = tid_ >> 6, nw = blockDim.x >> 6;
    const float* Yb = (const float*)(p.ws + WS_UR);
    bf16_t* MIX = (bf16_t*)(p.ws + WS_H);
    for (int it0 = (blockIdx.x * nw + wv) * 4; it0 < NTOK * NH; it0 += gridDim.x * nw * 4) {
        float y[4], a0[4], a1[4], r[4], vv[4], k[4], g[4];
        int tokv[4], chv[4];
#pragma unroll
        for (int u = 0; u < 4; ++u) {
            const int it = it0 + u, tok = it / NH, h = it % NH, ch = h * 64 + lane; tokv[u] = tok; chv[u] = ch;
            y[u] = Yb[(size_t)tok * 384 + ch] + Yb[((size_t)NTOK + tok) * 384 + ch];
            const unsigned char* rec = p.ws + WS_OPS + (size_t)tok * OPS_TOK + (size_t)h * OPS_REC;
            const float* rf = (const float*)rec; const bf16_t* rb = (const bf16_t*)(rec + 1280);
            a0[u] = rf[192 + lane]; a1[u] = rf[256 + lane];
            r[u] = bf2f(rb[lane]); vv[u] = bf2f(rb[64 + lane]); k[u] = bf2f(rb[128 + lane]); g[u] = bf2f(rb[192 + lane]);
        }
        float mu[4], var[4], bs[4];
#pragma unroll
        for (int u = 0; u < 4; ++u) mu[u] = y[u];
#pragma unroll
        for (int o = 1; o < 64; o <<= 1)
#pragma unroll
            for (int u = 0; u < 4; ++u) mu[u] += __shfl_xor(mu[u], o);
#pragma unroll
        for (int u = 0; u < 4; ++u) { mu[u] *= (1.f / 64.f); y[u] -= mu[u]; var[u] = y[u] * y[u];
            const float ka = p.k_a[(size_t)l * 384 + chv[u]];
            bs[u] = r[u] * (k[u] * (1.f + (a0[u] - 1.f) * ka) + k[u] * (1.f + (a1[u] - 1.f) * ka)) * p.r_k[(size_t)l * 384 + chv[u]]; }
#pragma unroll
        for (int o = 1; o < 64; o <<= 1)
#pragma unroll
            for (int u = 0; u < 4; ++u) { var[u] += __shfl_xor(var[u], o); bs[u] += __shfl_xor(bs[u], o); }
#pragma unroll
        for (int u = 0; u < 4; ++u) {
            const float yn = y[u] * rsqrtf(var[u] * (1.f / 64.f) + 64e-5f) * p.lnx_g[(size_t)l * 384 + chv[u]] + p.lnx_b[(size_t)l * 384 + chv[u]];
            MIX[(size_t)tokv[u] * 1024 + chv[u]] = f2bf((yn + bs[u] * vv[u]) * g[u]);
        }
    }
}

#define LAS __attribute__((address_space(3)))
namespace pg8 {
typedef short bf16x8 __attribute__((ext_vector_type(8)));
typedef float f32x4 __attribute__((ext_vector_type(4)));
constexpr int BM = 256, BK = 64, HALF = 128, HTB = HALF * BK * 2, STAGE_BYTES = 8 * HTB, NXCD = 8, WGM = 8;
__host__ __device__ __forceinline__ int lds_byte(int r, int c) { const int st = (r >> 4) * 2 + (c >> 5), rr = r & 15, cc = c & 31, ob = rr * 64 + cc * 2; return st * 1024 + (ob ^ (((ob >> 9) & 1) << 5)); }
__host__ __device__ __forceinline__ void stage_rc(int b, int& R, int& C) { const int st = b / 1024, sb = b % 1024, swz = sb ^ (((sb >> 9) & 1) << 5); R = (st >> 1) * 16 + swz / 64; C = (st & 1) * 32 + (swz % 64) / 2; }
struct Unit { int pm, pn; };
struct Gemm { const bf16_t* A; const bf16_t* Bt; int M, N, K; };
struct StaticOrder {
    int nM, nN, nwg, G, c;
    __device__ void init(int M, int N, int G_, int c_) { nM = M / BM; nN = N / BM; nwg = nM * nN; G = G_; c = c_; }
    __device__ bool next(int i, Unit& u) const {
        const long L = (long)i * G + c; if (L >= nwg) return false;
        int wgid = (int)L; { const int q = nwg / NXCD, r = nwg % NXCD, xcd = wgid % NXCD, off = wgid / NXCD; wgid = (xcd < r ? xcd * (q + 1) : r * (q + 1) + (xcd - r) * q) + off; }
        const int nig = WGM * nN, gid = wgid / nig, fm = gid * WGM, gsz = (nM - fm) < WGM ? (nM - fm) : WGM;
        u.pm = fm + ((wgid % nig) % gsz); u.pn = (wgid % nig) / gsz; return true;
    }
};
template <class Epi, class Sched>
__device__ __forceinline__ void gemm_phase(LAS unsigned char* lds, const Gemm g, const Sched& S, const Epi& E) {
    int tid_ = threadIdx.x; asm volatile("" : "+v"(tid_));
    const int tid = tid_, wid = __builtin_amdgcn_readfirstlane(tid >> 6), lane = tid & 63, wr = wid >> 2, wc = wid & 3, fr = lane & 15, fq = lane >> 4;
    const int K = g.K, nt = K / BK;
    unsigned voffA[2], voffB[2];
#pragma unroll
    for (int i = 0; i < 2; ++i) { int R, C; stage_rc(tid * 16 + i * 8192, R, C); voffA[i] = (unsigned)(R * K + C) * 2u; voffB[i] = (unsigned)(R * K + C) * 2u; }
    const size_t kstep = (size_t)(BK * 2);
    const size_t hstep = (size_t)HALF * K * 2;
    const size_t tstep = 2 * hstep;
    const unsigned ldsw = (unsigned)wid * 1024u;
    const int aoff = lds_byte(wr * 64 + fr, fq * 8), boff = lds_byte(wc * 32 + fr, fq * 8);
#define PG8_SA(b, h) (((b) * 2 + (h)) * HTB)
#define PG8_SB(b, h) ((4 + (b) * 2 + (h)) * HTB)
#define PG8_STAGE(bufoff, gbase, voff) do { _Pragma("unroll") for (int _i = 0; _i < 2; ++_i) \
        __builtin_amdgcn_global_load_lds((const unsigned*)((const char*)(gbase) + (voff)[_i]), (LAS unsigned*)(lds + (bufoff) + ldsw + _i * 8192), 16, 0, 0); } while (0)
#define PG8_LDA(dst, b, h) do { _Pragma("unroll") for (int m = 0; m < 4; ++m) _Pragma("unroll") for (int k = 0; k < 2; ++k) dst[m][k] = *(const LAS bf16x8*)(lds + PG8_SA(b, h) + aoff + m * 2048 + k * 1024); } while (0)
#define PG8_LDB(dst, b, h) do { _Pragma("unroll") for (int n = 0; n < 2; ++n) _Pragma("unroll") for (int k = 0; k < 2; ++k) dst[n][k] = *(const LAS bf16x8*)(lds + PG8_SB(b, h) + boff + n * 2048 + k * 1024); } while (0)
#define PG8_MMA(ai, bj, At, Bt) do { __builtin_amdgcn_s_setprio(1); _Pragma("unroll") for (int m = 0; m < 4; ++m) _Pragma("unroll") for (int n = 0; n < 2; ++n) _Pragma("unroll") for (int k = 0; k < 2; ++k) \
        acc[ai][bj][m][n] = __builtin_amdgcn_mfma_f32_16x16x32_bf16(Bt[n][k], At[m][k], acc[ai][bj][m][n], 0, 0, 0); __builtin_amdgcn_s_setprio(0); } while (0)
#define PG8_WAIT_V(n) asm volatile("s_waitcnt vmcnt(" #n ")" ::: "memory")
#define PG8_WAIT_L(n) asm volatile("s_waitcnt lgkmcnt(" #n ")" ::: "memory")
#define PG8_BAR __builtin_amdgcn_s_barrier()
#define PG8_SCHED __builtin_amdgcn_sched_barrier(0)
    Unit cur, nxt; int ui = 0;
    if (!S.next(0, cur)) return;
    f32x4 acc[2][2][4][2];
#pragma unroll
    for (int a = 0; a < 2; ++a)
#pragma unroll
        for (int b = 0; b < 2; ++b)
#pragma unroll
            for (int m = 0; m < 4; ++m)
#pragma unroll
                for (int n = 0; n < 2; ++n) acc[a][b][m][n] = (f32x4){0.f, 0.f, 0.f, 0.f};
    bf16x8 At[4][2], B0[2][2], B1[2][2];
    const char* cA = (const char*)g.A + (size_t)cur.pm * tstep; const char* cB = (const char*)g.Bt + (size_t)cur.pn * tstep;
    PG8_STAGE(PG8_SB(0, 0), cB, voffB); PG8_STAGE(PG8_SA(0, 0), cA, voffA); PG8_STAGE(PG8_SB(0, 1), cB + hstep, voffB); PG8_STAGE(PG8_SA(0, 1), cA + hstep, voffA);
    if (wr == 1) PG8_BAR;
    PG8_WAIT_V(4); PG8_BAR;
    PG8_STAGE(PG8_SB(1, 0), cB + kstep, voffB); PG8_STAGE(PG8_SA(1, 0), cA + kstep, voffA); PG8_STAGE(PG8_SB(1, 1), cB + hstep + kstep, voffB);
    PG8_WAIT_V(6); PG8_BAR;
    for (;;) {
        const bool has_next = S.next(ui + 1, nxt);
        const char* nA = has_next ? (const char*)g.A + (size_t)nxt.pm * tstep : cA; const char* nB = has_next ? (const char*)g.Bt + (size_t)nxt.pn * tstep : cB;
        for (int t = 0; t < nt; t += 2) {
            const bool last = (t == nt - 2);
            const char* a1 = cA + (size_t)(t + 1) * kstep;
            const char* a2 = last ? nA : cA + (size_t)(t + 2) * kstep; const char* b2 = last ? nB : cB + (size_t)(t + 2) * kstep;
            const char* a3 = a2 + kstep; const char* b3 = b2 + kstep;
            PG8_LDB(B0, 0, 0); PG8_SCHED; PG8_LDA(At, 0, 0); PG8_STAGE(PG8_SA(1, 1), a1 + hstep, voffA);
            PG8_WAIT_L(8); PG8_BAR; PG8_WAIT_L(0); PG8_MMA(0, 0, At, B0); PG8_BAR; PG8_SCHED;
            PG8_LDB(B1, 0, 1); PG8_STAGE(PG8_SB(0, 0), b2, voffB);
            PG8_BAR; PG8_WAIT_L(0); PG8_MMA(0, 1, At, B1); PG8_BAR;
            PG8_LDA(At, 0, 1); PG8_STAGE(PG8_SA(0, 0), a2, voffA);
            PG8_BAR; PG8_WAIT_L(0); PG8_MMA(1, 0, At, B0); PG8_BAR; PG8_SCHED;
            PG8_STAGE(PG8_SB(0, 1), b2 + hstep, voffB);
            PG8_WAIT_V(6); PG8_BAR; PG8_MMA(1, 1, At, B1); PG8_BAR;
            PG8_LDB(B0, 1, 0); PG8_SCHED; PG8_LDA(At, 1, 0); PG8_STAGE(PG8_SA(0, 1), a2 + hstep, voffA);
            PG8_WAIT_L(8); PG8_BAR; PG8_WAIT_L(0); PG8_MMA(0, 0, At, B0); PG8_BAR; PG8_SCHED;
            PG8_LDB(B1, 1, 1); PG8_STAGE(PG8_SB(1, 0), b3, voffB);
            PG8_BAR; PG8_WAIT_L(0); PG8_MMA(0, 1, At, B1); PG8_BAR;
            PG8_LDA(At, 1, 1); PG8_STAGE(PG8_SA(1, 0), a3, voffA);
            PG8_BAR; PG8_WAIT_L(0); PG8_MMA(1, 0, At, B0); PG8_BAR; PG8_SCHED;
            PG8_STAGE(PG8_SB(1, 1), b3 + hstep, voffB);
            PG8_WAIT_V(6); PG8_BAR; PG8_MMA(1, 1, At, B1); PG8_BAR;
        }
        E(acc, cur, wr, wc, fr, fq);
        if (!has_next) break;
#pragma unroll
        for (int a = 0; a < 2; ++a)
#pragma unroll
            for (int b = 0; b < 2; ++b)
#pragma unroll
                for (int m = 0; m < 4; ++m)
#pragma unroll
                    for (int n = 0; n < 2; ++n) acc[a][b][m][n] = (f32x4){0.f, 0.f, 0.f, 0.f};
        cur = nxt; cA = nA; cB = nB; ++ui;
    }
    PG8_WAIT_V(0);
    if (wr == 0) PG8_BAR;
    PG8_BAR;
#undef PG8_SA
#undef PG8_SB
#undef PG8_STAGE
#undef PG8_LDA
#undef PG8_LDB
#undef PG8_MMA
#undef PG8_WAIT_V
#undef PG8_WAIT_L
#undef PG8_BAR
#undef PG8_SCHED
}
template <class F> struct EpiWrap {
    const P* p; F f;
    __device__ __forceinline__ void operator()(const f32x4 (&acc)[2][2][4][2], const Unit& u, int wr, int wc, int fr, int fq) const {
        const int row0 = u.pm * BM + wr * 64 + fr, col0 = u.pn * BM + wc * 32 + 4 * fq;
#pragma unroll
        for (int ai = 0; ai < 2; ++ai)
#pragma unroll
            for (int m = 0; m < 4; ++m)
#pragma unroll
                for (int bj = 0; bj < 2; ++bj)
#pragma unroll
                    for (int n = 0; n < 2; ++n) {
                        const f32x4 a = acc[ai][bj][m][n]; const float v[4] = {a[0], a[1], a[2], a[3]};
                        f(*p, row0 + ai * HALF + m * 16, col0 + bj * HALF + n * 16, v);
                    }
    }
};
struct EpiFfn1 {
    const P* p;
    __device__ __forceinline__ void operator()(const f32x4 (&acc)[2][2][4][2], const Unit& u, int wr, int wc, int fr, int fq) const {
        const int row0 = u.pm * BM + wr * 64 + fr, j0 = u.pn * 128 + wc * 32 + 4 * fq;
        bf16_t* HA = (bf16_t*)(p->ws + WS_UR);
#pragma unroll
        for (int ai = 0; ai < 2; ++ai)
#pragma unroll
            for (int m = 0; m < 4; ++m)
#pragma unroll
                for (int n = 0; n < 2; ++n) {
                    const f32x4 g = acc[ai][0][m][n], up = acc[ai][1][m][n]; float h[4];
#pragma unroll
                    for (int e = 0; e < 4; ++e) h[e] = g[e] * sigmoidf_(g[e]) * up[e];
                    uint2 w; w.x = (unsigned)f2bf(h[0]) | ((unsigned)f2bf(h[1]) << 16); w.y = (unsigned)f2bf(h[2]) | ((unsigned)f2bf(h[3]) << 16);
                    *(uint2*)(HA + (size_t)(row0 + ai * HALF + m * 16) * D_FF + j0 + n * 16) = w;
                }
    }
};
}


typedef short bf16x8_t __attribute__((ext_vector_type(8)));
typedef short bf16x4_t __attribute__((ext_vector_type(4)));
typedef float f32x16_t __attribute__((ext_vector_type(16)));
#define AT_KS_BYTES (256 * 72 * 2)
__device__ __forceinline__ unsigned pk_bf16(float lo, float hi) { return (unsigned)f2bf(lo) | ((unsigned)f2bf(hi) << 16); }
__device__ __forceinline__ void attn_stage(const P& p, int l, int s, int h, int start, int nctx, int chunk, bool withV, bf16_t* Ks, bf16_t* Vt, int tid) {
    const int key = tid >> 1, half = tid & 1, j = chunk * 256 + key;
    if (j < nctx) {
        const size_t base = (((size_t)(s - 32) * 2 + l) * 512 + j) * 384 + h * 64 + half * 32;
        const float4* kp = (const float4*)(p.cache_k + base);
#pragma unroll
        for (int i = 0; i < 4; ++i) { const float4 a = kp[2 * i], b = kp[2 * i + 1]; uint4 o; o.x = pk_bf16(a.x, a.y); o.y = pk_bf16(a.z, a.w); o.z = pk_bf16(b.x, b.y); o.w = pk_bf16(b.z, b.w);
            *(uint4*)(Ks + key * 72 + half * 32 + i * 8) = o; }
        if (withV) { const float4* vp = (const float4*)(p.cache_v + base);
#pragma unroll
            for (int i = 0; i < 8; ++i) { const float4 a = vp[i]; bf16_t* d = Vt + (half * 32 + i * 4) * 260 + key; d[0] = f2bf(a.x); d[260] = f2bf(a.y); d[520] = f2bf(a.z); d[780] = f2bf(a.w); } }
    } else {
        const bf16_t* UD = (const bf16_t*)(p.ws + WS_UD);
        const size_t base = (size_t)(start + j - nctx) * 1152 + h * 64 + half * 32;
        const uint4* kp = (const uint4*)(UD + base + 384);
#pragma unroll
        for (int i = 0; i < 4; ++i) *(uint4*)(Ks + key * 72 + half * 32 + i * 8) = kp[i];
        if (withV) { const uint4* vp = (const uint4*)(UD + base + 768);
#pragma unroll
            for (int i = 0; i < 4; ++i) { const uint4 u = vp[i]; const unsigned w[4] = {u.x, u.y, u.z, u.w}; bf16_t* d = Vt + (half * 32 + i * 8) * 260 + key;
#pragma unroll
                for (int e = 0; e < 4; ++e) { d[(2 * e) * 260] = (bf16_t)(w[e] & 0xffff); d[(2 * e + 1) * 260] = (bf16_t)(w[e] >> 16); } } }
    }
}
__device__ __forceinline__ void attn_item(const P& p, int l, int item, unsigned char* lds, float lam, float lam_init) {
    const int tid = otid(), lane = tid & 63, wv = tid >> 6, n = lane & 31, hh = lane >> 5;
    int s, h, qb;
    if (item < 48) { s = 32 + item / 24; h = (item % 24) / 4; qb = item & 3; } else { const int r = item - 48; s = r / 6; h = r % 6; qb = 0; }
    int start, T; seq_info(s, start, T);
    const int nctx = s >= 32 ? 512 : 0, nchunks = (nctx + T) >> 8;
    bf16_t* Ks = (bf16_t*)lds; bf16_t* Vt = (bf16_t*)(lds + AT_KS_BYTES);
    const bf16_t* UD = (const bf16_t*)(p.ws + WS_UD);
    const int qtok = start + qb * 256 + wv * 32 + n;
    bf16x8_t Qf[2][2];
#pragma unroll
    for (int m = 0; m < 2; ++m)
#pragma unroll
        for (int si = 0; si < 2; ++si) Qf[m][si] = *(const bf16x8_t*)(UD + (size_t)qtok * 1152 + h * 64 + m * 32 + si * 16 + hh * 8);
    const float c = 0.17677669529663687f * 1.4426950408889634f;
    float m0 = -1e30f, m1 = -1e30f, l0 = 0.f, l1 = 0.f;
    for (int ch = 0; ch < nchunks; ++ch) {
        __syncthreads();
        attn_stage(p, l, s, h, start, nctx, ch, false, Ks, Vt, tid);
        __syncthreads();
#pragma unroll 1
        for (int kt = 0; kt < 8; ++kt) {
            f32x16_t S0 = {0,0,0,0,0,0,0,0,0,0,0,0,0,0,0,0}, S1 = S0;
#pragma unroll
            for (int si = 0; si < 2; ++si) {
                const bf16x8_t k0 = *(const bf16x8_t*)(Ks + (kt * 32 + n) * 72 + si * 16 + hh * 8);
                const bf16x8_t k1 = *(const bf16x8_t*)(Ks + (kt * 32 + n) * 72 + 32 + si * 16 + hh * 8);
                S0 = __builtin_amdgcn_mfma_f32_32x32x16_bf16(k0, Qf[0][si], S0, 0, 0, 0);
                S1 = __builtin_amdgcn_mfma_f32_32x32x16_bf16(k1, Qf[1][si], S1, 0, 0, 0);
            }
            float t0 = S0[0], t1 = S1[0];
#pragma unroll
            for (int r = 1; r < 16; ++r) { t0 = fmaxf(t0, S0[r]); t1 = fmaxf(t1, S1[r]); }
            const float n0 = fmaxf(m0, t0), n1 = fmaxf(m1, t1);
            float a0 = 0.f, a1 = 0.f;
#pragma unroll
            for (int r = 0; r < 16; ++r) { a0 += __builtin_amdgcn_exp2f((S0[r] - n0) * c); a1 += __builtin_amdgcn_exp2f((S1[r] - n1) * c); }
            l0 = l0 * __builtin_amdgcn_exp2f((m0 - n0) * c) + a0; l1 = l1 * __builtin_amdgcn_exp2f((m1 - n1) * c) + a1;
            m0 = n0; m1 = n1;
        }
    }
    {
        const float mo0 = __shfl_xor(m0, 32), lo0 = __shfl_xor(l0, 32), mo1 = __shfl_xor(m1, 32), lo1 = __shfl_xor(l1, 32);
        const float M0 = fmaxf(m0, mo0), M1 = fmaxf(m1, mo1);
        l0 = l0 * __builtin_amdgcn_exp2f((m0 - M0) * c) + lo0 * __builtin_amdgcn_exp2f((mo0 - M0) * c);
        l1 = l1 * __builtin_amdgcn_exp2f((m1 - M1) * c) + lo1 * __builtin_amdgcn_exp2f((mo1 - M1) * c);
        m0 = M0; m1 = M1;
    }
    const float i0 = 1.f / l0, i1 = lam / l1;
    f32x16_t O0 = {0,0,0,0,0,0,0,0,0,0,0,0,0,0,0,0}, O1 = O0;
    for (int ch = 0; ch < nchunks; ++ch) {
        __syncthreads();
        attn_stage(p, l, s, h, start, nctx, ch, true, Ks, Vt, tid);
        __syncthreads();
#pragma unroll 1
        for (int kt = 0; kt < 8; ++kt) {
            f32x16_t S0 = {0,0,0,0,0,0,0,0,0,0,0,0,0,0,0,0}, S1 = S0;
#pragma unroll
            for (int si = 0; si < 2; ++si) {
                const bf16x8_t k0 = *(const bf16x8_t*)(Ks + (kt * 32 + n) * 72 + si * 16 + hh * 8);
                const bf16x8_t k1 = *(const bf16x8_t*)(Ks + (kt * 32 + n) * 72 + 32 + si * 16 + hh * 8);
                S0 = __builtin_amdgcn_mfma_f32_32x32x16_bf16(k0, Qf[0][si], S0, 0, 0, 0);
                S1 = __builtin_amdgcn_mfma_f32_32x32x16_bf16(k1, Qf[1][si], S1, 0, 0, 0);
            }
            float pw[16];
#pragma unroll
            for (int r = 0; r < 16; ++r) pw[r] = __builtin_amdgcn_exp2f((S0[r] - m0) * c) * i0 - __builtin_amdgcn_exp2f((S1[r] - m1) * c) * i1;
#pragma unroll
            for (int si = 0; si < 2; ++si) {
                union { unsigned u[4]; bf16x8_t v; } pf;
#pragma unroll
                for (int e = 0; e < 4; ++e) pf.u[e] = pk_bf16(pw[8 * si + 2 * e], pw[8 * si + 2 * e + 1]);
                union { bf16x4_t h2[2]; bf16x8_t v; } va, vb;
                const bf16_t* v0 = Vt + n * 260 + kt * 32 + si * 16 + hh * 4;
                va.h2[0] = *(const bf16x4_t*)v0; va.h2[1] = *(const bf16x4_t*)(v0 + 8);
                vb.h2[0] = *(const bf16x4_t*)(v0 + 32 * 260); vb.h2[1] = *(const bf16x4_t*)(v0 + 32 * 260 + 8);
                O0 = __builtin_amdgcn_mfma_f32_32x32x16_bf16(va.v, pf.v, O0, 0, 0, 0);
                O1 = __builtin_amdgcn_mfma_f32_32x32x16_bf16(vb.v, pf.v, O1, 0, 0, 0);
            }
        }
    }
    float ss = 0.f;
#pragma unroll
    for (int r = 0; r < 16; ++r) ss += O0[r] * O0[r] + O1[r] * O1[r];
    ss += __shfl_xor(ss, 32);
    const float rs = rsqrtf(ss * (1.f / 64.f) + 1e-5f) * (1.f - lam_init);
    bf16_t* mo = (bf16_t*)(p.ws + WS_H) + (size_t)qtok * 1024 + 384 + h * 64;
    const float* sg = p.subln_g + (size_t)l * 64;
#pragma unroll
    for (int g = 0; g < 4; ++g) {
        const int vd = 8 * g + 4 * hh;
        uint2 w0, w1;
        w0.x = pk_bf16(O0[4 * g] * rs * sg[vd], O0[4 * g + 1] * rs * sg[vd + 1]); w0.y = pk_bf16(O0[4 * g + 2] * rs * sg[vd + 2], O0[4 * g + 3] * rs * sg[vd + 3]);
        w1.x = pk_bf16(O1[4 * g] * rs * sg[32 + vd], O1[4 * g + 1] * rs * sg[32 + vd + 1]); w1.y = pk_bf16(O1[4 * g + 2] * rs * sg[32 + vd + 2], O1[4 * g + 3] * rs * sg[32 + vd + 3]);
        *(uint2*)(mo + vd) = w0; *(uint2*)(mo + 32 + vd) = w1;
    }
}

struct EpiFnet {
    int samp;
    __device__ __forceinline__ void operator()(const P& p, int row, int col, const float* v) const {
        const int sq = col >> 8, ch = col & 255;
        const int tok = samp ? NPTOK + sq * 1024 + row : sq * 256 + row;
        uint2 w; w.x = pk_bf16(v[0], v[1]); w.y = pk_bf16(v[2], v[3]);
        *(uint2*)((bf16_t*)(p.ws + WS_H) + (size_t)tok * 1024 + 768 + ch) = w;
    }
};
struct OneUnit { int pm, pn; __device__ bool next(int i, pg8::Unit& u) const { if (i) return false; u.pm = pm; u.pn = pn; return true; } };

#define MX_ITEMS 532
template <class GemmFn>
__device__ __forceinline__ void ph_mixer(const P& p, int l, unsigned char* lds, volatile LAS unsigned* slot, GemmFn gemm_one) {
    const float lam_init = 0.8f - 0.6f * __expf(-0.3f * (float)l);
    float lam;
    { const float* lp = p.diff_lambda + (size_t)l * 128; float s01 = 0.f, s23 = 0.f;
      for (int d = 0; d < 32; ++d) { s01 += lp[d] * lp[32 + d]; s23 += lp[64 + d] * lp[96 + d]; }
      lam = __expf(s01) - __expf(s23) + lam_init; }
    unsigned* ctr = (unsigned*)(p.ws + WS_CTL) + CTL_QUEUE + 64 * l;
    for (;;) {
        __syncthreads();
        if (threadIdx.x == 0) *slot = atomicAdd(ctr, 1u);
        __syncthreads();
        const int item = (int)*slot;
        if (item >= MX_ITEMS) break;
#if PROBE_ID
        const unsigned long long it0 = __builtin_amdgcn_s_memrealtime();
#endif
        if (item < 48) attn_item(p, l, item, lds, lam, lam_init);
        else if (item < 60) ph_scan_job(p, l, 32 + (item - 48) / NH, (item - 48) % NH, 0, 0, 0, 0, SEG0_LEN, (float*)lds);
        else if (item < 108) { const int r = item - 60, sg = 1 + (r & 1), dr = (r >> 1) & 1, hh = (r >> 2) % NH, bb = r / 24;
            ph_scan_job(p, l, 32 + bb, hh, 1, dr, sg, sg == 1 ? SEG0_LEN : SEG0_LEN + SEGX_LEN, SEGX_LEN, (float*)lds); }
        else if (item < 300) ph_scan_job(p, l, (item - 108) / NH, (item - 108) % NH, 0, 0, 0, 0, TP, (float*)lds);
        else if (item < 308) gemm_one(1, (item - 300) >> 1, (item - 300) & 1);
        else if (item < 500) attn_item(p, l, 48 + item - 308, lds, lam, lam_init);
        else gemm_one(0, 0, item - 500);
#if PROBE_ID
        __syncthreads();
        if (threadIdx.x == 0 && l == 0) { const int cls = item < 48 ? 3 : item < 60 ? 0 : item < 108 ? 6 : item < 300 ? 2 : item < 308 ? 1 : item < 500 ? 5 : 4;
            atomicMax((unsigned*)(p.ws + WS_CTL) + 3712 + cls, (unsigned)(__builtin_amdgcn_s_memrealtime() - it0)); }
#endif
    }
}

#define XB_TMO      128
#define XB_XCNT(j)  (256  + 64 * (j))
#define XB_XSUB(j)  (1280 + 64 * (j))
#define XB_XGEN(j)  (2304 + 64 * (j))
#define XB_TOP      3328
#define XB_TOPGEN   3392
#define XCD_BAR_WORDS 3456
#define XB_SPIN_CAP (1u << 22)
__device__ __forceinline__ unsigned xb_ld(unsigned* p)              { return __hip_atomic_load(p, __ATOMIC_RELAXED, __HIP_MEMORY_SCOPE_AGENT); }
__device__ __forceinline__ unsigned xb_add(unsigned* p, unsigned v) { return __hip_atomic_fetch_add(p, v, __ATOMIC_RELAXED, __HIP_MEMORY_SCOPE_AGENT); }
__device__ __forceinline__ unsigned xb_xcc_id() { return (unsigned)__builtin_amdgcn_s_getreg((3 << 11) | 20) & 0xFu; }
#define XB_SPIN(cond, bar) do { unsigned _sp = 0; while (cond) { __builtin_amdgcn_s_sleep(1); \
    if ((++_sp & 255u) == 0u) { if (xb_ld(&(bar)[XB_TMO])) break; if (_sp > XB_SPIN_CAP) { atomicAdd(&(bar)[XB_TMO], 1u); break; } } } } while (0)
struct XcdBarrier { unsigned* bar; unsigned x; volatile LAS unsigned* st; };
__device__ __forceinline__ XcdBarrier xcd_barrier_post(unsigned* bar, volatile LAS unsigned* st) {
    XcdBarrier b; b.bar = bar; b.x = xb_xcc_id(); b.st = st;
    if (threadIdx.x == 0) (void)xb_add(&bar[XB_XCNT(b.x)], 1u);
    return b;
}
__device__ __forceinline__ void xcd_barrier_complete(unsigned* bar, unsigned x, unsigned& nloc, unsigned& nx) {
    const unsigned G = gridDim.x * gridDim.y * gridDim.z;
    unsigned sum, cnt, mine, sp = 0u;
    for (;;) {
        sum = 0u; cnt = 0u; mine = 0u;
#pragma unroll
        for (unsigned j = 0; j < 16; ++j) { const unsigned c = xb_ld(&bar[XB_XCNT(j)]); sum += c; cnt += (c > 0u) ? 1u : 0u; mine = (j == x) ? c : mine; }
        if (sum == G) break;
        __builtin_amdgcn_s_sleep(1);
        if ((++sp & 255u) == 0u) { if (xb_ld(&bar[XB_TMO])) break; if (sp > XB_SPIN_CAP) { atomicAdd(&bar[XB_TMO], 1u); break; } }
    }
    nloc = mine > 0u ? mine : 1u; nx = cnt > 0u ? cnt : 1u;
}
__device__ __forceinline__ void xcd_barrier(const XcdBarrier& b) {
    asm volatile("s_waitcnt vmcnt(0)" ::: "memory");
    __syncthreads();
    if (threadIdx.x == 0) {
        unsigned* bar = b.bar;
        __builtin_amdgcn_s_waitcnt(0);
        unsigned nloc = b.st[0], nx = b.st[1];
        if (nloc == 0u) { xcd_barrier_complete(bar, b.x, nloc, nx); b.st[0] = nloc; b.st[1] = nx; }
        const unsigned old = xb_add(&bar[XB_XSUB(b.x)], 1u);
        const unsigned gen = old / nloc;
        if (old + 1u == (gen + 1u) * nloc) {
            __builtin_amdgcn_fence(__ATOMIC_RELEASE, "agent");
            asm volatile("s_waitcnt vmcnt(0)" ::: "memory");
            const unsigned og = xb_add(&bar[XB_TOP], 1u);
            const unsigned tg = og / nx;
            if (og + 1u == (tg + 1u) * nx) xb_add(&bar[XB_TOPGEN], 1u);
            else XB_SPIN(xb_ld(&bar[XB_TOPGEN]) == tg, bar);
            __builtin_amdgcn_fence(__ATOMIC_ACQUIRE, "agent");
            xb_add(&bar[XB_XGEN(b.x)], 1u);
            asm volatile("s_waitcnt vmcnt(0)" ::: "memory");
        } else {
            XB_SPIN(xb_ld(&bar[XB_XGEN(b.x)]) == gen, bar);
            __builtin_amdgcn_fence(__ATOMIC_ACQUIRE, "agent");
            asm volatile("s_waitcnt vmcnt(0)" ::: "memory");
        }
    }
    __syncthreads();
}

#define LDS_BYTES (pg8::STAGE_BYTES + 1024)
#define N_PHASES 22
struct Args { P p; int ph_lo, ph_hi; };
__global__ __launch_bounds__(512, 2) void mega(Args a) {
    extern __shared__ __attribute__((aligned(16))) unsigned char lds[];
    const P& p = a.p;
    LAS unsigned char* l3 = (LAS unsigned char*)lds;
    volatile LAS unsigned* misc = (volatile LAS unsigned*)(l3 + pg8::STAGE_BYTES);
    if (threadIdx.x < 16) misc[threadIdx.x] = 0u;
    __syncthreads();
    XcdBarrier bar = xcd_barrier_post((unsigned*)(p.ws + WS_CTL), misc);
    float* sm = (float*)lds;
    const int lo = a.ph_lo, hi = a.ph_hi;
#define IN(k) (lo <= (k) && (k) < hi)
#if PROBE_ID
    unsigned long long* tsl = (unsigned long long*)(p.ws + WS_CTL + 15360);
    if (blockIdx.x == 0 && otid() == 0) tsl[0] = __builtin_amdgcn_s_memrealtime();
#define SEAM(k) do { if (IN(k) && IN((k) + 1)) xcd_barrier(bar); if (blockIdx.x == 0 && otid() == 0) tsl[1 + (k)] = __builtin_amdgcn_s_memrealtime(); } while (0)
#else
#define SEAM(k) do { if (IN(k) && IN((k) + 1)) xcd_barrier(bar); } while (0)
#endif
    if (IN(0)) ph_prep0(p, sm);
    SEAM(0);
    for (int l = 0; l < 2; ++l) {
        const int b0 = 1 + 10 * l;
        if (IN(b0 + 0)) ph_norm(p, l, 0);
        SEAM(b0 + 0);
        if (IN(b0 + 1)) { pg8::Gemm g{(const bf16_t*)(p.ws + WS_H), (const bf16_t*)(p.ws + WS_WIN) + (size_t)l * N1 * 1024, NTOK, N1, 1024};
            pg8::StaticOrder S; S.init(NTOK, N1, gridDim.x, blockIdx.x); pg8::EpiWrap<EpiG1> E{&p, EpiG1{l}}; pg8::gemm_phase(l3, g, S, E); }
        SEAM(b0 + 1);
        if (IN(b0 + 2)) ph_prep(p, l, sm);
        SEAM(b0 + 2);
        if (IN(b0 + 3)) {
            auto gemm_one = [&](int samp, int pm, int pn) {
                pg8::Gemm g{samp ? (const bf16_t*)(p.ws + WS_L1024) : (const bf16_t*)(p.ws + WS_L256), samp ? (const bf16_t*)(p.ws + WS_ZF) + (size_t)8192 * 512 : (const bf16_t*)(p.ws + WS_ZF),
                            samp ? 1024 : 256, samp ? 512 : 8192, samp ? 2048 : 512};
                OneUnit S{pm, pn}; pg8::EpiWrap<EpiFnet> E{&p, EpiFnet{samp}}; pg8::gemm_phase(l3, g, S, E); };
            ph_mixer(p, l, lds, misc + 4, gemm_one);
        }
        SEAM(b0 + 3);
        if (IN(b0 + 4)) ph_fixup(p, sm);
        SEAM(b0 + 4);
        if (IN(b0 + 5)) ph_finalize(p, l);
        SEAM(b0 + 5);
        if (IN(b0 + 6)) { pg8::Gemm g{(const bf16_t*)(p.ws + WS_H), (const bf16_t*)(p.ws + WS_WOUT) + (size_t)l * 1024 * 1024, NTOK, 1024, 1024};
            pg8::StaticOrder S; S.init(NTOK, 1024, gridDim.x, blockIdx.x); pg8::EpiWrap<EpiRes> E{&p, EpiRes{l, 2}}; pg8::gemm_phase(l3, g, S, E); }
        SEAM(b0 + 6);
        if (IN(b0 + 7)) ph_norm(p, l, 1);
        SEAM(b0 + 7);
        if (IN(b0 + 8)) { pg8::Gemm g{(const bf16_t*)(p.ws + WS_H), (const bf16_t*)(p.ws + WS_WF1) + (size_t)l * 5632 * 1024, NTOK, 5632, 1024};
            pg8::StaticOrder S; S.init(NTOK, 5632, gridDim.x, blockIdx.x); pg8::EpiFfn1 E{&p}; pg8::gemm_phase(l3, g, S, E); }
        SEAM(b0 + 8);
        if (IN(b0 + 9)) { pg8::Gemm g{(const bf16_t*)(p.ws + WS_UR), (const bf16_t*)(p.ws + WS_WF2) + (size_t)l * 1024 * 2816, NTOK, 1024, 2816};
            pg8::StaticOrder S; S.init(NTOK, 1024, gridDim.x, blockIdx.x); pg8::EpiWrap<EpiRes> E{&p, EpiRes{l, 5}}; pg8::gemm_phase(l3, g, S, E); }
        SEAM(b0 + 9);
    }
    if (IN(21)) ph_norm(p, 0, 2);
#if PROBE_ID
    __syncthreads();
    if (blockIdx.x == 0 && otid() == 0) {
        tsl[22] = __builtin_amdgcn_s_memrealtime();
        __threadfence();
        unsigned long long acc = 0;
#pragma unroll 1
        for (int k = 0; k < 22; ++k) {
            const int st = k == 0 ? -1 : (k == 21 ? -2 : (k - 1) % 10);
            bool sel = false;
            if (PROBE_ID == 1) sel = (k == 0);
            if (PROBE_ID == 2) sel = (st == 1 || st == 6 || st == 8 || st == 9);
            if (PROBE_ID == 3) sel = (st == 3);
            if (PROBE_ID == 4) sel = (st == 0 || st == 7 || st == -2);
            if (PROBE_ID == 5) sel = (st == 2);
            if (PROBE_ID == 6) sel = (st == 4);
            if (PROBE_ID == 7) sel = (st == 5);
            if (PROBE_ID == 8) sel = (st == 1);
            if (PROBE_ID == 9) sel = (st == 6);
            if (PROBE_ID == 10) sel = (st == 8);
            if (PROBE_ID == 11) sel = (st == 9);
            if (sel) acc += __hip_atomic_load(tsl + 1 + k, __ATOMIC_RELAXED, __HIP_MEMORY_SCOPE_AGENT) - __hip_atomic_load(tsl + k, __ATOMIC_RELAXED, __HIP_MEMORY_SCOPE_AGENT);
        }
        if (PROBE_ID >= 30 && PROBE_ID < 34) { unsigned long long* tsp = (unsigned long long*)(p.ws + WS_CTL + 15360) + 32; acc = __hip_atomic_load(tsp + (PROBE_ID - 29), __ATOMIC_RELAXED, __HIP_MEMORY_SCOPE_AGENT) - __hip_atomic_load(tsp + (PROBE_ID - 30), __ATOMIC_RELAXED, __HIP_MEMORY_SCOPE_AGENT); }
        else if (PROBE_ID >= 20) acc = __hip_atomic_load((unsigned*)(p.ws + WS_CTL) + 3712 + (PROBE_ID - 20), __ATOMIC_RELAXED, __HIP_MEMORY_SCOPE_AGENT);
        const unsigned long long t_end = __builtin_amdgcn_s_memrealtime();
        while (__builtin_amdgcn_s_memrealtime() - t_end < 4ull * acc) __builtin_amdgcn_s_sleep(8);
    }
#endif
#undef IN
#undef SEAM
}

extern "C" void kernel_launch(void* const* d_in, const int* in_sizes, int n_in, void* d_out, int out_size, void* d_ws, size_t ws_size, hipStream_t stream) {
    static int grid = 0;
    if (grid == 0) {
        if (n_in != 29 || ws_size < WS_END) { fprintf(stderr, "kernel_launch: bad n_in %d or ws_size %zu (need %zu)\n", n_in, ws_size, (size_t)WS_END); grid = -1; return; }
        int dev = 0, cus = 0, per_cu = 0;
        hipGetDevice(&dev); hipDeviceGetAttribute(&cus, hipDeviceAttributeMultiprocessorCount, dev);
        if (hipFuncSetAttribute((const void*)mega, hipFuncAttributeMaxDynamicSharedMemorySize, LDS_BYTES) != hipSuccess) { fprintf(stderr, "kernel_launch: hipFuncSetAttribute failed\n"); grid = -1; return; }
        if (hipOccupancyMaxActiveBlocksPerMultiprocessor(&per_cu, (const void*)mega, 512, LDS_BYTES) != hipSuccess || per_cu < 1) { fprintf(stderr, "kernel_launch: occupancy query says %d\n", per_cu); per_cu = 1; }
        (void)hipGetLastError();
        grid = cus;
    }
    if (grid < 0) return;
    hipMemsetAsync((unsigned char*)d_ws + WS_CTL, 0, 16384, stream);
    Args a{};
    const float** f = (const float**)&a.p;
    for (int i = 0; i < 29; ++i) f[i] = (const float*)d_in[i];
    a.p.out = (float*)d_out; a.p.ws = (unsigned char*)d_ws;
#if ONE_LAUNCH
    a.ph_lo = 0; a.ph_hi = N_PHASES;
    hipLaunchKernelGGL(mega, dim3(grid), dim3(512), LDS_BYTES, stream, a);
#else
    for (int ph = 0; ph < N_PHASES; ++ph) { a.ph_lo = ph; a.ph_hi = ph + 1; hipLaunchKernelGGL(mega, dim3(grid), dim3(512), LDS_BYTES, stream, a); }
#endif
}
```

```cpp
#include <hip/hip_runtime.h>
#include <stdint.h>
#include <stdio.h>
#ifndef ONE_LAUNCH
#define ONE_LAUNCH 1
#endif
#ifndef PROBE_ID
#define PROBE_ID 0
#endif

typedef unsigned short bf16_t;

#define D_MODEL 1024
#define NTOK 10240
#define NPTOK 8192
#define TP 256
#define TS 1024
#define NSEQ 34
#define NH 6
#define N1 3072
#define C_DIFF 0
#define C_FNET 1152
#define C_RWKV 1664
#define C_END 3008
#define N_RWKV 1344
#define D_FF 2816
#define D_IN 2752

#define OUT_YP 0
#define OUT_YS 8388608
#define OUT_ST 10485760
#define OUT_CK 13631488
#define OUT_CV 19922944

#define OPS_REC 1792
#define OPS_TOK (6 * OPS_REC)

#define WS_WIN   ((size_t)0)
#define WS_WOUT  (WS_WIN + (size_t)2 * N1 * 1024 * 2)
#define WS_WF1   (WS_WOUT + (size_t)2 * 1024 * 1024 * 2)
#define WS_WF2   (WS_WF1 + (size_t)2 * 5632 * 1024 * 2)
#define WS_H     (WS_WF2 + (size_t)2 * 1024 * 2816 * 2)
#define WS_UD    (WS_H + (size_t)NTOK * 1024 * 2)
#define WS_ZF    (WS_UD + (size_t)NTOK * 1152 * 2)
#define WS_UR    (WS_ZF + (size_t)NTOK * 512 * 2)
#define WS_OPS   (WS_UR + (size_t)2 * NTOK * 384 * 4)
#define WS_MOD   (WS_OPS + (size_t)NTOK * OPS_TOK)
#define WS_L256  (WS_MOD + (size_t)2 * 3 * 6144 * 4)
#define WS_L1024 (WS_L256 + (size_t)256 * 512 * 2)
#define WS_CTL   (WS_L1024 + (size_t)1024 * 2048 * 2)
#define WS_RSQ   (WS_CTL + (size_t)16384)
#define WS_ZS    (WS_RSQ + (size_t)4 * NTOK * 4)
#define WS_SS    (WS_ZS + (size_t)2 * 2048 * 384 * 4)
#define WS_WLT   (WS_SS + (size_t)24 * 3 * 4096 * 4)
#define WLT_L    73728
#define WS_BIAS  (WS_WLT + (size_t)2 * WLT_L * 2)
#define WS_END   (WS_BIAS + (size_t)(2 * 3 * 3072 + 2 * 3 * 5632) * 4)
#define WS_H2    (WS_OPS + ((size_t)64 << 20))
#define CTL_QUEUE 3584
static_assert(WS_END <= ((size_t)256 << 20), "workspace exceeds 256 MiB");

struct P {
    const float *x_prompt, *x_sample, *c, *state_rwkv, *cache_k, *cache_v, *c_ctx, *norm1_g, *norm2_g, *final_g;
    const float *w_mod, *b_mod, *w_in, *w_out, *shift_mu, *decay_w0, *decay_up, *iclr_a0, *iclr_up, *gate_up;
    const float *k_k, *k_a, *r_k, *lnx_g, *lnx_b, *diff_lambda, *subln_g, *w_ffn_in, *w_ffn_out;
    float* out;
    unsigned char* ws;
};

__device__ __forceinline__ bf16_t f2bf(float f) { unsigned u = __builtin_bit_cast(unsigned, f); return (bf16_t)((u + 0x7fffu + ((u >> 16) & 1u)) >> 16); }
__device__ __forceinline__ float bf2f(bf16_t b) { return __builtin_bit_cast(float, ((unsigned)b) << 16); }
__device__ __forceinline__ float sigmoidf_(float x) { return 1.f / (1.f + __expf(-x)); }
__device__ __forceinline__ float wave_sum(float v) {
#pragma unroll
    for (int o = 1; o < 64; o <<= 1) v += __shfl_xor(v, o);
    return v;
}
__device__ __forceinline__ int otid() { int t = threadIdx.x; asm volatile("" : "+v"(t)); return t; }
__device__ __forceinline__ int tok_cls(int tok) { return tok < NPTOK ? 0 : 1 + ((tok - NPTOK) >> 10); }
__device__ __forceinline__ const float* xin_row(const P& p, int tok) { return tok < NPTOK ? p.x_prompt + (size_t)tok * 1024 : p.x_sample + (size_t)(tok - NPTOK) * 1024; }
__device__ __forceinline__ float* X_row(const P& p, int tok) { return p.out + (size_t)tok * 1024; }
__device__ __forceinline__ const float* mod_vec(const P& p, int l, int cls, int which) { return (const float*)(p.ws + WS_MOD) + ((size_t)(l * 3 + cls) * 6144 + which * 1024); }
__device__ __forceinline__ void seq_info(int s, int& start, int& T) { if (s < 32) { start = s * TP; T = TP; } else { start = NPTOK + (s - 32) * TS; T = TS; } }
__device__ __forceinline__ void tok_info(int tok, int& s, int& t, int& T, int& start) {
    if (tok < NPTOK) { s = tok >> 8; t = tok & 255; T = TP; start = s * TP; } else { int r = tok - NPTOK; s = 32 + (r >> 10); t = r & 1023; T = TS; start = NPTOK + ((r >> 10) << 10); }
}

#define P0_MOD 192
#define P0_TILES_L 3136
struct P0Tile { const float* src; bf16_t* dst; int srcN, K, n0, k0, mode, scol; };
__device__ __forceinline__ P0Tile p0_decode(const P& p, int it) {
    P0Tile t; const int l = it / P0_TILES_L; it %= P0_TILES_L; int ntile, ktile; t.mode = 0; t.scol = 0;
    if (it < 768) { ntile = it / 16; ktile = it % 16; t.K = 1024; t.srcN = D_IN; t.src = p.w_in + (size_t)l * 1024 * D_IN; t.dst = (bf16_t*)(p.ws + WS_WIN) + (size_t)l * N1 * 1024;
        t.n0 = ntile * 64;
        if (t.n0 < C_FNET) { t.scol = 1344 + t.n0; } else if (t.n0 < C_RWKV) { t.mode = 1 + ((t.n0 - C_FNET) / 64) % 2; t.scol = 2496 + ((t.n0 - C_FNET) / 128) * 64; } else if (t.n0 < C_END) { t.scol = t.n0 - C_RWKV; } else t.mode = 3; }
    else if (it < 1024) { it -= 768; ntile = it / 16; ktile = it % 16; t.K = 1024; t.srcN = 1024; t.src = p.w_out + (size_t)l * 1024 * 1024; t.dst = (bf16_t*)(p.ws + WS_WOUT) + (size_t)l * 1024 * 1024; t.n0 = ntile * 64; t.scol = t.n0; }
    else if (it < 2432) { it -= 1024; ntile = it / 16; ktile = it % 16; t.K = 1024; t.srcN = 5632; t.src = p.w_ffn_in + (size_t)l * 1024 * 5632; t.dst = (bf16_t*)(p.ws + WS_WF1) + (size_t)l * 5632 * 1024; t.n0 = ntile * 64;
        const int pn = ntile >> 2, sub = ntile & 3; t.scol = (sub < 2) ? (128 * pn + 64 * sub) : (2816 + 128 * pn + 64 * (sub - 2)); }
    else { it -= 2432; ntile = it / 44; ktile = it % 44; t.K = 2816; t.srcN = 1024; t.src = p.w_ffn_out + (size_t)l * 2816 * 1024; t.dst = (bf16_t*)(p.ws + WS_WF2) + (size_t)l * 1024 * 2816; t.n0 = ntile * 64; t.scol = t.n0; }
    t.k0 = ktile * 64;
    return t;
}
#define P0_TGROUPS 1568
__device__ __forceinline__ void ph_prep0(const P& p, float* sm) {
    const int tid = otid();
    const int nitems = P0_MOD + P0_TGROUPS + 1280 + 10;
    for (int item = blockIdx.x; item < nitems; item += gridDim.x) {
        __syncthreads();
        if (item < P0_MOD) {
            const int l = item / 96, cg = item % 96, col = cg * 64 + (tid & 63), ks = tid >> 6;
            const float* W = p.w_mod + (size_t)l * 1024 * 6144;
            float* sl = sm + 2048;
            for (int e = tid; e < 3072; e += blockDim.x) { const int cls = e >> 10, k = e & 1023; const float c = cls == 0 ? p.c_ctx[k] : p.c[(cls - 1) * 1024 + k]; sl[e] = c * sigmoidf_(c); }
            __syncthreads();
            float a0 = 0.f, a1 = 0.f, a2 = 0.f;
#pragma unroll 8
            for (int k = ks * 128; k < ks * 128 + 128; ++k) {
                const float w = W[(size_t)k * 6144 + col];
                a0 += sl[k] * w; a1 += sl[1024 + k] * w; a2 += sl[2048 + k] * w;
            }
            sm[(ks * 3 + 0) * 64 + (tid & 63)] = a0; sm[(ks * 3 + 1) * 64 + (tid & 63)] = a1; sm[(ks * 3 + 2) * 64 + (tid & 63)] = a2;
            __syncthreads();
            if (tid < 192) {
                const int cls = tid >> 6, cc = tid & 63; float s = 0.f;
                for (int k = 0; k < 8; ++k) s += sm[(k * 3 + cls) * 64 + cc];
                const int colo = cg * 64 + cc;
                ((float*)(p.ws + WS_MOD))[(size_t)(l * 3 + cls) * 6144 + colo] = s + p.b_mod[(size_t)l * 6144 + colo];
            }
        } else if (item < P0_MOD + P0_TGROUPS) {
            const int it0 = (item - P0_MOD) * 4;
            float* cs = sm + 4 * 64 * 65;
            if (tid < 64) { cs[tid] = cospif((float)tid / 32.f); cs[64 + tid] = sinpif((float)tid / 32.f); }
#pragma unroll
            for (int u = 0; u < 4; ++u) {
                const P0Tile t = p0_decode(p, it0 + u); float* tile = sm + u * 64 * 65;
                if (t.mode != 3) {
#pragma unroll
                    for (int i = 0; i < 8; ++i) { const int k = i * 8 + (tid >> 6), n = tid & 63; tile[k * 65 + n] = t.src[(size_t)(t.k0 + k) * t.srcN + t.scol + n]; }
                }
            }
            __syncthreads();
#pragma unroll 1
            for (int u = 0; u < 4; ++u) {
                const P0Tile t = p0_decode(p, it0 + u); const float* tile = sm + u * 64 * 65;
                const int n = tid >> 3, k8 = (tid & 7) * 8;
                float v[8];
                if (t.mode == 0) {
#pragma unroll
                    for (int j = 0; j < 8; ++j) v[j] = tile[(k8 + j) * 65 + n];
                } else if (t.mode == 3) {
#pragma unroll
                    for (int j = 0; j < 8; ++j) v[j] = 0.f;
                } else {
#pragma unroll
                    for (int j = 0; j < 8; ++j) v[j] = 0.f;
                    for (int cc = 0; cc < 64; ++cc) {
                        const int idx = (n * cc) & 63;
                        const float tr = (t.mode == 1) ? cs[idx] * 0.125f : -cs[64 + idx] * 0.125f;
#pragma unroll
                        for (int j = 0; j < 8; ++j) v[j] += tile[(k8 + j) * 65 + cc] * tr;
                    }
                }
                uint4 o;
                o.x = (unsigned)f2bf(v[0]) | ((unsigned)f2bf(v[1]) << 16); o.y = (unsigned)f2bf(v[2]) | ((unsigned)f2bf(v[3]) << 16);
                o.z = (unsigned)f2bf(v[4]) | ((unsigned)f2bf(v[5]) << 16); o.w = (unsigned)f2bf(v[6]) | ((unsigned)f2bf(v[7]) << 16);
                *(uint4*)(t.dst + (size_t)(t.n0 + n) * t.K + t.k0 + k8) = o;
            }
        } else if (item >= P0_MOD + P0_TGROUPS + 1280) {
            const int it = item - (P0_MOD + P0_TGROUPS + 1280), l = it / 5, kind = it % 5, K = kind == 4 ? 64 : 32;
            const float* src = kind == 4 ? p.gate_up + (size_t)l * 64 * 384 : ((kind >> 1) ? p.iclr_up : p.decay_up) + (size_t)((l * 2 + (kind & 1)) * 32) * 384;
            bf16_t* dst = (bf16_t*)(p.ws + WS_WLT) + (size_t)l * WLT_L + kind * 12288;
            for (int e = tid; e < 384 * K; e += blockDim.x) { const int n = e % 384, k = e / 384; dst[n * K + k] = f2bf(src[(size_t)k * 384 + n]); }
        } else {
            const int r = item - (P0_MOD + P0_TGROUPS);
            const int T = r < 256 ? 256 : 1024, ft = r < 256 ? r : r - 256;
            bf16_t* L = r < 256 ? (bf16_t*)(p.ws + WS_L256) + (size_t)ft * 512 : (bf16_t*)(p.ws + WS_L1024) + (size_t)ft * 2048;
            const float sc = r < 256 ? 0.0625f : 0.03125f;
            for (int k = tid; k < 2 * T; k += blockDim.x) {
                const int t = k & (T - 1), idx = (ft * t) & (T - 1);
                const float ang = (float)(2 * idx) / (float)T;
                L[k] = f2bf((k < T ? cospif(ang) : sinpif(ang)) * sc);
            }
        }
    }
}

__device__ __forceinline__ void ph_prep0b(const P& p) {
    const int tid_ = otid(); const int lane = tid_ & 63, wv = tid_ >> 6, nw = blockDim.x >> 6;
    for (int r = blockIdx.x * nw + wv; r < 2 * 3072 + 2 * 5632; r += gridDim.x * nw) {
        int l, n, which; const bf16_t* W; float* out; int N;
        if (r < 6144) { l = r / 3072; n = r % 3072; W = (const bf16_t*)(p.ws + WS_WIN) + ((size_t)l * N1 + n) * 1024; which = 0; N = 3072; out = (float*)(p.ws + WS_BIAS) + (size_t)(l * 3) * 3072 + n; }
        else { const int q = r - 6144; l = q / 5632; n = q % 5632; W = (const bf16_t*)(p.ws + WS_WF1) + ((size_t)l * 5632 + n) * 1024; which = 3; N = 5632; out = (float*)(p.ws + WS_BIAS) + 2 * 3 * 3072 + (size_t)(l * 3) * 5632 + n; }
        const uint4 w0 = *(const uint4*)(W + lane * 16), w1 = *(const uint4*)(W + lane * 16 + 8);
        const unsigned ww[8] = {w0.x, w0.y, w0.z, w0.w, w1.x, w1.y, w1.z, w1.w};
        float acc[3] = {0.f, 0.f, 0.f};
#pragma unroll
        for (int c = 0; c < 3; ++c) {
            const float* sh = mod_vec(p, l, c, which) + lane * 16;
#pragma unroll
            for (int e = 0; e < 8; ++e) acc[c] += sh[2 * e] * bf2f((bf16_t)(ww[e] & 0xffff)) + sh[2 * e + 1] * bf2f((bf16_t)(ww[e] >> 16));
        }
#pragma unroll
        for (int c = 0; c < 3; ++c) { const float t = wave_sum(acc[c]); if (lane == 0) out[(size_t)c * N] = t; }
    }
    float* rsq0 = (float*)(p.ws + WS_RSQ);
    for (int row = blockIdx.x * nw + wv; row < NTOK; row += gridDim.x * nw) {
        const float* xr = xin_row(p, row);
        float4 x[4]; float ss = 0.f;
#pragma unroll
        for (int i = 0; i < 4; ++i) { x[i] = *(const float4*)(xr + i * 256 + lane * 4); ss += x[i].x * x[i].x + x[i].y * x[i].y + x[i].z * x[i].z + x[i].w * x[i].w; }
        ss = wave_sum(ss);
        if (lane == 0) rsq0[row] = ss;
        const float* sc = mod_vec(p, 0, tok_cls(row), 1);
        bf16_t* h = (bf16_t*)(p.ws + WS_H) + (size_t)row * 1024;
#pragma unroll
        for (int i = 0; i < 4; ++i) { const int c = i * 256 + lane * 4;
            const float4 gg = *(const float4*)(p.norm1_g + c), s1 = *(const float4*)(sc + c);
            uint2 o; o.x = (unsigned)f2bf(x[i].x * gg.x * (1.f + s1.x)) | ((unsigned)f2bf(x[i].y * gg.y * (1.f + s1.y)) << 16);
            o.y = (unsigned)f2bf(x[i].z * gg.z * (1.f + s1.z)) | ((unsigned)f2bf(x[i].w * gg.w * (1.f + s1.w)) << 16);
            *(uint2*)(h + c) = o; }
    }
}

__device__ __forceinline__ void ph_norm(const P& p, int l, int which) {
    const int tid_ = otid(); const int lane = tid_ & 63, wv = tid_ >> 6, nw = blockDim.x >> 6;
    for (int row = blockIdx.x * nw + wv; row < NTOK; row += gridDim.x * nw) {
        const float* xr = (which == 0 && l == 0) ? xin_row(p, row) : X_row(p, row);
        float4 x[4]; float ss = 0.f;
#pragma unroll
        for (int i = 0; i < 4; ++i) { x[i] = *(const float4*)(xr + i * 256 + lane * 4); ss += x[i].x * x[i].x + x[i].y * x[i].y + x[i].z * x[i].z + x[i].w * x[i].w; }
        ss = wave_sum(ss);
        const float rstd = rsqrtf(ss * (1.f / 1024.f) + 1e-6f);
        if (which == 2) {
            float* o = p.out + (size_t)row * 1024;
#pragma unroll
            for (int i = 0; i < 4; ++i) { const float4 g = *(const float4*)(p.final_g + i * 256 + lane * 4);
                float4 y; y.x = x[i].x * rstd * g.x; y.y = x[i].y * rstd * g.y; y.z = x[i].z * rstd * g.z; y.w = x[i].w * rstd * g.w;
                *(float4*)(o + i * 256 + lane * 4) = y; }
        } else {
            const int cls = tok_cls(row);
            const float* g = (which == 0 ? p.norm1_g : p.norm2_g) + (size_t)l * 1024;
            const float* sh = mod_vec(p, l, cls, which == 0 ? 0 : 3);
            const float* sc = mod_vec(p, l, cls, which == 0 ? 1 : 4);
            bf16_t* h = (bf16_t*)(p.ws + WS_H) + (size_t)row * 1024;
#pragma unroll
            for (int i = 0; i < 4; ++i) { const int c = i * 256 + lane * 4;
                const float4 gg = *(const float4*)(g + c), s1 = *(const float4*)(sc + c), s0 = *(const float4*)(sh + c);
                const float y0 = x[i].x * rstd * gg.x * (1.f + s1.x) + s0.x, y1 = x[i].y * rstd * gg.y * (1.f + s1.y) + s0.y;
                const float y2 = x[i].z * rstd * gg.z * (1.f + s1.z) + s0.z, y3 = x[i].w * rstd * gg.w * (1.f + s1.w) + s0.w;
                uint2 o; o.x = (unsigned)f2bf(y0) | ((unsigned)f2bf(y1) << 16); o.y = (unsigned)f2bf(y2) | ((unsigned)f2bf(y3) << 16);
                *(uint2*)(h + c) = o; }
        }
    }
}

struct EpiG1 {
    int l;
    __device__ __forceinline__ void operator()(const P& p, int row, int col, const float* v) const {
        if (col < C_FNET) {
            bf16_t* o = (bf16_t*)(p.ws + WS_UD) + (size_t)row * 1152 + col;
            uint2 w; w.x = (unsigned)f2bf(v[0]) | ((unsigned)f2bf(v[1]) << 16); w.y = (unsigned)f2bf(v[2]) | ((unsigned)f2bf(v[3]) << 16);
            *(uint2*)o = w;
            if (row < NPTOK && col >= 384) {
                const int b = row >> 8, t = row & 255;
                float* dst = p.out + (col < 768 ? OUT_CK : OUT_CV) + ((size_t)(b * 2 + l) * 256 + t) * 384 + (col < 768 ? col - 384 : col - 768);
                *(float4*)dst = make_float4(v[0], v[1], v[2], v[3]);
            }
        } else if (col < C_RWKV) {
            const int cc = col - C_FNET, g = cc >> 7, half = (cc >> 6) & 1, fc = cc & 63;
            bf16_t* o;
            if (row < NPTOK) { const int sq = row >> 8, t = row & 255; o = (bf16_t*)(p.ws + WS_ZF) + ((size_t)(sq * 256 + g * 64 + fc) * 512 + half * 256 + t);
                o[0] = f2bf(v[0]); o[512] = f2bf(v[1]); o[1024] = f2bf(v[2]); o[1536] = f2bf(v[3]); }
            else { const int r = row - NPTOK, b = r >> 10, t = r & 1023; o = (bf16_t*)(p.ws + WS_ZF) + (size_t)8192 * 512 + ((size_t)(b * 256 + g * 64 + fc) * 2048 + half * 1024 + t);
                o[0] = f2bf(v[0]); o[2048] = f2bf(v[1]); o[4096] = f2bf(v[2]); o[6144] = f2bf(v[3]); }
        } else if (col < C_END) {
            bf16_t* o = (bf16_t*)(p.ws + WS_UR) + (size_t)row * N_RWKV + (col - C_RWKV);
            uint2 w; w.x = (unsigned)f2bf(v[0]) | ((unsigned)f2bf(v[1]) << 16); w.y = (unsigned)f2bf(v[2]) | ((unsigned)f2bf(v[3]) << 16);
            *(uint2*)o = w;
        }
    }
};
struct EpiRes {
    int l, which;
    __device__ __forceinline__ void operator()(const P& p, int row, int col, const float* v) const {
        const float* g = mod_vec(p, l, tok_cls(row), which) + col;
        const float* xo = (which == 2 && l == 0) ? xin_row(p, row) + col : X_row(p, row) + col;
        const float4 x = *(const float4*)xo; const float4 gg = *(const float4*)g;
        *(float4*)(X_row(p, row) + col) = make_float4(x.x + gg.x * v[0], x.y + gg.y * v[1], x.z + gg.z * v[2], x.w + gg.w * v[3]);
    }
};

#define PR_TT 40
#define PR_LS 200
typedef short bf16x8p __attribute__((ext_vector_type(8)));
typedef float f32x4p __attribute__((ext_vector_type(4)));
#define PR_ROWB 2688
__device__ __forceinline__ void ph_prep(const P& p, int l, float* sm) {
    const int tid = otid(), lane = tid & 63, wv = tid >> 6;
    const bf16_t* UR = (const bf16_t*)(p.ws + WS_UR);
    unsigned char* lb = (unsigned char*)sm;
    bf16_t* urt = (bf16_t*)lb;
    bf16_t* linb = (bf16_t*)(lb + 42 * PR_ROWB);
    const float* mu0 = p.shift_mu + (size_t)l * 2 * N_RWKV; const float* mu1 = mu0 + N_RWKV;
#if PROBE_ID
    unsigned long long* tsp = (unsigned long long*)(p.ws + WS_CTL + 15360) + 32;
#define PSTAMP(i) do { __syncthreads(); if (blockIdx.x == 0 && tid == 0 && l == 0) tsp[i] = __builtin_amdgcn_s_memrealtime(); } while (0)
#else
#define PSTAMP(i)
#endif
    PSTAMP(0);
    for (int tile = blockIdx.x; tile < NTOK / PR_TT; tile += gridDim.x) {
        const int tok0 = tile * PR_TT;
        __syncthreads();
        for (int e = tid; e < 42 * 168; e += blockDim.x) {
            const int r = e / 168, c = e % 168, tok = tok0 - 1 + r;
            uint4 v = make_uint4(0u, 0u, 0u, 0u);
            if (tok >= 0 && tok < NTOK) v = *(const uint4*)((const unsigned char*)UR + (size_t)tok * PR_ROWB + c * 16);
            *(uint4*)(lb + r * PR_ROWB + c * 16) = v;
        }
        __syncthreads();
        for (int e = tid; e < 48 * 192; e += blockDim.x) {
            const int tk = e / 192, j = e % 192, col = 1152 + j;
            float x = 0.f;
            if (tk < PR_TT) {
                int s, t, T, st; tok_info(tok0 + tk, s, t, T, st);
                const float xc = bf2f(urt[(tk + 1) * 1344 + col]);
                const float xp = t > 0 ? bf2f(urt[tk * 1344 + col]) : 0.f;
                const float xn = t < T - 1 ? bf2f(urt[(tk + 2) * 1344 + col]) : 0.f;
                x = xc + mu0[col] * (xp - xc) + mu1[col] * (xn - xc);
                if (j < 64) x = tanhf(x); else if (j >= 128) x = sigmoidf_(x);
            }
            linb[tk * PR_LS + j] = f2bf(x);
        }
        __syncthreads();
        PSTAMP(1);
        {
            const int n = lane & 15, kg = lane >> 4;
            const bf16_t* WLT = (const bf16_t*)(p.ws + WS_WLT) + (size_t)l * WLT_L;
#pragma unroll 3
            for (int combo = wv; combo < 120; combo += 8) {
                const int kind = combo / 24, nt = combo % 24, ch = nt * 16 + n, h = ch >> 6, cl = ch & 63;
                const int K = kind == 4 ? 64 : 32, loff = kind == 4 ? 128 : (kind >> 1) * 64 + (kind & 1) * 32;
                const bf16_t* wrow = WLT + kind * 12288 + (size_t)ch * K + 8 * kg;
                const bf16x8p b0 = *(const bf16x8p*)wrow;
                bf16x8p b1 = b0; if (kind == 4) b1 = *(const bf16x8p*)(wrow + 32);
                float bias = 0.f;
                if (kind < 4) bias = ((kind >> 1) ? p.iclr_a0 : p.decay_w0)[(size_t)(l * 2 + (kind & 1)) * 384 + ch];
#pragma unroll
                for (int mt = 0; mt < 3; ++mt) {
                    f32x4p acc = {bias, bias, bias, bias};
                    const bf16x8p a0 = *(const bf16x8p*)(linb + (mt * 16 + n) * PR_LS + loff + 8 * kg);
                    acc = __builtin_amdgcn_mfma_f32_16x16x32_bf16(a0, b0, acc, 0, 0, 0);
                    if (kind == 4) { const bf16x8p a1 = *(const bf16x8p*)(linb + (mt * 16 + n) * PR_LS + loff + 32 + 8 * kg); acc = __builtin_amdgcn_mfma_f32_16x16x32_bf16(a1, b1, acc, 0, 0, 0); }
#pragma unroll
                    for (int r = 0; r < 4; ++r) {
                        const int tk = mt * 16 + kg * 4 + r;
                        if (tk < PR_TT) {
                            unsigned char* rec = p.ws + WS_OPS + (size_t)(tok0 + tk) * OPS_TOK + (size_t)h * OPS_REC;
                            if (kind == 4) ((bf16_t*)(rec + 1280))[192 + cl] = f2bf(acc[r]);
                            else { const float sg = sigmoidf_(acc[r]); ((float*)rec)[64 + (kind >> 1) * 128 + (kind & 1) * 64 + cl] = (kind >> 1) ? sg : __expf(-0.60653065971263342f * sg); }
                        }
                    }
                }
            }
        }
#if PROBE_ID
        if (blockIdx.x == 0 && tid == 0 && l == 0) tsp[2] = __builtin_amdgcn_s_memrealtime();
#endif
        {
#pragma unroll 2
            for (int pr = wv; pr < PR_TT * NH; pr += 8) {
                const int tk = pr / NH, h = pr % NH, ch = h * 64 + lane, tok = tok0 + tk; int s, t, T, st; tok_info(tok, s, t, T, st);
                float rkv[3];
#pragma unroll
                for (int q = 0; q < 3; ++q) { const int col = q * 384 + ch;
                    const float xc = bf2f(urt[(tk + 1) * 1344 + col]);
                    const float xp = t > 0 ? bf2f(urt[tk * 1344 + col]) : 0.f;
                    const float xn = t < T - 1 ? bf2f(urt[(tk + 2) * 1344 + col]) : 0.f;
                    rkv[q] = xc + mu0[col] * (xp - xc) + mu1[col] * (xn - xc); }
                const float kkr = rkv[1] * p.k_k[(size_t)l * 384 + ch];
                const float nrm = sqrtf(wave_sum(kkr * kkr));
                const float kk = kkr / fmaxf(nrm, 1e-12f);
                unsigned char* rec = p.ws + WS_OPS + (size_t)tok * OPS_TOK + (size_t)h * OPS_REC;
                ((float*)rec)[lane] = -kk;
                bf16_t* rb = (bf16_t*)(rec + 1280);
                rb[lane] = f2bf(rkv[0]); rb[64 + lane] = f2bf(rkv[2]); rb[128 + lane] = f2bf(rkv[1]);
            }
        }
    }
    PSTAMP(3);
    bf16_t* UD = (bf16_t*)(p.ws + WS_UD);
    for (int e = blockIdx.x * blockDim.x + tid; e < 2048 * 384; e += gridDim.x * blockDim.x) {
        const int tk = e / 384, pi = e % 384;
        const int grp = pi >> 3, pr = pi & 7, col = grp * 16 + pr;
        const int axis = grp & 1;
        const int t = tk & 1023, pos = axis == 0 ? (t >> 6) : (t & 63);
        const float inv = __powf(10000.f, -(float)pr / 8.f);
        float sn, cs; __sincosf((float)pos * inv, &sn, &cs);
        bf16_t* ptr = UD + (size_t)(NPTOK + tk) * 1152 + col;
        const float x1 = bf2f(ptr[0]), x2 = bf2f(ptr[8]);
        ptr[0] = f2bf(x1 * cs - x2 * sn); ptr[8] = f2bf(x2 * cs + x1 * sn);
    }
    PSTAMP(4);
}

#define SC_TC 16
typedef float f32x2 __attribute__((ext_vector_type(2)));
template <int CTRL> __device__ __forceinline__ float dpp_add(float x) {
    return x + __builtin_bit_cast(float, __builtin_amdgcn_update_dpp(0, __builtin_bit_cast(int, x), CTRL, 0xf, 0xf, false));
}
__device__ __forceinline__ float reduce8(float x) { x = dpp_add<0xB1>(x); x = dpp_add<0x4E>(x); x = dpp_add<0x141>(x); return x; }
struct ScanStage { float nkk[4], w[4], a[4]; bf16_t r[4], v[4], k[4]; };
__device__ __forceinline__ void scan_load(const P& p, int h, int dir, int T, int start, int st_base, int ht, ScanStage& g) {
#pragma unroll
    for (int rpt = 0; rpt < 4; ++rpt) {
        const int e = rpt * 256 + ht, i = e >> 6, ch = e & 63;
        const int st = st_base + i, t = dir == 0 ? st : T - 1 - st, tok = start + t;
        const unsigned char* rec = p.ws + WS_OPS + (size_t)tok * OPS_TOK + (size_t)h * OPS_REC;
        const float* rf = (const float*)rec; const bf16_t* rb = (const bf16_t*)(rec + 1280);
        g.nkk[rpt] = rf[ch]; g.w[rpt] = rf[64 + dir * 64 + ch]; g.a[rpt] = rf[192 + dir * 64 + ch];
        g.r[rpt] = rb[ch]; g.v[rpt] = rb[64 + ch]; g.k[rpt] = rb[128 + ch];
    }
}
__device__ __forceinline__ void scan_store(const ScanStage& g, float ka, float vmul, int ht, float* ops) {
#pragma unroll
    for (int rpt = 0; rpt < 4; ++rpt) {
        const int e = rpt * 256 + ht, i = e >> 6, ch = e & 63;
        float* o = ops + i * 384;
        const float k = bf2f(g.k[rpt]);
        o[ch] = bf2f(g.r[rpt]); o[64 + ch] = g.nkk[rpt]; o[128 + ch] = bf2f(g.v[rpt]) * vmul; o[192 + ch] = g.w[rpt];
        o[256 + ch] = k * (1.f + (g.a[rpt] - 1.f) * ka); o[320 + ch] = -g.nkk[rpt] * g.a[rpt];
    }
}
struct StepOps { float4 r0, r1, nk0, nk1, w0, w1, kd0, kd1, ka0, ka1; float2 v; };
__device__ __forceinline__ void step_load(const float* o, int kq, int rp, StepOps& x) {
    x.r0 = *(const float4*)(o + kq * 8); x.r1 = *(const float4*)(o + kq * 8 + 4);
    x.nk0 = *(const float4*)(o + 64 + kq * 8); x.nk1 = *(const float4*)(o + 64 + kq * 8 + 4);
    x.w0 = *(const float4*)(o + 192 + kq * 8); x.w1 = *(const float4*)(o + 192 + kq * 8 + 4);
    x.kd0 = *(const float4*)(o + 256 + kq * 8); x.kd1 = *(const float4*)(o + 256 + kq * 8 + 4);
    x.ka0 = *(const float4*)(o + 320 + kq * 8); x.ka1 = *(const float4*)(o + 320 + kq * 8 + 4);
    x.v = *(const float2*)(o + 128 + 2 * rp);
}
#define F2LO(q) ((f32x2){(q).x, (q).y})
#define F2HI(q) ((f32x2){(q).z, (q).w})
__device__ __forceinline__ void step_compute(f32x2 (&S)[2][4], const StepOps& x, float (&yo)[2]) {
    const f32x2 nk[4] = {F2LO(x.nk0), F2HI(x.nk0), F2LO(x.nk1), F2HI(x.nk1)}, w[4] = {F2LO(x.w0), F2HI(x.w0), F2LO(x.w1), F2HI(x.w1)};
    const f32x2 kd[4] = {F2LO(x.kd0), F2HI(x.kd0), F2LO(x.kd1), F2HI(x.kd1)}, kk[4] = {F2LO(x.ka0), F2HI(x.ka0), F2LO(x.ka1), F2HI(x.ka1)};
    const f32x2 rr[4] = {F2LO(x.r0), F2HI(x.r0), F2LO(x.r1), F2HI(x.r1)};
    const float vv[2] = {x.v.x, x.v.y};
#pragma unroll
    for (int r = 0; r < 2; ++r) {
        f32x2 t = S[r][0] * nk[0]; t += S[r][1] * nk[1]; t += S[r][2] * nk[2]; t += S[r][3] * nk[3];
        const float sa = reduce8(t.x + t.y);
        const f32x2 sa2 = (f32x2){sa, sa}, v2b = (f32x2){vv[r], vv[r]};
        f32x2 y = (f32x2){0.f, 0.f};
#pragma unroll
        for (int e = 0; e < 4; ++e) { S[r][e] = S[r][e] * w[e] + v2b * kd[e] + sa2 * kk[e]; y += S[r][e] * rr[e]; }
        yo[r] = reduce8(y.x + y.y);
    }
}
__device__ __forceinline__ void ph_scan_job(const P& p, int l, int s, int h, int mode, int pdir, int seg, int st0, int nsteps, float* sm) {
    const int tid = otid(), half = tid >> 8, ht = tid & 255, kq = ht & 7, rp = ht >> 3;
    const int dir = mode == 0 ? half : pdir, kind = mode == 0 ? 0 : 1 + half;
    int start, T; seq_info(s, start, T);
    f32x2 S[2][4];
#pragma unroll
    for (int r = 0; r < 2; ++r)
#pragma unroll
        for (int e = 0; e < 4; ++e) S[r][e] = (f32x2){0.f, 0.f};
    if (kind == 0 && s >= 32) {
        const float* s0 = p.state_rwkv + ((((size_t)(s - 32) * 2 + l) * 2 + dir) * NH + h) * 4096 + (2 * rp) * 64 + kq * 8;
#pragma unroll
        for (int r = 0; r < 2; ++r)
#pragma unroll
            for (int e = 0; e < 4; ++e) S[r][e] = *(const f32x2*)(s0 + r * 64 + 2 * e);
    } else if (kind == 1) {
#pragma unroll
        for (int r = 0; r < 2; ++r)
#pragma unroll
            for (int e = 0; e < 4; ++e) { const int row = 2 * rp + r, k = 8 * kq + 2 * e; S[r][e] = (f32x2){row == k ? 1.f : 0.f, row == k + 1 ? 1.f : 0.f}; }
    }
    const float vmul = kind == 1 ? 0.f : 1.f;
    float* ybase = kind == 1 ? (float*)(p.ws + WS_ZS) + ((ptrdiff_t)dir * 2048 - (ptrdiff_t)NPTOK) * 384 : (float*)(p.ws + WS_UR) + (size_t)dir * NTOK * 384;
    ybase += h * 64 + 2 * rp;
    const float ka = p.k_a[(size_t)l * 384 + h * 64 + (ht & 63)];
    const int nc = nsteps / SC_TC;
    ScanStage g;
    __syncthreads();
    scan_load(p, h, dir, T, start, st0, ht, g);
    scan_store(g, ka, vmul, ht, sm + half * (SC_TC * 384));
    __syncthreads();
    for (int c = 0; c < nc; ++c) {
        const float* ops = sm + ((c & 1) * 2 + half) * (SC_TC * 384);
        if (c + 1 < nc) scan_load(p, h, dir, T, start, st0 + (c + 1) * SC_TC, ht, g);
        StepOps A, B;
        step_load(ops, kq, rp, A);
#pragma unroll 1
        for (int i = 0; i < SC_TC; i += 2) {
            float yo[2];
            step_load(ops + (i + 1) * 384, kq, rp, B);
            step_compute(S, A, yo);
            if (kq == 0) { const int st = st0 + c * SC_TC + i, t = dir == 0 ? st : T - 1 - st; *(float2*)(ybase + (size_t)(start + t) * 384) = make_float2(yo[0], yo[1]); }
            if (i + 2 < SC_TC) step_load(ops + (i + 2) * 384, kq, rp, A);
            step_compute(S, B, yo);
            if (kq == 0) { const int st = st0 + c * SC_TC + i + 1, t = dir == 0 ? st : T - 1 - st; *(float2*)(ybase + (size_t)(start + t) * 384) = make_float2(yo[0], yo[1]); }
        }
        if (c + 1 < nc) scan_store(g, ka, vmul, ht, sm + (((c + 1) & 1) * 2 + half) * (SC_TC * 384));
        __syncthreads();
    }
    float* so = nullptr;
    if (mode == 0) so = s < 32 ? p.out + OUT_ST + ((((size_t)s * 2 + l) * 2 + dir) * NH + h) * 4096
                              : (float*)(p.ws + WS_SS) + ((size_t)(((s - 32) * NH + h) * 2 + dir) * 3 + 0) * 4096;
    else if (seg == 1) so = (float*)(p.ws + WS_SS) + ((size_t)(((s - 32) * NH + h) * 2 + dir) * 3 + kind) * 4096;
    if (so) {
        so += (2 * rp) * 64 + kq * 8;
#pragma unroll
        for (int r = 0; r < 2; ++r)
#pragma unroll
            for (int e = 0; e < 4; ++e) *(f32x2*)(so + r * 64 + 2 * e) = S[r][e];
    }
}

#define SEG0_LEN 352
#define SEGX_LEN 336
__device__ __forceinline__ void ph_fixup(const P& p, float* sm) {
    const int tid = otid(), lane = tid & 63, wv = tid >> 6;
    for (int item4 = blockIdx.x; item4 < 192; item4 += gridDim.x) {
        const int item = item4 >> 2, qtr = item4 & 3;
        const int b = item / 24, h = (item % 24) >> 2, dir = (item >> 1) & 1, seg = 1 + (item & 1);
        const float* E0 = (const float*)(p.ws + WS_SS) + (size_t)(((b * NH + h) * 2 + dir) * 3) * 4096; const float* P1 = E0 + 4096; const float* Q1 = E0 + 8192;
        __syncthreads();
        { const int v = tid >> 3, kg = tid & 7;
          float acc[8];
          if (seg == 1) {
#pragma unroll
              for (int j = 0; j < 8; ++j) acc[j] = E0[v * 64 + kg * 8 + j];
          } else {
#pragma unroll
              for (int j = 0; j < 8; ++j) acc[j] = Q1[v * 64 + kg * 8 + j];
#pragma unroll 8
              for (int i = 0; i < 64; ++i) { const float e = E0[v * 64 + i]; const float4 pa = *(const float4*)(P1 + i * 64 + kg * 8), pb = *(const float4*)(P1 + i * 64 + kg * 8 + 4);
                  acc[0] += e * pa.x; acc[1] += e * pa.y; acc[2] += e * pa.z; acc[3] += e * pa.w; acc[4] += e * pb.x; acc[5] += e * pb.y; acc[6] += e * pb.z; acc[7] += e * pb.w; }
          }
#pragma unroll
          for (int j = 0; j < 8; ++j) sm[v * 65 + kg * 8 + j] = acc[j]; }
        __syncthreads();
        float Srow[64];
#pragma unroll
        for (int i = 0; i < 64; ++i) Srow[i] = sm[lane * 65 + i];
        const int st0 = (seg == 1 ? SEG0_LEN : SEG0_LEN + SEGX_LEN) + qtr * (SEGX_LEN / 4);
        const float* Zb = (const float*)(p.ws + WS_ZS) + (size_t)dir * 2048 * 384; float* Yb = (float*)(p.ws + WS_UR) + (size_t)dir * NTOK * 384;
#pragma unroll 1
        for (int q = wv * 4; q < SEGX_LEN / 4; q += 32) {
            int zi[4]; float yv[4]; float* yp[4]; bool ok[4];
#pragma unroll
            for (int u = 0; u < 4; ++u) {
                ok[u] = (q + u) < SEGX_LEN / 4;
                const int st = st0 + (ok[u] ? q + u : 0), t = dir ? 1023 - st : st, stok = b * 1024 + t;
                zi[u] = __builtin_bit_cast(int, Zb[(size_t)stok * 384 + h * 64 + lane]);
                yp[u] = Yb + (size_t)(NPTOK + stok) * 384 + h * 64 + lane; yv[u] = *yp[u];
            }
#pragma unroll
            for (int i = 0; i < 64; ++i)
#pragma unroll
                for (int u = 0; u < 4; ++u) yv[u] += Srow[i] * __builtin_bit_cast(float, __builtin_amdgcn_readlane(zi[u], i));
#pragma unroll
            for (int u = 0; u < 4; ++u) if (ok[u]) *yp[u] = yv[u];
        }
    }
}

__device__ __forceinline__ void ph_finalize(const P& p, int l) {
    const int tid_ = otid(); const int lane = tid_ & 63, wv = tid_ >> 6, nw = blockDim.x >> 6;
    const float* Yb = (const float*)(p.ws + WS_UR);
    bf16_t* MIX = (bf16_t*)(p.ws + WS_H);
    for (int it0 = (blockIdx.x * nw + wv) * 4; it0 < NTOK * NH; it0 += gridDim.x * nw * 4) {
        float y[4], a0[4], a1[4], r[4], vv[4], k[4], g[4];
        int tokv[4], chv[4];
#pragma unroll
        for (int u = 0; u < 4; ++u) {
            const int it = it0 + u, tok = it / NH, h = it % NH, ch = h * 64 + lane; tokv[u] = tok; chv[u] = ch;
            y[u] = Yb[(size_t)tok * 384 + ch] + Yb[((size_t)NTOK + tok) * 384 + ch];
            const unsigned char* rec = p.ws + WS_OPS + (size_t)tok * OPS_TOK + (size_t)h * OPS_REC;
            const float* rf = (const float*)rec; const bf16_t* rb = (const bf16_t*)(rec + 1280);
            a0[u] = rf[192 + lane]; a1[u] = rf[256 + lane];
            r[u] = bf2f(rb[lane]); vv[u] = bf2f(rb[64 + lane]); k[u] = bf2f(rb[128 + lane]); g[u] = bf2f(rb[192 + lane]);
        }
        float mu[4], var[4], bs[4];
#pragma unroll
        for (int u = 0; u < 4; ++u) mu[u] = y[u];
#pragma unroll
        for (int o = 1; o < 64; o <<= 1)
#pragma unroll
            for (int u = 0; u < 4; ++u) mu[u] += __shfl_xor(mu[u], o);
#pragma unroll
        for (int u = 0; u < 4; ++u) { mu[u] *= (1.f / 64.f); y[u] -= mu[u]; var[u] = y[u] * y[u];
            const float ka = p.k_a[(size_t)l * 384 + chv[u]];
            bs[u] = r[u] * (k[u] * (1.f + (a0[u] - 1.f) * ka) + k[u] * (1.f + (a1[u] - 1.f) * ka)) * p.r_k[(size_t)l * 384 + chv[u]]; }
#pragma unroll
        for (int o = 1; o < 64; o <<= 1)
#pragma unroll
            for (int u = 0; u < 4; ++u) { var[u] += __shfl_xor(var[u], o); bs[u] += __shfl_xor(bs[u], o); }
#pragma unroll
        for (int u = 0; u < 4; ++u) {
            const float yn = y[u] * rsqrtf(var[u] * (1.f / 64.f) + 64e-5f) * p.lnx_g[(size_t)l * 384 + chv[u]] + p.lnx_b[(size_t)l * 384 + chv[u]];
            MIX[(size_t)tokv[u] * 1024 + chv[u]] = f2bf((yn + bs[u] * vv[u]) * g[u]);
        }
    }
}

#define LAS __attribute__((address_space(3)))
namespace pg8 {
typedef short bf16x8 __attribute__((ext_vector_type(8)));
typedef float f32x4 __attribute__((ext_vector_type(4)));
constexpr int BM = 256, BK = 64, HALF = 128, HTB = HALF * BK * 2, STAGE_BYTES = 8 * HTB, NXCD = 8, WGM = 8;
__host__ __device__ __forceinline__ int lds_byte(int r, int c) { const int st = (r >> 4) * 2 + (c >> 5), rr = r & 15, cc = c & 31, ob = rr * 64 + cc * 2; return st * 1024 + (ob ^ (((ob >> 9) & 1) << 5)); }
__host__ __device__ __forceinline__ void stage_rc(int b, int& R, int& C) { const int st = b / 1024, sb = b % 1024, swz = sb ^ (((sb >> 9) & 1) << 5); R = (st >> 1) * 16 + swz / 64; C = (st & 1) * 32 + (swz % 64) / 2; }
struct Unit { int pm, pn; };
struct Gemm { const bf16_t* A; const bf16_t* Bt; int M, N, K; };
struct StaticOrder {
    int nM, nN, nwg, G, c;
    __device__ void init(int M, int N, int G_, int c_) { nM = M / BM; nN = N / BM; nwg = nM * nN; G = G_; c = c_; }
    __device__ bool next(int i, Unit& u) const {
        const long L = (long)i * G + c; if (L >= nwg) return false;
        int wgid = (int)L; { const int q = nwg / NXCD, r = nwg % NXCD, xcd = wgid % NXCD, off = wgid / NXCD; wgid = (xcd < r ? xcd * (q + 1) : r * (q + 1) + (xcd - r) * q) + off; }
        const int nig = WGM * nN, gid = wgid / nig, fm = gid * WGM, gsz = (nM - fm) < WGM ? (nM - fm) : WGM;
        u.pm = fm + ((wgid % nig) % gsz); u.pn = (wgid % nig) / gsz; return true;
    }
};
template <class Epi, class Sched>
__device__ __forceinline__ void gemm_phase(LAS unsigned char* lds, const Gemm g, const Sched& S, const Epi& E) {
    int tid_ = threadIdx.x; asm volatile("" : "+v"(tid_));
    const int tid = tid_, wid = __builtin_amdgcn_readfirstlane(tid >> 6), lane = tid & 63, wr = wid >> 2, wc = wid & 3, fr = lane & 15, fq = lane >> 4;
    const int K = g.K, nt = K / BK;
    unsigned voffA[2], voffB[2];
#pragma unroll
    for (int i = 0; i < 2; ++i) { int R, C; stage_rc(tid * 16 + i * 8192, R, C); voffA[i] = (unsigned)(R * K + C) * 2u; voffB[i] = (unsigned)(R * K + C) * 2u; }
    const size_t kstep = (size_t)(BK * 2);
    const size_t hstep = (size_t)HALF * K * 2;
    const size_t tstep = 2 * hstep;
    const unsigned ldsw = (unsigned)wid * 1024u;
    const int aoff = lds_byte(wr * 64 + fr, fq * 8), boff = lds_byte(wc * 32 + fr, fq * 8);
#define PG8_SA(b, h) (((b) * 2 + (h)) * HTB)
#define PG8_SB(b, h) ((4 + (b) * 2 + (h)) * HTB)
#define PG8_STAGE(bufoff, gbase, voff) do { _Pragma("unroll") for (int _i = 0; _i < 2; ++_i) \
        __builtin_amdgcn_global_load_lds((const unsigned*)((const char*)(gbase) + (voff)[_i]), (LAS unsigned*)(lds + (bufoff) + ldsw + _i * 8192), 16, 0, 0); } while (0)
#define PG8_LDA(dst, b, h) do { _Pragma("unroll") for (int m = 0; m < 4; ++m) _Pragma("unroll") for (int k = 0; k < 2; ++k) dst[m][k] = *(const LAS bf16x8*)(lds + PG8_SA(b, h) + aoff + m * 2048 + k * 1024); } while (0)
#define PG8_LDB(dst, b, h) do { _Pragma("unroll") for (int n = 0; n < 2; ++n) _Pragma("unroll") for (int k = 0; k < 2; ++k) dst[n][k] = *(const LAS bf16x8*)(lds + PG8_SB(b, h) + boff + n * 2048 + k * 1024); } while (0)
#define PG8_MMA(ai, bj, At, Bt) do { __builtin_amdgcn_s_setprio(1); _Pragma("unroll") for (int m = 0; m < 4; ++m) _Pragma("unroll") for (int n = 0; n < 2; ++n) _Pragma("unroll") for (int k = 0; k < 2; ++k) \
        acc[ai][bj][m][n] = __builtin_amdgcn_mfma_f32_16x16x32_bf16(Bt[n][k], At[m][k], acc[ai][bj][m][n], 0, 0, 0); __builtin_amdgcn_s_setprio(0); } while (0)
#define PG8_WAIT_V(n) asm volatile("s_waitcnt vmcnt(" #n ")" ::: "memory")
#define PG8_WAIT_L(n) asm volatile("s_waitcnt lgkmcnt(" #n ")" ::: "memory")
#define PG8_BAR __builtin_amdgcn_s_barrier()
#define PG8_SCHED __builtin_amdgcn_sched_barrier(0)
    Unit cur, nxt; int ui = 0;
    if (!S.next(0, cur)) return;
    f32x4 acc[2][2][4][2];
#pragma unroll
    for (int a = 0; a < 2; ++a)
#pragma unroll
        for (int b = 0; b < 2; ++b)
#pragma unroll
            for (int m = 0; m < 4; ++m)
#pragma unroll
                for (int n = 0; n < 2; ++n) acc[a][b][m][n] = (f32x4){0.f, 0.f, 0.f, 0.f};
    bf16x8 At[4][2], B0[2][2], B1[2][2];
    const char* cA = (const char*)g.A + (size_t)cur.pm * tstep; const char* cB = (const char*)g.Bt + (size_t)cur.pn * tstep;
    PG8_STAGE(PG8_SB(0, 0), cB, voffB); PG8_STAGE(PG8_SA(0, 0), cA, voffA); PG8_STAGE(PG8_SB(0, 1), cB + hstep, voffB); PG8_STAGE(PG8_SA(0, 1), cA + hstep, voffA);
    if (wr == 1) PG8_BAR;
    PG8_WAIT_V(4); PG8_BAR;
    PG8_STAGE(PG8_SB(1, 0), cB + kstep, voffB); PG8_STAGE(PG8_SA(1, 0), cA + kstep, voffA); PG8_STAGE(PG8_SB(1, 1), cB + hstep + kstep, voffB);
    PG8_WAIT_V(6); PG8_BAR;
    for (;;) {
        const bool has_next = S.next(ui + 1, nxt);
        const char* nA = has_next ? (const char*)g.A + (size_t)nxt.pm * tstep : cA; const char* nB = has_next ? (const char*)g.Bt + (size_t)nxt.pn * tstep : cB;
        for (int t = 0; t < nt; t += 2) {
            const bool last = (t == nt - 2);
            const char* a1 = cA + (size_t)(t + 1) * kstep;
            const char* a2 = last ? nA : cA + (size_t)(t + 2) * kstep; const char* b2 = last ? nB : cB + (size_t)(t + 2) * kstep;
            const char* a3 = a2 + kstep; const char* b3 = b2 + kstep;
            PG8_LDB(B0, 0, 0); PG8_SCHED; PG8_LDA(At, 0, 0); PG8_STAGE(PG8_SA(1, 1), a1 + hstep, voffA);
            PG8_WAIT_L(8); PG8_BAR; PG8_WAIT_L(0); PG8_MMA(0, 0, At, B0); PG8_BAR; PG8_SCHED;
            PG8_LDB(B1, 0, 1); PG8_STAGE(PG8_SB(0, 0), b2, voffB);
            PG8_BAR; PG8_WAIT_L(0); PG8_MMA(0, 1, At, B1); PG8_BAR;
            PG8_LDA(At, 0, 1); PG8_STAGE(PG8_SA(0, 0), a2, voffA);
            PG8_BAR; PG8_WAIT_L(0); PG8_MMA(1, 0, At, B0); PG8_BAR; PG8_SCHED;
            PG8_STAGE(PG8_SB(0, 1), b2 + hstep, voffB);
            PG8_WAIT_V(6); PG8_BAR; PG8_MMA(1, 1, At, B1); PG8_BAR;
            PG8_LDB(B0, 1, 0); PG8_SCHED; PG8_LDA(At, 1, 0); PG8_STAGE(PG8_SA(0, 1), a2 + hstep, voffA);
            PG8_WAIT_L(8); PG8_BAR; PG8_WAIT_L(0); PG8_MMA(0, 0, At, B0); PG8_BAR; PG8_SCHED;
            PG8_LDB(B1, 1, 1); PG8_STAGE(PG8_SB(1, 0), b3, voffB);
            PG8_BAR; PG8_WAIT_L(0); PG8_MMA(0, 1, At, B1); PG8_BAR;
            PG8_LDA(At, 1, 1); PG8_STAGE(PG8_SA(1, 0), a3, voffA);
            PG8_BAR; PG8_WAIT_L(0); PG8_MMA(1, 0, At, B0); PG8_BAR; PG8_SCHED;
            PG8_STAGE(PG8_SB(1, 1), b3 + hstep, voffB);
            PG8_WAIT_V(6); PG8_BAR; PG8_MMA(1, 1, At, B1); PG8_BAR;
        }
        E(acc, cur, wr, wc, fr, fq);
        if (!has_next) break;
#pragma unroll
        for (int a = 0; a < 2; ++a)
#pragma unroll
            for (int b = 0; b < 2; ++b)
#pragma unroll
                for (int m = 0; m < 4; ++m)
#pragma unroll
                    for (int n = 0; n < 2; ++n) acc[a][b][m][n] = (f32x4){0.f, 0.f, 0.f, 0.f};
        cur = nxt; cA = nA; cB = nB; ++ui;
    }
    PG8_WAIT_V(0);
    if (wr == 0) PG8_BAR;
    PG8_BAR;
#undef PG8_SA
#undef PG8_SB
#undef PG8_STAGE
#undef PG8_LDA
#undef PG8_LDB
#undef PG8_MMA
#undef PG8_WAIT_V
#undef PG8_WAIT_L
#undef PG8_BAR
#undef PG8_SCHED
}
template <class F> struct EpiWrap {
    const P* p; F f;
    __device__ __forceinline__ void operator()(const f32x4 (&acc)[2][2][4][2], const Unit& u, int wr, int wc, int fr, int fq) const {
        const int row0 = u.pm * BM + wr * 64 + fr, col0 = u.pn * BM + wc * 32 + 4 * fq;
#pragma unroll
        for (int ai = 0; ai < 2; ++ai)
#pragma unroll
            for (int m = 0; m < 4; ++m)
#pragma unroll
                for (int bj = 0; bj < 2; ++bj)
#pragma unroll
                    for (int n = 0; n < 2; ++n) {
                        const f32x4 a = acc[ai][bj][m][n]; const float v[4] = {a[0], a[1], a[2], a[3]};
                        f(*p, row0 + ai * HALF + m * 16, col0 + bj * HALF + n * 16, v);
                    }
    }
};
struct EpiG1H {
    const P* p; int l;
    __device__ __forceinline__ void operator()(const f32x4 (&acc)[2][2][4][2], const Unit& u, int wr, int wc, int fr, int fq) const {
        const int row0 = u.pm * BM + wr * 64 + fr, col0 = u.pn * BM + wc * 32 + 4 * fq;
        const float* rsq = (const float*)(p->ws + WS_RSQ) + (size_t)(2 * l) * NTOK;
        const float* bias = (const float*)(p->ws + WS_BIAS) + (size_t)(l * 3 + tok_cls(u.pm * BM)) * 3072 + col0;
        float rs[2][4]; float4 bb[2][2];
#pragma unroll
        for (int ai = 0; ai < 2; ++ai)
#pragma unroll
            for (int m = 0; m < 4; ++m) rs[ai][m] = rsq[row0 + ai * HALF + m * 16];
#pragma unroll
        for (int bj = 0; bj < 2; ++bj)
#pragma unroll
            for (int n = 0; n < 2; ++n) bb[bj][n] = *(const float4*)(bias + bj * HALF + n * 16);
#pragma unroll
        for (int ai = 0; ai < 2; ++ai)
#pragma unroll
            for (int m = 0; m < 4; ++m) rs[ai][m] = rsqrtf(rs[ai][m] * (1.f / 1024.f) + 1e-6f);
        const EpiG1 f{l};
#pragma unroll
        for (int ai = 0; ai < 2; ++ai)
#pragma unroll
            for (int m = 0; m < 4; ++m)
#pragma unroll
                for (int bj = 0; bj < 2; ++bj)
#pragma unroll
                    for (int n = 0; n < 2; ++n) {
                        const f32x4 a = acc[ai][bj][m][n]; const float r = rs[ai][m]; const float4 b = bb[bj][n];
                        const float v[4] = {a[0] * r + b.x, a[1] * r + b.y, a[2] * r + b.z, a[3] * r + b.w};
                        f(*p, row0 + ai * HALF + m * 16, col0 + bj * HALF + n * 16, v);
                    }
    }
};
struct EpiFfn1 {
    const P* p; int l;
    __device__ __forceinline__ void operator()(const f32x4 (&acc)[2][2][4][2], const Unit& u, int wr, int wc, int fr, int fq) const {
        const int row0 = u.pm * BM + wr * 64 + fr, j0 = u.pn * 128 + wc * 32 + 4 * fq, c0 = u.pn * 256 + wc * 32 + 4 * fq;
        bf16_t* HA = (bf16_t*)(p->ws + WS_UR);
        const float* rsq = (const float*)(p->ws + WS_RSQ) + (size_t)(2 * l + 1) * NTOK;
        const float* bc = (const float*)(p->ws + WS_BIAS) + 2 * 3 * 3072 + (size_t)(l * 3 + tok_cls(u.pm * BM)) * 5632 + c0;
        float rs[2][4]; float4 bg[2], bu[2];
#pragma unroll
        for (int ai = 0; ai < 2; ++ai)
#pragma unroll
            for (int m = 0; m < 4; ++m) rs[ai][m] = rsq[row0 + ai * HALF + m * 16];
#pragma unroll
        for (int n = 0; n < 2; ++n) { bg[n] = *(const float4*)(bc + n * 16); bu[n] = *(const float4*)(bc + 128 + n * 16); }
#pragma unroll
        for (int ai = 0; ai < 2; ++ai)
#pragma unroll
            for (int m = 0; m < 4; ++m) rs[ai][m] = rsqrtf(rs[ai][m] * (1.f / 1024.f) + 1e-6f);
#pragma unroll
        for (int ai = 0; ai < 2; ++ai)
#pragma unroll
            for (int m = 0; m < 4; ++m) {
                const int row = row0 + ai * HALF + m * 16; const float r = rs[ai][m];
#pragma unroll
                for (int n = 0; n < 2; ++n) {
                    const f32x4 g = acc[ai][0][m][n], up = acc[ai][1][m][n]; float h[4];
                    const float bgv[4] = {bg[n].x, bg[n].y, bg[n].z, bg[n].w}, buv[4] = {bu[n].x, bu[n].y, bu[n].z, bu[n].w};
#pragma unroll
                    for (int e = 0; e < 4; ++e) { const float gt = g[e] * r + bgv[e], uu = up[e] * r + buv[e]; h[e] = gt * sigmoidf_(gt) * uu; }
                    uint2 w; w.x = (unsigned)f2bf(h[0]) | ((unsigned)f2bf(h[1]) << 16); w.y = (unsigned)f2bf(h[2]) | ((unsigned)f2bf(h[3]) << 16);
                    *(uint2*)(HA + (size_t)row * D_FF + j0 + n * 16) = w;
                }
            }
    }
};
struct EpiResN {
    const P* p; int l, which;
    const float* ng; int nl, nsc;
    bf16_t* Hout; float* rsq;
    __device__ __forceinline__ void operator()(const f32x4 (&acc)[2][2][4][2], const Unit& u, int wr, int wc, int fr, int fq) const {
        const int row0 = u.pm * BM + wr * 64 + fr, col0 = u.pn * BM + wc * 32 + 4 * fq;
        const int cls = tok_cls(u.pm * BM);
        const float* g = mod_vec(*p, l, cls, which) + col0;
        float4 gg[2][2], gw[2][2];
#pragma unroll
        for (int bj = 0; bj < 2; ++bj)
#pragma unroll
            for (int n = 0; n < 2; ++n) {
                gg[bj][n] = *(const float4*)(g + bj * HALF + n * 16);
                if (ng) { const float4 gn = *(const float4*)(ng + col0 + bj * HALF + n * 16), sc = *(const float4*)(mod_vec(*p, nl, cls, nsc) + col0 + bj * HALF + n * 16);
                    gw[bj][n] = make_float4(gn.x * (1.f + sc.x), gn.y * (1.f + sc.y), gn.z * (1.f + sc.z), gn.w * (1.f + sc.w)); }
            }
#pragma unroll
        for (int ai = 0; ai < 2; ++ai)
#pragma unroll
            for (int mp = 0; mp < 4; mp += 2) {
                float4 x[2][2][2];
#pragma unroll
                for (int q = 0; q < 2; ++q) {
                    const int row = row0 + ai * HALF + (mp + q) * 16;
                    const float* xo = ((which == 2 && l == 0) ? xin_row(*p, row) : X_row(*p, row)) + col0;
#pragma unroll
                    for (int bj = 0; bj < 2; ++bj)
#pragma unroll
                        for (int n = 0; n < 2; ++n) x[q][bj][n] = *(const float4*)(xo + bj * HALF + n * 16);
                }
#pragma unroll
                for (int q = 0; q < 2; ++q) {
                    const int row = row0 + ai * HALF + (mp + q) * 16;
                    float ssq = 0.f;
#pragma unroll
                    for (int bj = 0; bj < 2; ++bj)
#pragma unroll
                        for (int n = 0; n < 2; ++n) {
                            const int col = col0 + bj * HALF + n * 16; const f32x4 a = acc[ai][bj][mp + q][n]; const float4 xv = x[q][bj][n], gv = gg[bj][n];
                            const float4 xn = make_float4(xv.x + gv.x * a[0], xv.y + gv.y * a[1], xv.z + gv.z * a[2], xv.w + gv.w * a[3]);
                            *(float4*)(X_row(*p, row) + col) = xn;
                            if (ng) {
                                ssq += xn.x * xn.x + xn.y * xn.y + xn.z * xn.z + xn.w * xn.w;
                                const float4 w4 = gw[bj][n];
                                uint2 w; w.x = (unsigned)f2bf(xn.x * w4.x) | ((unsigned)f2bf(xn.y * w4.y) << 16); w.y = (unsigned)f2bf(xn.z * w4.z) | ((unsigned)f2bf(xn.w * w4.w) << 16);
                                *(uint2*)(Hout + (size_t)row * 1024 + col) = w;
                            }
                        }
                    if (ng) { ssq += __shfl_xor(ssq, 16); ssq += __shfl_xor(ssq, 32); if (fq == 0) unsafeAtomicAdd(rsq + row, ssq); }
                }
            }
    }
};
}


typedef short bf16x8_t __attribute__((ext_vector_type(8)));
typedef short bf16x4_t __attribute__((ext_vector_type(4)));
typedef float f32x16_t __attribute__((ext_vector_type(16)));
#define AT_KS_BYTES (256 * 72 * 2)
__device__ __forceinline__ unsigned pk_bf16(float lo, float hi) { return (unsigned)f2bf(lo) | ((unsigned)f2bf(hi) << 16); }
__device__ __forceinline__ void attn_stage(const P& p, int l, int s, int h, int start, int nctx, int chunk, bool withV, bf16_t* Ks, bf16_t* Vt, int tid) {
    const int key = tid >> 1, half = tid & 1, j = chunk * 256 + key;
    if (j < nctx) {
        const size_t base = (((size_t)(s - 32) * 2 + l) * 512 + j) * 384 + h * 64 + half * 32;
        const float4* kp = (const float4*)(p.cache_k + base);
#pragma unroll
        for (int i = 0; i < 4; ++i) { const float4 a = kp[2 * i], b = kp[2 * i + 1]; uint4 o; o.x = pk_bf16(a.x, a.y); o.y = pk_bf16(a.z, a.w); o.z = pk_bf16(b.x, b.y); o.w = pk_bf16(b.z, b.w);
            *(uint4*)(Ks + key * 72 + half * 32 + i * 8) = o; }
        if (withV) { const float4* vp = (const float4*)(p.cache_v + base);
#pragma unroll
            for (int i = 0; i < 8; ++i) { const float4 a = vp[i]; bf16_t* d = Vt + (half * 32 + i * 4) * 260 + key; d[0] = f2bf(a.x); d[260] = f2bf(a.y); d[520] = f2bf(a.z); d[780] = f2bf(a.w); } }
    } else {
        const bf16_t* UD = (const bf16_t*)(p.ws + WS_UD);
        const size_t base = (size_t)(start + j - nctx) * 1152 + h * 64 + half * 32;
        const uint4* kp = (const uint4*)(UD + base + 384);
#pragma unroll
        for (int i = 0; i < 4; ++i) *(uint4*)(Ks + key * 72 + half * 32 + i * 8) = kp[i];
        if (withV) { const uint4* vp = (const uint4*)(UD + base + 768);
#pragma unroll
            for (int i = 0; i < 4; ++i) { const uint4 u = vp[i]; const unsigned w[4] = {u.x, u.y, u.z, u.w}; bf16_t* d = Vt + (half * 32 + i * 8) * 260 + key;
#pragma unroll
                for (int e = 0; e < 4; ++e) { d[(2 * e) * 260] = (bf16_t)(w[e] & 0xffff); d[(2 * e + 1) * 260] = (bf16_t)(w[e] >> 16); } } }
    }
}
__device__ __forceinline__ void attn_item(const P& p, int l, int item, unsigned char* lds, float lam, float lam_init) {
    const int tid = otid(), lane = tid & 63, wv = tid >> 6, n = lane & 31, hh = lane >> 5;
    int s, h, qb;
    if (item < 48) { s = 32 + item / 24; h = (item % 24) / 4; qb = item & 3; } else { const int r = item - 48; s = r / 6; h = r % 6; qb = 0; }
    int start, T; seq_info(s, start, T);
    const int nctx = s >= 32 ? 512 : 0, nchunks = (nctx + T) >> 8;
    bf16_t* Ks = (bf16_t*)lds; bf16_t* Vt = (bf16_t*)(lds + AT_KS_BYTES);
    const bf16_t* UD = (const bf16_t*)(p.ws + WS_UD);
    const int qtok = start + qb * 256 + wv * 32 + n;
    bf16x8_t Qf[2][2];
#pragma unroll
    for (int m = 0; m < 2; ++m)
#pragma unroll
        for (int si = 0; si < 2; ++si) Qf[m][si] = *(const bf16x8_t*)(UD + (size_t)qtok * 1152 + h * 64 + m * 32 + si * 16 + hh * 8);
    const float c = 0.17677669529663687f * 1.4426950408889634f;
    float m0 = -1e30f, m1 = -1e30f, l0 = 0.f, l1 = 0.f;
    for (int ch = 0; ch < nchunks; ++ch) {
        __syncthreads();
        attn_stage(p, l, s, h, start, nctx, ch, false, Ks, Vt, tid);
        __syncthreads();
#pragma unroll 1
        for (int kt = 0; kt < 8; ++kt) {
            f32x16_t S0 = {0,0,0,0,0,0,0,0,0,0,0,0,0,0,0,0}, S1 = S0;
#pragma unroll
            for (int si = 0; si < 2; ++si) {
                const bf16x8_t k0 = *(const bf16x8_t*)(Ks + (kt * 32 + n) * 72 + si * 16 + hh * 8);
                const bf16x8_t k1 = *(const bf16x8_t*)(Ks + (kt * 32 + n) * 72 + 32 + si * 16 + hh * 8);
                S0 = __builtin_amdgcn_mfma_f32_32x32x16_bf16(k0, Qf[0][si], S0, 0, 0, 0);
                S1 = __builtin_amdgcn_mfma_f32_32x32x16_bf16(k1, Qf[1][si], S1, 0, 0, 0);
            }
            float t0 = S0[0], t1 = S1[0];
#pragma unroll
            for (int r = 1; r < 16; ++r) { t0 = fmaxf(t0, S0[r]); t1 = fmaxf(t1, S1[r]); }
            const float n0 = fmaxf(m0, t0), n1 = fmaxf(m1, t1);
            float a0 = 0.f, a1 = 0.f;
#pragma unroll
            for (int r = 0; r < 16; ++r) { a0 += __builtin_amdgcn_exp2f((S0[r] - n0) * c); a1 += __builtin_amdgcn_exp2f((S1[r] - n1) * c); }
            l0 = l0 * __builtin_amdgcn_exp2f((m0 - n0) * c) + a0; l1 = l1 * __builtin_amdgcn_exp2f((m1 - n1) * c) + a1;
            m0 = n0; m1 = n1;
        }
    }
    {
        const float mo0 = __shfl_xor(m0, 32), lo0 = __shfl_xor(l0, 32), mo1 = __shfl_xor(m1, 32), lo1 = __shfl_xor(l1, 32);
        const float M0 = fmaxf(m0, mo0), M1 = fmaxf(m1, mo1);
        l0 = l0 * __builtin_amdgcn_exp2f((m0 - M0) * c) + lo0 * __builtin_amdgcn_exp2f((mo0 - M0) * c);
        l1 = l1 * __builtin_amdgcn_exp2f((m1 - M1) * c) + lo1 * __builtin_amdgcn_exp2f((mo1 - M1) * c);
        m0 = M0; m1 = M1;
    }
    const float i0 = 1.f / l0, i1 = lam / l1;
    f32x16_t O0 = {0,0,0,0,0,0,0,0,0,0,0,0,0,0,0,0}, O1 = O0;
    for (int ch = 0; ch < nchunks; ++ch) {
        __syncthreads();
        attn_stage(p, l, s, h, start, nctx, ch, true, Ks, Vt, tid);
        __syncthreads();
#pragma unroll 1
        for (int kt = 0; kt < 8; ++kt) {
            f32x16_t S0 = {0,0,0,0,0,0,0,0,0,0,0,0,0,0,0,0}, S1 = S0;
#pragma unroll
            for (int si = 0; si < 2; ++si) {
                const bf16x8_t k0 = *(const bf16x8_t*)(Ks + (kt * 32 + n) * 72 + si * 16 + hh * 8);
                const bf16x8_t k1 = *(const bf16x8_t*)(Ks + (kt * 32 + n) * 72 + 32 + si * 16 + hh * 8);
                S0 = __builtin_amdgcn_mfma_f32_32x32x16_bf16(k0, Qf[0][si], S0, 0, 0, 0);
                S1 = __builtin_amdgcn_mfma_f32_32x32x16_bf16(k1, Qf[1][si], S1, 0, 0, 0);
            }
            float pw[16];
#pragma unroll
            for (int r = 0; r < 16; ++r) pw[r] = __builtin_amdgcn_exp2f((S0[r] - m0) * c) * i0 - __builtin_amdgcn_exp2f((S1[r] - m1) * c) * i1;
#pragma unroll
            for (int si = 0; si < 2; ++si) {
                union { unsigned u[4]; bf16x8_t v; } pf;
#pragma unroll
                for (int e = 0; e < 4; ++e) pf.u[e] = pk_bf16(pw[8 * si + 2 * e], pw[8 * si + 2 * e + 1]);
                union { bf16x4_t h2[2]; bf16x8_t v; } va, vb;
                const bf16_t* v0 = Vt + n * 260 + kt * 32 + si * 16 + hh * 4;
                va.h2[0] = *(const bf16x4_t*)v0; va.h2[1] = *(const bf16x4_t*)(v0 + 8);
                vb.h2[0] = *(const bf16x4_t*)(v0 + 32 * 260); vb.h2[1] = *(const bf16x4_t*)(v0 + 32 * 260 + 8);
                O0 = __builtin_amdgcn_mfma_f32_32x32x16_bf16(va.v, pf.v, O0, 0, 0, 0);
                O1 = __builtin_amdgcn_mfma_f32_32x32x16_bf16(vb.v, pf.v, O1, 0, 0, 0);
            }
        }
    }
    float ss = 0.f;
#pragma unroll
    for (int r = 0; r < 16; ++r) ss += O0[r] * O0[r] + O1[r] * O1[r];
    ss += __shfl_xor(ss, 32);
    const float rs = rsqrtf(ss * (1.f / 64.f) + 1e-5f) * (1.f - lam_init);
    bf16_t* mo = (bf16_t*)(p.ws + WS_H) + (size_t)qtok * 1024 + 384 + h * 64;
    const float* sg = p.subln_g + (size_t)l * 64;
#pragma unroll
    for (int g = 0; g < 4; ++g) {
        const int vd = 8 * g + 4 * hh;
        uint2 w0, w1;
        w0.x = pk_bf16(O0[4 * g] * rs * sg[vd], O0[4 * g + 1] * rs * sg[vd + 1]); w0.y = pk_bf16(O0[4 * g + 2] * rs * sg[vd + 2], O0[4 * g + 3] * rs * sg[vd + 3]);
        w1.x = pk_bf16(O1[4 * g] * rs * sg[32 + vd], O1[4 * g + 1] * rs * sg[32 + vd + 1]); w1.y = pk_bf16(O1[4 * g + 2] * rs * sg[32 + vd + 2], O1[4 * g + 3] * rs * sg[32 + vd + 3]);
        *(uint2*)(mo + vd) = w0; *(uint2*)(mo + 32 + vd) = w1;
    }
}

struct EpiFnet {
    int samp;
    __device__ __forceinline__ void operator()(const P& p, int row, int col, const float* v) const {
        const int sq = col >> 8, ch = col & 255;
        const int tok = samp ? NPTOK + sq * 1024 + row : sq * 256 + row;
        uint2 w; w.x = pk_bf16(v[0], v[1]); w.y = pk_bf16(v[2], v[3]);
        *(uint2*)((bf16_t*)(p.ws + WS_H) + (size_t)tok * 1024 + 768 + ch) = w;
    }
};
struct OneUnit { int pm, pn; __device__ bool next(int i, pg8::Unit& u) const { if (i) return false; u.pm = pm; u.pn = pn; return true; } };

#define MX_ITEMS 532
template <class GemmFn>
__device__ __forceinline__ void ph_mixer(const P& p, int l, unsigned char* lds, volatile LAS unsigned* slot, GemmFn gemm_one) {
    const float lam_init = 0.8f - 0.6f * __expf(-0.3f * (float)l);
    float lam;
    { const float* lp = p.diff_lambda + (size_t)l * 128; float s01 = 0.f, s23 = 0.f;
      for (int d = 0; d < 32; ++d) { s01 += lp[d] * lp[32 + d]; s23 += lp[64 + d] * lp[96 + d]; }
      lam = __expf(s01) - __expf(s23) + lam_init; }
    unsigned* ctr = (unsigned*)(p.ws + WS_CTL) + CTL_QUEUE + 64 * l;
    for (;;) {
        __syncthreads();
        if (threadIdx.x == 0) *slot = atomicAdd(ctr, 1u);
        __syncthreads();
        const int item = (int)*slot;
        if (item >= MX_ITEMS) break;
#if PROBE_ID
        const unsigned long long it0 = __builtin_amdgcn_s_memrealtime();
#endif
        if (item < 48) attn_item(p, l, item, lds, lam, lam_init);
        else if (item < 60) ph_scan_job(p, l, 32 + (item - 48) / NH, (item - 48) % NH, 0, 0, 0, 0, SEG0_LEN, (float*)lds);
        else if (item < 108) { const int r = item - 60, sg = 1 + (r & 1), dr = (r >> 1) & 1, hh = (r >> 2) % NH, bb = r / 24;
            ph_scan_job(p, l, 32 + bb, hh, 1, dr, sg, sg == 1 ? SEG0_LEN : SEG0_LEN + SEGX_LEN, SEGX_LEN, (float*)lds); }
        else if (item < 300) ph_scan_job(p, l, (item - 108) / NH, (item - 108) % NH, 0, 0, 0, 0, TP, (float*)lds);
        else if (item < 308) gemm_one(1, (item - 300) >> 1, (item - 300) & 1);
        else if (item < 500) attn_item(p, l, 48 + item - 308, lds, lam, lam_init);
        else gemm_one(0, 0, item - 500);
#if PROBE_ID
        __syncthreads();
        if (threadIdx.x == 0 && l == 0) { const int cls = item < 48 ? 3 : item < 60 ? 0 : item < 108 ? 6 : item < 300 ? 2 : item < 308 ? 1 : item < 500 ? 5 : 4;
            atomicMax((unsigned*)(p.ws + WS_CTL) + 3712 + cls, (unsigned)(__builtin_amdgcn_s_memrealtime() - it0)); }
#endif
    }
}

#define XB_TMO      128
#define XB_XCNT(j)  (256  + 64 * (j))
#define XB_XSUB(j)  (1280 + 64 * (j))
#define XB_XGEN(j)  (2304 + 64 * (j))
#define XB_TOP      3328
#define XB_TOPGEN   3392
#define XCD_BAR_WORDS 3456
#define XB_SPIN_CAP (1u << 22)
__device__ __forceinline__ unsigned xb_ld(unsigned* p)              { return __hip_atomic_load(p, __ATOMIC_RELAXED, __HIP_MEMORY_SCOPE_AGENT); }
__device__ __forceinline__ unsigned xb_add(unsigned* p, unsigned v) { return __hip_atomic_fetch_add(p, v, __ATOMIC_RELAXED, __HIP_MEMORY_SCOPE_AGENT); }
__device__ __forceinline__ unsigned xb_xcc_id() { return (unsigned)__builtin_amdgcn_s_getreg((3 << 11) | 20) & 0xFu; }
#define XB_SPIN(cond, bar) do { unsigned _sp = 0; while (cond) { __builtin_amdgcn_s_sleep(1); \
    if ((++_sp & 255u) == 0u) { if (xb_ld(&(bar)[XB_TMO])) break; if (_sp > XB_SPIN_CAP) { atomicAdd(&(bar)[XB_TMO], 1u); break; } } } } while (0)
struct XcdBarrier { unsigned* bar; unsigned x; volatile LAS unsigned* st; };
__device__ __forceinline__ XcdBarrier xcd_barrier_post(unsigned* bar, volatile LAS unsigned* st) {
    XcdBarrier b; b.bar = bar; b.x = xb_xcc_id(); b.st = st;
    if (threadIdx.x == 0) (void)xb_add(&bar[XB_XCNT(b.x)], 1u);
    return b;
}
__device__ __forceinline__ void xcd_barrier_complete(unsigned* bar, unsigned x, unsigned& nloc, unsigned& nx) {
    const unsigned G = gridDim.x * gridDim.y * gridDim.z;
    unsigned sum, cnt, mine, sp = 0u;
    for (;;) {
        sum = 0u; cnt = 0u; mine = 0u;
#pragma unroll
        for (unsigned j = 0; j < 16; ++j) { const unsigned c = xb_ld(&bar[XB_XCNT(j)]); sum += c; cnt += (c > 0u) ? 1u : 0u; mine = (j == x) ? c : mine; }
        if (sum == G) break;
        __builtin_amdgcn_s_sleep(1);
        if ((++sp & 255u) == 0u) { if (xb_ld(&bar[XB_TMO])) break; if (sp > XB_SPIN_CAP) { atomicAdd(&bar[XB_TMO], 1u); break; } }
    }
    nloc = mine > 0u ? mine : 1u; nx = cnt > 0u ? cnt : 1u;
}
__device__ __forceinline__ void xcd_barrier(const XcdBarrier& b) {
    asm volatile("s_waitcnt vmcnt(0)" ::: "memory");
    __syncthreads();
    if (threadIdx.x == 0) {
        unsigned* bar = b.bar;
        __builtin_amdgcn_s_waitcnt(0);
        unsigned nloc = b.st[0], nx = b.st[1];
        if (nloc == 0u) { xcd_barrier_complete(bar, b.x, nloc, nx); b.st[0] = nloc; b.st[1] = nx; }
        const unsigned old = xb_add(&bar[XB_XSUB(b.x)], 1u);
        const unsigned gen = old / nloc;
        if (old + 1u == (gen + 1u) * nloc) {
            __builtin_amdgcn_fence(__ATOMIC_RELEASE, "agent");
            asm volatile("s_waitcnt vmcnt(0)" ::: "memory");
            const unsigned og = xb_add(&bar[XB_TOP], 1u);
            const unsigned tg = og / nx;
            if (og + 1u == (tg + 1u) * nx) xb_add(&bar[XB_TOPGEN], 1u);
            else XB_SPIN(xb_ld(&bar[XB_TOPGEN]) == tg, bar);
            __builtin_amdgcn_fence(__ATOMIC_ACQUIRE, "agent");
            xb_add(&bar[XB_XGEN(b.x)], 1u);
            asm volatile("s_waitcnt vmcnt(0)" ::: "memory");
        } else {
            XB_SPIN(xb_ld(&bar[XB_XGEN(b.x)]) == gen, bar);
            __builtin_amdgcn_fence(__ATOMIC_ACQUIRE, "agent");
            asm volatile("s_waitcnt vmcnt(0)" ::: "memory");
        }
    }
    __syncthreads();
}

#define MISC_OFF 133120
#define LDS_BYTES (MISC_OFF + 1024)
#define N_PHASES 19
struct Args { P p; int ph_lo, ph_hi; };
__global__ __launch_bounds__(512, 2) void mega(Args a) {
    extern __shared__ __attribute__((aligned(16))) unsigned char lds[];
    const P& p = a.p;
    LAS unsigned char* l3 = (LAS unsigned char*)lds;
    volatile LAS unsigned* misc = (volatile LAS unsigned*)(l3 + MISC_OFF);
    if (threadIdx.x < 16) misc[threadIdx.x] = 0u;
    __syncthreads();
    XcdBarrier bar = xcd_barrier_post((unsigned*)(p.ws + WS_CTL), misc);
    float* sm = (float*)lds;
    const int lo = a.ph_lo, hi = a.ph_hi;
#define IN(k) (lo <= (k) && (k) < hi)
#if PROBE_ID
    unsigned long long* tsl = (unsigned long long*)(p.ws + WS_CTL + 15360);
    if (blockIdx.x == 0 && otid() == 0) tsl[0] = __builtin_amdgcn_s_memrealtime();
#define SEAM(k) do { if (IN(k) && IN((k) + 1)) xcd_barrier(bar); if (blockIdx.x == 0 && otid() == 0) tsl[1 + (k)] = __builtin_amdgcn_s_memrealtime(); } while (0)
#else
#define SEAM(k) do { if (IN(k) && IN((k) + 1)) xcd_barrier(bar); } while (0)
#endif
    if (IN(0)) ph_prep0(p, sm);
    SEAM(0);
    if (IN(1)) ph_prep0b(p);
    SEAM(1);
    for (int l = 0; l < 2; ++l) {
        const int b0 = 2 + 8 * l;
        if (IN(b0 + 0)) { pg8::Gemm g{(const bf16_t*)(p.ws + WS_H), (const bf16_t*)(p.ws + WS_WIN) + (size_t)l * N1 * 1024, NTOK, N1, 1024};
            pg8::StaticOrder S; S.init(NTOK, N1, gridDim.x, blockIdx.x); pg8::EpiG1H E{&p, l}; pg8::gemm_phase(l3, g, S, E); }
        SEAM(b0 + 0);
        if (IN(b0 + 1)) ph_prep(p, l, sm);
        SEAM(b0 + 1);
        if (IN(b0 + 2)) {
            auto gemm_one = [&](int samp, int pm, int pn) {
                pg8::Gemm g{samp ? (const bf16_t*)(p.ws + WS_L1024) : (const bf16_t*)(p.ws + WS_L256), samp ? (const bf16_t*)(p.ws + WS_ZF) + (size_t)8192 * 512 : (const bf16_t*)(p.ws + WS_ZF),
                            samp ? 1024 : 256, samp ? 512 : 8192, samp ? 2048 : 512};
                OneUnit S{pm, pn}; pg8::EpiWrap<EpiFnet> E{&p, EpiFnet{samp}}; pg8::gemm_phase(l3, g, S, E); };
            ph_mixer(p, l, lds, misc + 4, gemm_one);
        }
        SEAM(b0 + 2);
        if (IN(b0 + 3)) ph_fixup(p, sm);
        SEAM(b0 + 3);
        if (IN(b0 + 4)) ph_finalize(p, l);
        SEAM(b0 + 4);
        if (IN(b0 + 5)) { pg8::Gemm g{(const bf16_t*)(p.ws + WS_H), (const bf16_t*)(p.ws + WS_WOUT) + (size_t)l * 1024 * 1024, NTOK, 1024, 1024};
            pg8::StaticOrder S; S.init(NTOK, 1024, gridDim.x, blockIdx.x);
            pg8::EpiResN E{&p, l, 2, p.norm2_g + (size_t)l * 1024, l, 4, (bf16_t*)(p.ws + WS_H2), (float*)(p.ws + WS_RSQ) + (size_t)(2 * l + 1) * NTOK}; pg8::gemm_phase(l3, g, S, E); }
        SEAM(b0 + 5);
        if (IN(b0 + 6)) { pg8::Gemm g{(const bf16_t*)(p.ws + WS_H2), (const bf16_t*)(p.ws + WS_WF1) + (size_t)l * 5632 * 1024, NTOK, 5632, 1024};
            pg8::StaticOrder S; S.init(NTOK, 5632, gridDim.x, blockIdx.x); pg8::EpiFfn1 E{&p, l}; pg8::gemm_phase(l3, g, S, E); }
        SEAM(b0 + 6);
        if (IN(b0 + 7)) { pg8::Gemm g{(const bf16_t*)(p.ws + WS_UR), (const bf16_t*)(p.ws + WS_WF2) + (size_t)l * 1024 * 2816, NTOK, 1024, 2816};
            pg8::StaticOrder S; S.init(NTOK, 1024, gridDim.x, blockIdx.x);
            pg8::EpiResN E{&p, l, 5, l == 0 ? p.norm1_g + 1024 : (const float*)nullptr, 1, 1, (bf16_t*)(p.ws + WS_H), (float*)(p.ws + WS_RSQ) + (size_t)2 * NTOK}; pg8::gemm_phase(l3, g, S, E); }
        SEAM(b0 + 7);
    }
    if (IN(18)) ph_norm(p, 0, 2);
#if PROBE_ID
    __syncthreads();
    if (blockIdx.x == 0 && otid() == 0) {
        tsl[19] = __builtin_amdgcn_s_memrealtime();
        __threadfence();
        unsigned long long acc = 0;
#pragma unroll 1
        for (int k = 0; k < 19; ++k) {
            const int st = k == 0 ? -1 : (k == 1 ? -3 : (k == 18 ? -2 : 10 + (k - 2) % 8));
            bool sel = false;
            if (PROBE_ID == 1) sel = (k == 0);
            if (PROBE_ID == 2) sel = (st == 10 || st == 15 || st == 16 || st == 17);
            if (PROBE_ID == 3) sel = (st == 12);
            if (PROBE_ID == 4) sel = (st == -2 || st == -3);
            if (PROBE_ID == 5) sel = (st == 11);
            if (PROBE_ID == 6) sel = (st == 13);
            if (PROBE_ID == 7) sel = (st == 14);
            if (PROBE_ID == 8) sel = (st == 10);
            if (PROBE_ID == 9) sel = (st == 15);
            if (PROBE_ID == 10) sel = (st == 16);
            if (PROBE_ID == 11) sel = (st == 17);
            if (sel) acc += __hip_atomic_load(tsl + 1 + k, __ATOMIC_RELAXED, __HIP_MEMORY_SCOPE_AGENT) - __hip_atomic_load(tsl + k, __ATOMIC_RELAXED, __HIP_MEMORY_SCOPE_AGENT);
        }
        if (PROBE_ID >= 30 && PROBE_ID < 34) { unsigned long long* tsp = (unsigned long long*)(p.ws + WS_CTL + 15360) + 32; acc = __hip_atomic_load(tsp + (PROBE_ID - 29), __ATOMIC_RELAXED, __HIP_MEMORY_SCOPE_AGENT) - __hip_atomic_load(tsp + (PROBE_ID - 30), __ATOMIC_RELAXED, __HIP_MEMORY_SCOPE_AGENT); }
        else if (PROBE_ID >= 20) acc = __hip_atomic_load((unsigned*)(p.ws + WS_CTL) + 3712 + (PROBE_ID - 20), __ATOMIC_RELAXED, __HIP_MEMORY_SCOPE_AGENT);
        const unsigned long long t_end = __builtin_amdgcn_s_memrealtime();
        while (__builtin_amdgcn_s_memrealtime() - t_end < 4ull * acc) __builtin_amdgcn_s_sleep(8);
    }
#endif
#undef IN
#undef SEAM
}

extern "C" void kernel_launch(void* const* d_in, const int* in_sizes, int n_in, void* d_out, int out_size, void* d_ws, size_t ws_size, hipStream_t stream) {
    static int grid = 0;
    if (grid == 0) {
        if (n_in != 29 || ws_size < WS_END) { fprintf(stderr, "kernel_launch: bad n_in %d or ws_size %zu (need %zu)\n", n_in, ws_size, (size_t)WS_END); grid = -1; return; }
        int dev = 0, cus = 0, per_cu = 0;
        hipGetDevice(&dev); hipDeviceGetAttribute(&cus, hipDeviceAttributeMultiprocessorCount, dev);
        if (hipFuncSetAttribute((const void*)mega, hipFuncAttributeMaxDynamicSharedMemorySize, LDS_BYTES) != hipSuccess) { fprintf(stderr, "kernel_launch: hipFuncSetAttribute failed\n"); grid = -1; return; }
        if (hipOccupancyMaxActiveBlocksPerMultiprocessor(&per_cu, (const void*)mega, 512, LDS_BYTES) != hipSuccess || per_cu < 1) { fprintf(stderr, "kernel_launch: occupancy query says %d\n", per_cu); per_cu = 1; }
        (void)hipGetLastError();
        grid = cus;
    }
    if (grid < 0) return;
    hipMemsetAsync((unsigned char*)d_ws + WS_CTL, 0, 16384 + 4 * NTOK * 4, stream);
    Args a{};
    const float** f = (const float**)&a.p;
    for (int i = 0; i < 29; ++i) f[i] = (const float*)d_in[i];
    a.p.out = (float*)d_out; a.p.ws = (unsigned char*)d_ws;
#if ONE_LAUNCH
    a.ph_lo = 0; a.ph_hi = N_PHASES;
    hipLaunchKernelGGL(mega, dim3(grid), dim3(512), LDS_BYTES, stream, a);
#else
    for (int ph = 0; ph < N_PHASES; ++ph) { a.ph_lo = ph; a.ph_hi = ph + 1; hipLaunchKernelGGL(mega, dim3(grid), dim3(512), LDS_BYTES, stream, a); }
#endif
}
```

```cpp
#include <hip/hip_runtime.h>
#include <stdint.h>
#include <stdio.h>
#ifndef ONE_LAUNCH
#define ONE_LAUNCH 1
#endif
#ifndef PROBE_ID
#define PROBE_ID 0
#endif

typedef unsigned short bf16_t;

#define D_MODEL 1024
#define NTOK 10240
#define NPTOK 8192
#define TP 256
#define TS 1024
#define NSEQ 34
#define NH 6
#define N1 3072
#define C_DIFF 0
#define C_FNET 1152
#define C_RWKV 1664
#define C_END 3008
#define N_RWKV 1344
#define D_FF 2816
#define D_IN 2752

#define OUT_YP 0
#define OUT_YS 8388608
#define OUT_ST 10485760
#define OUT_CK 13631488
#define OUT_CV 19922944

#define OPS_REC 1792
#define OPS_TOK (6 * OPS_REC)

#define WS_WIN   ((size_t)0)
#define WS_WOUT  (WS_WIN + (size_t)2 * N1 * 1024 * 2)
#define WS_WF1   (WS_WOUT + (size_t)2 * 1024 * 1024 * 2)
#define WS_WF2   (WS_WF1 + (size_t)2 * 5632 * 1024 * 2)
#define WS_H     (WS_WF2 + (size_t)2 * 1024 * 2816 * 2)
#define WS_UD    (WS_H + (size_t)NTOK * 1024 * 2)
#define WS_ZF    (WS_UD + (size_t)NTOK * 1152 * 2)
#define WS_UR    (WS_ZF + (size_t)NTOK * 512 * 2)
#define WS_OPS   (WS_UR + (size_t)2 * NTOK * 384 * 4)
#define WS_MOD   (WS_OPS + (size_t)NTOK * OPS_TOK)
#define WS_L256  (WS_MOD + (size_t)2 * 3 * 6144 * 4)
#define WS_L1024 (WS_L256 + (size_t)256 * 512 * 2)
#define WS_CTL   (WS_L1024 + (size_t)1024 * 2048 * 2)
#define WS_RSQ   (WS_CTL + (size_t)16384)
#define WS_ZS    (WS_RSQ + (size_t)4 * NTOK * 4)
#define WS_SS    (WS_ZS + (size_t)2 * 2048 * 384 * 4)
#define WS_WLT   (WS_SS + (size_t)24 * 3 * 4096 * 4)
#define WLT_L    73728
#define WS_BIAS  (WS_WLT + (size_t)2 * WLT_L * 2)
#define WS_END   (WS_BIAS + (size_t)(2 * 3 * 3072 + 2 * 3 * 5632) * 4)
#define WS_H2    (WS_OPS + ((size_t)64 << 20))
#define CTL_QUEUE 3584
static_assert(WS_END <= ((size_t)256 << 20), "workspace exceeds 256 MiB");

struct P {
    const float *x_prompt, *x_sample, *c, *state_rwkv, *cache_k, *cache_v, *c_ctx, *norm1_g, *norm2_g, *final_g;
    const float *w_mod, *b_mod, *w_in, *w_out, *shift_mu, *decay_w0, *decay_up, *iclr_a0, *iclr_up, *gate_up;
    const float *k_k, *k_a, *r_k, *lnx_g, *lnx_b, *diff_lambda, *subln_g, *w_ffn_in, *w_ffn_out;
    float* out;
    unsigned char* ws;
};

typedef float f32x2c __attribute__((ext_vector_type(2)));
typedef __bf16 bf16x2c __attribute__((ext_vector_type(2)));
__device__ __forceinline__ bf16_t f2bf(float f) { return __builtin_bit_cast(unsigned short, (__bf16)f); }
__device__ __forceinline__ unsigned pk_bf16(float lo, float hi) { const f32x2c v = {lo, hi}; return __builtin_bit_cast(unsigned, __builtin_convertvector(v, bf16x2c)); }
__device__ __forceinline__ float bf2f(bf16_t b) { return __builtin_bit_cast(float, ((unsigned)b) << 16); }
__device__ __forceinline__ float sigmoidf_(float x) { return 1.f / (1.f + __expf(-x)); }
__device__ __forceinline__ float wave_sum(float v) {
#pragma unroll
    for (int o = 1; o < 64; o <<= 1) v += __shfl_xor(v, o);
    return v;
}
__device__ __forceinline__ int otid() { int t = threadIdx.x; asm volatile("" : "+v"(t)); return t; }
__device__ __forceinline__ int tok_cls(int tok) { return tok < NPTOK ? 0 : 1 + ((tok - NPTOK) >> 10); }
__device__ __forceinline__ const float* xin_row(const P& p, int tok) { return tok < NPTOK ? p.x_prompt + (size_t)tok * 1024 : p.x_sample + (size_t)(tok - NPTOK) * 1024; }
__device__ __forceinline__ float* X_row(const P& p, int tok) { return p.out + (size_t)tok * 1024; }
__device__ __forceinline__ const float* mod_vec(const P& p, int l, int cls, int which) { return (const float*)(p.ws + WS_MOD) + ((size_t)(l * 3 + cls) * 6144 + which * 1024); }
__device__ __forceinline__ void seq_info(int s, int& start, int& T) { if (s < 32) { start = s * TP; T = TP; } else { start = NPTOK + (s - 32) * TS; T = TS; } }
__device__ __forceinline__ void tok_info(int tok, int& s, int& t, int& T, int& start) {
    if (tok < NPTOK) { s = tok >> 8; t = tok & 255; T = TP; start = s * TP; } else { int r = tok - NPTOK; s = 32 + (r >> 10); t = r & 1023; T = TS; start = NPTOK + ((r >> 10) << 10); }
}

#define P0_MOD 192
#define P0_TILES_L 3136
struct P0Tile { const float* src; bf16_t* dst; int srcN, K, n0, k0, mode, scol; };
__device__ __forceinline__ P0Tile p0_decode(const P& p, int it) {
    P0Tile t; const int l = it / P0_TILES_L; it %= P0_TILES_L; int ntile, ktile; t.mode = 0; t.scol = 0;
    if (it < 768) { ntile = it / 16; ktile = it % 16; t.K = 1024; t.srcN = D_IN; t.src = p.w_in + (size_t)l * 1024 * D_IN; t.dst = (bf16_t*)(p.ws + WS_WIN) + (size_t)l * N1 * 1024;
        t.n0 = ntile * 64;
        if (t.n0 < C_FNET) { t.scol = 1344 + t.n0; } else if (t.n0 < C_RWKV) { t.mode = 1 + ((t.n0 - C_FNET) / 64) % 2; t.scol = 2496 + ((t.n0 - C_FNET) / 128) * 64; } else if (t.n0 < C_END) { t.scol = t.n0 - C_RWKV; } else t.mode = 3; }
    else if (it < 1024) { it -= 768; ntile = it / 16; ktile = it % 16; t.K = 1024; t.srcN = 1024; t.src = p.w_out + (size_t)l * 1024 * 1024; t.dst = (bf16_t*)(p.ws + WS_WOUT) + (size_t)l * 1024 * 1024; t.n0 = ntile * 64; t.scol = t.n0; }
    else if (it < 2432) { it -= 1024; ntile = it / 16; ktile = it % 16; t.K = 1024; t.srcN = 5632; t.src = p.w_ffn_in + (size_t)l * 1024 * 5632; t.dst = (bf16_t*)(p.ws + WS_WF1) + (size_t)l * 5632 * 1024; t.n0 = ntile * 64;
        const int pn = ntile >> 2, sub = ntile & 3; t.scol = (sub < 2) ? (128 * pn + 64 * sub) : (2816 + 128 * pn + 64 * (sub - 2)); }
    else { it -= 2432; ntile = it / 44; ktile = it % 44; t.K = 2816; t.srcN = 1024; t.src = p.w_ffn_out + (size_t)l * 2816 * 1024; t.dst = (bf16_t*)(p.ws + WS_WF2) + (size_t)l * 1024 * 2816; t.n0 = ntile * 64; t.scol = t.n0; }
    t.k0 = ktile * 64;
    return t;
}
#define P0_TGROUPS 1568
__device__ __forceinline__ void ph_prep0(const P& p, float* sm) {
    const int tid = otid();
    const int nitems = P0_MOD + P0_TGROUPS + 1280 + 10;
    for (int item = blockIdx.x; item < nitems; item += gridDim.x) {
        __syncthreads();
        if (item < P0_MOD) {
            const int l = item / 96, cg = item % 96, col = cg * 64 + (tid & 63), ks = tid >> 6;
            const float* W = p.w_mod + (size_t)l * 1024 * 6144;
            float* sl = sm + 2048;
            for (int e = tid; e < 3072; e += blockDim.x) { const int cls = e >> 10, k = e & 1023; const float c = cls == 0 ? p.c_ctx[k] : p.c[(cls - 1) * 1024 + k]; sl[e] = c * sigmoidf_(c); }
            __syncthreads();
            float a0 = 0.f, a1 = 0.f, a2 = 0.f;
#pragma unroll 8
            for (int k = ks * 128; k < ks * 128 + 128; ++k) {
                const float w = W[(size_t)k * 6144 + col];
                a0 += sl[k] * w; a1 += sl[1024 + k] * w; a2 += sl[2048 + k] * w;
            }
            sm[(ks * 3 + 0) * 64 + (tid & 63)] = a0; sm[(ks * 3 + 1) * 64 + (tid & 63)] = a1; sm[(ks * 3 + 2) * 64 + (tid & 63)] = a2;
            __syncthreads();
            if (tid < 192) {
                const int cls = tid >> 6, cc = tid & 63; float s = 0.f;
                for (int k = 0; k < 8; ++k) s += sm[(k * 3 + cls) * 64 + cc];
                const int colo = cg * 64 + cc;
                ((float*)(p.ws + WS_MOD))[(size_t)(l * 3 + cls) * 6144 + colo] = s + p.b_mod[(size_t)l * 6144 + colo];
            }
        } else if (item < P0_MOD + P0_TGROUPS) {
            const int it0 = (item - P0_MOD) * 4;
            float* cs = sm + 4 * 64 * 65;
            if (tid < 64) { cs[tid] = cospif((float)tid / 32.f); cs[64 + tid] = sinpif((float)tid / 32.f); }
#pragma unroll
            for (int u = 0; u < 4; ++u) {
                const P0Tile t = p0_decode(p, it0 + u); float* tile = sm + u * 64 * 65;
                if (t.mode != 3) {
#pragma unroll
                    for (int i = 0; i < 8; ++i) { const int k = i * 8 + (tid >> 6), n = tid & 63; tile[k * 65 + n] = t.src[(size_t)(t.k0 + k) * t.srcN + t.scol + n]; }
                }
            }
            __syncthreads();
#pragma unroll 1
            for (int u = 0; u < 4; ++u) {
                const P0Tile t = p0_decode(p, it0 + u); const float* tile = sm + u * 64 * 65;
                const int n = tid >> 3, k8 = (tid & 7) * 8;
                float v[8];
                if (t.mode == 0) {
#pragma unroll
                    for (int j = 0; j < 8; ++j) v[j] = tile[(k8 + j) * 65 + n];
                } else if (t.mode == 3) {
#pragma unroll
                    for (int j = 0; j < 8; ++j) v[j] = 0.f;
                } else {
#pragma unroll
                    for (int j = 0; j < 8; ++j) v[j] = 0.f;
                    for (int cc = 0; cc < 64; ++cc) {
                        const int idx = (n * cc) & 63;
                        const float tr = (t.mode == 1) ? cs[idx] * 0.125f : -cs[64 + idx] * 0.125f;
#pragma unroll
                        for (int j = 0; j < 8; ++j) v[j] += tile[(k8 + j) * 65 + cc] * tr;
                    }
                }
                uint4 o;
                o.x = pk_bf16(v[0], v[1]); o.y = pk_bf16(v[2], v[3]);
                o.z = pk_bf16(v[4], v[5]); o.w = pk_bf16(v[6], v[7]);
                *(uint4*)(t.dst + (size_t)(t.n0 + n) * t.K + t.k0 + k8) = o;
            }
        } else if (item >= P0_MOD + P0_TGROUPS + 1280) {
            const int it = item - (P0_MOD + P0_TGROUPS + 1280), l = it / 5, kind = it % 5, K = kind == 4 ? 64 : 32;
            const float* src = kind == 4 ? p.gate_up + (size_t)l * 64 * 384 : ((kind >> 1) ? p.iclr_up : p.decay_up) + (size_t)((l * 2 + (kind & 1)) * 32) * 384;
            bf16_t* dst = (bf16_t*)(p.ws + WS_WLT) + (size_t)l * WLT_L + kind * 12288;
            for (int e = tid; e < 384 * K; e += blockDim.x) { const int n = e % 384, k = e / 384; dst[n * K + k] = f2bf(src[(size_t)k * 384 + n]); }
        } else {
            const int r = item - (P0_MOD + P0_TGROUPS);
            const int T = r < 256 ? 256 : 1024, ft = r < 256 ? r : r - 256;
            bf16_t* L = r < 256 ? (bf16_t*)(p.ws + WS_L256) + (size_t)ft * 512 : (bf16_t*)(p.ws + WS_L1024) + (size_t)ft * 2048;
            const float sc = r < 256 ? 0.0625f : 0.03125f;
            for (int k = tid; k < 2 * T; k += blockDim.x) {
                const int t = k & (T - 1), idx = (ft * t) & (T - 1);
                const float ang = (float)(2 * idx) / (float)T;
                L[k] = f2bf((k < T ? cospif(ang) : sinpif(ang)) * sc);
            }
        }
    }
}

__device__ __forceinline__ void ph_prep0b(const P& p) {
    const int tid_ = otid(); const int lane = tid_ & 63, wv = tid_ >> 6, nw = blockDim.x >> 6;
#pragma unroll 1
    for (int grp = 0; grp < 4; ++grp) {
        const int l = grp & 1, isf = grp >> 1, N = isf ? 5632 : 3072, which = isf ? 3 : 0;
        const bf16_t* Wb = isf ? (const bf16_t*)(p.ws + WS_WF1) + (size_t)l * 5632 * 1024 : (const bf16_t*)(p.ws + WS_WIN) + (size_t)l * N1 * 1024;
        float* outb = (float*)(p.ws + WS_BIAS) + (isf ? 2 * 3 * 3072 + (size_t)(l * 3) * 5632 : (size_t)(l * 3) * 3072);
        float sh[3][16];
#pragma unroll
        for (int c = 0; c < 3; ++c) { const float* sp = mod_vec(p, l, c, which) + lane * 16;
#pragma unroll
            for (int e = 0; e < 4; ++e) { const float4 v = *(const float4*)(sp + 4 * e); sh[c][4 * e] = v.x; sh[c][4 * e + 1] = v.y; sh[c][4 * e + 2] = v.z; sh[c][4 * e + 3] = v.w; } }
#pragma unroll 2
        for (int n = blockIdx.x * nw + wv; n < N; n += gridDim.x * nw) {
            const bf16_t* W = Wb + (size_t)n * 1024;
            const uint4 w0 = *(const uint4*)(W + lane * 16), w1 = *(const uint4*)(W + lane * 16 + 8);
            const unsigned ww[8] = {w0.x, w0.y, w0.z, w0.w, w1.x, w1.y, w1.z, w1.w};
            float acc[3] = {0.f, 0.f, 0.f};
#pragma unroll
            for (int c = 0; c < 3; ++c)
#pragma unroll
                for (int e = 0; e < 8; ++e) acc[c] += sh[c][2 * e] * bf2f((bf16_t)(ww[e] & 0xffff)) + sh[c][2 * e + 1] * bf2f((bf16_t)(ww[e] >> 16));
#pragma unroll
            for (int c = 0; c < 3; ++c) { const float t = wave_sum(acc[c]); if (lane == 0) outb[(size_t)c * N + n] = t; }
        }
    }
    float* rsq0 = (float*)(p.ws + WS_RSQ);
    for (int row = blockIdx.x * nw + wv; row < NTOK; row += gridDim.x * nw) {
        const float* xr = xin_row(p, row);
        float4 x[4]; float ss = 0.f;
#pragma unroll
        for (int i = 0; i < 4; ++i) { x[i] = *(const float4*)(xr + i * 256 + lane * 4); ss += x[i].x * x[i].x + x[i].y * x[i].y + x[i].z * x[i].z + x[i].w * x[i].w; }
        ss = wave_sum(ss);
        if (lane == 0) rsq0[row] = ss;
        const float* sc = mod_vec(p, 0, tok_cls(row), 1);
        bf16_t* h = (bf16_t*)(p.ws + WS_H) + (size_t)row * 1024;
#pragma unroll
        for (int i = 0; i < 4; ++i) { const int c = i * 256 + lane * 4;
            const float4 gg = *(const float4*)(p.norm1_g + c), s1 = *(const float4*)(sc + c);
            uint2 o; o.x = pk_bf16(x[i].x * gg.x * (1.f + s1.x), x[i].y * gg.y * (1.f + s1.y));
            o.y = pk_bf16(x[i].z * gg.z * (1.f + s1.z), x[i].w * gg.w * (1.f + s1.w));
            *(uint2*)(h + c) = o; }
    }
}

__device__ __forceinline__ void ph_norm(const P& p, int l, int which) {
    const int tid_ = otid(); const int lane = tid_ & 63, wv = tid_ >> 6, nw = blockDim.x >> 6;
    for (int row = blockIdx.x * nw + wv; row < NTOK; row += gridDim.x * nw) {
        const float* xr = (which == 0 && l == 0) ? xin_row(p, row) : X_row(p, row);
        float4 x[4]; float ss = 0.f;
#pragma unroll
        for (int i = 0; i < 4; ++i) { x[i] = *(const float4*)(xr + i * 256 + lane * 4); ss += x[i].x * x[i].x + x[i].y * x[i].y + x[i].z * x[i].z + x[i].w * x[i].w; }
        ss = wave_sum(ss);
        const float rstd = rsqrtf(ss * (1.f / 1024.f) + 1e-6f);
        if (which == 2) {
            float* o = p.out + (size_t)row * 1024;
#pragma unroll
            for (int i = 0; i < 4; ++i) { const float4 g = *(const float4*)(p.final_g + i * 256 + lane * 4);
                float4 y; y.x = x[i].x * rstd * g.x; y.y = x[i].y * rstd * g.y; y.z = x[i].z * rstd * g.z; y.w = x[i].w * rstd * g.w;
                *(float4*)(o + i * 256 + lane * 4) = y; }
        } else {
            const int cls = tok_cls(row);
            const float* g = (which == 0 ? p.norm1_g : p.norm2_g) + (size_t)l * 1024;
            const float* sh = mod_vec(p, l, cls, which == 0 ? 0 : 3);
            const float* sc = mod_vec(p, l, cls, which == 0 ? 1 : 4);
            bf16_t* h = (bf16_t*)(p.ws + WS_H) + (size_t)row * 1024;
#pragma unroll
            for (int i = 0; i < 4; ++i) { const int c = i * 256 + lane * 4;
                const float4 gg = *(const float4*)(g + c), s1 = *(const float4*)(sc + c), s0 = *(const float4*)(sh + c);
                const float y0 = x[i].x * rstd * gg.x * (1.f + s1.x) + s0.x, y1 = x[i].y * rstd * gg.y * (1.f + s1.y) + s0.y;
                const float y2 = x[i].z * rstd * gg.z * (1.f + s1.z) + s0.z, y3 = x[i].w * rstd * gg.w * (1.f + s1.w) + s0.w;
                uint2 o; o.x = pk_bf16(y0, y1); o.y = pk_bf16(y2, y3);
                *(uint2*)(h + c) = o; }
        }
    }
}

struct EpiG1 {
    int l;
    __device__ __forceinline__ void operator()(const P& p, int row, int col, const float* v) const {
        if (col < C_FNET) {
            bf16_t* o = (bf16_t*)(p.ws + WS_UD) + (size_t)row * 1152 + col;
            uint2 w; w.x = pk_bf16(v[0], v[1]); w.y = pk_bf16(v[2], v[3]);
            *(uint2*)o = w;
            if (row < NPTOK && col >= 384) {
                const int b = row >> 8, t = row & 255;
                float* dst = p.out + (col < 768 ? OUT_CK : OUT_CV) + ((size_t)(b * 2 + l) * 256 + t) * 384 + (col < 768 ? col - 384 : col - 768);
                *(float4*)dst = make_float4(v[0], v[1], v[2], v[3]);
            }
        } else if (col < C_RWKV) {
            const int cc = col - C_FNET, g = cc >> 7, half = (cc >> 6) & 1, fc = cc & 63;
            bf16_t* o;
            if (row < NPTOK) { const int sq = row >> 8, t = row & 255; o = (bf16_t*)(p.ws + WS_ZF) + ((size_t)(sq * 256 + g * 64 + fc) * 512 + half * 256 + t);
                o[0] = f2bf(v[0]); o[512] = f2bf(v[1]); o[1024] = f2bf(v[2]); o[1536] = f2bf(v[3]); }
            else { const int r = row - NPTOK, b = r >> 10, t = r & 1023; o = (bf16_t*)(p.ws + WS_ZF) + (size_t)8192 * 512 + ((size_t)(b * 256 + g * 64 + fc) * 2048 + half * 1024 + t);
                o[0] = f2bf(v[0]); o[2048] = f2bf(v[1]); o[4096] = f2bf(v[2]); o[6144] = f2bf(v[3]); }
        } else if (col < C_END) {
            bf16_t* o = (bf16_t*)(p.ws + WS_UR) + (size_t)row * N_RWKV + (col - C_RWKV);
            uint2 w; w.x = pk_bf16(v[0], v[1]); w.y = pk_bf16(v[2], v[3]);
            *(uint2*)o = w;
        }
    }
};
struct EpiRes {
    int l, which;
    __device__ __forceinline__ void operator()(const P& p, int row, int col, const float* v) const {
        const float* g = mod_vec(p, l, tok_cls(row), which) + col;
        const float* xo = (which == 2 && l == 0) ? xin_row(p, row) + col : X_row(p, row) + col;
        const float4 x = *(const float4*)xo; const float4 gg = *(const float4*)g;
        *(float4*)(X_row(p, row) + col) = make_float4(x.x + gg.x * v[0], x.y + gg.y * v[1], x.z + gg.z * v[2], x.w + gg.w * v[3]);
    }
};

#define PR_TT 40
#define PR_LS 200
typedef short bf16x8p __attribute__((ext_vector_type(8)));
typedef float f32x4p __attribute__((ext_vector_type(4)));
#define PR_ROWB 2688
__device__ __forceinline__ void ph_prep(const P& p, int l, float* sm) {
    const int tid = otid(), lane = tid & 63, wv = tid >> 6;
    const bf16_t* UR = (const bf16_t*)(p.ws + WS_UR);
    unsigned char* lb = (unsigned char*)sm;
    bf16_t* urt = (bf16_t*)lb;
    bf16_t* linb = (bf16_t*)(lb + 42 * PR_ROWB);
    const float* mu0 = p.shift_mu + (size_t)l * 2 * N_RWKV; const float* mu1 = mu0 + N_RWKV;
#if PROBE_ID
    unsigned long long* tsp = (unsigned long long*)(p.ws + WS_CTL + 15360) + 32;
#define PSTAMP(i) do { __syncthreads(); if (blockIdx.x == 0 && tid == 0 && l == 0) tsp[i] = __builtin_amdgcn_s_memrealtime(); } while (0)
#else
#define PSTAMP(i)
#endif
    PSTAMP(0);
    for (int tile = blockIdx.x; tile < NTOK / PR_TT; tile += gridDim.x) {
        const int tok0 = tile * PR_TT;
        __syncthreads();
        for (int e = tid; e < 42 * 168; e += blockDim.x) {
            const int r = e / 168, c = e % 168, tok = tok0 - 1 + r;
            uint4 v = make_uint4(0u, 0u, 0u, 0u);
            if (tok >= 0 && tok < NTOK) v = *(const uint4*)((const unsigned char*)UR + (size_t)tok * PR_ROWB + c * 16);
            *(uint4*)(lb + r * PR_ROWB + c * 16) = v;
        }
        __syncthreads();
        for (int e = tid; e < 48 * 192; e += blockDim.x) {
            const int tk = e / 192, j = e % 192, col = 1152 + j;
            float x = 0.f;
            if (tk < PR_TT) {
                int s, t, T, st; tok_info(tok0 + tk, s, t, T, st);
                const float xc = bf2f(urt[(tk + 1) * 1344 + col]);
                const float xp = t > 0 ? bf2f(urt[tk * 1344 + col]) : 0.f;
                const float xn = t < T - 1 ? bf2f(urt[(tk + 2) * 1344 + col]) : 0.f;
                x = xc + mu0[col] * (xp - xc) + mu1[col] * (xn - xc);
                if (j < 64) x = tanhf(x); else if (j >= 128) x = sigmoidf_(x);
            }
            linb[tk * PR_LS + j] = f2bf(x);
        }
        __syncthreads();
        PSTAMP(1);
        {
            const int n = lane & 15, kg = lane >> 4;
            const bf16_t* WLT = (const bf16_t*)(p.ws + WS_WLT) + (size_t)l * WLT_L;
#pragma unroll 3
            for (int combo = wv; combo < 120; combo += 8) {
                const int kind = combo / 24, nt = combo % 24, ch = nt * 16 + n, h = ch >> 6, cl = ch & 63;
                const int K = kind == 4 ? 64 : 32, loff = kind == 4 ? 128 : (kind >> 1) * 64 + (kind & 1) * 32;
                const bf16_t* wrow = WLT + kind * 12288 + (size_t)ch * K + 8 * kg;
                const bf16x8p b0 = *(const bf16x8p*)wrow;
                bf16x8p b1 = b0; if (kind == 4) b1 = *(const bf16x8p*)(wrow + 32);
                float bias = 0.f;
                if (kind < 4) bias = ((kind >> 1) ? p.iclr_a0 : p.decay_w0)[(size_t)(l * 2 + (kind & 1)) * 384 + ch];
#pragma unroll
                for (int mt = 0; mt < 3; ++mt) {
                    f32x4p acc = {bias, bias, bias, bias};
                    const bf16x8p a0 = *(const bf16x8p*)(linb + (mt * 16 + n) * PR_LS + loff + 8 * kg);
                    acc = __builtin_amdgcn_mfma_f32_16x16x32_bf16(a0, b0, acc, 0, 0, 0);
                    if (kind == 4) { const bf16x8p a1 = *(const bf16x8p*)(linb + (mt * 16 + n) * PR_LS + loff + 32 + 8 * kg); acc = __builtin_amdgcn_mfma_f32_16x16x32_bf16(a1, b1, acc, 0, 0, 0); }
#pragma unroll
                    for (int r = 0; r < 4; ++r) {
                        const int tk = mt * 16 + kg * 4 + r;
                        if (tk < PR_TT) {
                            unsigned char* rec = p.ws + WS_OPS + (size_t)(tok0 + tk) * OPS_TOK + (size_t)h * OPS_REC;
                            if (kind == 4) ((bf16_t*)(rec + 1280))[192 + cl] = f2bf(acc[r]);
                            else { const float sg = sigmoidf_(acc[r]); ((float*)rec)[64 + (kind >> 1) * 128 + (kind & 1) * 64 + cl] = (kind >> 1) ? sg : __expf(-0.60653065971263342f * sg); }
                        }
                    }
                }
            }
        }
#if PROBE_ID
        if (blockIdx.x == 0 && tid == 0 && l == 0) tsp[2] = __builtin_amdgcn_s_memrealtime();
#endif
        {
#pragma unroll 2
            for (int pr = wv; pr < PR_TT * NH; pr += 8) {
                const int tk = pr / NH, h = pr % NH, ch = h * 64 + lane, tok = tok0 + tk; int s, t, T, st; tok_info(tok, s, t, T, st);
                float rkv[3];
#pragma unroll
                for (int q = 0; q < 3; ++q) { const int col = q * 384 + ch;
                    const float xc = bf2f(urt[(tk + 1) * 1344 + col]);
                    const float xp = t > 0 ? bf2f(urt[tk * 1344 + col]) : 0.f;
                    const float xn = t < T - 1 ? bf2f(urt[(tk + 2) * 1344 + col]) : 0.f;
                    rkv[q] = xc + mu0[col] * (xp - xc) + mu1[col] * (xn - xc); }
                const float kkr = rkv[1] * p.k_k[(size_t)l * 384 + ch];
                const float nrm = sqrtf(wave_sum(kkr * kkr));
                const float kk = kkr / fmaxf(nrm, 1e-12f);
                unsigned char* rec = p.ws + WS_OPS + (size_t)tok * OPS_TOK + (size_t)h * OPS_REC;
                ((float*)rec)[lane] = -kk;
                bf16_t* rb = (bf16_t*)(rec + 1280);
                rb[lane] = f2bf(rkv[0]); rb[64 + lane] = f2bf(rkv[2]); rb[128 + lane] = f2bf(rkv[1]);
            }
        }
    }
    PSTAMP(3);
    bf16_t* UD = (bf16_t*)(p.ws + WS_UD);
    for (int e = blockIdx.x * blockDim.x + tid; e < 2048 * 384; e += gridDim.x * blockDim.x) {
        const int tk = e / 384, pi = e % 384;
        const int grp = pi >> 3, pr = pi & 7, col = grp * 16 + pr;
        const int axis = grp & 1;
        const int t = tk & 1023, pos = axis == 0 ? (t >> 6) : (t & 63);
        const float inv = __powf(10000.f, -(float)pr / 8.f);
        float sn, cs; __sincosf((float)pos * inv, &sn, &cs);
        bf16_t* ptr = UD + (size_t)(NPTOK + tk) * 1152 + col;
        const float x1 = bf2f(ptr[0]), x2 = bf2f(ptr[8]);
        ptr[0] = f2bf(x1 * cs - x2 * sn); ptr[8] = f2bf(x2 * cs + x1 * sn);
    }
    PSTAMP(4);
}

#define SC_TC 16
typedef float f32x2 __attribute__((ext_vector_type(2)));
template <int CTRL> __device__ __forceinline__ float dpp_add(float x) {
    return x + __builtin_bit_cast(float, __builtin_amdgcn_update_dpp(0, __builtin_bit_cast(int, x), CTRL, 0xf, 0xf, false));
}
__device__ __forceinline__ float reduce8(float x) { x = dpp_add<0xB1>(x); x = dpp_add<0x4E>(x); x = dpp_add<0x141>(x); return x; }
struct ScanStage { float nkk[4], w[4], a[4]; bf16_t r[4], v[4], k[4]; };
__device__ __forceinline__ void scan_load(const P& p, int h, int dir, int T, int start, int st_base, int ht, ScanStage& g) {
#pragma unroll
    for (int rpt = 0; rpt < 4; ++rpt) {
        const int e = rpt * 256 + ht, i = e >> 6, ch = e & 63;
        const int st = st_base + i, t = dir == 0 ? st : T - 1 - st, tok = start + t;
        const unsigned char* rec = p.ws + WS_OPS + (size_t)tok * OPS_TOK + (size_t)h * OPS_REC;
        const float* rf = (const float*)rec; const bf16_t* rb = (const bf16_t*)(rec + 1280);
        g.nkk[rpt] = rf[ch]; g.w[rpt] = rf[64 + dir * 64 + ch]; g.a[rpt] = rf[192 + dir * 64 + ch];
        g.r[rpt] = rb[ch]; g.v[rpt] = rb[64 + ch]; g.k[rpt] = rb[128 + ch];
    }
}
__device__ __forceinline__ void scan_store(const ScanStage& g, float ka, float vmul, int ht, float* ops) {
#pragma unroll
    for (int rpt = 0; rpt < 4; ++rpt) {
        const int e = rpt * 256 + ht, i = e >> 6, ch = e & 63;
        float* o = ops + i * 384;
        const float k = bf2f(g.k[rpt]);
        o[ch] = bf2f(g.r[rpt]); o[64 + ch] = g.nkk[rpt]; o[128 + ch] = bf2f(g.v[rpt]) * vmul; o[192 + ch] = g.w[rpt];
        o[256 + ch] = k * (1.f + (g.a[rpt] - 1.f) * ka); o[320 + ch] = -g.nkk[rpt] * g.a[rpt];
    }
}
struct StepOps { float4 r0, r1, nk0, nk1, w0, w1, kd0, kd1, ka0, ka1; float2 v; };
__device__ __forceinline__ void step_load(const float* o, int kq, int rp, StepOps& x) {
    x.r0 = *(const float4*)(o + kq * 8); x.r1 = *(const float4*)(o + kq * 8 + 4);
    x.nk0 = *(const float4*)(o + 64 + kq * 8); x.nk1 = *(const float4*)(o + 64 + kq * 8 + 4);
    x.w0 = *(const float4*)(o + 192 + kq * 8); x.w1 = *(const float4*)(o + 192 + kq * 8 + 4);
    x.kd0 = *(const float4*)(o + 256 + kq * 8); x.kd1 = *(const float4*)(o + 256 + kq * 8 + 4);
    x.ka0 = *(const float4*)(o + 320 + kq * 8); x.ka1 = *(const float4*)(o + 320 + kq * 8 + 4);
    x.v = *(const float2*)(o + 128 + 2 * rp);
}
#define F2LO(q) ((f32x2){(q).x, (q).y})
#define F2HI(q) ((f32x2){(q).z, (q).w})
__device__ __forceinline__ void step_compute(f32x2 (&S)[2][4], const StepOps& x, float (&yo)[2]) {
    const f32x2 nk[4] = {F2LO(x.nk0), F2HI(x.nk0), F2LO(x.nk1), F2HI(x.nk1)}, w[4] = {F2LO(x.w0), F2HI(x.w0), F2LO(x.w1), F2HI(x.w1)};
    const f32x2 kd[4] = {F2LO(x.kd0), F2HI(x.kd0), F2LO(x.kd1), F2HI(x.kd1)}, kk[4] = {F2LO(x.ka0), F2HI(x.ka0), F2LO(x.ka1), F2HI(x.ka1)};
    const f32x2 rr[4] = {F2LO(x.r0), F2HI(x.r0), F2LO(x.r1), F2HI(x.r1)};
    const float vv[2] = {x.v.x, x.v.y};
#pragma unroll
    for (int r = 0; r < 2; ++r) {
        f32x2 t = S[r][0] * nk[0]; t += S[r][1] * nk[1]; t += S[r][2] * nk[2]; t += S[r][3] * nk[3];
        const float sa = reduce8(t.x + t.y);
        const f32x2 sa2 = (f32x2){sa, sa}, v2b = (f32x2){vv[r], vv[r]};
        f32x2 y = (f32x2){0.f, 0.f};
#pragma unroll
        for (int e = 0; e < 4; ++e) { S[r][e] = S[r][e] * w[e] + v2b * kd[e] + sa2 * kk[e]; y += S[r][e] * rr[e]; }
        yo[r] = reduce8(y.x + y.y);
    }
}
__device__ __forceinline__ void ph_scan_job(const P& p, int l, int s, int h, int mode, int pdir, int seg, int st0, int nsteps, float* sm) {
    const int tid = otid(), half = tid >> 8, ht = tid & 255, kq = ht & 7, rp = ht >> 3;
    const int dir = mode == 0 ? half : pdir, kind = mode == 0 ? 0 : 1 + half;
    int start, T; seq_info(s, start, T);
    f32x2 S[2][4];
#pragma unroll
    for (int r = 0; r < 2; ++r)
#pragma unroll
        for (int e = 0; e < 4; ++e) S[r][e] = (f32x2){0.f, 0.f};
    if (kind == 0 && s >= 32) {
        const float* s0 = p.state_rwkv + ((((size_t)(s - 32) * 2 + l) * 2 + dir) * NH + h) * 4096 + (2 * rp) * 64 + kq * 8;
#pragma unroll
        for (int r = 0; r < 2; ++r)
#pragma unroll
            for (int e = 0; e < 4; ++e) S[r][e] = *(const f32x2*)(s0 + r * 64 + 2 * e);
    } else if (kind == 1) {
#pragma unroll
        for (int r = 0; r < 2; ++r)
#pragma unroll
            for (int e = 0; e < 4; ++e) { const int row = 2 * rp + r, k = 8 * kq + 2 * e; S[r][e] = (f32x2){row == k ? 1.f : 0.f, row == k + 1 ? 1.f : 0.f}; }
    }
    const float vmul = kind == 1 ? 0.f : 1.f;
    float* ybase = kind == 1 ? (float*)(p.ws + WS_ZS) + ((ptrdiff_t)dir * 2048 - (ptrdiff_t)NPTOK) * 384 : (float*)(p.ws + WS_UR) + (size_t)dir * NTOK * 384;
    ybase += h * 64 + 2 * rp;
    const float ka = p.k_a[(size_t)l * 384 + h * 64 + (ht & 63)];
    const int nc = nsteps / SC_TC;
    ScanStage g;
    __syncthreads();
    scan_load(p, h, dir, T, start, st0, ht, g);
    scan_store(g, ka, vmul, ht, sm + half * (SC_TC * 384));
    __syncthreads();
    for (int c = 0; c < nc; ++c) {
        const float* ops = sm + ((c & 1) * 2 + half) * (SC_TC * 384);
        if (c + 1 < nc) scan_load(p, h, dir, T, start, st0 + (c + 1) * SC_TC, ht, g);
        StepOps A, B;
        step_load(ops, kq, rp, A);
#pragma unroll 1
        for (int i = 0; i < SC_TC; i += 2) {
            float yo[2];
            step_load(ops + (i + 1) * 384, kq, rp, B);
            step_compute(S, A, yo);
            if (kq == 0) { const int st = st0 + c * SC_TC + i, t = dir == 0 ? st : T - 1 - st; *(float2*)(ybase + (size_t)(start + t) * 384) = make_float2(yo[0], yo[1]); }
            if (i + 2 < SC_TC) step_load(ops + (i + 2) * 384, kq, rp, A);
            step_compute(S, B, yo);
            if (kq == 0) { const int st = st0 + c * SC_TC + i + 1, t = dir == 0 ? st : T - 1 - st; *(float2*)(ybase + (size_t)(start + t) * 384) = make_float2(yo[0], yo[1]); }
        }
        if (c + 1 < nc) scan_store(g, ka, vmul, ht, sm + (((c + 1) & 1) * 2 + half) * (SC_TC * 384));
        __syncthreads();
    }
    float* so = nullptr;
    if (mode == 0) so = s < 32 ? p.out + OUT_ST + ((((size_t)s * 2 + l) * 2 + dir) * NH + h) * 4096
                              : (float*)(p.ws + WS_SS) + ((size_t)(((s - 32) * NH + h) * 2 + dir) * 3 + 0) * 4096;
    else if (seg == 1) so = (float*)(p.ws + WS_SS) + ((size_t)(((s - 32) * NH + h) * 2 + dir) * 3 + kind) * 4096;
    if (so) {
        so += (2 * rp) * 64 + kq * 8;
#pragma unroll
        for (int r = 0; r < 2; ++r)
#pragma unroll
            for (int e = 0; e < 4; ++e) *(f32x2*)(so + r * 64 + 2 * e) = S[r][e];
    }
}

#define SEG0_LEN 352
#define SEGX_LEN 336
#define CTL_SCANDONE 3720
__device__ __forceinline__ void fixup_item(const P& p, int l, int item4, float* sm) {
    const int tid = otid(), lane = tid & 63, wv = tid >> 6;
    {
        const int item = item4 >> 2, qtr = item4 & 3;
        const int b = item / 24, h = (item % 24) >> 2, dir = (item >> 1) & 1, seg = 1 + (item & 1);
        const float* E0 = (const float*)(p.ws + WS_SS) + (size_t)(((b * NH + h) * 2 + dir) * 3) * 4096; const float* P1 = E0 + 4096; const float* Q1 = E0 + 8192;
        if (tid == 0) {
            unsigned* cnt = (unsigned*)(p.ws + WS_CTL) + CTL_SCANDONE + 32 * l + (b * NH + h) * 2 + dir; unsigned sp = 0;
            while (__hip_atomic_load(cnt, __ATOMIC_RELAXED, __HIP_MEMORY_SCOPE_AGENT) < 3u && ++sp < (1u << 24)) __builtin_amdgcn_s_sleep(4);
            __builtin_amdgcn_fence(__ATOMIC_ACQUIRE, "agent");
            asm volatile("s_waitcnt vmcnt(0)" ::: "memory");
        }
        __syncthreads();
        { const int v = tid >> 3, kg = tid & 7;
          float acc[8];
          if (seg == 1) {
#pragma unroll
              for (int j = 0; j < 8; ++j) acc[j] = E0[v * 64 + kg * 8 + j];
          } else {
#pragma unroll
              for (int j = 0; j < 8; ++j) acc[j] = Q1[v * 64 + kg * 8 + j];
#pragma unroll 8
              for (int i = 0; i < 64; ++i) { const float e = E0[v * 64 + i]; const float4 pa = *(const float4*)(P1 + i * 64 + kg * 8), pb = *(const float4*)(P1 + i * 64 + kg * 8 + 4);
                  acc[0] += e * pa.x; acc[1] += e * pa.y; acc[2] += e * pa.z; acc[3] += e * pa.w; acc[4] += e * pb.x; acc[5] += e * pb.y; acc[6] += e * pb.z; acc[7] += e * pb.w; }
          }
#pragma unroll
          for (int j = 0; j < 8; ++j) sm[v * 65 + kg * 8 + j] = acc[j]; }
        __syncthreads();
        float Srow[64];
#pragma unroll
        for (int i = 0; i < 64; ++i) Srow[i] = sm[lane * 65 + i];
        const int st0 = (seg == 1 ? SEG0_LEN : SEG0_LEN + SEGX_LEN) + qtr * (SEGX_LEN / 4);
        const float* Zb = (const float*)(p.ws + WS_ZS) + (size_t)dir * 2048 * 384; float* Yb = (float*)(p.ws + WS_UR) + (size_t)dir * NTOK * 384;
#pragma unroll 1
        for (int q = wv * 4; q < SEGX_LEN / 4; q += 32) {
            int zi[4]; float yv[4]; float* yp[4]; bool ok[4];
#pragma unroll
            for (int u = 0; u < 4; ++u) {
                ok[u] = (q + u) < SEGX_LEN / 4;
                const int st = st0 + (ok[u] ? q + u : 0), t = dir ? 1023 - st : st, stok = b * 1024 + t;
                zi[u] = __builtin_bit_cast(int, Zb[(size_t)stok * 384 + h * 64 + lane]);
                yp[u] = Yb + (size_t)(NPTOK + stok) * 384 + h * 64 + lane; yv[u] = *yp[u];
            }
#pragma unroll
            for (int i = 0; i < 64; ++i)
#pragma unroll
                for (int u = 0; u < 4; ++u) yv[u] += Srow[i] * __builtin_bit_cast(float, __builtin_amdgcn_readlane(zi[u], i));
#pragma unroll
            for (int u = 0; u < 4; ++u) if (ok[u]) *yp[u] = yv[u];
        }
    }
}

__device__ __forceinline__ void ph_finalize(const P& p, int l) {
    const int tid_ = otid(); const int lane = tid_ & 63, wv = tid_ >> 6, nw = blockDim.x >> 6;
    const float* Yb = (const float*)(p.ws + WS_UR);
    bf16_t* MIX = (bf16_t*)(p.ws + WS_H);
    for (int it0 = (blockIdx.x * nw + wv) * 8; it0 < NTOK * NH; it0 += gridDim.x * nw * 8) {
        float y[8], a0[8], a1[8], r[8], vv[8], k[8], g[8];
        int tokv[8], chv[8];
#pragma unroll
        for (int u = 0; u < 8; ++u) {
            const int it = it0 + u, tok = it / NH, h = it % NH, ch = h * 64 + lane; tokv[u] = tok; chv[u] = ch;
            y[u] = Yb[(size_t)tok * 384 + ch] + Yb[((size_t)NTOK + tok) * 384 + ch];
            const unsigned char* rec = p.ws + WS_OPS + (size_t)tok * OPS_TOK + (size_t)h * OPS_REC;
            const float* rf = (const float*)rec; const bf16_t* rb = (const bf16_t*)(rec + 1280);
            a0[u] = rf[192 + lane]; a1[u] = rf[256 + lane];
            r[u] = bf2f(rb[lane]); vv[u] = bf2f(rb[64 + lane]); k[u] = bf2f(rb[128 + lane]); g[u] = bf2f(rb[192 + lane]);
        }
        float mu[8], var[8], bs[8];
#pragma unroll
        for (int u = 0; u < 8; ++u) mu[u] = y[u];
#pragma unroll
        for (int o = 1; o < 64; o <<= 1)
#pragma unroll
            for (int u = 0; u < 8; ++u) mu[u] += __shfl_xor(mu[u], o);
#pragma unroll
        for (int u = 0; u < 8; ++u) { mu[u] *= (1.f / 64.f); y[u] -= mu[u]; var[u] = y[u] * y[u];
            const float ka = p.k_a[(size_t)l * 384 + chv[u]];
            bs[u] = r[u] * (k[u] * (1.f + (a0[u] - 1.f) * ka) + k[u] * (1.f + (a1[u] - 1.f) * ka)) * p.r_k[(size_t)l * 384 + chv[u]]; }
#pragma unroll
        for (int o = 1; o < 64; o <<= 1)
#pragma unroll
            for (int u = 0; u < 8; ++u) { var[u] += __shfl_xor(var[u], o); bs[u] += __shfl_xor(bs[u], o); }
#pragma unroll
        for (int u = 0; u < 8; ++u) {
            const float yn = y[u] * rsqrtf(var[u] * (1.f / 64.f) + 64e-5f) * p.lnx_g[(size_t)l * 384 + chv[u]] + p.lnx_b[(size_t)l * 384 + chv[u]];
            MIX[(size_t)tokv[u] * 1024 + chv[u]] = f2bf((yn + bs[u] * vv[u]) * g[u]);
        }
    }
}

#define LAS __attribute__((address_space(3)))
namespace pg8 {
typedef short bf16x8 __attribute__((ext_vector_type(8)));
typedef float f32x4 __attribute__((ext_vector_type(4)));
constexpr int BM = 256, BK = 64, HALF = 128, HTB = HALF * BK * 2, STAGE_BYTES = 8 * HTB, NXCD = 8, WGM = 8;
__host__ __device__ __forceinline__ int lds_byte(int r, int c) { const int st = (r >> 4) * 2 + (c >> 5), rr = r & 15, cc = c & 31, ob = rr * 64 + cc * 2; return st * 1024 + (ob ^ (((ob >> 9) & 1) << 5)); }
__host__ __device__ __forceinline__ void stage_rc(int b, int& R, int& C) { const int st = b / 1024, sb = b % 1024, swz = sb ^ (((sb >> 9) & 1) << 5); R = (st >> 1) * 16 + swz / 64; C = (st & 1) * 32 + (swz % 64) / 2; }
struct Unit { int pm, pn; };
struct Gemm { const bf16_t* A; const bf16_t* Bt; int M, N, K; };
struct StaticOrder {
    int nM, nN, nwg, G, c;
    __device__ void init(int M, int N, int G_, int c_) { nM = M / BM; nN = N / BM; nwg = nM * nN; G = G_; c = c_; }
    __device__ bool next(int i, Unit& u) const {
        const long L = (long)i * G + c; if (L >= nwg) return false;
        int wgid = (int)L; { const int q = nwg / NXCD, r = nwg % NXCD, xcd = wgid % NXCD, off = wgid / NXCD; wgid = (xcd < r ? xcd * (q + 1) : r * (q + 1) + (xcd - r) * q) + off; }
        const int nig = WGM * nN, gid = wgid / nig, fm = gid * WGM, gsz = (nM - fm) < WGM ? (nM - fm) : WGM;
        u.pm = fm + ((wgid % nig) % gsz); u.pn = (wgid % nig) / gsz; return true;
    }
};
template <class Epi, class Sched>
__device__ __forceinline__ void gemm_phase(LAS unsigned char* lds, const Gemm g, const Sched& S, const Epi& E) {
    int tid_ = threadIdx.x; asm volatile("" : "+v"(tid_));
    const int tid = tid_, wid = __builtin_amdgcn_readfirstlane(tid >> 6), lane = tid & 63, wr = wid >> 2, wc = wid & 3, fr = lane & 15, fq = lane >> 4;
    const int K = g.K, nt = K / BK;
    unsigned voffA[2], voffB[2];
#pragma unroll
    for (int i = 0; i < 2; ++i) { int R, C; stage_rc(tid * 16 + i * 8192, R, C); voffA[i] = (unsigned)(R * K + C) * 2u; voffB[i] = (unsigned)(R * K + C) * 2u; }
    const size_t kstep = (size_t)(BK * 2);
    const size_t hstep = (size_t)HALF * K * 2;
    const size_t tstep = 2 * hstep;
    const unsigned ldsw = (unsigned)wid * 1024u;
    const int aoff = lds_byte(wr * 64 + fr, fq * 8), boff = lds_byte(wc * 32 + fr, fq * 8);
#define PG8_SA(b, h) (((b) * 2 + (h)) * HTB)
#define PG8_SB(b, h) ((4 + (b) * 2 + (h)) * HTB)
#define PG8_STAGE(bufoff, gbase, voff) do { _Pragma("unroll") for (int _i = 0; _i < 2; ++_i) \
        __builtin_amdgcn_global_load_lds((const unsigned*)((const char*)(gbase) + (voff)[_i]), (LAS unsigned*)(lds + (bufoff) + ldsw + _i * 8192), 16, 0, 0); } while (0)
#define PG8_LDA(dst, b, h) do { _Pragma("unroll") for (int m = 0; m < 4; ++m) _Pragma("unroll") for (int k = 0; k < 2; ++k) dst[m][k] = *(const LAS bf16x8*)(lds + PG8_SA(b, h) + aoff + m * 2048 + k * 1024); } while (0)
#define PG8_LDB(dst, b, h) do { _Pragma("unroll") for (int n = 0; n < 2; ++n) _Pragma("unroll") for (int k = 0; k < 2; ++k) dst[n][k] = *(const LAS bf16x8*)(lds + PG8_SB(b, h) + boff + n * 2048 + k * 1024); } while (0)
#define PG8_MMA(ai, bj, At, Bt) do { __builtin_amdgcn_s_setprio(1); _Pragma("unroll") for (int m = 0; m < 4; ++m) _Pragma("unroll") for (int n = 0; n < 2; ++n) _Pragma("unroll") for (int k = 0; k < 2; ++k) \
        acc[ai][bj][m][n] = __builtin_amdgcn_mfma_f32_16x16x32_bf16(Bt[n][k], At[m][k], acc[ai][bj][m][n], 0, 0, 0); __builtin_amdgcn_s_setprio(0); } while (0)
#define PG8_WAIT_V(n) asm volatile("s_waitcnt vmcnt(" #n ")" ::: "memory")
#define PG8_WAIT_L(n) asm volatile("s_waitcnt lgkmcnt(" #n ")" ::: "memory")
#define PG8_BAR __builtin_amdgcn_s_barrier()
#define PG8_SCHED __builtin_amdgcn_sched_barrier(0)
    Unit cur, nxt; int ui = 0;
    if (!S.next(0, cur)) return;
    f32x4 acc[2][2][4][2];
#pragma unroll
    for (int a = 0; a < 2; ++a)
#pragma unroll
        for (int b = 0; b < 2; ++b)
#pragma unroll
            for (int m = 0; m < 4; ++m)
#pragma unroll
                for (int n = 0; n < 2; ++n) acc[a][b][m][n] = (f32x4){0.f, 0.f, 0.f, 0.f};
    bf16x8 At[4][2], B0[2][2], B1[2][2];
    const char* cA = (const char*)g.A + (size_t)cur.pm * tstep; const char* cB = (const char*)g.Bt + (size_t)cur.pn * tstep;
    PG8_STAGE(PG8_SB(0, 0), cB, voffB); PG8_STAGE(PG8_SA(0, 0), cA, voffA); PG8_STAGE(PG8_SB(0, 1), cB + hstep, voffB); PG8_STAGE(PG8_SA(0, 1), cA + hstep, voffA);
    if (wr == 1) PG8_BAR;
    PG8_WAIT_V(4); PG8_BAR;
    PG8_STAGE(PG8_SB(1, 0), cB + kstep, voffB); PG8_STAGE(PG8_SA(1, 0), cA + kstep, voffA); PG8_STAGE(PG8_SB(1, 1), cB + hstep + kstep, voffB);
    PG8_WAIT_V(6); PG8_BAR;
    for (;;) {
        const bool has_next = S.next(ui + 1, nxt);
        const char* nA = has_next ? (const char*)g.A + (size_t)nxt.pm * tstep : cA; const char* nB = has_next ? (const char*)g.Bt + (size_t)nxt.pn * tstep : cB;
        for (int t = 0; t < nt; t += 2) {
            const bool last = (t == nt - 2);
            const char* a1 = cA + (size_t)(t + 1) * kstep;
            const char* a2 = last ? nA : cA + (size_t)(t + 2) * kstep; const char* b2 = last ? nB : cB + (size_t)(t + 2) * kstep;
            const char* a3 = a2 + kstep; const char* b3 = b2 + kstep;
            PG8_LDB(B0, 0, 0); PG8_SCHED; PG8_LDA(At, 0, 0); PG8_STAGE(PG8_SA(1, 1), a1 + hstep, voffA);
            PG8_WAIT_L(8); PG8_BAR; PG8_WAIT_L(0); PG8_MMA(0, 0, At, B0); PG8_BAR; PG8_SCHED;
            PG8_LDB(B1, 0, 1); PG8_STAGE(PG8_SB(0, 0), b2, voffB);
            PG8_BAR; PG8_WAIT_L(0); PG8_MMA(0, 1, At, B1); PG8_BAR;
            PG8_LDA(At, 0, 1); PG8_STAGE(PG8_SA(0, 0), a2, voffA);
            PG8_BAR; PG8_WAIT_L(0); PG8_MMA(1, 0, At, B0); PG8_BAR; PG8_SCHED;
            PG8_STAGE(PG8_SB(0, 1), b2 + hstep, voffB);
            PG8_WAIT_V(6); PG8_BAR; PG8_MMA(1, 1, At, B1); PG8_BAR;
            PG8_LDB(B0, 1, 0); PG8_SCHED; PG8_LDA(At, 1, 0); PG8_STAGE(PG8_SA(0, 1), a2 + hstep, voffA);
            PG8_WAIT_L(8); PG8_BAR; PG8_WAIT_L(0); PG8_MMA(0, 0, At, B0); PG8_BAR; PG8_SCHED;
            PG8_LDB(B1, 1, 1); PG8_STAGE(PG8_SB(1, 0), b3, voffB);
            PG8_BAR; PG8_WAIT_L(0); PG8_MMA(0, 1, At, B1); PG8_BAR;
            PG8_LDA(At, 1, 1); PG8_STAGE(PG8_SA(1, 0), a3, voffA);
            PG8_BAR; PG8_WAIT_L(0); PG8_MMA(1, 0, At, B0); PG8_BAR; PG8_SCHED;
            PG8_STAGE(PG8_SB(1, 1), b3 + hstep, voffB);
            PG8_WAIT_V(6); PG8_BAR; PG8_MMA(1, 1, At, B1); PG8_BAR;
        }
        E(acc, cur, wr, wc, fr, fq);
        if (!has_next) break;
#pragma unroll
        for (int a = 0; a < 2; ++a)
#pragma unroll
            for (int b = 0; b < 2; ++b)
#pragma unroll
                for (int m = 0; m < 4; ++m)
#pragma unroll
                    for (int n = 0; n < 2; ++n) acc[a][b][m][n] = (f32x4){0.f, 0.f, 0.f, 0.f};
        cur = nxt; cA = nA; cB = nB; ++ui;
    }
    PG8_WAIT_V(0);
    if (wr == 0) PG8_BAR;
    PG8_BAR;
#undef PG8_SA
#undef PG8_SB
#undef PG8_STAGE
#undef PG8_LDA
#undef PG8_LDB
#undef PG8_MMA
#undef PG8_WAIT_V
#undef PG8_WAIT_L
#undef PG8_BAR
#undef PG8_SCHED
}
template <class F> struct EpiWrap {
    const P* p; F f;
    __device__ __forceinline__ void operator()(const f32x4 (&acc)[2][2][4][2], const Unit& u, int wr, int wc, int fr, int fq) const {
        const int row0 = u.pm * BM + wr * 64 + fr, col0 = u.pn * BM + wc * 32 + 4 * fq;
#pragma unroll
        for (int ai = 0; ai < 2; ++ai)
#pragma unroll
            for (int m = 0; m < 4; ++m)
#pragma unroll
                for (int bj = 0; bj < 2; ++bj)
#pragma unroll
                    for (int n = 0; n < 2; ++n) {
                        const f32x4 a = acc[ai][bj][m][n]; const float v[4] = {a[0], a[1], a[2], a[3]};
                        f(*p, row0 + ai * HALF + m * 16, col0 + bj * HALF + n * 16, v);
                    }
    }
};
struct EpiG1H {
    const P* p; int l;
    __device__ __forceinline__ void operator()(const f32x4 (&acc)[2][2][4][2], const Unit& u, int wr, int wc, int fr, int fq) const {
        const int row0 = u.pm * BM + wr * 64 + fr, col0 = u.pn * BM + wc * 32 + 4 * fq;
        const float* rsq = (const float*)(p->ws + WS_RSQ) + (size_t)(2 * l) * NTOK;
        const float* bias = (const float*)(p->ws + WS_BIAS) + (size_t)(l * 3 + tok_cls(u.pm * BM)) * 3072 + col0;
        float rs[2][4]; float4 bb[2][2];
#pragma unroll
        for (int ai = 0; ai < 2; ++ai)
#pragma unroll
            for (int m = 0; m < 4; ++m) rs[ai][m] = rsq[row0 + ai * HALF + m * 16];
#pragma unroll
        for (int bj = 0; bj < 2; ++bj)
#pragma unroll
            for (int n = 0; n < 2; ++n) bb[bj][n] = *(const float4*)(bias + bj * HALF + n * 16);
#pragma unroll
        for (int ai = 0; ai < 2; ++ai)
#pragma unroll
            for (int m = 0; m < 4; ++m) rs[ai][m] = rsqrtf(rs[ai][m] * (1.f / 1024.f) + 1e-6f);
        const EpiG1 f{l};
#pragma unroll
        for (int ai = 0; ai < 2; ++ai)
#pragma unroll
            for (int m = 0; m < 4; ++m)
#pragma unroll
                for (int bj = 0; bj < 2; ++bj)
#pragma unroll
                    for (int n = 0; n < 2; ++n) {
                        const f32x4 a = acc[ai][bj][m][n]; const float r = rs[ai][m]; const float4 b = bb[bj][n];
                        const float v[4] = {a[0] * r + b.x, a[1] * r + b.y, a[2] * r + b.z, a[3] * r + b.w};
                        f(*p, row0 + ai * HALF + m * 16, col0 + bj * HALF + n * 16, v);
                    }
    }
};
struct EpiFfn1 {
    const P* p; int l;
    __device__ __forceinline__ void operator()(const f32x4 (&acc)[2][2][4][2], const Unit& u, int wr, int wc, int fr, int fq) const {
        const int row0 = u.pm * BM + wr * 64 + fr, j0 = u.pn * 128 + wc * 32 + 4 * fq, c0 = u.pn * 256 + wc * 32 + 4 * fq;
        bf16_t* HA = (bf16_t*)(p->ws + WS_UR);
        const float* rsq = (const float*)(p->ws + WS_RSQ) + (size_t)(2 * l + 1) * NTOK;
        const float* bc = (const float*)(p->ws + WS_BIAS) + 2 * 3 * 3072 + (size_t)(l * 3 + tok_cls(u.pm * BM)) * 5632 + c0;
        float rs[2][4]; float4 bg[2], bu[2];
#pragma unroll
        for (int ai = 0; ai < 2; ++ai)
#pragma unroll
            for (int m = 0; m < 4; ++m) rs[ai][m] = rsq[row0 + ai * HALF + m * 16];
#pragma unroll
        for (int n = 0; n < 2; ++n) { bg[n] = *(const float4*)(bc + n * 16); bu[n] = *(const float4*)(bc + 128 + n * 16); }
#pragma unroll
        for (int ai = 0; ai < 2; ++ai)
#pragma unroll
            for (int m = 0; m < 4; ++m) rs[ai][m] = rsqrtf(rs[ai][m] * (1.f / 1024.f) + 1e-6f);
#pragma unroll
        for (int ai = 0; ai < 2; ++ai)
#pragma unroll
            for (int m = 0; m < 4; ++m) {
                const int row = row0 + ai * HALF + m * 16; const float r = rs[ai][m];
#pragma unroll
                for (int n = 0; n < 2; ++n) {
                    const f32x4 g = acc[ai][0][m][n], up = acc[ai][1][m][n]; float h[4];
                    const float bgv[4] = {bg[n].x, bg[n].y, bg[n].z, bg[n].w}, buv[4] = {bu[n].x, bu[n].y, bu[n].z, bu[n].w};
#pragma unroll
                    for (int e = 0; e < 4; ++e) { const float gt = g[e] * r + bgv[e], uu = up[e] * r + buv[e]; h[e] = gt * sigmoidf_(gt) * uu; }
                    uint2 w; w.x = pk_bf16(h[0], h[1]); w.y = pk_bf16(h[2], h[3]);
                    *(uint2*)(HA + (size_t)row * D_FF + j0 + n * 16) = w;
                }
            }
    }
};
struct EpiResN {
    const P* p; int l, which;
    const float* ng; int nl, nsc;
    bf16_t* Hout; float* rsq;
    __device__ __forceinline__ void operator()(const f32x4 (&acc)[2][2][4][2], const Unit& u, int wr, int wc, int fr, int fq) const {
        const int row0 = u.pm * BM + wr * 64 + fr, col0 = u.pn * BM + wc * 32 + 4 * fq;
        const int cls = tok_cls(u.pm * BM);
        const float* g = mod_vec(*p, l, cls, which) + col0;
        float4 gg[2][2], gw[2][2];
#pragma unroll
        for (int bj = 0; bj < 2; ++bj)
#pragma unroll
            for (int n = 0; n < 2; ++n) {
                gg[bj][n] = *(const float4*)(g + bj * HALF + n * 16);
                if (ng) { const float4 gn = *(const float4*)(ng + col0 + bj * HALF + n * 16), sc = *(const float4*)(mod_vec(*p, nl, cls, nsc) + col0 + bj * HALF + n * 16);
                    gw[bj][n] = make_float4(gn.x * (1.f + sc.x), gn.y * (1.f + sc.y), gn.z * (1.f + sc.z), gn.w * (1.f + sc.w)); }
            }
#pragma unroll
        for (int ai = 0; ai < 2; ++ai)
#pragma unroll
            for (int mp = 0; mp < 4; mp += 2) {
                float4 x[2][2][2];
#pragma unroll
                for (int q = 0; q < 2; ++q) {
                    const int row = row0 + ai * HALF + (mp + q) * 16;
                    const float* xo = ((which == 2 && l == 0) ? xin_row(*p, row) : X_row(*p, row)) + col0;
#pragma unroll
                    for (int bj = 0; bj < 2; ++bj)
#pragma unroll
                        for (int n = 0; n < 2; ++n) x[q][bj][n] = *(const float4*)(xo + bj * HALF + n * 16);
                }
#pragma unroll
                for (int q = 0; q < 2; ++q) {
                    const int row = row0 + ai * HALF + (mp + q) * 16;
                    float ssq = 0.f;
#pragma unroll
                    for (int bj = 0; bj < 2; ++bj)
#pragma unroll
                        for (int n = 0; n < 2; ++n) {
                            const int col = col0 + bj * HALF + n * 16; const f32x4 a = acc[ai][bj][mp + q][n]; const float4 xv = x[q][bj][n], gv = gg[bj][n];
                            const float4 xn = make_float4(xv.x + gv.x * a[0], xv.y + gv.y * a[1], xv.z + gv.z * a[2], xv.w + gv.w * a[3]);
                            *(float4*)(X_row(*p, row) + col) = xn;
                            if (ng) {
                                ssq += xn.x * xn.x + xn.y * xn.y + xn.z * xn.z + xn.w * xn.w;
                                const float4 w4 = gw[bj][n];
                                uint2 w; w.x = pk_bf16(xn.x * w4.x, xn.y * w4.y); w.y = pk_bf16(xn.z * w4.z, xn.w * w4.w);
                                *(uint2*)(Hout + (size_t)row * 1024 + col) = w;
                            }
                        }
                    if (ng) { ssq += __shfl_xor(ssq, 16); ssq += __shfl_xor(ssq, 32); if (fq == 0) unsafeAtomicAdd(rsq + row, ssq); }
                }
            }
    }
};
}


typedef short bf16x8_t __attribute__((ext_vector_type(8)));
typedef short bf16x4_t __attribute__((ext_vector_type(4)));
typedef float f32x16_t __attribute__((ext_vector_type(16)));
#define AT_KS_BYTES (256 * 72 * 2)
__device__ __forceinline__ void attn_stage(const P& p, int l, int s, int h, int start, int nctx, int chunk, bool withV, bf16_t* Ks, bf16_t* Vt, int tid) {
    const int key = tid >> 1, half = tid & 1, j = chunk * 256 + key;
    if (j < nctx) {
        const size_t base = (((size_t)(s - 32) * 2 + l) * 512 + j) * 384 + h * 64 + half * 32;
        const float4* kp = (const float4*)(p.cache_k + base);
#pragma unroll
        for (int i = 0; i < 4; ++i) { const float4 a = kp[2 * i], b = kp[2 * i + 1]; uint4 o; o.x = pk_bf16(a.x, a.y); o.y = pk_bf16(a.z, a.w); o.z = pk_bf16(b.x, b.y); o.w = pk_bf16(b.z, b.w);
            *(uint4*)(Ks + key * 72 + half * 32 + i * 8) = o; }
        if (withV) { const float4* vp = (const float4*)(p.cache_v + base);
#pragma unroll
            for (int i = 0; i < 8; ++i) { const float4 a = vp[i]; bf16_t* d = Vt + (half * 32 + i * 4) * 260 + key; d[0] = f2bf(a.x); d[260] = f2bf(a.y); d[520] = f2bf(a.z); d[780] = f2bf(a.w); } }
    } else {
        const bf16_t* UD = (const bf16_t*)(p.ws + WS_UD);
        const size_t base = (size_t)(start + j - nctx) * 1152 + h * 64 + half * 32;
        const uint4* kp = (const uint4*)(UD + base + 384);
#pragma unroll
        for (int i = 0; i < 4; ++i) *(uint4*)(Ks + key * 72 + half * 32 + i * 8) = kp[i];
        if (withV) { const uint4* vp = (const uint4*)(UD + base + 768);
#pragma unroll
            for (int i = 0; i < 4; ++i) { const uint4 u = vp[i]; const unsigned w[4] = {u.x, u.y, u.z, u.w}; bf16_t* d = Vt + (half * 32 + i * 8) * 260 + key;
#pragma unroll
                for (int e = 0; e < 4; ++e) { d[(2 * e) * 260] = (bf16_t)(w[e] & 0xffff); d[(2 * e + 1) * 260] = (bf16_t)(w[e] >> 16); } } }
    }
}
__device__ __forceinline__ void attn_item(const P& p, int l, int item, unsigned char* lds, float lam, float lam_init) {
    const int tid = otid(), lane = tid & 63, wv = tid >> 6, n = lane & 31, hh = lane >> 5;
    int s, h, qb;
    if (item < 48) { s = 32 + item / 24; h = (item % 24) / 4; qb = item & 3; } else { const int r = item - 48; s = r / 6; h = r % 6; qb = 0; }
    int start, T; seq_info(s, start, T);
    const int nctx = s >= 32 ? 512 : 0, nchunks = (nctx + T) >> 8;
    bf16_t* Ks = (bf16_t*)lds; bf16_t* Vt = (bf16_t*)(lds + AT_KS_BYTES);
    const bf16_t* UD = (const bf16_t*)(p.ws + WS_UD);
    const int qtok = start + qb * 256 + wv * 32 + n;
    bf16x8_t Qf[2][2];
#pragma unroll
    for (int m = 0; m < 2; ++m)
#pragma unroll
        for (int si = 0; si < 2; ++si) Qf[m][si] = *(const bf16x8_t*)(UD + (size_t)qtok * 1152 + h * 64 + m * 32 + si * 16 + hh * 8);
    const float c = 0.17677669529663687f * 1.4426950408889634f;
    float m0 = -1e30f, m1 = -1e30f, l0 = 0.f, l1 = 0.f;
    for (int ch = 0; ch < nchunks; ++ch) {
        __syncthreads();
        attn_stage(p, l, s, h, start, nctx, ch, false, Ks, Vt, tid);
        __syncthreads();
#pragma unroll 1
        for (int kt = 0; kt < 8; ++kt) {
            f32x16_t S0 = {0,0,0,0,0,0,0,0,0,0,0,0,0,0,0,0}, S1 = S0;
#pragma unroll
            for (int si = 0; si < 2; ++si) {
                const bf16x8_t k0 = *(const bf16x8_t*)(Ks + (kt * 32 + n) * 72 + si * 16 + hh * 8);
                const bf16x8_t k1 = *(const bf16x8_t*)(Ks + (kt * 32 + n) * 72 + 32 + si * 16 + hh * 8);
                S0 = __builtin_amdgcn_mfma_f32_32x32x16_bf16(k0, Qf[0][si], S0, 0, 0, 0);
                S1 = __builtin_amdgcn_mfma_f32_32x32x16_bf16(k1, Qf[1][si], S1, 0, 0, 0);
            }
            float t0 = S0[0], t1 = S1[0];
#pragma unroll
            for (int r = 1; r < 16; ++r) { t0 = fmaxf(t0, S0[r]); t1 = fmaxf(t1, S1[r]); }
            const float n0 = fmaxf(m0, t0), n1 = fmaxf(m1, t1);
            float a0 = 0.f, a1 = 0.f;
#pragma unroll
            for (int r = 0; r < 16; ++r) { a0 += __builtin_amdgcn_exp2f((S0[r] - n0) * c); a1 += __builtin_amdgcn_exp2f((S1[r] - n1) * c); }
            l0 = l0 * __builtin_amdgcn_exp2f((m0 - n0) * c) + a0; l1 = l1 * __builtin_amdgcn_exp2f((m1 - n1) * c) + a1;
            m0 = n0; m1 = n1;
        }
    }
    {
        const float mo0 = __shfl_xor(m0, 32), lo0 = __shfl_xor(l0, 32), mo1 = __shfl_xor(m1, 32), lo1 = __shfl_xor(l1, 32);
        const float M0 = fmaxf(m0, mo0), M1 = fmaxf(m1, mo1);
        l0 = l0 * __builtin_amdgcn_exp2f((m0 - M0) * c) + lo0 * __builtin_amdgcn_exp2f((mo0 - M0) * c);
        l1 = l1 * __builtin_amdgcn_exp2f((m1 - M1) * c) + lo1 * __builtin_amdgcn_exp2f((mo1 - M1) * c);
        m0 = M0; m1 = M1;
    }
    const float i0 = 1.f / l0, i1 = lam / l1;
    f32x16_t O0 = {0,0,0,0,0,0,0,0,0,0,0,0,0,0,0,0}, O1 = O0;
    for (int ch = 0; ch < nchunks; ++ch) {
        __syncthreads();
        attn_stage(p, l, s, h, start, nctx, ch, true, Ks, Vt, tid);
        __syncthreads();
#pragma unroll 1
        for (int kt = 0; kt < 8; ++kt) {
            f32x16_t S0 = {0,0,0,0,0,0,0,0,0,0,0,0,0,0,0,0}, S1 = S0;
#pragma unroll
            for (int si = 0; si < 2; ++si) {
                const bf16x8_t k0 = *(const bf16x8_t*)(Ks + (kt * 32 + n) * 72 + si * 16 + hh * 8);
                const bf16x8_t k1 = *(const bf16x8_t*)(Ks + (kt * 32 + n) * 72 + 32 + si * 16 + hh * 8);
                S0 = __builtin_amdgcn_mfma_f32_32x32x16_bf16(k0, Qf[0][si], S0, 0, 0, 0);
                S1 = __builtin_amdgcn_mfma_f32_32x32x16_bf16(k1, Qf[1][si], S1, 0, 0, 0);
            }
            float pw[16];
#pragma unroll
            for (int r = 0; r < 16; ++r) pw[r] = __builtin_amdgcn_exp2f((S0[r] - m0) * c) * i0 - __builtin_amdgcn_exp2f((S1[r] - m1) * c) * i1;
#pragma unroll
            for (int si = 0; si < 2; ++si) {
                union { unsigned u[4]; bf16x8_t v; } pf;
#pragma unroll
                for (int e = 0; e < 4; ++e) pf.u[e] = pk_bf16(pw[8 * si + 2 * e], pw[8 * si + 2 * e + 1]);
                union { bf16x4_t h2[2]; bf16x8_t v; } va, vb;
                const bf16_t* v0 = Vt + n * 260 + kt * 32 + si * 16 + hh * 4;
                va.h2[0] = *(const bf16x4_t*)v0; va.h2[1] = *(const bf16x4_t*)(v0 + 8);
                vb.h2[0] = *(const bf16x4_t*)(v0 + 32 * 260); vb.h2[1] = *(const bf16x4_t*)(v0 + 32 * 260 + 8);
                O0 = __builtin_amdgcn_mfma_f32_32x32x16_bf16(va.v, pf.v, O0, 0, 0, 0);
                O1 = __builtin_amdgcn_mfma_f32_32x32x16_bf16(vb.v, pf.v, O1, 0, 0, 0);
            }
        }
    }
    float ss = 0.f;
#pragma unroll
    for (int r = 0; r < 16; ++r) ss += O0[r] * O0[r] + O1[r] * O1[r];
    ss += __shfl_xor(ss, 32);
    const float rs = rsqrtf(ss * (1.f / 64.f) + 1e-5f) * (1.f - lam_init);
    bf16_t* mo = (bf16_t*)(p.ws + WS_H) + (size_t)qtok * 1024 + 384 + h * 64;
    const float* sg = p.subln_g + (size_t)l * 64;
#pragma unroll
    for (int g = 0; g < 4; ++g) {
        const int vd = 8 * g + 4 * hh;
        uint2 w0, w1;
        w0.x = pk_bf16(O0[4 * g] * rs * sg[vd], O0[4 * g + 1] * rs * sg[vd + 1]); w0.y = pk_bf16(O0[4 * g + 2] * rs * sg[vd + 2], O0[4 * g + 3] * rs * sg[vd + 3]);
        w1.x = pk_bf16(O1[4 * g] * rs * sg[32 + vd], O1[4 * g + 1] * rs * sg[32 + vd + 1]); w1.y = pk_bf16(O1[4 * g + 2] * rs * sg[32 + vd + 2], O1[4 * g + 3] * rs * sg[32 + vd + 3]);
        *(uint2*)(mo + vd) = w0; *(uint2*)(mo + 32 + vd) = w1;
    }
}

struct EpiFnet {
    int samp;
    __device__ __forceinline__ void operator()(const P& p, int row, int col, const float* v) const {
        const int sq = col >> 8, ch = col & 255;
        const int tok = samp ? NPTOK + sq * 1024 + row : sq * 256 + row;
        uint2 w; w.x = pk_bf16(v[0], v[1]); w.y = pk_bf16(v[2], v[3]);
        *(uint2*)((bf16_t*)(p.ws + WS_H) + (size_t)tok * 1024 + 768 + ch) = w;
    }
};
struct OneUnit { int pm, pn; __device__ bool next(int i, pg8::Unit& u) const { if (i) return false; u.pm = pm; u.pn = pn; return true; } };

#define MX_ITEMS 724
template <class GemmFn>
__device__ __forceinline__ void ph_mixer(const P& p, int l, unsigned char* lds, volatile LAS unsigned* slot, GemmFn gemm_one) {
    const float lam_init = 0.8f - 0.6f * __expf(-0.3f * (float)l);
    float lam;
    { const float* lp = p.diff_lambda + (size_t)l * 128; float s01 = 0.f, s23 = 0.f;
      for (int d = 0; d < 32; ++d) { s01 += lp[d] * lp[32 + d]; s23 += lp[64 + d] * lp[96 + d]; }
      lam = __expf(s01) - __expf(s23) + lam_init; }
    unsigned* ctr = (unsigned*)(p.ws + WS_CTL) + CTL_QUEUE + 64 * l;
    for (;;) {
        __syncthreads();
        if (threadIdx.x == 0) *slot = atomicAdd(ctr, 1u);
        __syncthreads();
        const int item = (int)*slot;
        if (item >= MX_ITEMS) break;
#if PROBE_ID
        const unsigned long long it0 = __builtin_amdgcn_s_memrealtime();
#endif
        if (item < 48) attn_item(p, l, item, lds, lam, lam_init);
        else if (item < 60) ph_scan_job(p, l, 32 + (item - 48) / NH, (item - 48) % NH, 0, 0, 0, 0, SEG0_LEN, (float*)lds);
        else if (item < 108) { const int r = item - 60, sg = 1 + (r & 1), dr = (r >> 1) & 1, hh = (r >> 2) % NH, bb = r / 24;
            ph_scan_job(p, l, 32 + bb, hh, 1, dr, sg, sg == 1 ? SEG0_LEN : SEG0_LEN + SEGX_LEN, SEGX_LEN, (float*)lds); }
        else if (item < 300) ph_scan_job(p, l, (item - 108) / NH, (item - 108) % NH, 0, 0, 0, 0, TP, (float*)lds);
        else if (item < 308) gemm_one(1, (item - 300) >> 1, (item - 300) & 1);
        else if (item < 500) attn_item(p, l, 48 + item - 308, lds, lam, lam_init);
        else if (item < 532) gemm_one(0, 0, item - 500);
        else fixup_item(p, l, item - 532, (float*)lds);
        if (item >= 48 && item < 108) {
            asm volatile("s_waitcnt vmcnt(0)" ::: "memory");
            __syncthreads();
            if (threadIdx.x == 0) {
                __builtin_amdgcn_fence(__ATOMIC_RELEASE, "agent");
                asm volatile("s_waitcnt vmcnt(0)" ::: "memory");
                unsigned* cnt = (unsigned*)(p.ws + WS_CTL) + CTL_SCANDONE + 32 * l;
                if (item < 60) { const int bh = item - 48; __hip_atomic_fetch_add(cnt + bh * 2, 1u, __ATOMIC_RELAXED, __HIP_MEMORY_SCOPE_AGENT); __hip_atomic_fetch_add(cnt + bh * 2 + 1, 1u, __ATOMIC_RELAXED, __HIP_MEMORY_SCOPE_AGENT); }
                else { const int r = item - 60, dr = (r >> 1) & 1, hh = (r >> 2) % NH, bb = r / 24; __hip_atomic_fetch_add(cnt + (bb * NH + hh) * 2 + dr, 1u, __ATOMIC_RELAXED, __HIP_MEMORY_SCOPE_AGENT); }
            }
        }
#if PROBE_ID
        __syncthreads();
        if (threadIdx.x == 0 && l == 0) { const int cls = item < 48 ? 3 : item < 60 ? 0 : item < 108 ? 6 : item < 300 ? 2 : item < 308 ? 1 : item < 500 ? 5 : 4;
            atomicMax((unsigned*)(p.ws + WS_CTL) + 3712 + cls, (unsigned)(__builtin_amdgcn_s_memrealtime() - it0)); }
#endif
    }
}

#define XB_TMO      128
#define XB_XCNT(j)  (256  + 64 * (j))
#define XB_XSUB(j)  (1280 + 64 * (j))
#define XB_XGEN(j)  (2304 + 64 * (j))
#define XB_TOP      3328
#define XB_TOPGEN   3392
#define XCD_BAR_WORDS 3456
#define XB_SPIN_CAP (1u << 22)
__device__ __forceinline__ unsigned xb_ld(unsigned* p)              { return __hip_atomic_load(p, __ATOMIC_RELAXED, __HIP_MEMORY_SCOPE_AGENT); }
__device__ __forceinline__ unsigned xb_add(unsigned* p, unsigned v) { return __hip_atomic_fetch_add(p, v, __ATOMIC_RELAXED, __HIP_MEMORY_SCOPE_AGENT); }
__device__ __forceinline__ unsigned xb_xcc_id() { return (unsigned)__builtin_amdgcn_s_getreg((3 << 11) | 20) & 0xFu; }
#define XB_SPIN(cond, bar) do { unsigned _sp = 0; while (cond) { __builtin_amdgcn_s_sleep(1); \
    if ((++_sp & 255u) == 0u) { if (xb_ld(&(bar)[XB_TMO])) break; if (_sp > XB_SPIN_CAP) { atomicAdd(&(bar)[XB_TMO], 1u); break; } } } } while (0)
struct XcdBarrier { unsigned* bar; unsigned x; volatile LAS unsigned* st; };
__device__ __forceinline__ XcdBarrier xcd_barrier_post(unsigned* bar, volatile LAS unsigned* st) {
    XcdBarrier b; b.bar = bar; b.x = xb_xcc_id(); b.st = st;
    if (threadIdx.x == 0) (void)xb_add(&bar[XB_XCNT(b.x)], 1u);
    return b;
}
__device__ __forceinline__ void xcd_barrier_complete(unsigned* bar, unsigned x, unsigned& nloc, unsigned& nx) {
    const unsigned G = gridDim.x * gridDim.y * gridDim.z;
    unsigned sum, cnt, mine, sp = 0u;
    for (;;) {
        sum = 0u; cnt = 0u; mine = 0u;
#pragma unroll
        for (unsigned j = 0; j < 16; ++j) { const unsigned c = xb_ld(&bar[XB_XCNT(j)]); sum += c; cnt += (c > 0u) ? 1u : 0u; mine = (j == x) ? c : mine; }
        if (sum == G) break;
        __builtin_amdgcn_s_sleep(1);
        if ((++sp & 255u) == 0u) { if (xb_ld(&bar[XB_TMO])) break; if (sp > XB_SPIN_CAP) { atomicAdd(&bar[XB_TMO], 1u); break; } }
    }
    nloc = mine > 0u ? mine : 1u; nx = cnt > 0u ? cnt : 1u;
}
__device__ __forceinline__ void xcd_barrier(const XcdBarrier& b) {
    asm volatile("s_waitcnt vmcnt(0)" ::: "memory");
    __syncthreads();
    if (threadIdx.x == 0) {
        unsigned* bar = b.bar;
        __builtin_amdgcn_s_waitcnt(0);
        unsigned nloc = b.st[0], nx = b.st[1];
        if (nloc == 0u) { xcd_barrier_complete(bar, b.x, nloc, nx); b.st[0] = nloc; b.st[1] = nx; }
        const unsigned old = xb_add(&bar[XB_XSUB(b.x)], 1u);
        const unsigned gen = old / nloc;
        if (old + 1u == (gen + 1u) * nloc) {
            __builtin_amdgcn_fence(__ATOMIC_RELEASE, "agent");
            asm volatile("s_waitcnt vmcnt(0)" ::: "memory");
            const unsigned og = xb_add(&bar[XB_TOP], 1u);
            const unsigned tg = og / nx;
            if (og + 1u == (tg + 1u) * nx) xb_add(&bar[XB_TOPGEN], 1u);
            else XB_SPIN(xb_ld(&bar[XB_TOPGEN]) == tg, bar);
            __builtin_amdgcn_fence(__ATOMIC_ACQUIRE, "agent");
            xb_add(&bar[XB_XGEN(b.x)], 1u);
            asm volatile("s_waitcnt vmcnt(0)" ::: "memory");
        } else {
            XB_SPIN(xb_ld(&bar[XB_XGEN(b.x)]) == gen, bar);
            __builtin_amdgcn_fence(__ATOMIC_ACQUIRE, "agent");
            asm volatile("s_waitcnt vmcnt(0)" ::: "memory");
        }
    }
    __syncthreads();
}

#define MISC_OFF 133120
#define LDS_BYTES (MISC_OFF + 1024)
#define N_PHASES 17
struct Args { P p; int ph_lo, ph_hi; };
__global__ __launch_bounds__(512, 2) void mega(Args a) {
    extern __shared__ __attribute__((aligned(16))) unsigned char lds[];
    const P& p = a.p;
    LAS unsigned char* l3 = (LAS unsigned char*)lds;
    volatile LAS unsigned* misc = (volatile LAS unsigned*)(l3 + MISC_OFF);
    if (threadIdx.x < 16) misc[threadIdx.x] = 0u;
    __syncthreads();
    XcdBarrier bar = xcd_barrier_post((unsigned*)(p.ws + WS_CTL), misc);
    float* sm = (float*)lds;
    const int lo = a.ph_lo, hi = a.ph_hi;
#define IN(k) (lo <= (k) && (k) < hi)
#if PROBE_ID
    unsigned long long* tsl = (unsigned long long*)(p.ws + WS_CTL + 15360);
    if (blockIdx.x == 0 && otid() == 0) tsl[0] = __builtin_amdgcn_s_memrealtime();
#define SEAM(k) do { if (IN(k) && IN((k) + 1)) xcd_barrier(bar); if (blockIdx.x == 0 && otid() == 0) tsl[1 + (k)] = __builtin_amdgcn_s_memrealtime(); } while (0)
#else
#define SEAM(k) do { if (IN(k) && IN((k) + 1)) xcd_barrier(bar); } while (0)
#endif
    if (IN(0)) ph_prep0(p, sm);
    SEAM(0);
    if (IN(1)) ph_prep0b(p);
    SEAM(1);
    for (int l = 0; l < 2; ++l) {
        const int b0 = 2 + 7 * l;
        if (IN(b0 + 0)) { pg8::Gemm g{(const bf16_t*)(p.ws + WS_H), (const bf16_t*)(p.ws + WS_WIN) + (size_t)l * N1 * 1024, NTOK, N1, 1024};
            pg8::StaticOrder S; S.init(NTOK, N1, gridDim.x, blockIdx.x); pg8::EpiG1H E{&p, l}; pg8::gemm_phase(l3, g, S, E); }
        SEAM(b0 + 0);
        if (IN(b0 + 1)) ph_prep(p, l, sm);
        SEAM(b0 + 1);
        if (IN(b0 + 2)) {
            auto gemm_one = [&](int samp, int pm, int pn) {
                pg8::Gemm g{samp ? (const bf16_t*)(p.ws + WS_L1024) : (const bf16_t*)(p.ws + WS_L256), samp ? (const bf16_t*)(p.ws + WS_ZF) + (size_t)8192 * 512 : (const bf16_t*)(p.ws + WS_ZF),
                            samp ? 1024 : 256, samp ? 512 : 8192, samp ? 2048 : 512};
                OneUnit S{pm, pn}; pg8::EpiWrap<EpiFnet> E{&p, EpiFnet{samp}}; pg8::gemm_phase(l3, g, S, E); };
            ph_mixer(p, l, lds, misc + 4, gemm_one);
        }
        SEAM(b0 + 2);
        if (IN(b0 + 3)) ph_finalize(p, l);
        SEAM(b0 + 3);
        if (IN(b0 + 4)) { pg8::Gemm g{(const bf16_t*)(p.ws + WS_H), (const bf16_t*)(p.ws + WS_WOUT) + (size_t)l * 1024 * 1024, NTOK, 1024, 1024};
            pg8::StaticOrder S; S.init(NTOK, 1024, gridDim.x, blockIdx.x);
            pg8::EpiResN E{&p, l, 2, p.norm2_g + (size_t)l * 1024, l, 4, (bf16_t*)(p.ws + WS_H2), (float*)(p.ws + WS_RSQ) + (size_t)(2 * l + 1) * NTOK}; pg8::gemm_phase(l3, g, S, E); }
        SEAM(b0 + 4);
        if (IN(b0 + 5)) { pg8::Gemm g{(const bf16_t*)(p.ws + WS_H2), (const bf16_t*)(p.ws + WS_WF1) + (size_t)l * 5632 * 1024, NTOK, 5632, 1024};
            pg8::StaticOrder S; S.init(NTOK, 5632, gridDim.x, blockIdx.x); pg8::EpiFfn1 E{&p, l}; pg8::gemm_phase(l3, g, S, E); }
        SEAM(b0 + 5);
        if (IN(b0 + 6)) { pg8::Gemm g{(const bf16_t*)(p.ws + WS_UR), (const bf16_t*)(p.ws + WS_WF2) + (size_t)l * 1024 * 2816, NTOK, 1024, 2816};
            pg8::StaticOrder S; S.init(NTOK, 1024, gridDim.x, blockIdx.x);
            pg8::EpiResN E{&p, l, 5, l == 0 ? p.norm1_g + 1024 : (const float*)nullptr, 1, 1, (bf16_t*)(p.ws + WS_H), (float*)(p.ws + WS_RSQ) + (size_t)2 * NTOK}; pg8::gemm_phase(l3, g, S, E); }
        SEAM(b0 + 6);
    }
    if (IN(16)) ph_norm(p, 0, 2);
#if PROBE_ID
    __syncthreads();
    if (blockIdx.x == 0 && otid() == 0) {
        tsl[17] = __builtin_amdgcn_s_memrealtime();
        __threadfence();
        unsigned long long acc = 0;
#pragma unroll 1
        for (int k = 0; k < 17; ++k) {
            const int st = k == 0 ? -1 : (k == 1 ? -3 : (k == 16 ? -2 : 20 + (k - 2) % 7));
            bool sel = false;
            if (PROBE_ID == 1) sel = (k == 0);
            if (PROBE_ID == 2) sel = (st == 10 || st == 15 || st == 16 || st == 17);
            if (PROBE_ID == 3) sel = (st == 12);
            if (PROBE_ID == 4) sel = (st == -2 || st == -3);
            if (PROBE_ID == 5) sel = (st == 11);
            if (PROBE_ID == 6) sel = (st == 13);
            if (PROBE_ID == 7) sel = (st == 14);
            if (PROBE_ID == 8) sel = (st == 10);
            if (PROBE_ID == 9) sel = (st == 15);
            if (PROBE_ID == 10) sel = (st == 16);
            if (PROBE_ID == 11) sel = (st == 17);
            if (sel) acc += __hip_atomic_load(tsl + 1 + k, __ATOMIC_RELAXED, __HIP_MEMORY_SCOPE_AGENT) - __hip_atomic_load(tsl + k, __ATOMIC_RELAXED, __HIP_MEMORY_SCOPE_AGENT);
        }
        if (PROBE_ID >= 30 && PROBE_ID < 34) { unsigned long long* tsp = (unsigned long long*)(p.ws + WS_CTL + 15360) + 32; acc = __hip_atomic_load(tsp + (PROBE_ID - 29), __ATOMIC_RELAXED, __HIP_MEMORY_SCOPE_AGENT) - __hip_atomic_load(tsp + (PROBE_ID - 30), __ATOMIC_RELAXED, __HIP_MEMORY_SCOPE_AGENT); }
        else if (PROBE_ID >= 20) acc = __hip_atomic_load((unsigned*)(p.ws + WS_CTL) + 3712 + (PROBE_ID - 20), __ATOMIC_RELAXED, __HIP_MEMORY_SCOPE_AGENT);
        const unsigned long long t_end = __builtin_amdgcn_s_memrealtime();
        while (__builtin_amdgcn_s_memrealtime() - t_end < 4ull * acc) __builtin_amdgcn_s_sleep(8);
    }
#endif
#undef IN
#undef SEAM
}

extern "C" void kernel_launch(void* const* d_in, const int* in_sizes, int n_in, void* d_out, int out_size, void* d_ws, size_t ws_size, hipStream_t stream) {
    static int grid = 0;
    if (grid == 0) {
        if (n_in != 29 || ws_size < WS_END) { fprintf(stderr, "kernel_launch: bad n_in %d or ws_size %zu (need %zu)\n", n_in, ws_size, (size_t)WS_END); grid = -1; return; }
        int dev = 0, cus = 0, per_cu = 0;
        hipGetDevice(&dev); hipDeviceGetAttribute(&cus, hipDeviceAttributeMultiprocessorCount, dev);
        if (hipFuncSetAttribute((const void*)mega, hipFuncAttributeMaxDynamicSharedMemorySize, LDS_BYTES) != hipSuccess) { fprintf(stderr, "kernel_launch: hipFuncSetAttribute failed\n"); grid = -1; return; }
        if (hipOccupancyMaxActiveBlocksPerMultiprocessor(&per_cu, (const void*)mega, 512, LDS_BYTES) != hipSuccess || per_cu < 1) { fprintf(stderr, "kernel_launch: occupancy query says %d\n", per_cu); per_cu = 1; }
        (void)hipGetLastError();
        grid = cus;
    }
    if (grid < 0) return;
    hipMemsetAsync((unsigned char*)d_ws + WS_CTL, 0, 16384 + 4 * NTOK * 4, stream);
    Args a{};
    const float** f = (const float**)&a.p;
    for (int i = 0; i < 29; ++i) f[i] = (const float*)d_in[i];
    a.p.out = (float*)d_out; a.p.ws = (unsigned char*)d_ws;
#if ONE_LAUNCH
    a.ph_lo = 0; a.ph_hi = N_PHASES;
    hipLaunchKernelGGL(mega, dim3(grid), dim3(512), LDS_BYTES, stream, a);
#else
    for (int ph = 0; ph < N_PHASES; ++ph) { a.ph_lo = ph; a.ph_hi = ph + 1; hipLaunchKernelGGL(mega, dim3(grid), dim3(512), LDS_BYTES, stream, a); }
#endif
}
```

```cpp
#include <hip/hip_runtime.h>
#include <stdint.h>
#include <stdio.h>
#ifndef ONE_LAUNCH
#define ONE_LAUNCH 1
#endif
#ifndef PROBE_ID
#define PROBE_ID 0
#endif

typedef unsigned short bf16_t;

#define D_MODEL 1024
#define NTOK 10240
#define NPTOK 8192
#define TP 256
#define TS 1024
#define NSEQ 34
#define NH 6
#define N1 3072
#define C_DIFF 0
#define C_FNET 1152
#define C_RWKV 1664
#define C_END 3008
#define N_RWKV 1344
#define D_FF 2816
#define D_IN 2752

#define OUT_YP 0
#define OUT_YS 8388608
#define OUT_ST 10485760
#define OUT_CK 13631488
#define OUT_CV 19922944

#define OPS_REC 1792
#define OPS_TOK (6 * OPS_REC)

#define WS_WIN   ((size_t)0)
#define WS_WOUT  (WS_WIN + (size_t)2 * N1 * 1024 * 2)
#define WS_WF1   (WS_WOUT + (size_t)2 * 1024 * 1024 * 2)
#define WS_WF2   (WS_WF1 + (size_t)2 * 5632 * 1024 * 2)
#define WS_H     (WS_WF2 + (size_t)2 * 1024 * 2816 * 2)
#define WS_UD    (WS_H + (size_t)NTOK * 1024 * 2)
#define WS_ZF    (WS_UD + (size_t)NTOK * 1152 * 2)
#define WS_UR    (WS_ZF + (size_t)NTOK * 512 * 2)
#define WS_OPS   (WS_UR + (size_t)2 * NTOK * 384 * 4)
#define WS_MOD   (WS_OPS + (size_t)NTOK * OPS_TOK)
#define WS_L256  (WS_MOD + (size_t)2 * 3 * 6144 * 4)
#define WS_L1024 (WS_L256 + (size_t)256 * 512 * 2)
#define WS_CTL   (WS_L1024 + (size_t)1024 * 2048 * 2)
#define WS_RSQ   (WS_CTL + (size_t)16384)
#define WS_ZS    (WS_RSQ + (size_t)4 * NTOK * 4)
#define WS_SS    (WS_ZS + (size_t)2 * 2048 * 384 * 4)
#define WS_WLT   (WS_SS + (size_t)24 * 3 * 4096 * 4)
#define WLT_L    73728
#define WS_BIAS  (WS_WLT + (size_t)2 * WLT_L * 2)
#define WS_END   (WS_BIAS + (size_t)(2 * 3 * 3072 + 2 * 3 * 5632) * 4)
#define WS_H2    (WS_OPS + ((size_t)64 << 20))
#define CTL_QUEUE 3584
static_assert(WS_END <= ((size_t)256 << 20), "workspace exceeds 256 MiB");

struct P {
    const float *x_prompt, *x_sample, *c, *state_rwkv, *cache_k, *cache_v, *c_ctx, *norm1_g, *norm2_g, *final_g;
    const float *w_mod, *b_mod, *w_in, *w_out, *shift_mu, *decay_w0, *decay_up, *iclr_a0, *iclr_up, *gate_up;
    const float *k_k, *k_a, *r_k, *lnx_g, *lnx_b, *diff_lambda, *subln_g, *w_ffn_in, *w_ffn_out;
    float* out;
    unsigned char* ws;
};

typedef float f32x2c __attribute__((ext_vector_type(2)));
typedef __bf16 bf16x2c __attribute__((ext_vector_type(2)));
__device__ __forceinline__ bf16_t f2bf(float f) { return __builtin_bit_cast(unsigned short, (__bf16)f); }
__device__ __forceinline__ unsigned pk_bf16(float lo, float hi) { const f32x2c v = {lo, hi}; return __builtin_bit_cast(unsigned, __builtin_convertvector(v, bf16x2c)); }
__device__ __forceinline__ float bf2f(bf16_t b) { return __builtin_bit_cast(float, ((unsigned)b) << 16); }
__device__ __forceinline__ float sigmoidf_(float x) { return 1.f / (1.f + __expf(-x)); }
__device__ __forceinline__ float wave_sum(float v) {
#pragma unroll
    for (int o = 1; o < 64; o <<= 1) v += __shfl_xor(v, o);
    return v;
}
__device__ __forceinline__ int otid() { int t = threadIdx.x; asm volatile("" : "+v"(t)); return t; }
__device__ __forceinline__ int tok_cls(int tok) { return tok < NPTOK ? 0 : 1 + ((tok - NPTOK) >> 10); }
__device__ __forceinline__ const float* xin_row(const P& p, int tok) { return tok < NPTOK ? p.x_prompt + (size_t)tok * 1024 : p.x_sample + (size_t)(tok - NPTOK) * 1024; }
__device__ __forceinline__ float* X_row(const P& p, int tok) { return p.out + (size_t)tok * 1024; }
__device__ __forceinline__ const float* mod_vec(const P& p, int l, int cls, int which) { return (const float*)(p.ws + WS_MOD) + ((size_t)(l * 3 + cls) * 6144 + which * 1024); }
__device__ __forceinline__ void seq_info(int s, int& start, int& T) { if (s < 32) { start = s * TP; T = TP; } else { start = NPTOK + (s - 32) * TS; T = TS; } }
__device__ __forceinline__ void tok_info(int tok, int& s, int& t, int& T, int& start) {
    if (tok < NPTOK) { s = tok >> 8; t = tok & 255; T = TP; start = s * TP; } else { int r = tok - NPTOK; s = 32 + (r >> 10); t = r & 1023; T = TS; start = NPTOK + ((r >> 10) << 10); }
}

#define P0_MOD 192
#define P0_TILES_L 3136
struct P0Tile { const float* src; bf16_t* dst; int srcN, K, n0, k0, mode, scol; };
__device__ __forceinline__ P0Tile p0_decode(const P& p, int it) {
    P0Tile t; const int l = it / P0_TILES_L; it %= P0_TILES_L; int ntile, ktile; t.mode = 0; t.scol = 0;
    if (it < 768) { ntile = it / 16; ktile = it % 16; t.K = 1024; t.srcN = D_IN; t.src = p.w_in + (size_t)l * 1024 * D_IN; t.dst = (bf16_t*)(p.ws + WS_WIN) + (size_t)l * N1 * 1024;
        t.n0 = ntile * 64;
        if (t.n0 < C_FNET) { t.scol = 1344 + t.n0; } else if (t.n0 < C_RWKV) { t.mode = 1 + ((t.n0 - C_FNET) / 64) % 2; t.scol = 2496 + ((t.n0 - C_FNET) / 128) * 64; } else if (t.n0 < C_END) { t.scol = t.n0 - C_RWKV; } else t.mode = 3; }
    else if (it < 1024) { it -= 768; ntile = it / 16; ktile = it % 16; t.K = 1024; t.srcN = 1024; t.src = p.w_out + (size_t)l * 1024 * 1024; t.dst = (bf16_t*)(p.ws + WS_WOUT) + (size_t)l * 1024 * 1024; t.n0 = ntile * 64; t.scol = t.n0; }
    else if (it < 2432) { it -= 1024; ntile = it / 16; ktile = it % 16; t.K = 1024; t.srcN = 5632; t.src = p.w_ffn_in + (size_t)l * 1024 * 5632; t.dst = (bf16_t*)(p.ws + WS_WF1) + (size_t)l * 5632 * 1024; t.n0 = ntile * 64;
        const int pn = ntile >> 2, sub = ntile & 3; t.scol = (sub < 2) ? (128 * pn + 64 * sub) : (2816 + 128 * pn + 64 * (sub - 2)); }
    else { it -= 2432; ntile = it / 44; ktile = it % 44; t.K = 2816; t.srcN = 1024; t.src = p.w_ffn_out + (size_t)l * 2816 * 1024; t.dst = (bf16_t*)(p.ws + WS_WF2) + (size_t)l * 1024 * 2816; t.n0 = ntile * 64; t.scol = t.n0; }
    t.k0 = ktile * 64;
    return t;
}
#define P0_TGROUPS 1568
__device__ __forceinline__ void ph_prep0(const P& p, float* sm) {
    const int tid = otid();
    const int nitems = P0_MOD + P0_TGROUPS + 1280 + 10;
    for (int item = blockIdx.x; item < nitems; item += gridDim.x) {
        __syncthreads();
        if (item < P0_MOD) {
            const int l = item / 96, cg = item % 96, col = cg * 64 + (tid & 63), ks = tid >> 6;
            const float* W = p.w_mod + (size_t)l * 1024 * 6144;
            float* sl = sm + 2048;
            for (int e = tid; e < 3072; e += blockDim.x) { const int cls = e >> 10, k = e & 1023; const float c = cls == 0 ? p.c_ctx[k] : p.c[(cls - 1) * 1024 + k]; sl[e] = c * sigmoidf_(c); }
            __syncthreads();
            float a0 = 0.f, a1 = 0.f, a2 = 0.f;
#pragma unroll 8
            for (int k = ks * 128; k < ks * 128 + 128; ++k) {
                const float w = W[(size_t)k * 6144 + col];
                a0 += sl[k] * w; a1 += sl[1024 + k] * w; a2 += sl[2048 + k] * w;
            }
            sm[(ks * 3 + 0) * 64 + (tid & 63)] = a0; sm[(ks * 3 + 1) * 64 + (tid & 63)] = a1; sm[(ks * 3 + 2) * 64 + (tid & 63)] = a2;
            __syncthreads();
            if (tid < 192) {
                const int cls = tid >> 6, cc = tid & 63; float s = 0.f;
                for (int k = 0; k < 8; ++k) s += sm[(k * 3 + cls) * 64 + cc];
                const int colo = cg * 64 + cc;
                ((float*)(p.ws + WS_MOD))[(size_t)(l * 3 + cls) * 6144 + colo] = s + p.b_mod[(size_t)l * 6144 + colo];
            }
        } else if (item < P0_MOD + P0_TGROUPS) {
            int gi = item - P0_MOD; const int gl = gi / 784; gi %= 784;
            int base, nK; if (gi < 192) { base = 0; nK = 16; } else if (gi < 256) { gi -= 192; base = 768; nK = 16; } else if (gi < 608) { gi -= 256; base = 1024; nK = 16; } else { gi -= 608; base = 2432; nK = 44; }
            const int ng = gi / nK, kt = gi % nK;
#define P0_ITEM(u) (gl * P0_TILES_L + base + (ng * 4 + (u)) * nK + kt)
            float* cs = sm + 4 * 64 * 65;
            if (tid < 64) { cs[tid] = cospif((float)tid / 32.f); cs[64 + tid] = sinpif((float)tid / 32.f); }
#pragma unroll
            for (int u = 0; u < 4; ++u) {
                const P0Tile t = p0_decode(p, P0_ITEM(u)); float* tile = sm + u * 64 * 65;
                if (t.mode != 3) {
#pragma unroll
                    for (int i = 0; i < 8; ++i) { const int k = i * 8 + (tid >> 6), n = tid & 63; tile[k * 65 + n] = t.src[(size_t)(t.k0 + k) * t.srcN + t.scol + n]; }
                }
            }
            __syncthreads();
#pragma unroll 1
            for (int u = 0; u < 4; ++u) {
                const P0Tile t = p0_decode(p, P0_ITEM(u)); const float* tile = sm + u * 64 * 65;
                const int n = tid >> 3, k8 = (tid & 7) * 8;
                float v[8];
                if (t.mode == 0) {
#pragma unroll
                    for (int j = 0; j < 8; ++j) v[j] = tile[(k8 + j) * 65 + n];
                } else if (t.mode == 3) {
#pragma unroll
                    for (int j = 0; j < 8; ++j) v[j] = 0.f;
                } else {
#pragma unroll
                    for (int j = 0; j < 8; ++j) v[j] = 0.f;
                    for (int cc = 0; cc < 64; ++cc) {
                        const int idx = (n * cc) & 63;
                        const float tr = (t.mode == 1) ? cs[idx] * 0.125f : -cs[64 + idx] * 0.125f;
#pragma unroll
                        for (int j = 0; j < 8; ++j) v[j] += tile[(k8 + j) * 65 + cc] * tr;
                    }
                }
                uint4 o;
                o.x = pk_bf16(v[0], v[1]); o.y = pk_bf16(v[2], v[3]);
                o.z = pk_bf16(v[4], v[5]); o.w = pk_bf16(v[6], v[7]);
                *(uint4*)(t.dst + (size_t)(t.n0 + n) * t.K + t.k0 + k8) = o;
            }
        } else if (item >= P0_MOD + P0_TGROUPS + 1280) {
            const int it = item - (P0_MOD + P0_TGROUPS + 1280), l = it / 5, kind = it % 5, K = kind == 4 ? 64 : 32;
            const float* src = kind == 4 ? p.gate_up + (size_t)l * 64 * 384 : ((kind >> 1) ? p.iclr_up : p.decay_up) + (size_t)((l * 2 + (kind & 1)) * 32) * 384;
            bf16_t* dst = (bf16_t*)(p.ws + WS_WLT) + (size_t)l * WLT_L + kind * 12288;
            for (int e = tid; e < 384 * K; e += blockDim.x) { const int n = e % 384, k = e / 384; dst[n * K + k] = f2bf(src[(size_t)k * 384 + n]); }
        } else {
            const int r = item - (P0_MOD + P0_TGROUPS);
            const int T = r < 256 ? 256 : 1024, ft = r < 256 ? r : r - 256;
            bf16_t* L = r < 256 ? (bf16_t*)(p.ws + WS_L256) + (size_t)ft * 512 : (bf16_t*)(p.ws + WS_L1024) + (size_t)ft * 2048;
            const float sc = r < 256 ? 0.0625f : 0.03125f;
            for (int k = tid; k < 2 * T; k += blockDim.x) {
                const int t = k & (T - 1), idx = (ft * t) & (T - 1);
                const float ang = (float)(2 * idx) / (float)T;
                L[k] = f2bf((k < T ? cospif(ang) : sinpif(ang)) * sc);
            }
        }
    }
}

__device__ __forceinline__ void ph_prep0b(const P& p) {
    const int tid_ = otid(); const int lane = tid_ & 63, wv = tid_ >> 6, nw = blockDim.x >> 6;
#pragma unroll 1
    for (int grp = 0; grp < 4; ++grp) {
        const int l = grp & 1, isf = grp >> 1, N = isf ? 5632 : 3072, which = isf ? 3 : 0;
        const bf16_t* Wb = isf ? (const bf16_t*)(p.ws + WS_WF1) + (size_t)l * 5632 * 1024 : (const bf16_t*)(p.ws + WS_WIN) + (size_t)l * N1 * 1024;
        float* outb = (float*)(p.ws + WS_BIAS) + (isf ? 2 * 3 * 3072 + (size_t)(l * 3) * 5632 : (size_t)(l * 3) * 3072);
        float sh[3][16];
#pragma unroll
        for (int c = 0; c < 3; ++c) { const float* sp = mod_vec(p, l, c, which) + lane * 16;
#pragma unroll
            for (int e = 0; e < 4; ++e) { const float4 v = *(const float4*)(sp + 4 * e); sh[c][4 * e] = v.x; sh[c][4 * e + 1] = v.y; sh[c][4 * e + 2] = v.z; sh[c][4 * e + 3] = v.w; } }
#pragma unroll 2
        for (int n = blockIdx.x * nw + wv; n < N; n += gridDim.x * nw) {
            const bf16_t* W = Wb + (size_t)n * 1024;
            const uint4 w0 = *(const uint4*)(W + lane * 16), w1 = *(const uint4*)(W + lane * 16 + 8);
            const unsigned ww[8] = {w0.x, w0.y, w0.z, w0.w, w1.x, w1.y, w1.z, w1.w};
            float acc[3] = {0.f, 0.f, 0.f};
#pragma unroll
            for (int c = 0; c < 3; ++c)
#pragma unroll
                for (int e = 0; e < 8; ++e) acc[c] += sh[c][2 * e] * bf2f((bf16_t)(ww[e] & 0xffff)) + sh[c][2 * e + 1] * bf2f((bf16_t)(ww[e] >> 16));
#pragma unroll
            for (int c = 0; c < 3; ++c) { const float t = wave_sum(acc[c]); if (lane == 0) outb[(size_t)c * N + n] = t; }
        }
    }
    float* rsq0 = (float*)(p.ws + WS_RSQ);
    for (int row = blockIdx.x * nw + wv; row < NTOK; row += gridDim.x * nw) {
        const float* xr = xin_row(p, row);
        float4 x[4]; float ss = 0.f;
#pragma unroll
        for (int i = 0; i < 4; ++i) { x[i] = *(const float4*)(xr + i * 256 + lane * 4); ss += x[i].x * x[i].x + x[i].y * x[i].y + x[i].z * x[i].z + x[i].w * x[i].w; }
        ss = wave_sum(ss);
        if (lane == 0) rsq0[row] = ss;
        const float* sc = mod_vec(p, 0, tok_cls(row), 1);
        bf16_t* h = (bf16_t*)(p.ws + WS_H) + (size_t)row * 1024;
#pragma unroll
        for (int i = 0; i < 4; ++i) { const int c = i * 256 + lane * 4;
            const float4 gg = *(const float4*)(p.norm1_g + c), s1 = *(const float4*)(sc + c);
            uint2 o; o.x = pk_bf16(x[i].x * gg.x * (1.f + s1.x), x[i].y * gg.y * (1.f + s1.y));
            o.y = pk_bf16(x[i].z * gg.z * (1.f + s1.z), x[i].w * gg.w * (1.f + s1.w));
            *(uint2*)(h + c) = o; }
    }
}

__device__ __forceinline__ void ph_norm(const P& p, int l, int which) {
    const int tid_ = otid(); const int lane = tid_ & 63, wv = tid_ >> 6, nw = blockDim.x >> 6;
    for (int row = blockIdx.x * nw + wv; row < NTOK; row += gridDim.x * nw) {
        const float* xr = (which == 0 && l == 0) ? xin_row(p, row) : X_row(p, row);
        float4 x[4]; float ss = 0.f;
#pragma unroll
        for (int i = 0; i < 4; ++i) { x[i] = *(const float4*)(xr + i * 256 + lane * 4); ss += x[i].x * x[i].x + x[i].y * x[i].y + x[i].z * x[i].z + x[i].w * x[i].w; }
        ss = wave_sum(ss);
        const float rstd = rsqrtf(ss * (1.f / 1024.f) + 1e-6f);
        if (which == 2) {
            float* o = p.out + (size_t)row * 1024;
#pragma unroll
            for (int i = 0; i < 4; ++i) { const float4 g = *(const float4*)(p.final_g + i * 256 + lane * 4);
                float4 y; y.x = x[i].x * rstd * g.x; y.y = x[i].y * rstd * g.y; y.z = x[i].z * rstd * g.z; y.w = x[i].w * rstd * g.w;
                *(float4*)(o + i * 256 + lane * 4) = y; }
        } else {
            const int cls = tok_cls(row);
            const float* g = (which == 0 ? p.norm1_g : p.norm2_g) + (size_t)l * 1024;
            const float* sh = mod_vec(p, l, cls, which == 0 ? 0 : 3);
            const float* sc = mod_vec(p, l, cls, which == 0 ? 1 : 4);
            bf16_t* h = (bf16_t*)(p.ws + WS_H) + (size_t)row * 1024;
#pragma unroll
            for (int i = 0; i < 4; ++i) { const int c = i * 256 + lane * 4;
                const float4 gg = *(const float4*)(g + c), s1 = *(const float4*)(sc + c), s0 = *(const float4*)(sh + c);
                const float y0 = x[i].x * rstd * gg.x * (1.f + s1.x) + s0.x, y1 = x[i].y * rstd * gg.y * (1.f + s1.y) + s0.y;
                const float y2 = x[i].z * rstd * gg.z * (1.f + s1.z) + s0.z, y3 = x[i].w * rstd * gg.w * (1.f + s1.w) + s0.w;
                uint2 o; o.x = pk_bf16(y0, y1); o.y = pk_bf16(y2, y3);
                *(uint2*)(h + c) = o; }
        }
    }
}

struct EpiG1 {
    int l;
    __device__ __forceinline__ void operator()(const P& p, int row, int col, const float* v) const {
        if (col < C_FNET) {
            bf16_t* o = (bf16_t*)(p.ws + WS_UD) + (size_t)row * 1152 + col;
            uint2 w; w.x = pk_bf16(v[0], v[1]); w.y = pk_bf16(v[2], v[3]);
            *(uint2*)o = w;
            if (row < NPTOK && col >= 384) {
                const int b = row >> 8, t = row & 255;
                float* dst = p.out + (col < 768 ? OUT_CK : OUT_CV) + ((size_t)(b * 2 + l) * 256 + t) * 384 + (col < 768 ? col - 384 : col - 768);
                *(float4*)dst = make_float4(v[0], v[1], v[2], v[3]);
            }
        } else if (col < C_RWKV) {
            const int cc = col - C_FNET, g = cc >> 7, half = (cc >> 6) & 1, fc = cc & 63;
            bf16_t* o;
            if (row < NPTOK) { const int sq = row >> 8, t = row & 255; o = (bf16_t*)(p.ws + WS_ZF) + ((size_t)(sq * 256 + g * 64 + fc) * 512 + half * 256 + t);
                o[0] = f2bf(v[0]); o[512] = f2bf(v[1]); o[1024] = f2bf(v[2]); o[1536] = f2bf(v[3]); }
            else { const int r = row - NPTOK, b = r >> 10, t = r & 1023; o = (bf16_t*)(p.ws + WS_ZF) + (size_t)8192 * 512 + ((size_t)(b * 256 + g * 64 + fc) * 2048 + half * 1024 + t);
                o[0] = f2bf(v[0]); o[2048] = f2bf(v[1]); o[4096] = f2bf(v[2]); o[6144] = f2bf(v[3]); }
        } else if (col < C_END) {
            bf16_t* o = (bf16_t*)(p.ws + WS_UR) + (size_t)row * N_RWKV + (col - C_RWKV);
            uint2 w; w.x = pk_bf16(v[0], v[1]); w.y = pk_bf16(v[2], v[3]);
            *(uint2*)o = w;
        }
    }
};
struct EpiRes {
    int l, which;
    __device__ __forceinline__ void operator()(const P& p, int row, int col, const float* v) const {
        const float* g = mod_vec(p, l, tok_cls(row), which) + col;
        const float* xo = (which == 2 && l == 0) ? xin_row(p, row) + col : X_row(p, row) + col;
        const float4 x = *(const float4*)xo; const float4 gg = *(const float4*)g;
        *(float4*)(X_row(p, row) + col) = make_float4(x.x + gg.x * v[0], x.y + gg.y * v[1], x.z + gg.z * v[2], x.w + gg.w * v[3]);
    }
};

#define PR_TT 40
#define PR_LS 200
typedef short bf16x8p __attribute__((ext_vector_type(8)));
typedef float f32x4p __attribute__((ext_vector_type(4)));
#define PR_ROWB 2688
__device__ __forceinline__ void ph_prep(const P& p, int l, float* sm) {
    const int tid = otid(), lane = tid & 63, wv = tid >> 6;
    const bf16_t* UR = (const bf16_t*)(p.ws + WS_UR);
    unsigned char* lb = (unsigned char*)sm;
    bf16_t* urt = (bf16_t*)lb;
    bf16_t* linb = (bf16_t*)(lb + 42 * PR_ROWB);
    const float* mu0 = p.shift_mu + (size_t)l * 2 * N_RWKV; const float* mu1 = mu0 + N_RWKV;
#if PROBE_ID
    unsigned long long* tsp = (unsigned long long*)(p.ws + WS_CTL + 15360) + 32;
#define PSTAMP(i) do { __syncthreads(); if (blockIdx.x == 0 && tid == 0 && l == 0) tsp[i] = __builtin_amdgcn_s_memrealtime(); } while (0)
#else
#define PSTAMP(i)
#endif
    PSTAMP(0);
    for (int tile = blockIdx.x; tile < NTOK / PR_TT; tile += gridDim.x) {
        const int tok0 = tile * PR_TT;
        __syncthreads();
        for (int e = tid; e < 42 * 168; e += blockDim.x) {
            const int r = e / 168, c = e % 168, tok = tok0 - 1 + r;
            uint4 v = make_uint4(0u, 0u, 0u, 0u);
            if (tok >= 0 && tok < NTOK) v = *(const uint4*)((const unsigned char*)UR + (size_t)tok * PR_ROWB + c * 16);
            *(uint4*)(lb + r * PR_ROWB + c * 16) = v;
        }
        __syncthreads();
        for (int e = tid; e < 48 * 192; e += blockDim.x) {
            const int tk = e / 192, j = e % 192, col = 1152 + j;
            float x = 0.f;
            if (tk < PR_TT) {
                int s, t, T, st; tok_info(tok0 + tk, s, t, T, st);
                const float xc = bf2f(urt[(tk + 1) * 1344 + col]);
                const float xp = t > 0 ? bf2f(urt[tk * 1344 + col]) : 0.f;
                const float xn = t < T - 1 ? bf2f(urt[(tk + 2) * 1344 + col]) : 0.f;
                x = xc + mu0[col] * (xp - xc) + mu1[col] * (xn - xc);
                if (j < 64) x = tanhf(x); else if (j >= 128) x = sigmoidf_(x);
            }
            linb[tk * PR_LS + j] = f2bf(x);
        }
        __syncthreads();
        PSTAMP(1);
        {
            const int n = lane & 15, kg = lane >> 4;
            const bf16_t* WLT = (const bf16_t*)(p.ws + WS_WLT) + (size_t)l * WLT_L;
#pragma unroll 3
            for (int combo = wv; combo < 120; combo += 8) {
                const int kind = combo / 24, nt = combo % 24, ch = nt * 16 + n, h = ch >> 6, cl = ch & 63;
                const int K = kind == 4 ? 64 : 32, loff = kind == 4 ? 128 : (kind >> 1) * 64 + (kind & 1) * 32;
                const bf16_t* wrow = WLT + kind * 12288 + (size_t)ch * K + 8 * kg;
                const bf16x8p b0 = *(const bf16x8p*)wrow;
                bf16x8p b1 = b0; if (kind == 4) b1 = *(const bf16x8p*)(wrow + 32);
                float bias = 0.f;
                if (kind < 4) bias = ((kind >> 1) ? p.iclr_a0 : p.decay_w0)[(size_t)(l * 2 + (kind & 1)) * 384 + ch];
#pragma unroll
                for (int mt = 0; mt < 3; ++mt) {
                    f32x4p acc = {bias, bias, bias, bias};
                    const bf16x8p a0 = *(const bf16x8p*)(linb + (mt * 16 + n) * PR_LS + loff + 8 * kg);
                    acc = __builtin_amdgcn_mfma_f32_16x16x32_bf16(a0, b0, acc, 0, 0, 0);
                    if (kind == 4) { const bf16x8p a1 = *(const bf16x8p*)(linb + (mt * 16 + n) * PR_LS + loff + 32 + 8 * kg); acc = __builtin_amdgcn_mfma_f32_16x16x32_bf16(a1, b1, acc, 0, 0, 0); }
#pragma unroll
                    for (int r = 0; r < 4; ++r) {
                        const int tk = mt * 16 + kg * 4 + r;
                        if (tk < PR_TT) {
                            unsigned char* rec = p.ws + WS_OPS + (size_t)(tok0 + tk) * OPS_TOK + (size_t)h * OPS_REC;
                            if (kind == 4) ((bf16_t*)(rec + 1280))[192 + cl] = f2bf(acc[r]);
                            else { const float sg = sigmoidf_(acc[r]); ((float*)rec)[64 + (kind >> 1) * 128 + (kind & 1) * 64 + cl] = (kind >> 1) ? sg : __expf(-0.60653065971263342f * sg); }
                        }
                    }
                }
            }
        }
#if PROBE_ID
        if (blockIdx.x == 0 && tid == 0 && l == 0) tsp[2] = __builtin_amdgcn_s_memrealtime();
#endif
        {
#pragma unroll 2
            for (int pr = wv; pr < PR_TT * NH; pr += 8) {
                const int tk = pr / NH, h = pr % NH, ch = h * 64 + lane, tok = tok0 + tk; int s, t, T, st; tok_info(tok, s, t, T, st);
                float rkv[3];
#pragma unroll
                for (int q = 0; q < 3; ++q) { const int col = q * 384 + ch;
                    const float xc = bf2f(urt[(tk + 1) * 1344 + col]);
                    const float xp = t > 0 ? bf2f(urt[tk * 1344 + col]) : 0.f;
                    const float xn = t < T - 1 ? bf2f(urt[(tk + 2) * 1344 + col]) : 0.f;
                    rkv[q] = xc + mu0[col] * (xp - xc) + mu1[col] * (xn - xc); }
                const float kkr = rkv[1] * p.k_k[(size_t)l * 384 + ch];
                const float nrm = sqrtf(wave_sum(kkr * kkr));
                const float kk = kkr / fmaxf(nrm, 1e-12f);
                unsigned char* rec = p.ws + WS_OPS + (size_t)tok * OPS_TOK + (size_t)h * OPS_REC;
                ((float*)rec)[lane] = -kk;
                bf16_t* rb = (bf16_t*)(rec + 1280);
                rb[lane] = f2bf(rkv[0]); rb[64 + lane] = f2bf(rkv[2]); rb[128 + lane] = f2bf(rkv[1]);
            }
        }
    }
    PSTAMP(3);
    bf16_t* UD = (bf16_t*)(p.ws + WS_UD);
    for (int e = blockIdx.x * blockDim.x + tid; e < 2048 * 384; e += gridDim.x * blockDim.x) {
        const int tk = e / 384, pi = e % 384;
        const int grp = pi >> 3, pr = pi & 7, col = grp * 16 + pr;
        const int axis = grp & 1;
        const int t = tk & 1023, pos = axis == 0 ? (t >> 6) : (t & 63);
        const float inv = __powf(10000.f, -(float)pr / 8.f);
        float sn, cs; __sincosf((float)pos * inv, &sn, &cs);
        bf16_t* ptr = UD + (size_t)(NPTOK + tk) * 1152 + col;
        const float x1 = bf2f(ptr[0]), x2 = bf2f(ptr[8]);
        ptr[0] = f2bf(x1 * cs - x2 * sn); ptr[8] = f2bf(x2 * cs + x1 * sn);
    }
    PSTAMP(4);
}

#define SC_TC 32
template <int CTRL> __device__ __forceinline__ float dpp_add(float x) {
    return x + __builtin_bit_cast(float, __builtin_amdgcn_update_dpp(0, __builtin_bit_cast(int, x), CTRL, 0xf, 0xf, false));
}
#define SJ_RT   0
#define SJ_AT   4608
#define SJ_ZT   9216
#define SJ_ZPT  18432
#define SJ_WT   27648
#define SJ_S    36864
#define SJ_LAB  54272
#define SJ_LAKB 58880
#define SJ_MRB  61440
#define SJ_HB   66048
#define SJ_PC   74752
#define SJ_BYTES 75008
typedef float f32x4s __attribute__((ext_vector_type(4)));
typedef short bf16x8s __attribute__((ext_vector_type(8)));
#define MFMAB(a, b, c) __builtin_amdgcn_mfma_f32_16x16x32_bf16((a), (b), (c), 0, 0, 0)
struct ScanStage { float nkk[8], w[8], a[8]; bf16_t r[8], v[8], k[8]; };
__device__ __forceinline__ void scan_load(const P& p, int h, int dir, int T, int start, int st_base, int ht, ScanStage& g) {
    const int k = 16 * (ht >> 6) + ((ht & 63) >> 2), seg = ht & 3;
#pragma unroll
    for (int j = 0; j < 8; ++j) {
        const int st = st_base + 8 * seg + j, t = dir == 0 ? st : T - 1 - st, tok = start + t;
        const unsigned char* rec = p.ws + WS_OPS + (size_t)tok * OPS_TOK + (size_t)h * OPS_REC;
        const float* rf = (const float*)rec; const bf16_t* rb = (const bf16_t*)(rec + 1280);
        g.nkk[j] = rf[k]; g.w[j] = rf[64 + dir * 64 + k]; g.a[j] = rf[192 + dir * 64 + k];
        g.r[j] = rb[k]; g.v[j] = rb[64 + k]; g.k[j] = rb[128 + k];
    }
}
__device__ __forceinline__ void scan_store(const ScanStage& g, float ka, float vmul, int ht, unsigned char* J) {
    const int k = 16 * (ht >> 6) + ((ht & 63) >> 2), seg = ht & 3;
    float cp[9]; cp[0] = 1.f;
#pragma unroll
    for (int j = 0; j < 8; ++j) cp[j + 1] = cp[j] * g.w[j];
    const int ci = __builtin_bit_cast(int, cp[8]);
    const float T0 = __builtin_bit_cast(float, __builtin_amdgcn_mov_dpp(ci, 0x00, 0xf, 0xf, true)), T1 = __builtin_bit_cast(float, __builtin_amdgcn_mov_dpp(ci, 0x55, 0xf, 0xf, true)),
                T2 = __builtin_bit_cast(float, __builtin_amdgcn_mov_dpp(ci, 0xAA, 0xf, 0xf, true)), T3 = __builtin_bit_cast(float, __builtin_amdgcn_mov_dpp(ci, 0xFF, 0xf, 0xf, true));
    const float pre = seg == 0 ? 1.f : (seg == 1 ? T0 : (seg == 2 ? T0 * T1 : T0 * T1 * T2));
    const float PCk = T0 * T1 * T2 * T3;
    bf16_t* RT = (bf16_t*)(J + SJ_RT); bf16_t* AT = (bf16_t*)(J + SJ_AT); bf16_t* ZT = (bf16_t*)(J + SJ_ZT); bf16_t* ZPT = (bf16_t*)(J + SJ_ZPT); bf16_t* WT = (bf16_t*)(J + SJ_WT);
#pragma unroll
    for (int j = 0; j < 8; ++j) {
        const int t = 8 * seg + j;
        const float Pm = pre * cp[j], Pt = pre * cp[j + 1], inv = __builtin_amdgcn_rcpf(Pt), kk = bf2f(g.k[j]);
        const float bt = -g.nkk[j] * g.a[j] * inv, kt = kk * (1.f + (g.a[j] - 1.f) * ka) * inv;
        RT[t * 72 + k] = f2bf(bf2f(g.r[j]) * Pt); AT[t * 72 + k] = f2bf(g.nkk[j] * Pm);
        ZT[t * 72 + k] = f2bf(bt); ZT[(32 + t) * 72 + k] = f2bf(kt);
        ZPT[k * 72 + t] = f2bf(bt * PCk); ZPT[k * 72 + 32 + t] = f2bf(kt * PCk);
        WT[k * 72 + 32 + t] = f2bf(bf2f(g.v[j]) * vmul);
    }
    if (seg == 0) ((float*)(J + SJ_PC))[k] = PCk;
}
__device__ __forceinline__ bf16x8s lds_b8(const unsigned char* p) { return *(const bf16x8s*)p; }
__device__ __forceinline__ void ph_scan_job(const P& p, int l, int s, int h, int mode, int pdir, int seg, int st0, int nsteps, float* sm) {
    const int tid = otid(), half = tid >> 8, ht = tid & 255, wq = ht >> 6, lane = ht & 63, l15 = lane & 15, l4 = lane >> 4;
    const int dir = mode == 0 ? half : pdir, kind = mode == 0 ? 0 : 1 + half;
    int start, T; seq_info(s, start, T);
    unsigned char* J = (unsigned char*)sm + half * SJ_BYTES;
    float* S = (float*)(J + SJ_S); float* LAB = (float*)(J + SJ_LAB); float* HB = (float*)(J + SJ_HB); const float* PC = (const float*)(J + SJ_PC);
    bf16_t* WT = (bf16_t*)(J + SJ_WT); bf16_t* LAKB = (bf16_t*)(J + SJ_LAKB); bf16_t* MRB = (bf16_t*)(J + SJ_MRB);
    const float vmul = kind == 1 ? 0.f : 1.f;
    float* ybase = kind == 1 ? (float*)(p.ws + WS_ZS) + ((ptrdiff_t)dir * 2048 - (ptrdiff_t)NPTOK) * 384 : (float*)(p.ws + WS_UR) + (size_t)dir * NTOK * 384;
    ybase += h * 64 + 16 * wq + l15;
    const float ka = p.k_a[(size_t)l * 384 + h * 64 + 16 * wq + (lane >> 2)];
    const int nc = nsteps / SC_TC;
    ScanStage g;
    __syncthreads();
    {
        const float* s0 = (kind == 0 && s >= 32) ? p.state_rwkv + ((((size_t)(s - 32) * 2 + l) * 2 + dir) * NH + h) * 4096 : nullptr;
        for (int e = ht; e < 4096; e += 256) { const int v = e >> 6, k = e & 63; S[v * 68 + k] = s0 ? s0[e] : (kind == 1 && v == k ? 1.f : 0.f); }
    }
    scan_load(p, h, dir, T, start, st0, ht, g);
    scan_store(g, ka, vmul, ht, J);
    __syncthreads();
    for (int c = 0; c < nc; ++c) {
        if (c + 1 < nc) scan_load(p, h, dir, T, start, st0 + (c + 1) * SC_TC, ht, g);
        f32x4s accG[2], accY[2];
#pragma unroll
        for (int tt = 0; tt < 2; ++tt) { accG[tt] = (f32x4s){0.f, 0.f, 0.f, 0.f}; accY[tt] = accG[tt]; }
#pragma unroll
        for (int ks = 0; ks < 2; ++ks) {
            const float4 s0 = *(const float4*)(S + (16 * wq + l15) * 68 + 32 * ks + 8 * l4), s1 = *(const float4*)(S + (16 * wq + l15) * 68 + 32 * ks + 8 * l4 + 4);
            const float sv[8] = {s0.x, s0.y, s0.z, s0.w, s1.x, s1.y, s1.z, s1.w};
            union { unsigned u[4]; bf16x8s v; } hi, lo;
#pragma unroll
            for (int e = 0; e < 4; ++e) {
                const float h0 = bf2f(f2bf(sv[2 * e])), h1 = bf2f(f2bf(sv[2 * e + 1]));
                hi.u[e] = pk_bf16(sv[2 * e], sv[2 * e + 1]); lo.u[e] = pk_bf16(sv[2 * e] - h0, sv[2 * e + 1] - h1);
            }
#pragma unroll
            for (int tt = 0; tt < 2; ++tt) {
                const bf16x8s a = lds_b8(J + SJ_AT + (16 * tt + l15) * 144 + 64 * ks + 16 * l4), r = lds_b8(J + SJ_RT + (16 * tt + l15) * 144 + 64 * ks + 16 * l4);
                accG[tt] = MFMAB(a, hi.v, accG[tt]); accG[tt] = MFMAB(a, lo.v, accG[tt]);
                accY[tt] = MFMAB(r, hi.v, accY[tt]); accY[tt] = MFMAB(r, lo.v, accY[tt]);
            }
        }
        {
            const int xoff = wq < 2 ? SJ_AT + (16 * wq + l15) * 144 : SJ_RT + (16 * (wq - 2) + l15) * 144;
            const bf16x8s xa0 = lds_b8(J + xoff + 16 * l4), xa1 = lds_b8(J + xoff + 64 + 16 * l4);
#pragma unroll
            for (int zt = 0; zt < 4; ++zt) {
                f32x4s m = {0.f, 0.f, 0.f, 0.f};
                m = MFMAB(xa0, lds_b8(J + SJ_ZT + (16 * zt + l15) * 144 + 16 * l4), m);
                m = MFMAB(xa1, lds_b8(J + SJ_ZT + (16 * zt + l15) * 144 + 64 + 16 * l4), m);
#pragma unroll
                for (int r = 0; r < 4; ++r) {
                    const int t = (16 * wq + 4 * l4 + r) & 31, i = (16 * zt + l15) & 31;
                    if (wq < 2) { const float val = i < t ? m[r] : 0.f; if (zt < 2) LAB[t * 36 + i] = val; else LAKB[t * 40 + i] = f2bf(val); }
                    else MRB[t * 72 + 16 * zt + l15] = f2bf(i <= t ? m[r] : 0.f);
                }
            }
        }
        __syncthreads();
        {
            const bf16x8s vb = lds_b8(J + SJ_WT + (16 * wq + l15) * 144 + 64 + 16 * l4);
#pragma unroll
            for (int tt = 0; tt < 2; ++tt) {
                accG[tt] = MFMAB(lds_b8(J + SJ_LAKB + (16 * tt + l15) * 80 + 16 * l4), vb, accG[tt]);
#pragma unroll
                for (int r = 0; r < 4; ++r) HB[(16 * tt + 4 * l4 + r) * 68 + 16 * wq + l15] = accG[tt][r];
            }
        }
        asm volatile("s_waitcnt lgkmcnt(0)" ::: "memory");
        {
            const int vloc = lane >> 2, part = lane & 3, v = 16 * wq + vloc;
            float um[8];
#pragma unroll
            for (int j = 0; j < 8; ++j) um[j] = 0.f;
#pragma unroll
            for (int tb = 0; tb < 4; ++tb) {
                float lab[8][8], hb[8];
#pragma unroll
                for (int q = 0; q < 8; ++q) { const int t = 8 * tb + q; hb[q] = HB[t * 68 + v];
#pragma unroll
                    for (int j = 0; j < 8; ++j) lab[q][j] = (4 * j < t) ? LAB[t * 36 + 4 * j + part] : 0.f; }
#pragma unroll
                for (int q = 0; q < 8; ++q) {
                    const int t = 8 * tb + q;
                    float sacc = 0.f;
#pragma unroll
                    for (int j = 0; j < 8; ++j) if (4 * j < t) sacc += lab[q][j] * um[j];
                    sacc = dpp_add<0xB1>(sacc); sacc = dpp_add<0x4E>(sacc);
                    const float u = hb[q] + sacc;
                    if ((t & 3) == part) um[t >> 2] = u;
                    WT[v * 72 + t] = f2bf(u);
                }
            }
        }
        asm volatile("s_waitcnt lgkmcnt(0)" ::: "memory");
        {
            const bf16x8s w0 = lds_b8(J + SJ_WT + (16 * wq + l15) * 144 + 16 * l4), w1 = lds_b8(J + SJ_WT + (16 * wq + l15) * 144 + 64 + 16 * l4);
#pragma unroll
            for (int tt = 0; tt < 2; ++tt) {
                accY[tt] = MFMAB(lds_b8(J + SJ_MRB + (16 * tt + l15) * 144 + 16 * l4), w0, accY[tt]);
                accY[tt] = MFMAB(lds_b8(J + SJ_MRB + (16 * tt + l15) * 144 + 64 + 16 * l4), w1, accY[tt]);
#pragma unroll
                for (int r = 0; r < 4; ++r) { const int st = st0 + c * SC_TC + 16 * tt + 4 * l4 + r, t = dir == 0 ? st : T - 1 - st; ybase[(size_t)(start + t) * 384] = accY[tt][r]; }
            }
#pragma unroll
            for (int kt = 0; kt < 4; ++kt) {
                const int k = 16 * kt + l15; const float pc = PC[k];
                f32x4s acc;
#pragma unroll
                for (int r = 0; r < 4; ++r) acc[r] = S[(16 * wq + 4 * l4 + r) * 68 + k] * pc;
                acc = MFMAB(w0, lds_b8(J + SJ_ZPT + k * 144 + 16 * l4), acc);
                acc = MFMAB(w1, lds_b8(J + SJ_ZPT + k * 144 + 64 + 16 * l4), acc);
#pragma unroll
                for (int r = 0; r < 4; ++r) S[(16 * wq + 4 * l4 + r) * 68 + k] = acc[r];
            }
        }
        __syncthreads();
        if (c + 1 < nc) { scan_store(g, ka, vmul, ht, J); __syncthreads(); }
    }
    float* so = nullptr;
    if (mode == 0) so = s < 32 ? p.out + OUT_ST + ((((size_t)s * 2 + l) * 2 + dir) * NH + h) * 4096
                              : (float*)(p.ws + WS_SS) + ((size_t)(((s - 32) * NH + h) * 2 + dir) * 3 + 0) * 4096;
    else if (seg == 1) so = (float*)(p.ws + WS_SS) + ((size_t)(((s - 32) * NH + h) * 2 + dir) * 3 + kind) * 4096;
    if (so) for (int e = ht; e < 4096; e += 256) so[e] = S[(e >> 6) * 68 + (e & 63)];
}

#define SEG0_LEN 352
#define SEG1_LEN 352
#define SEG2_LEN 320
#define CTL_SCANDONE 3720
__device__ __forceinline__ void fixup_item(const P& p, int l, int item4, float* sm) {
    const int tid = otid(), lane = tid & 63, wv = tid >> 6;
    {
        const int item = item4 >> 2, qtr = item4 & 3;
        const int b = item / 24, h = (item % 24) >> 2, dir = (item >> 1) & 1, seg = 1 + (item & 1);
        const float* E0 = (const float*)(p.ws + WS_SS) + (size_t)(((b * NH + h) * 2 + dir) * 3) * 4096; const float* P1 = E0 + 4096; const float* Q1 = E0 + 8192;
        if (tid == 0) {
            unsigned* cnt = (unsigned*)(p.ws + WS_CTL) + CTL_SCANDONE + 32 * l + (b * NH + h) * 2 + dir; unsigned sp = 0;
            while (__hip_atomic_load(cnt, __ATOMIC_RELAXED, __HIP_MEMORY_SCOPE_AGENT) < 3u && ++sp < (1u << 24)) __builtin_amdgcn_s_sleep(4);
            __builtin_amdgcn_fence(__ATOMIC_ACQUIRE, "agent");
            asm volatile("s_waitcnt vmcnt(0)" ::: "memory");
        }
        __syncthreads();
        { const int v = tid >> 3, kg = tid & 7;
          float acc[8];
          if (seg == 1) {
#pragma unroll
              for (int j = 0; j < 8; ++j) acc[j] = E0[v * 64 + kg * 8 + j];
          } else {
#pragma unroll
              for (int j = 0; j < 8; ++j) acc[j] = Q1[v * 64 + kg * 8 + j];
#pragma unroll 8
              for (int i = 0; i < 64; ++i) { const float e = E0[v * 64 + i]; const float4 pa = *(const float4*)(P1 + i * 64 + kg * 8), pb = *(const float4*)(P1 + i * 64 + kg * 8 + 4);
                  acc[0] += e * pa.x; acc[1] += e * pa.y; acc[2] += e * pa.z; acc[3] += e * pa.w; acc[4] += e * pb.x; acc[5] += e * pb.y; acc[6] += e * pb.z; acc[7] += e * pb.w; }
          }
#pragma unroll
          for (int j = 0; j < 8; ++j) sm[v * 65 + kg * 8 + j] = acc[j]; }
        __syncthreads();
        float Srow[64];
#pragma unroll
        for (int i = 0; i < 64; ++i) Srow[i] = sm[lane * 65 + i];
        const int qlen = (seg == 1 ? SEG1_LEN : SEG2_LEN) / 4;
        const int st0 = (seg == 1 ? SEG0_LEN : SEG0_LEN + SEG1_LEN) + qtr * qlen;
        const float* Zb = (const float*)(p.ws + WS_ZS) + (size_t)dir * 2048 * 384; float* Yb = (float*)(p.ws + WS_UR) + (size_t)dir * NTOK * 384;
#pragma unroll 1
        for (int q = wv * 4; q < qlen; q += 32) {
            int zi[4]; float yv[4]; float* yp[4]; bool ok[4];
#pragma unroll
            for (int u = 0; u < 4; ++u) {
                ok[u] = (q + u) < qlen;
                const int st = st0 + (ok[u] ? q + u : 0), t = dir ? 1023 - st : st, stok = b * 1024 + t;
                zi[u] = __builtin_bit_cast(int, Zb[(size_t)stok * 384 + h * 64 + lane]);
                yp[u] = Yb + (size_t)(NPTOK + stok) * 384 + h * 64 + lane; yv[u] = *yp[u];
            }
#pragma unroll
            for (int i = 0; i < 64; ++i)
#pragma unroll
                for (int u = 0; u < 4; ++u) yv[u] += Srow[i] * __builtin_bit_cast(float, __builtin_amdgcn_readlane(zi[u], i));
#pragma unroll
            for (int u = 0; u < 4; ++u) if (ok[u]) *yp[u] = yv[u];
        }
    }
}

__device__ __forceinline__ void ph_finalize(const P& p, int l) {
    const int tid_ = otid(); const int lane = tid_ & 63, wv = tid_ >> 6, nw = blockDim.x >> 6;
    const float* Yb = (const float*)(p.ws + WS_UR);
    bf16_t* MIX = (bf16_t*)(p.ws + WS_H);
    for (int it0 = (blockIdx.x * nw + wv) * 8; it0 < NTOK * NH; it0 += gridDim.x * nw * 8) {
        float y[8], a0[8], a1[8], r[8], vv[8], k[8], g[8];
        int tokv[8], chv[8];
#pragma unroll
        for (int u = 0; u < 8; ++u) {
            const int it = it0 + u, tok = it / NH, h = it % NH, ch = h * 64 + lane; tokv[u] = tok; chv[u] = ch;
            y[u] = Yb[(size_t)tok * 384 + ch] + Yb[((size_t)NTOK + tok) * 384 + ch];
            const unsigned char* rec = p.ws + WS_OPS + (size_t)tok * OPS_TOK + (size_t)h * OPS_REC;
            const float* rf = (const float*)rec; const bf16_t* rb = (const bf16_t*)(rec + 1280);
            a0[u] = rf[192 + lane]; a1[u] = rf[256 + lane];
            r[u] = bf2f(rb[lane]); vv[u] = bf2f(rb[64 + lane]); k[u] = bf2f(rb[128 + lane]); g[u] = bf2f(rb[192 + lane]);
        }
        float mu[8], var[8], bs[8];
#pragma unroll
        for (int u = 0; u < 8; ++u) mu[u] = y[u];
#pragma unroll
        for (int o = 1; o < 64; o <<= 1)
#pragma unroll
            for (int u = 0; u < 8; ++u) mu[u] += __shfl_xor(mu[u], o);
#pragma unroll
        for (int u = 0; u < 8; ++u) { mu[u] *= (1.f / 64.f); y[u] -= mu[u]; var[u] = y[u] * y[u];
            const float ka = p.k_a[(size_t)l * 384 + chv[u]];
            bs[u] = r[u] * (k[u] * (1.f + (a0[u] - 1.f) * ka) + k[u] * (1.f + (a1[u] - 1.f) * ka)) * p.r_k[(size_t)l * 384 + chv[u]]; }
#pragma unroll
        for (int o = 1; o < 64; o <<= 1)
#pragma unroll
            for (int u = 0; u < 8; ++u) { var[u] += __shfl_xor(var[u], o); bs[u] += __shfl_xor(bs[u], o); }
#pragma unroll
        for (int u = 0; u < 8; ++u) {
            const float yn = y[u] * rsqrtf(var[u] * (1.f / 64.f) + 64e-5f) * p.lnx_g[(size_t)l * 384 + chv[u]] + p.lnx_b[(size_t)l * 384 + chv[u]];
            MIX[(size_t)tokv[u] * 1024 + chv[u]] = f2bf((yn + bs[u] * vv[u]) * g[u]);
        }
    }
}

#define LAS __attribute__((address_space(3)))
namespace pg8 {
typedef short bf16x8 __attribute__((ext_vector_type(8)));
typedef float f32x4 __attribute__((ext_vector_type(4)));
constexpr int BM = 256, BK = 64, HALF = 128, HTB = HALF * BK * 2, STAGE_BYTES = 8 * HTB, NXCD = 8, WGM = 8;
__host__ __device__ __forceinline__ int lds_byte(int r, int c) { const int st = (r >> 4) * 2 + (c >> 5), rr = r & 15, cc = c & 31, ob = rr * 64 + cc * 2; return st * 1024 + (ob ^ (((ob >> 9) & 1) << 5)); }
__host__ __device__ __forceinline__ void stage_rc(int b, int& R, int& C) { const int st = b / 1024, sb = b % 1024, swz = sb ^ (((sb >> 9) & 1) << 5); R = (st >> 1) * 16 + swz / 64; C = (st & 1) * 32 + (swz % 64) / 2; }
struct Unit { int pm, pn; };
struct Gemm { const bf16_t* A; const bf16_t* Bt; int M, N, K; };
struct StaticOrder {
    int nM, nN, nwg, G, c;
    __device__ void init(int M, int N, int G_, int c_) { nM = M / BM; nN = N / BM; nwg = nM * nN; G = G_; c = c_; }
    __device__ bool next(int i, Unit& u) const {
        const long L = (long)i * G + c; if (L >= nwg) return false;
        int wgid = (int)L; { const int q = nwg / NXCD, r = nwg % NXCD, xcd = wgid % NXCD, off = wgid / NXCD; wgid = (xcd < r ? xcd * (q + 1) : r * (q + 1) + (xcd - r) * q) + off; }
        const int nig = WGM * nN, gid = wgid / nig, fm = gid * WGM, gsz = (nM - fm) < WGM ? (nM - fm) : WGM;
        u.pm = fm + ((wgid % nig) % gsz); u.pn = (wgid % nig) / gsz; return true;
    }
};
template <class Epi, class Sched>
__device__ __forceinline__ void gemm_phase(LAS unsigned char* lds, const Gemm g, const Sched& S, const Epi& E) {
    int tid_ = threadIdx.x; asm volatile("" : "+v"(tid_));
    const int tid = tid_, wid = __builtin_amdgcn_readfirstlane(tid >> 6), lane = tid & 63, wr = wid >> 2, wc = wid & 3, fr = lane & 15, fq = lane >> 4;
    const int K = g.K, nt = K / BK;
    unsigned voffA[2], voffB[2];
#pragma unroll
    for (int i = 0; i < 2; ++i) { int R, C; stage_rc(tid * 16 + i * 8192, R, C); voffA[i] = (unsigned)(R * K + C) * 2u; voffB[i] = (unsigned)(R * K + C) * 2u; }
    const size_t kstep = (size_t)(BK * 2);
    const size_t hstep = (size_t)HALF * K * 2;
    const size_t tstep = 2 * hstep;
    const unsigned ldsw = (unsigned)wid * 1024u;
    const int aoff = lds_byte(wr * 64 + fr, fq * 8), boff = lds_byte(wc * 32 + fr, fq * 8);
#define PG8_SA(b, h) (((b) * 2 + (h)) * HTB)
#define PG8_SB(b, h) ((4 + (b) * 2 + (h)) * HTB)
#define PG8_STAGE(bufoff, gbase, voff) do { _Pragma("unroll") for (int _i = 0; _i < 2; ++_i) \
        __builtin_amdgcn_global_load_lds((const unsigned*)((const char*)(gbase) + (voff)[_i]), (LAS unsigned*)(lds + (bufoff) + ldsw + _i * 8192), 16, 0, 0); } while (0)
#define PG8_LDA(dst, b, h) do { _Pragma("unroll") for (int m = 0; m < 4; ++m) _Pragma("unroll") for (int k = 0; k < 2; ++k) dst[m][k] = *(const LAS bf16x8*)(lds + PG8_SA(b, h) + aoff + m * 2048 + k * 1024); } while (0)
#define PG8_LDB(dst, b, h) do { _Pragma("unroll") for (int n = 0; n < 2; ++n) _Pragma("unroll") for (int k = 0; k < 2; ++k) dst[n][k] = *(const LAS bf16x8*)(lds + PG8_SB(b, h) + boff + n * 2048 + k * 1024); } while (0)
#define PG8_MMA(ai, bj, At, Bt) do { __builtin_amdgcn_s_setprio(1); _Pragma("unroll") for (int m = 0; m < 4; ++m) _Pragma("unroll") for (int n = 0; n < 2; ++n) _Pragma("unroll") for (int k = 0; k < 2; ++k) \
        acc[ai][bj][m][n] = __builtin_amdgcn_mfma_f32_16x16x32_bf16(Bt[n][k], At[m][k], acc[ai][bj][m][n], 0, 0, 0); __builtin_amdgcn_s_setprio(0); } while (0)
#define PG8_WAIT_V(n) asm volatile("s_waitcnt vmcnt(" #n ")" ::: "memory")
#define PG8_WAIT_L(n) asm volatile("s_waitcnt lgkmcnt(" #n ")" ::: "memory")
#define PG8_BAR __builtin_amdgcn_s_barrier()
#define PG8_SCHED __builtin_amdgcn_sched_barrier(0)
    Unit cur, nxt; int ui = 0;
    if (!S.next(0, cur)) return;
    f32x4 acc[2][2][4][2];
#pragma unroll
    for (int a = 0; a < 2; ++a)
#pragma unroll
        for (int b = 0; b < 2; ++b)
#pragma unroll
            for (int m = 0; m < 4; ++m)
#pragma unroll
                for (int n = 0; n < 2; ++n) acc[a][b][m][n] = (f32x4){0.f, 0.f, 0.f, 0.f};
    bf16x8 At[4][2], B0[2][2], B1[2][2];
    const char* cA = (const char*)g.A + (size_t)cur.pm * tstep; const char* cB = (const char*)g.Bt + (size_t)cur.pn * tstep;
    PG8_STAGE(PG8_SB(0, 0), cB, voffB); PG8_STAGE(PG8_SA(0, 0), cA, voffA); PG8_STAGE(PG8_SB(0, 1), cB + hstep, voffB); PG8_STAGE(PG8_SA(0, 1), cA + hstep, voffA);
    if (wr == 1) PG8_BAR;
    PG8_WAIT_V(4); PG8_BAR;
    PG8_STAGE(PG8_SB(1, 0), cB + kstep, voffB); PG8_STAGE(PG8_SA(1, 0), cA + kstep, voffA); PG8_STAGE(PG8_SB(1, 1), cB + hstep + kstep, voffB);
    PG8_WAIT_V(6); PG8_BAR;
    for (;;) {
        const bool has_next = S.next(ui + 1, nxt);
        const char* nA = has_next ? (const char*)g.A + (size_t)nxt.pm * tstep : cA; const char* nB = has_next ? (const char*)g.Bt + (size_t)nxt.pn * tstep : cB;
        for (int t = 0; t < nt; t += 2) {
            const bool last = (t == nt - 2);
            const char* a1 = cA + (size_t)(t + 1) * kstep;
            const char* a2 = last ? nA : cA + (size_t)(t + 2) * kstep; const char* b2 = last ? nB : cB + (size_t)(t + 2) * kstep;
            const char* a3 = a2 + kstep; const char* b3 = b2 + kstep;
            PG8_LDB(B0, 0, 0); PG8_SCHED; PG8_LDA(At, 0, 0); PG8_STAGE(PG8_SA(1, 1), a1 + hstep, voffA);
            PG8_WAIT_L(8); PG8_BAR; PG8_WAIT_L(0); PG8_MMA(0, 0, At, B0); PG8_BAR; PG8_SCHED;
            PG8_LDB(B1, 0, 1); PG8_STAGE(PG8_SB(0, 0), b2, voffB);
            PG8_BAR; PG8_WAIT_L(0); PG8_MMA(0, 1, At, B1); PG8_BAR;
            PG8_LDA(At, 0, 1); PG8_STAGE(PG8_SA(0, 0), a2, voffA);
            PG8_BAR; PG8_WAIT_L(0); PG8_MMA(1, 0, At, B0); PG8_BAR; PG8_SCHED;
            PG8_STAGE(PG8_SB(0, 1), b2 + hstep, voffB);
            PG8_WAIT_V(6); PG8_BAR; PG8_MMA(1, 1, At, B1); PG8_BAR;
            PG8_LDB(B0, 1, 0); PG8_SCHED; PG8_LDA(At, 1, 0); PG8_STAGE(PG8_SA(0, 1), a2 + hstep, voffA);
            PG8_WAIT_L(8); PG8_BAR; PG8_WAIT_L(0); PG8_MMA(0, 0, At, B0); PG8_BAR; PG8_SCHED;
            PG8_LDB(B1, 1, 1); PG8_STAGE(PG8_SB(1, 0), b3, voffB);
            PG8_BAR; PG8_WAIT_L(0); PG8_MMA(0, 1, At, B1); PG8_BAR;
            PG8_LDA(At, 1, 1); PG8_STAGE(PG8_SA(1, 0), a3, voffA);
            PG8_BAR; PG8_WAIT_L(0); PG8_MMA(1, 0, At, B0); PG8_BAR; PG8_SCHED;
            PG8_STAGE(PG8_SB(1, 1), b3 + hstep, voffB);
            PG8_WAIT_V(6); PG8_BAR; PG8_MMA(1, 1, At, B1); PG8_BAR;
        }
        E(acc, cur, wr, wc, fr, fq);
        if (!has_next) break;
#pragma unroll
        for (int a = 0; a < 2; ++a)
#pragma unroll
            for (int b = 0; b < 2; ++b)
#pragma unroll
                for (int m = 0; m < 4; ++m)
#pragma unroll
                    for (int n = 0; n < 2; ++n) acc[a][b][m][n] = (f32x4){0.f, 0.f, 0.f, 0.f};
        cur = nxt; cA = nA; cB = nB; ++ui;
    }
    PG8_WAIT_V(0);
    if (wr == 0) PG8_BAR;
    PG8_BAR;
#undef PG8_SA
#undef PG8_SB
#undef PG8_STAGE
#undef PG8_LDA
#undef PG8_LDB
#undef PG8_MMA
#undef PG8_WAIT_V
#undef PG8_WAIT_L
#undef PG8_BAR
#undef PG8_SCHED
}
template <class F> struct EpiWrap {
    const P* p; F f;
    __device__ __forceinline__ void operator()(const f32x4 (&acc)[2][2][4][2], const Unit& u, int wr, int wc, int fr, int fq) const {
        const int row0 = u.pm * BM + wr * 64 + fr, col0 = u.pn * BM + wc * 32 + 4 * fq;
#pragma unroll
        for (int ai = 0; ai < 2; ++ai)
#pragma unroll
            for (int m = 0; m < 4; ++m)
#pragma unroll
                for (int bj = 0; bj < 2; ++bj)
#pragma unroll
                    for (int n = 0; n < 2; ++n) {
                        const f32x4 a = acc[ai][bj][m][n]; const float v[4] = {a[0], a[1], a[2], a[3]};
                        f(*p, row0 + ai * HALF + m * 16, col0 + bj * HALF + n * 16, v);
                    }
    }
};
struct EpiG1H {
    const P* p; int l;
    __device__ __forceinline__ void operator()(const f32x4 (&acc)[2][2][4][2], const Unit& u, int wr, int wc, int fr, int fq) const {
        const int row0 = u.pm * BM + wr * 64 + fr, col0 = u.pn * BM + wc * 32 + 4 * fq;
        const float* rsq = (const float*)(p->ws + WS_RSQ) + (size_t)(2 * l) * NTOK;
        const float* bias = (const float*)(p->ws + WS_BIAS) + (size_t)(l * 3 + tok_cls(u.pm * BM)) * 3072 + col0;
        float rs[2][4]; float4 bb[2][2];
#pragma unroll
        for (int ai = 0; ai < 2; ++ai)
#pragma unroll
            for (int m = 0; m < 4; ++m) rs[ai][m] = rsq[row0 + ai * HALF + m * 16];
#pragma unroll
        for (int bj = 0; bj < 2; ++bj)
#pragma unroll
            for (int n = 0; n < 2; ++n) bb[bj][n] = *(const float4*)(bias + bj * HALF + n * 16);
#pragma unroll
        for (int ai = 0; ai < 2; ++ai)
#pragma unroll
            for (int m = 0; m < 4; ++m) rs[ai][m] = rsqrtf(rs[ai][m] * (1.f / 1024.f) + 1e-6f);
        const EpiG1 f{l};
#pragma unroll
        for (int ai = 0; ai < 2; ++ai)
#pragma unroll
            for (int m = 0; m < 4; ++m)
#pragma unroll
                for (int bj = 0; bj < 2; ++bj)
#pragma unroll
                    for (int n = 0; n < 2; ++n) {
                        const f32x4 a = acc[ai][bj][m][n]; const float r = rs[ai][m]; const float4 b = bb[bj][n];
                        const float v[4] = {a[0] * r + b.x, a[1] * r + b.y, a[2] * r + b.z, a[3] * r + b.w};
                        f(*p, row0 + ai * HALF + m * 16, col0 + bj * HALF + n * 16, v);
                    }
    }
};
struct EpiFfn1 {
    const P* p; int l;
    __device__ __forceinline__ void operator()(const f32x4 (&acc)[2][2][4][2], const Unit& u, int wr, int wc, int fr, int fq) const {
        const int row0 = u.pm * BM + wr * 64 + fr, j0 = u.pn * 128 + wc * 32 + 4 * fq, c0 = u.pn * 256 + wc * 32 + 4 * fq;
        bf16_t* HA = (bf16_t*)(p->ws + WS_UR);
        const float* rsq = (const float*)(p->ws + WS_RSQ) + (size_t)(2 * l + 1) * NTOK;
        const float* bc = (const float*)(p->ws + WS_BIAS) + 2 * 3 * 3072 + (size_t)(l * 3 + tok_cls(u.pm * BM)) * 5632 + c0;
        float rs[2][4]; float4 bg[2], bu[2];
#pragma unroll
        for (int ai = 0; ai < 2; ++ai)
#pragma unroll
            for (int m = 0; m < 4; ++m) rs[ai][m] = rsq[row0 + ai * HALF + m * 16];
#pragma unroll
        for (int n = 0; n < 2; ++n) { bg[n] = *(const float4*)(bc + n * 16); bu[n] = *(const float4*)(bc + 128 + n * 16); }
#pragma unroll
        for (int ai = 0; ai < 2; ++ai)
#pragma unroll
            for (int m = 0; m < 4; ++m) rs[ai][m] = rsqrtf(rs[ai][m] * (1.f / 1024.f) + 1e-6f);
#pragma unroll
        for (int ai = 0; ai < 2; ++ai)
#pragma unroll
            for (int m = 0; m < 4; ++m) {
                const int row = row0 + ai * HALF + m * 16; const float r = rs[ai][m];
#pragma unroll
                for (int n = 0; n < 2; ++n) {
                    const f32x4 g = acc[ai][0][m][n], up = acc[ai][1][m][n]; float h[4];
                    const float bgv[4] = {bg[n].x, bg[n].y, bg[n].z, bg[n].w}, buv[4] = {bu[n].x, bu[n].y, bu[n].z, bu[n].w};
#pragma unroll
                    for (int e = 0; e < 4; ++e) { const float gt = g[e] * r + bgv[e], uu = up[e] * r + buv[e]; h[e] = gt * sigmoidf_(gt) * uu; }
                    uint2 w; w.x = pk_bf16(h[0], h[1]); w.y = pk_bf16(h[2], h[3]);
                    *(uint2*)(HA + (size_t)row * D_FF + j0 + n * 16) = w;
                }
            }
    }
};
struct EpiResN {
    const P* p; int l, which;
    const float* ng; int nl, nsc;
    bf16_t* Hout; float* rsq;
    __device__ __forceinline__ void operator()(const f32x4 (&acc)[2][2][4][2], const Unit& u, int wr, int wc, int fr, int fq) const {
        const int row0 = u.pm * BM + wr * 64 + fr, col0 = u.pn * BM + wc * 32 + 4 * fq;
        const int cls = tok_cls(u.pm * BM);
        const float* g = mod_vec(*p, l, cls, which) + col0;
        float4 gg[2][2], gw[2][2];
#pragma unroll
        for (int bj = 0; bj < 2; ++bj)
#pragma unroll
            for (int n = 0; n < 2; ++n) {
                gg[bj][n] = *(const float4*)(g + bj * HALF + n * 16);
                if (ng) { const float4 gn = *(const float4*)(ng + col0 + bj * HALF + n * 16), sc = *(const float4*)(mod_vec(*p, nl, cls, nsc) + col0 + bj * HALF + n * 16);
                    gw[bj][n] = make_float4(gn.x * (1.f + sc.x), gn.y * (1.f + sc.y), gn.z * (1.f + sc.z), gn.w * (1.f + sc.w)); }
            }
#pragma unroll
        for (int ai = 0; ai < 2; ++ai)
#pragma unroll
            for (int mp = 0; mp < 4; mp += 2) {
                float4 x[2][2][2];
#pragma unroll
                for (int q = 0; q < 2; ++q) {
                    const int row = row0 + ai * HALF + (mp + q) * 16;
                    const float* xo = ((which == 2 && l == 0) ? xin_row(*p, row) : X_row(*p, row)) + col0;
#pragma unroll
                    for (int bj = 0; bj < 2; ++bj)
#pragma unroll
                        for (int n = 0; n < 2; ++n) x[q][bj][n] = *(const float4*)(xo + bj * HALF + n * 16);
                }
#pragma unroll
                for (int q = 0; q < 2; ++q) {
                    const int row = row0 + ai * HALF + (mp + q) * 16;
                    float ssq = 0.f;
#pragma unroll
                    for (int bj = 0; bj < 2; ++bj)
#pragma unroll
                        for (int n = 0; n < 2; ++n) {
                            const int col = col0 + bj * HALF + n * 16; const f32x4 a = acc[ai][bj][mp + q][n]; const float4 xv = x[q][bj][n], gv = gg[bj][n];
                            const float4 xn = make_float4(xv.x + gv.x * a[0], xv.y + gv.y * a[1], xv.z + gv.z * a[2], xv.w + gv.w * a[3]);
                            *(float4*)(X_row(*p, row) + col) = xn;
                            if (ng) {
                                ssq += xn.x * xn.x + xn.y * xn.y + xn.z * xn.z + xn.w * xn.w;
                                const float4 w4 = gw[bj][n];
                                uint2 w; w.x = pk_bf16(xn.x * w4.x, xn.y * w4.y); w.y = pk_bf16(xn.z * w4.z, xn.w * w4.w);
                                *(uint2*)(Hout + (size_t)row * 1024 + col) = w;
                            }
                        }
                    if (ng) { ssq += __shfl_xor(ssq, 16); ssq += __shfl_xor(ssq, 32); if (fq == 0) unsafeAtomicAdd(rsq + row, ssq); }
                }
            }
    }
};
}


typedef short bf16x8_t __attribute__((ext_vector_type(8)));
typedef short bf16x4_t __attribute__((ext_vector_type(4)));
typedef float f32x16_t __attribute__((ext_vector_type(16)));
#define AT_KS_BYTES (256 * 72 * 2)
__device__ __forceinline__ void attn_stage(const P& p, int l, int s, int h, int start, int nctx, int chunk, bool withV, bf16_t* Ks, bf16_t* Vt, int tid) {
    const int key = tid >> 1, half = tid & 1, j = chunk * 256 + key;
    if (j < nctx) {
        const size_t base = (((size_t)(s - 32) * 2 + l) * 512 + j) * 384 + h * 64 + half * 32;
        const float4* kp = (const float4*)(p.cache_k + base);
#pragma unroll
        for (int i = 0; i < 4; ++i) { const float4 a = kp[2 * i], b = kp[2 * i + 1]; uint4 o; o.x = pk_bf16(a.x, a.y); o.y = pk_bf16(a.z, a.w); o.z = pk_bf16(b.x, b.y); o.w = pk_bf16(b.z, b.w);
            *(uint4*)(Ks + key * 72 + half * 32 + i * 8) = o; }
        if (withV) { const float4* vp = (const float4*)(p.cache_v + base);
#pragma unroll
            for (int i = 0; i < 8; ++i) { const float4 a = vp[i]; bf16_t* d = Vt + (half * 32 + i * 4) * 260 + key; d[0] = f2bf(a.x); d[260] = f2bf(a.y); d[520] = f2bf(a.z); d[780] = f2bf(a.w); } }
    } else {
        const bf16_t* UD = (const bf16_t*)(p.ws + WS_UD);
        const size_t base = (size_t)(start + j - nctx) * 1152 + h * 64 + half * 32;
        const uint4* kp = (const uint4*)(UD + base + 384);
#pragma unroll
        for (int i = 0; i < 4; ++i) *(uint4*)(Ks + key * 72 + half * 32 + i * 8) = kp[i];
        if (withV) { const uint4* vp = (const uint4*)(UD + base + 768);
#pragma unroll
            for (int i = 0; i < 4; ++i) { const uint4 u = vp[i]; const unsigned w[4] = {u.x, u.y, u.z, u.w}; bf16_t* d = Vt + (half * 32 + i * 8) * 260 + key;
#pragma unroll
                for (int e = 0; e < 4; ++e) { d[(2 * e) * 260] = (bf16_t)(w[e] & 0xffff); d[(2 * e + 1) * 260] = (bf16_t)(w[e] >> 16); } } }
    }
}
__device__ __forceinline__ void attn_item(const P& p, int l, int item, unsigned char* lds, float lam, float lam_init) {
    const int tid = otid(), lane = tid & 63, wv = tid >> 6, n = lane & 31, hh = lane >> 5;
    int s, h, qb;
    if (item < 48) { s = 32 + item / 24; h = (item % 24) / 4; qb = item & 3; } else { const int r = item - 48; s = r / 6; h = r % 6; qb = 0; }
    int start, T; seq_info(s, start, T);
    const int nctx = s >= 32 ? 512 : 0, nchunks = (nctx + T) >> 8;
    bf16_t* Ks = (bf16_t*)lds; bf16_t* Vt = (bf16_t*)(lds + AT_KS_BYTES);
    const bf16_t* UD = (const bf16_t*)(p.ws + WS_UD);
    const int qtok = start + qb * 256 + wv * 32 + n;
    bf16x8_t Qf[2][2];
#pragma unroll
    for (int m = 0; m < 2; ++m)
#pragma unroll
        for (int si = 0; si < 2; ++si) Qf[m][si] = *(const bf16x8_t*)(UD + (size_t)qtok * 1152 + h * 64 + m * 32 + si * 16 + hh * 8);
    const float c = 0.17677669529663687f * 1.4426950408889634f;
    float m0 = -1e30f, m1 = -1e30f, l0 = 0.f, l1 = 0.f;
    for (int ch = 0; ch < nchunks; ++ch) {
        __syncthreads();
        attn_stage(p, l, s, h, start, nctx, ch, false, Ks, Vt, tid);
        __syncthreads();
#pragma unroll 1
        for (int kt = 0; kt < 8; ++kt) {
            f32x16_t S0 = {0,0,0,0,0,0,0,0,0,0,0,0,0,0,0,0}, S1 = S0;
#pragma unroll
            for (int si = 0; si < 2; ++si) {
                const bf16x8_t k0 = *(const bf16x8_t*)(Ks + (kt * 32 + n) * 72 + si * 16 + hh * 8);
                const bf16x8_t k1 = *(const bf16x8_t*)(Ks + (kt * 32 + n) * 72 + 32 + si * 16 + hh * 8);
                S0 = __builtin_amdgcn_mfma_f32_32x32x16_bf16(k0, Qf[0][si], S0, 0, 0, 0);
                S1 = __builtin_amdgcn_mfma_f32_32x32x16_bf16(k1, Qf[1][si], S1, 0, 0, 0);
            }
            float t0 = S0[0], t1 = S1[0];
#pragma unroll
            for (int r = 1; r < 16; ++r) { t0 = fmaxf(t0, S0[r]); t1 = fmaxf(t1, S1[r]); }
            const float n0 = fmaxf(m0, t0), n1 = fmaxf(m1, t1);
            float a0 = 0.f, a1 = 0.f;
#pragma unroll
            for (int r = 0; r < 16; ++r) { a0 += __builtin_amdgcn_exp2f((S0[r] - n0) * c); a1 += __builtin_amdgcn_exp2f((S1[r] - n1) * c); }
            l0 = l0 * __builtin_amdgcn_exp2f((m0 - n0) * c) + a0; l1 = l1 * __builtin_amdgcn_exp2f((m1 - n1) * c) + a1;
            m0 = n0; m1 = n1;
        }
    }
    {
        const float mo0 = __shfl_xor(m0, 32), lo0 = __shfl_xor(l0, 32), mo1 = __shfl_xor(m1, 32), lo1 = __shfl_xor(l1, 32);
        const float M0 = fmaxf(m0, mo0), M1 = fmaxf(m1, mo1);
        l0 = l0 * __builtin_amdgcn_exp2f((m0 - M0) * c) + lo0 * __builtin_amdgcn_exp2f((mo0 - M0) * c);
        l1 = l1 * __builtin_amdgcn_exp2f((m1 - M1) * c) + lo1 * __builtin_amdgcn_exp2f((mo1 - M1) * c);
        m0 = M0; m1 = M1;
    }
    const float i0 = 1.f / l0, i1 = lam / l1;
    f32x16_t O0 = {0,0,0,0,0,0,0,0,0,0,0,0,0,0,0,0}, O1 = O0;
    for (int ch = 0; ch < nchunks; ++ch) {
        __syncthreads();
        attn_stage(p, l, s, h, start, nctx, ch, true, Ks, Vt, tid);
        __syncthreads();
#pragma unroll 1
        for (int kt = 0; kt < 8; ++kt) {
            f32x16_t S0 = {0,0,0,0,0,0,0,0,0,0,0,0,0,0,0,0}, S1 = S0;
#pragma unroll
            for (int si = 0; si < 2; ++si) {
                const bf16x8_t k0 = *(const bf16x8_t*)(Ks + (kt * 32 + n) * 72 + si * 16 + hh * 8);
                const bf16x8_t k1 = *(const bf16x8_t*)(Ks + (kt * 32 + n) * 72 + 32 + si * 16 + hh * 8);
                S0 = __builtin_amdgcn_mfma_f32_32x32x16_bf16(k0, Qf[0][si], S0, 0, 0, 0);
                S1 = __builtin_amdgcn_mfma_f32_32x32x16_bf16(k1, Qf[1][si], S1, 0, 0, 0);
            }
            float pw[16];
#pragma unroll
            for (int r = 0; r < 16; ++r) pw[r] = __builtin_amdgcn_exp2f((S0[r] - m0) * c) * i0 - __builtin_amdgcn_exp2f((S1[r] - m1) * c) * i1;
#pragma unroll
            for (int si = 0; si < 2; ++si) {
                union { unsigned u[4]; bf16x8_t v; } pf;
#pragma unroll
                for (int e = 0; e < 4; ++e) pf.u[e] = pk_bf16(pw[8 * si + 2 * e], pw[8 * si + 2 * e + 1]);
                union { bf16x4_t h2[2]; bf16x8_t v; } va, vb;
                const bf16_t* v0 = Vt + n * 260 + kt * 32 + si * 16 + hh * 4;
                va.h2[0] = *(const bf16x4_t*)v0; va.h2[1] = *(const bf16x4_t*)(v0 + 8);
                vb.h2[0] = *(const bf16x4_t*)(v0 + 32 * 260); vb.h2[1] = *(const bf16x4_t*)(v0 + 32 * 260 + 8);
                O0 = __builtin_amdgcn_mfma_f32_32x32x16_bf16(va.v, pf.v, O0, 0, 0, 0);
                O1 = __builtin_amdgcn_mfma_f32_32x32x16_bf16(vb.v, pf.v, O1, 0, 0, 0);
            }
        }
    }
    float ss = 0.f;
#pragma unroll
    for (int r = 0; r < 16; ++r) ss += O0[r] * O0[r] + O1[r] * O1[r];
    ss += __shfl_xor(ss, 32);
    const float rs = rsqrtf(ss * (1.f / 64.f) + 1e-5f) * (1.f - lam_init);
    bf16_t* mo = (bf16_t*)(p.ws + WS_H) + (size_t)qtok * 1024 + 384 + h * 64;
    const float* sg = p.subln_g + (size_t)l * 64;
#pragma unroll
    for (int g = 0; g < 4; ++g) {
        const int vd = 8 * g + 4 * hh;
        uint2 w0, w1;
        w0.x = pk_bf16(O0[4 * g] * rs * sg[vd], O0[4 * g + 1] * rs * sg[vd + 1]); w0.y = pk_bf16(O0[4 * g + 2] * rs * sg[vd + 2], O0[4 * g + 3] * rs * sg[vd + 3]);
        w1.x = pk_bf16(O1[4 * g] * rs * sg[32 + vd], O1[4 * g + 1] * rs * sg[32 + vd + 1]); w1.y = pk_bf16(O1[4 * g + 2] * rs * sg[32 + vd + 2], O1[4 * g + 3] * rs * sg[32 + vd + 3]);
        *(uint2*)(mo + vd) = w0; *(uint2*)(mo + 32 + vd) = w1;
    }
}

struct EpiFnet {
    int samp;
    __device__ __forceinline__ void operator()(const P& p, int row, int col, const float* v) const {
        const int sq = col >> 8, ch = col & 255;
        const int tok = samp ? NPTOK + sq * 1024 + row : sq * 256 + row;
        uint2 w; w.x = pk_bf16(v[0], v[1]); w.y = pk_bf16(v[2], v[3]);
        *(uint2*)((bf16_t*)(p.ws + WS_H) + (size_t)tok * 1024 + 768 + ch) = w;
    }
};
struct OneUnit { int pm, pn; __device__ bool next(int i, pg8::Unit& u) const { if (i) return false; u.pm = pm; u.pn = pn; return true; } };

#define MX_ITEMS 724
template <class GemmFn>
__device__ __forceinline__ void ph_mixer(const P& p, int l, unsigned char* lds, volatile LAS unsigned* slot, GemmFn gemm_one) {
    const float lam_init = 0.8f - 0.6f * __expf(-0.3f * (float)l);
    float lam;
    { const float* lp = p.diff_lambda + (size_t)l * 128; float s01 = 0.f, s23 = 0.f;
      for (int d = 0; d < 32; ++d) { s01 += lp[d] * lp[32 + d]; s23 += lp[64 + d] * lp[96 + d]; }
      lam = __expf(s01) - __expf(s23) + lam_init; }
    unsigned* ctr = (unsigned*)(p.ws + WS_CTL) + CTL_QUEUE + 64 * l;
    for (;;) {
        __syncthreads();
        if (threadIdx.x == 0) *slot = atomicAdd(ctr, 1u);
        __syncthreads();
        const int item = (int)*slot;
        if (item >= MX_ITEMS) break;
#if PROBE_ID
        const unsigned long long it0 = __builtin_amdgcn_s_memrealtime();
#endif
        if (item < 48) attn_item(p, l, item, lds, lam, lam_init);
        else if (item < 60) ph_scan_job(p, l, 32 + (item - 48) / NH, (item - 48) % NH, 0, 0, 0, 0, SEG0_LEN, (float*)lds);
        else if (item < 108) { const int r = item - 60, sg = 1 + (r & 1), dr = (r >> 1) & 1, hh = (r >> 2) % NH, bb = r / 24;
            ph_scan_job(p, l, 32 + bb, hh, 1, dr, sg, sg == 1 ? SEG0_LEN : SEG0_LEN + SEG1_LEN, sg == 1 ? SEG1_LEN : SEG2_LEN, (float*)lds); }
        else if (item < 300) ph_scan_job(p, l, (item - 108) / NH, (item - 108) % NH, 0, 0, 0, 0, TP, (float*)lds);
        else if (item < 308) gemm_one(1, (item - 300) >> 1, (item - 300) & 1);
        else if (item < 500) attn_item(p, l, 48 + item - 308, lds, lam, lam_init);
        else if (item < 532) gemm_one(0, 0, item - 500);
        else fixup_item(p, l, item - 532, (float*)lds);
        if (item >= 48 && item < 108) {
            asm volatile("s_waitcnt vmcnt(0)" ::: "memory");
            __syncthreads();
            if (threadIdx.x == 0) {
                __builtin_amdgcn_fence(__ATOMIC_RELEASE, "agent");
                asm volatile("s_waitcnt vmcnt(0)" ::: "memory");
                unsigned* cnt = (unsigned*)(p.ws + WS_CTL) + CTL_SCANDONE + 32 * l;
                if (item < 60) { const int bh = item - 48; __hip_atomic_fetch_add(cnt + bh * 2, 1u, __ATOMIC_RELAXED, __HIP_MEMORY_SCOPE_AGENT); __hip_atomic_fetch_add(cnt + bh * 2 + 1, 1u, __ATOMIC_RELAXED, __HIP_MEMORY_SCOPE_AGENT); }
                else { const int r = item - 60, dr = (r >> 1) & 1, hh = (r >> 2) % NH, bb = r / 24; __hip_atomic_fetch_add(cnt + (bb * NH + hh) * 2 + dr, 1u, __ATOMIC_RELAXED, __HIP_MEMORY_SCOPE_AGENT); }
            }
        }
#if PROBE_ID
        __syncthreads();
        if (threadIdx.x == 0 && l == 0) { const int cls = item < 48 ? 3 : item < 60 ? 0 : item < 108 ? 6 : item < 300 ? 2 : item < 308 ? 1 : item < 500 ? 5 : 4;
            atomicMax((unsigned*)(p.ws + WS_CTL) + 3712 + cls, (unsigned)(__builtin_amdgcn_s_memrealtime() - it0)); }
#endif
    }
}

#define XB_TMO      128
#define XB_XCNT(j)  (256  + 64 * (j))
#define XB_XSUB(j)  (1280 + 64 * (j))
#define XB_XGEN(j)  (2304 + 64 * (j))
#define XB_TOP      3328
#define XB_TOPGEN   3392
#define XCD_BAR_WORDS 3456
#define XB_SPIN_CAP (1u << 22)
__device__ __forceinline__ unsigned xb_ld(unsigned* p)              { return __hip_atomic_load(p, __ATOMIC_RELAXED, __HIP_MEMORY_SCOPE_AGENT); }
__device__ __forceinline__ unsigned xb_add(unsigned* p, unsigned v) { return __hip_atomic_fetch_add(p, v, __ATOMIC_RELAXED, __HIP_MEMORY_SCOPE_AGENT); }
__device__ __forceinline__ unsigned xb_xcc_id() { return (unsigned)__builtin_amdgcn_s_getreg((3 << 11) | 20) & 0xFu; }
#define XB_SPIN(cond, bar) do { unsigned _sp = 0; while (cond) { __builtin_amdgcn_s_sleep(1); \
    if ((++_sp & 255u) == 0u) { if (xb_ld(&(bar)[XB_TMO])) break; if (_sp > XB_SPIN_CAP) { atomicAdd(&(bar)[XB_TMO], 1u); break; } } } } while (0)
struct XcdBarrier { unsigned* bar; unsigned x; volatile LAS unsigned* st; };
__device__ __forceinline__ XcdBarrier xcd_barrier_post(unsigned* bar, volatile LAS unsigned* st) {
    XcdBarrier b; b.bar = bar; b.x = xb_xcc_id(); b.st = st;
    if (threadIdx.x == 0) (void)xb_add(&bar[XB_XCNT(b.x)], 1u);
    return b;
}
__device__ __forceinline__ void xcd_barrier_complete(unsigned* bar, unsigned x, unsigned& nloc, unsigned& nx) {
    const unsigned G = gridDim.x * gridDim.y * gridDim.z;
    unsigned sum, cnt, mine, sp = 0u;
    for (;;) {
        sum = 0u; cnt = 0u; mine = 0u;
#pragma unroll
        for (unsigned j = 0; j < 16; ++j) { const unsigned c = xb_ld(&bar[XB_XCNT(j)]); sum += c; cnt += (c > 0u) ? 1u : 0u; mine = (j == x) ? c : mine; }
        if (sum == G) break;
        __builtin_amdgcn_s_sleep(1);
        if ((++sp & 255u) == 0u) { if (xb_ld(&bar[XB_TMO])) break; if (sp > XB_SPIN_CAP) { atomicAdd(&bar[XB_TMO], 1u); break; } }
    }
    nloc = mine > 0u ? mine : 1u; nx = cnt > 0u ? cnt : 1u;
}
__device__ __forceinline__ void xcd_barrier(const XcdBarrier& b) {
    asm volatile("s_waitcnt vmcnt(0)" ::: "memory");
    __syncthreads();
    if (threadIdx.x == 0) {
        unsigned* bar = b.bar;
        __builtin_amdgcn_s_waitcnt(0);
        unsigned nloc = b.st[0], nx = b.st[1];
        if (nloc == 0u) { xcd_barrier_complete(bar, b.x, nloc, nx); b.st[0] = nloc; b.st[1] = nx; }
        const unsigned old = xb_add(&bar[XB_XSUB(b.x)], 1u);
        const unsigned gen = old / nloc;
        if (old + 1u == (gen + 1u) * nloc) {
            __builtin_amdgcn_fence(__ATOMIC_RELEASE, "agent");
            asm volatile("s_waitcnt vmcnt(0)" ::: "memory");
            const unsigned og = xb_add(&bar[XB_TOP], 1u);
            const unsigned tg = og / nx;
            if (og + 1u == (tg + 1u) * nx) xb_add(&bar[XB_TOPGEN], 1u);
            else XB_SPIN(xb_ld(&bar[XB_TOPGEN]) == tg, bar);
            __builtin_amdgcn_fence(__ATOMIC_ACQUIRE, "agent");
            xb_add(&bar[XB_XGEN(b.x)], 1u);
            asm volatile("s_waitcnt vmcnt(0)" ::: "memory");
        } else {
            XB_SPIN(xb_ld(&bar[XB_XGEN(b.x)]) == gen, bar);
            __builtin_amdgcn_fence(__ATOMIC_ACQUIRE, "agent");
            asm volatile("s_waitcnt vmcnt(0)" ::: "memory");
        }
    }
    __syncthreads();
}

#define MISC_OFF 150528
#define LDS_BYTES (MISC_OFF + 1024)
#define N_PHASES 17
struct Args { P p; int ph_lo, ph_hi; };
__global__ __launch_bounds__(512, 2) void mega(Args a) {
    extern __shared__ __attribute__((aligned(16))) unsigned char lds[];
    const P& p = a.p;
    LAS unsigned char* l3 = (LAS unsigned char*)lds;
    volatile LAS unsigned* misc = (volatile LAS unsigned*)(l3 + MISC_OFF);
    if (threadIdx.x < 16) misc[threadIdx.x] = 0u;
    __syncthreads();
    XcdBarrier bar = xcd_barrier_post((unsigned*)(p.ws + WS_CTL), misc);
    float* sm = (float*)lds;
    const int lo = a.ph_lo, hi = a.ph_hi;
#define IN(k) (lo <= (k) && (k) < hi)
#if PROBE_ID
    unsigned long long* tsl = (unsigned long long*)(p.ws + WS_CTL + 15360);
    if (blockIdx.x == 0 && otid() == 0) tsl[0] = __builtin_amdgcn_s_memrealtime();
#define SEAM(k) do { if (IN(k) && IN((k) + 1)) xcd_barrier(bar); if (blockIdx.x == 0 && otid() == 0) tsl[1 + (k)] = __builtin_amdgcn_s_memrealtime(); } while (0)
#else
#define SEAM(k) do { if (IN(k) && IN((k) + 1)) xcd_barrier(bar); } while (0)
#endif
    if (IN(0)) ph_prep0(p, sm);
    SEAM(0);
    if (IN(1)) ph_prep0b(p);
    SEAM(1);
    for (int l = 0; l < 2; ++l) {
        const int b0 = 2 + 7 * l;
        if (IN(b0 + 0)) { pg8::Gemm g{(const bf16_t*)(p.ws + WS_H), (const bf16_t*)(p.ws + WS_WIN) + (size_t)l * N1 * 1024, NTOK, N1, 1024};
            pg8::StaticOrder S; S.init(NTOK, N1, gridDim.x, blockIdx.x); pg8::EpiG1H E{&p, l}; pg8::gemm_phase(l3, g, S, E); }
        SEAM(b0 + 0);
        if (IN(b0 + 1)) ph_prep(p, l, sm);
        SEAM(b0 + 1);
        if (IN(b0 + 2)) {
            auto gemm_one = [&](int samp, int pm, int pn) {
                pg8::Gemm g{samp ? (const bf16_t*)(p.ws + WS_L1024) : (const bf16_t*)(p.ws + WS_L256), samp ? (const bf16_t*)(p.ws + WS_ZF) + (size_t)8192 * 512 : (const bf16_t*)(p.ws + WS_ZF),
                            samp ? 1024 : 256, samp ? 512 : 8192, samp ? 2048 : 512};
                OneUnit S{pm, pn}; pg8::EpiWrap<EpiFnet> E{&p, EpiFnet{samp}}; pg8::gemm_phase(l3, g, S, E); };
            ph_mixer(p, l, lds, misc + 4, gemm_one);
        }
        SEAM(b0 + 2);
        if (IN(b0 + 3)) ph_finalize(p, l);
        SEAM(b0 + 3);
        if (IN(b0 + 4)) { pg8::Gemm g{(const bf16_t*)(p.ws + WS_H), (const bf16_t*)(p.ws + WS_WOUT) + (size_t)l * 1024 * 1024, NTOK, 1024, 1024};
            pg8::StaticOrder S; S.init(NTOK, 1024, gridDim.x, blockIdx.x);
            pg8::EpiResN E{&p, l, 2, p.norm2_g + (size_t)l * 1024, l, 4, (bf16_t*)(p.ws + WS_H2), (float*)(p.ws + WS_RSQ) + (size_t)(2 * l + 1) * NTOK}; pg8::gemm_phase(l3, g, S, E); }
        SEAM(b0 + 4);
        if (IN(b0 + 5)) { pg8::Gemm g{(const bf16_t*)(p.ws + WS_H2), (const bf16_t*)(p.ws + WS_WF1) + (size_t)l * 5632 * 1024, NTOK, 5632, 1024};
            pg8::StaticOrder S; S.init(NTOK, 5632, gridDim.x, blockIdx.x); pg8::EpiFfn1 E{&p, l}; pg8::gemm_phase(l3, g, S, E); }
        SEAM(b0 + 5);
        if (IN(b0 + 6)) { pg8::Gemm g{(const bf16_t*)(p.ws + WS_UR), (const bf16_t*)(p.ws + WS_WF2) + (size_t)l * 1024 * 2816, NTOK, 1024, 2816};
            pg8::StaticOrder S; S.init(NTOK, 1024, gridDim.x, blockIdx.x);
            pg8::EpiResN E{&p, l, 5, l == 0 ? p.norm1_g + 1024 : (const float*)nullptr, 1, 1, (bf16_t*)(p.ws + WS_H), (float*)(p.ws + WS_RSQ) + (size_t)2 * NTOK}; pg8::gemm_phase(l3, g, S, E); }
        SEAM(b0 + 6);
    }
    if (IN(16)) ph_norm(p, 0, 2);
#if PROBE_ID
    __syncthreads();
    if (blockIdx.x == 0 && otid() == 0) {
        tsl[17] = __builtin_amdgcn_s_memrealtime();
        __threadfence();
        unsigned long long acc = 0;
#pragma unroll 1
        for (int k = 0; k < 17; ++k) {
            const int st = k == 0 ? -1 : (k == 1 ? -3 : (k == 16 ? -2 : 20 + (k - 2) % 7));
            bool sel = false;
            if (PROBE_ID == 1) sel = (k == 0);
            if (PROBE_ID == 2) sel = (st == 10 || st == 15 || st == 16 || st == 17);
            if (PROBE_ID == 3) sel = (st == 12);
            if (PROBE_ID == 4) sel = (st == -2 || st == -3);
            if (PROBE_ID == 5) sel = (st == 11);
            if (PROBE_ID == 6) sel = (st == 13);
            if (PROBE_ID == 7) sel = (st == 14);
            if (PROBE_ID == 8) sel = (st == 10);
            if (PROBE_ID == 9) sel = (st == 15);
            if (PROBE_ID == 10) sel = (st == 16);
            if (PROBE_ID == 11) sel = (st == 17);
            if (sel) acc += __hip_atomic_load(tsl + 1 + k, __ATOMIC_RELAXED, __HIP_MEMORY_SCOPE_AGENT) - __hip_atomic_load(tsl + k, __ATOMIC_RELAXED, __HIP_MEMORY_SCOPE_AGENT);
        }
        if (PROBE_ID >= 30 && PROBE_ID < 34) { unsigned long long* tsp = (unsigned long long*)(p.ws + WS_CTL + 15360) + 32; acc = __hip_atomic_load(tsp + (PROBE_ID - 29), __ATOMIC_RELAXED, __HIP_MEMORY_SCOPE_AGENT) - __hip_atomic_load(tsp + (PROBE_ID - 30), __ATOMIC_RELAXED, __HIP_MEMORY_SCOPE_AGENT); }
        else if (PROBE_ID >= 20) acc = __hip_atomic_load((unsigned*)(p.ws + WS_CTL) + 3712 + (PROBE_ID - 20), __ATOMIC_RELAXED, __HIP_MEMORY_SCOPE_AGENT);
        const unsigned long long t_end = __builtin_amdgcn_s_memrealtime();
        while (__builtin_amdgcn_s_memrealtime() - t_end < 4ull * acc) __builtin_amdgcn_s_sleep(8);
    }
#endif
#undef IN
#undef SEAM
}

extern "C" void kernel_launch(void* const* d_in, const int* in_sizes, int n_in, void* d_out, int out_size, void* d_ws, size_t ws_size, hipStream_t stream) {
    static int grid = 0;
    if (grid == 0) {
        if (n_in != 29 || ws_size < WS_END) { fprintf(stderr, "kernel_launch: bad n_in %d or ws_size %zu (need %zu)\n", n_in, ws_size, (size_t)WS_END); grid = -1; return; }
        int dev = 0, cus = 0, per_cu = 0;
        hipGetDevice(&dev); hipDeviceGetAttribute(&cus, hipDeviceAttributeMultiprocessorCount, dev);
        if (hipFuncSetAttribute((const void*)mega, hipFuncAttributeMaxDynamicSharedMemorySize, LDS_BYTES) != hipSuccess) { fprintf(stderr, "kernel_launch: hipFuncSetAttribute failed\n"); grid = -1; return; }
        if (hipOccupancyMaxActiveBlocksPerMultiprocessor(&per_cu, (const void*)mega, 512, LDS_BYTES) != hipSuccess || per_cu < 1) { fprintf(stderr, "kernel_launch: occupancy query says %d\n", per_cu); per_cu = 1; }
        (void)hipGetLastError();
        grid = cus;
    }
    if (grid < 0) return;
    hipMemsetAsync((unsigned char*)d_ws + WS_CTL, 0, 16384 + 4 * NTOK * 4, stream);
    Args a{};
    const float** f = (const float**)&a.p;
    for (int i = 0; i < 29; ++i) f[i] = (const float*)d_in[i];
    a.p.out = (float*)d_out; a.p.ws = (unsigned char*)d_ws;
#if ONE_LAUNCH
    a.ph_lo = 0; a.ph_hi = N_PHASES;
    hipLaunchKernelGGL(mega, dim3(grid), dim3(512), LDS_BYTES, stream, a);
#else
    for (int ph = 0; ph < N_PHASES; ++ph) { a.ph_lo = ph; a.ph_hi = ph + 1; hipLaunchKernelGGL(mega, dim3(grid), dim3(512), LDS_BYTES, stream, a); }
#endif
}
```

```cpp
#include <hip/hip_runtime.h>
#include <stdint.h>
#include <stdio.h>
#ifndef ONE_LAUNCH
#define ONE_LAUNCH 1
#endif
#ifndef PROBE_ID
#define PROBE_ID 0
#endif

typedef unsigned short bf16_t;

#define D_MODEL 1024
#define NTOK 10240
#define NPTOK 8192
#define TP 256
#define TS 1024
#define NSEQ 34
#define NH 6
#define N1 3072
#define C_DIFF 0
#define C_FNET 1152
#define C_RWKV 1664
#define C_END 3008
#define N_RWKV 1344
#define D_FF 2816
#define D_IN 2752

#define OUT_YP 0
#define OUT_YS 8388608
#define OUT_ST 10485760
#define OUT_CK 13631488
#define OUT_CV 19922944

#define OPS_REC 1792
#define OPS_TOK (6 * OPS_REC)

#define WS_WIN   ((size_t)0)
#define WS_WOUT  (WS_WIN + (size_t)2 * N1 * 1024 * 2)
#define WS_WF1   (WS_WOUT + (size_t)2 * 1024 * 1024 * 2)
#define WS_WF2   (WS_WF1 + (size_t)2 * 5632 * 1024 * 2)
#define WS_H     (WS_WF2 + (size_t)2 * 1024 * 2816 * 2)
#define WS_UD    (WS_H + (size_t)NTOK * 1024 * 2)
#define WS_ZF    (WS_UD + (size_t)NTOK * 1152 * 2)
#define WS_UR    (WS_ZF + (size_t)NTOK * 512 * 2)
#define WS_OPS   (WS_UR + (size_t)2 * NTOK * 384 * 4)
#define WS_MOD   (WS_OPS + (size_t)NTOK * OPS_TOK)
#define WS_L256  (WS_MOD + (size_t)2 * 3 * 6144 * 4)
#define WS_L1024 (WS_L256 + (size_t)256 * 512 * 2)
#define WS_CTL   (WS_L1024 + (size_t)1024 * 2048 * 2)
#define WS_RSQ   (WS_CTL + (size_t)16384)
#define WS_ZS    (WS_RSQ + (size_t)4 * NTOK * 4)
#define WS_SS    (WS_ZS + (size_t)2 * 2048 * 384 * 4)
#define WS_WLT   (WS_SS + (size_t)24 * 3 * 4096 * 4)
#define WLT_L    73728
#define WS_BIAS  (WS_WLT + (size_t)2 * WLT_L * 2)
#define WS_END   (WS_BIAS + (size_t)(2 * 3 * 3072 + 2 * 3 * 5632) * 4)
#define WS_H2    (WS_OPS + ((size_t)64 << 20))
#define CTL_QUEUE 3584
static_assert(WS_END <= ((size_t)256 << 20), "workspace exceeds 256 MiB");

struct P {
    const float *x_prompt, *x_sample, *c, *state_rwkv, *cache_k, *cache_v, *c_ctx, *norm1_g, *norm2_g, *final_g;
    const float *w_mod, *b_mod, *w_in, *w_out, *shift_mu, *decay_w0, *decay_up, *iclr_a0, *iclr_up, *gate_up;
    const float *k_k, *k_a, *r_k, *lnx_g, *lnx_b, *diff_lambda, *subln_g, *w_ffn_in, *w_ffn_out;
    float* out;
    unsigned char* ws;
};

typedef float f32x2c __attribute__((ext_vector_type(2)));
typedef __bf16 bf16x2c __attribute__((ext_vector_type(2)));
__device__ __forceinline__ bf16_t f2bf(float f) { return __builtin_bit_cast(unsigned short, (__bf16)f); }
__device__ __forceinline__ unsigned pk_bf16(float lo, float hi) { const f32x2c v = {lo, hi}; return __builtin_bit_cast(unsigned, __builtin_convertvector(v, bf16x2c)); }
__device__ __forceinline__ float bf2f(bf16_t b) { return __builtin_bit_cast(float, ((unsigned)b) << 16); }
__device__ __forceinline__ float sigmoidf_(float x) { return 1.f / (1.f + __expf(-x)); }
__device__ __forceinline__ float wave_sum(float v) {
#pragma unroll
    for (int o = 1; o < 64; o <<= 1) v += __shfl_xor(v, o);
    return v;
}
__device__ __forceinline__ int otid() { int t = threadIdx.x; asm volatile("" : "+v"(t)); return t; }
__device__ __forceinline__ int tok_cls(int tok) { return tok < NPTOK ? 0 : 1 + ((tok - NPTOK) >> 10); }
__device__ __forceinline__ const float* xin_row(const P& p, int tok) { return tok < NPTOK ? p.x_prompt + (size_t)tok * 1024 : p.x_sample + (size_t)(tok - NPTOK) * 1024; }
__device__ __forceinline__ float* X_row(const P& p, int tok) { return p.out + (size_t)tok * 1024; }
__device__ __forceinline__ const float* mod_vec(const P& p, int l, int cls, int which) { return (const float*)(p.ws + WS_MOD) + ((size_t)(l * 3 + cls) * 6144 + which * 1024); }
__device__ __forceinline__ void seq_info(int s, int& start, int& T) { if (s < 32) { start = s * TP; T = TP; } else { start = NPTOK + (s - 32) * TS; T = TS; } }
__device__ __forceinline__ void tok_info(int tok, int& s, int& t, int& T, int& start) {
    if (tok < NPTOK) { s = tok >> 8; t = tok & 255; T = TP; start = s * TP; } else { int r = tok - NPTOK; s = 32 + (r >> 10); t = r & 1023; T = TS; start = NPTOK + ((r >> 10) << 10); }
}

#define P0_MOD 192
#define P0_TILES_L 3136
struct P0Tile { const float* src; bf16_t* dst; int srcN, K, n0, k0, mode, scol; };
__device__ __forceinline__ P0Tile p0_decode(const P& p, int it) {
    P0Tile t; const int l = it / P0_TILES_L; it %= P0_TILES_L; int ntile, ktile; t.mode = 0; t.scol = 0;
    if (it < 768) { ntile = it / 16; ktile = it % 16; t.K = 1024; t.srcN = D_IN; t.src = p.w_in + (size_t)l * 1024 * D_IN; t.dst = (bf16_t*)(p.ws + WS_WIN) + (size_t)l * N1 * 1024;
        t.n0 = ntile * 64;
        if (t.n0 < C_FNET) { t.scol = 1344 + t.n0; } else if (t.n0 < C_RWKV) { t.mode = 1 + ((t.n0 - C_FNET) / 64) % 2; t.scol = 2496 + ((t.n0 - C_FNET) / 128) * 64; } else if (t.n0 < C_END) { t.scol = t.n0 - C_RWKV; } else t.mode = 3; }
    else if (it < 1024) { it -= 768; ntile = it / 16; ktile = it % 16; t.K = 1024; t.srcN = 1024; t.src = p.w_out + (size_t)l * 1024 * 1024; t.dst = (bf16_t*)(p.ws + WS_WOUT) + (size_t)l * 1024 * 1024; t.n0 = ntile * 64; t.scol = t.n0; }
    else if (it < 2432) { it -= 1024; ntile = it / 16; ktile = it % 16; t.K = 1024; t.srcN = 5632; t.src = p.w_ffn_in + (size_t)l * 1024 * 5632; t.dst = (bf16_t*)(p.ws + WS_WF1) + (size_t)l * 5632 * 1024; t.n0 = ntile * 64;
        const int pn = ntile >> 2, sub = ntile & 3; t.scol = (sub < 2) ? (128 * pn + 64 * sub) : (2816 + 128 * pn + 64 * (sub - 2)); }
    else { it -= 2432; ntile = it / 44; ktile = it % 44; t.K = 2816; t.srcN = 1024; t.src = p.w_ffn_out + (size_t)l * 2816 * 1024; t.dst = (bf16_t*)(p.ws + WS_WF2) + (size_t)l * 1024 * 2816; t.n0 = ntile * 64; t.scol = t.n0; }
    t.k0 = ktile * 64;
    return t;
}
#define P0_TGROUPS 1568
__device__ __forceinline__ void ph_prep0(const P& p, float* sm) {
    const int tid = otid();
    const int nitems = P0_MOD + P0_TGROUPS + 1280 + 10;
    for (int item = blockIdx.x; item < nitems; item += gridDim.x) {
        __syncthreads();
        if (item < P0_MOD) {
            const int l = item / 96, cg = item % 96, c4 = tid & 15, ks = tid >> 4;
            const float* W = p.w_mod + (size_t)l * 1024 * 6144 + cg * 64 + c4 * 4;
            float* sl = sm + 6144;
            for (int e = tid; e < 3072; e += blockDim.x) { const int cls = e >> 10, k = e & 1023; const float c = cls == 0 ? p.c_ctx[k] : p.c[(cls - 1) * 1024 + k]; sl[e] = c * sigmoidf_(c); }
            __syncthreads();
            float4 a0 = make_float4(0.f, 0.f, 0.f, 0.f), a1 = a0, a2 = a0;
#pragma unroll 8
            for (int k = ks * 32; k < ks * 32 + 32; ++k) {
                const float4 w = *(const float4*)(W + (size_t)k * 6144);
                const float s0 = sl[k], s1 = sl[1024 + k], s2 = sl[2048 + k];
                a0.x += s0 * w.x; a0.y += s0 * w.y; a0.z += s0 * w.z; a0.w += s0 * w.w;
                a1.x += s1 * w.x; a1.y += s1 * w.y; a1.z += s1 * w.z; a1.w += s1 * w.w;
                a2.x += s2 * w.x; a2.y += s2 * w.y; a2.z += s2 * w.z; a2.w += s2 * w.w;
            }
            *(float4*)(sm + (ks * 3 + 0) * 64 + c4 * 4) = a0; *(float4*)(sm + (ks * 3 + 1) * 64 + c4 * 4) = a1; *(float4*)(sm + (ks * 3 + 2) * 64 + c4 * 4) = a2;
            __syncthreads();
            if (tid < 192) {
                const int cls = tid >> 6, cc = tid & 63; float s = 0.f;
                for (int k = 0; k < 32; ++k) s += sm[(k * 3 + cls) * 64 + cc];
                const int colo = cg * 64 + cc;
                ((float*)(p.ws + WS_MOD))[(size_t)(l * 3 + cls) * 6144 + colo] = s + p.b_mod[(size_t)l * 6144 + colo];
            }
        } else if (item < P0_MOD + P0_TGROUPS) {
            int gi = item - P0_MOD; const int gl = gi / 784; gi %= 784;
            int base, nK; if (gi < 192) { base = 0; nK = 16; } else if (gi < 256) { gi -= 192; base = 768; nK = 16; } else if (gi < 608) { gi -= 256; base = 1024; nK = 16; } else { gi -= 608; base = 2432; nK = 44; }
            const int ng = gi / nK, kt = gi % nK;
#define P0_ITEM(u) (gl * P0_TILES_L + base + (ng * 4 + (u)) * nK + kt)
            float* cs = sm + 4 * 64 * 65;
            if (tid < 64) { cs[tid] = cospif((float)tid / 32.f); cs[64 + tid] = sinpif((float)tid / 32.f); }
#pragma unroll
            for (int u = 0; u < 4; ++u) {
                const P0Tile t = p0_decode(p, P0_ITEM(u)); float* tile = sm + u * 64 * 65;
                if (t.mode != 3) {
#pragma unroll
                    for (int i = 0; i < 2; ++i) { const int k = i * 32 + (tid >> 4), n4 = (tid & 15) * 4;
                        const float4 v = *(const float4*)(t.src + (size_t)(t.k0 + k) * t.srcN + t.scol + n4);
                        tile[k * 65 + n4] = v.x; tile[k * 65 + n4 + 1] = v.y; tile[k * 65 + n4 + 2] = v.z; tile[k * 65 + n4 + 3] = v.w; }
                }
            }
            __syncthreads();
#pragma unroll 1
            for (int u = 0; u < 4; ++u) {
                const P0Tile t = p0_decode(p, P0_ITEM(u)); const float* tile = sm + u * 64 * 65;
                const int n = tid >> 3, k8 = (tid & 7) * 8;
                float v[8];
                if (t.mode == 0) {
#pragma unroll
                    for (int j = 0; j < 8; ++j) v[j] = tile[(k8 + j) * 65 + n];
                } else if (t.mode == 3) {
#pragma unroll
                    for (int j = 0; j < 8; ++j) v[j] = 0.f;
                } else {
#pragma unroll
                    for (int j = 0; j < 8; ++j) v[j] = 0.f;
                    for (int cc = 0; cc < 64; ++cc) {
                        const int idx = (n * cc) & 63;
                        const float tr = (t.mode == 1) ? cs[idx] * 0.125f : -cs[64 + idx] * 0.125f;
#pragma unroll
                        for (int j = 0; j < 8; ++j) v[j] += tile[(k8 + j) * 65 + cc] * tr;
                    }
                }
                uint4 o;
                o.x = pk_bf16(v[0], v[1]); o.y = pk_bf16(v[2], v[3]);
                o.z = pk_bf16(v[4], v[5]); o.w = pk_bf16(v[6], v[7]);
                *(uint4*)(t.dst + (size_t)(t.n0 + n) * t.K + t.k0 + k8) = o;
            }
        } else if (item >= P0_MOD + P0_TGROUPS + 1280) {
            const int it = item - (P0_MOD + P0_TGROUPS + 1280), l = it / 5, kind = it % 5, K = kind == 4 ? 64 : 32;
            const float* src = kind == 4 ? p.gate_up + (size_t)l * 64 * 384 : ((kind >> 1) ? p.iclr_up : p.decay_up) + (size_t)((l * 2 + (kind & 1)) * 32) * 384;
            bf16_t* dst = (bf16_t*)(p.ws + WS_WLT) + (size_t)l * WLT_L + kind * 12288;
            for (int e = tid; e < 384 * K; e += blockDim.x) { const int n = e % 384, k = e / 384; dst[n * K + k] = f2bf(src[(size_t)k * 384 + n]); }
        } else {
            const int r = item - (P0_MOD + P0_TGROUPS);
            const int T = r < 256 ? 256 : 1024, ft = r < 256 ? r : r - 256;
            bf16_t* L = r < 256 ? (bf16_t*)(p.ws + WS_L256) + (size_t)ft * 512 : (bf16_t*)(p.ws + WS_L1024) + (size_t)ft * 2048;
            const float sc = r < 256 ? 0.0625f : 0.03125f;
            for (int k = tid; k < 2 * T; k += blockDim.x) {
                const int t = k & (T - 1), idx = (ft * t) & (T - 1);
                const float ang = (float)(2 * idx) / (float)T;
                L[k] = f2bf((k < T ? cospif(ang) : sinpif(ang)) * sc);
            }
        }
    }
}

__device__ __forceinline__ void ph_prep0b(const P& p) {
    const int tid_ = otid(); const int lane = tid_ & 63, wv = tid_ >> 6, nw = blockDim.x >> 6;
#pragma unroll 1
    for (int grp = 0; grp < 4; ++grp) {
        const int l = grp & 1, isf = grp >> 1, N = isf ? 5632 : 3072, which = isf ? 3 : 0;
        const bf16_t* Wb = isf ? (const bf16_t*)(p.ws + WS_WF1) + (size_t)l * 5632 * 1024 : (const bf16_t*)(p.ws + WS_WIN) + (size_t)l * N1 * 1024;
        float* outb = (float*)(p.ws + WS_BIAS) + (isf ? 2 * 3 * 3072 + (size_t)(l * 3) * 5632 : (size_t)(l * 3) * 3072);
        float sh[3][16];
#pragma unroll
        for (int c = 0; c < 3; ++c) { const float* sp = mod_vec(p, l, c, which) + lane * 16;
#pragma unroll
            for (int e = 0; e < 4; ++e) { const float4 v = *(const float4*)(sp + 4 * e); sh[c][4 * e] = v.x; sh[c][4 * e + 1] = v.y; sh[c][4 * e + 2] = v.z; sh[c][4 * e + 3] = v.w; } }
#pragma unroll 2
        for (int n = blockIdx.x * nw + wv; n < N; n += gridDim.x * nw) {
            const bf16_t* W = Wb + (size_t)n * 1024;
            const uint4 w0 = *(const uint4*)(W + lane * 16), w1 = *(const uint4*)(W + lane * 16 + 8);
            const unsigned ww[8] = {w0.x, w0.y, w0.z, w0.w, w1.x, w1.y, w1.z, w1.w};
            float acc[3] = {0.f, 0.f, 0.f};
#pragma unroll
            for (int c = 0; c < 3; ++c)
#pragma unroll
                for (int e = 0; e < 8; ++e) acc[c] += sh[c][2 * e] * bf2f((bf16_t)(ww[e] & 0xffff)) + sh[c][2 * e + 1] * bf2f((bf16_t)(ww[e] >> 16));
#pragma unroll
            for (int c = 0; c < 3; ++c) { const float t = wave_sum(acc[c]); if (lane == 0) outb[(size_t)c * N + n] = t; }
        }
    }
    float* rsq0 = (float*)(p.ws + WS_RSQ);
    for (int row = blockIdx.x * nw + wv; row < NTOK; row += gridDim.x * nw) {
        const float* xr = xin_row(p, row);
        float4 x[4]; float ss = 0.f;
#pragma unroll
        for (int i = 0; i < 4; ++i) { x[i] = *(const float4*)(xr + i * 256 + lane * 4); ss += x[i].x * x[i].x + x[i].y * x[i].y + x[i].z * x[i].z + x[i].w * x[i].w; }
        ss = wave_sum(ss);
        if (lane == 0) rsq0[row] = ss;
        const float* sc = mod_vec(p, 0, tok_cls(row), 1);
        bf16_t* h = (bf16_t*)(p.ws + WS_H) + (size_t)row * 1024;
#pragma unroll
        for (int i = 0; i < 4; ++i) { const int c = i * 256 + lane * 4;
            const float4 gg = *(const float4*)(p.norm1_g + c), s1 = *(const float4*)(sc + c);
            uint2 o; o.x = pk_bf16(x[i].x * gg.x * (1.f + s1.x), x[i].y * gg.y * (1.f + s1.y));
            o.y = pk_bf16(x[i].z * gg.z * (1.f + s1.z), x[i].w * gg.w * (1.f + s1.w));
            *(uint2*)(h + c) = o; }
    }
}

__device__ __forceinline__ void ph_norm(const P& p, int l, int which) {
    const int tid_ = otid(); const int lane = tid_ & 63, wv = tid_ >> 6, nw = blockDim.x >> 6;
    for (int row = blockIdx.x * nw + wv; row < NTOK; row += gridDim.x * nw) {
        const float* xr = (which == 0 && l == 0) ? xin_row(p, row) : X_row(p, row);
        float4 x[4]; float ss = 0.f;
#pragma unroll
        for (int i = 0; i < 4; ++i) { x[i] = *(const float4*)(xr + i * 256 + lane * 4); ss += x[i].x * x[i].x + x[i].y * x[i].y + x[i].z * x[i].z + x[i].w * x[i].w; }
        ss = wave_sum(ss);
        const float rstd = rsqrtf(ss * (1.f / 1024.f) + 1e-6f);
        if (which == 2) {
            float* o = p.out + (size_t)row * 1024;
#pragma unroll
            for (int i = 0; i < 4; ++i) { const float4 g = *(const float4*)(p.final_g + i * 256 + lane * 4);
                float4 y; y.x = x[i].x * rstd * g.x; y.y = x[i].y * rstd * g.y; y.z = x[i].z * rstd * g.z; y.w = x[i].w * rstd * g.w;
                *(float4*)(o + i * 256 + lane * 4) = y; }
        } else {
            const int cls = tok_cls(row);
            const float* g = (which == 0 ? p.norm1_g : p.norm2_g) + (size_t)l * 1024;
            const float* sh = mod_vec(p, l, cls, which == 0 ? 0 : 3);
            const float* sc = mod_vec(p, l, cls, which == 0 ? 1 : 4);
            bf16_t* h = (bf16_t*)(p.ws + WS_H) + (size_t)row * 1024;
#pragma unroll
            for (int i = 0; i < 4; ++i) { const int c = i * 256 + lane * 4;
                const float4 gg = *(const float4*)(g + c), s1 = *(const float4*)(sc + c), s0 = *(const float4*)(sh + c);
                const float y0 = x[i].x * rstd * gg.x * (1.f + s1.x) + s0.x, y1 = x[i].y * rstd * gg.y * (1.f + s1.y) + s0.y;
                const float y2 = x[i].z * rstd * gg.z * (1.f + s1.z) + s0.z, y3 = x[i].w * rstd * gg.w * (1.f + s1.w) + s0.w;
                uint2 o; o.x = pk_bf16(y0, y1); o.y = pk_bf16(y2, y3);
                *(uint2*)(h + c) = o; }
        }
    }
}

struct EpiG1 {
    int l;
    __device__ __forceinline__ void operator()(const P& p, int row, int col, const float* v) const {
        if (col < C_FNET) {
            bf16_t* o = (bf16_t*)(p.ws + WS_UD) + (size_t)row * 1152 + col;
            uint2 w; w.x = pk_bf16(v[0], v[1]); w.y = pk_bf16(v[2], v[3]);
            *(uint2*)o = w;
            if (row < NPTOK && col >= 384) {
                const int b = row >> 8, t = row & 255;
                float* dst = p.out + (col < 768 ? OUT_CK : OUT_CV) + ((size_t)(b * 2 + l) * 256 + t) * 384 + (col < 768 ? col - 384 : col - 768);
                *(float4*)dst = make_float4(v[0], v[1], v[2], v[3]);
            }
        } else if (col < C_RWKV) {
            const int cc = col - C_FNET, g = cc >> 7, half = (cc >> 6) & 1, fc = cc & 63;
            bf16_t* o;
            if (row < NPTOK) { const int sq = row >> 8, t = row & 255; o = (bf16_t*)(p.ws + WS_ZF) + ((size_t)(sq * 256 + g * 64 + fc) * 512 + half * 256 + t);
                o[0] = f2bf(v[0]); o[512] = f2bf(v[1]); o[1024] = f2bf(v[2]); o[1536] = f2bf(v[3]); }
            else { const int r = row - NPTOK, b = r >> 10, t = r & 1023; o = (bf16_t*)(p.ws + WS_ZF) + (size_t)8192 * 512 + ((size_t)(b * 256 + g * 64 + fc) * 2048 + half * 1024 + t);
                o[0] = f2bf(v[0]); o[2048] = f2bf(v[1]); o[4096] = f2bf(v[2]); o[6144] = f2bf(v[3]); }
        } else if (col < C_END) {
            bf16_t* o = (bf16_t*)(p.ws + WS_UR) + (size_t)row * N_RWKV + (col - C_RWKV);
            uint2 w; w.x = pk_bf16(v[0], v[1]); w.y = pk_bf16(v[2], v[3]);
            *(uint2*)o = w;
        }
    }
};
struct EpiRes {
    int l, which;
    __device__ __forceinline__ void operator()(const P& p, int row, int col, const float* v) const {
        const float* g = mod_vec(p, l, tok_cls(row), which) + col;
        const float* xo = (which == 2 && l == 0) ? xin_row(p, row) + col : X_row(p, row) + col;
        const float4 x = *(const float4*)xo; const float4 gg = *(const float4*)g;
        *(float4*)(X_row(p, row) + col) = make_float4(x.x + gg.x * v[0], x.y + gg.y * v[1], x.z + gg.z * v[2], x.w + gg.w * v[3]);
    }
};

#define PR_TT 40
#define PR_LS 200
typedef short bf16x8p __attribute__((ext_vector_type(8)));
typedef float f32x4p __attribute__((ext_vector_type(4)));
#define PR_ROWB 2688
__device__ __forceinline__ void ph_prep(const P& p, int l, float* sm) {
    const int tid = otid(), lane = tid & 63, wv = tid >> 6;
    const bf16_t* UR = (const bf16_t*)(p.ws + WS_UR);
    unsigned char* lb = (unsigned char*)sm;
    bf16_t* urt = (bf16_t*)lb;
    bf16_t* linb = (bf16_t*)(lb + 42 * PR_ROWB);
    const float* mu0 = p.shift_mu + (size_t)l * 2 * N_RWKV; const float* mu1 = mu0 + N_RWKV;
#if PROBE_ID
    unsigned long long* tsp = (unsigned long long*)(p.ws + WS_CTL + 15360) + 32;
#define PSTAMP(i) do { __syncthreads(); if (blockIdx.x == 0 && tid == 0 && l == 0) tsp[i] = __builtin_amdgcn_s_memrealtime(); } while (0)
#else
#define PSTAMP(i)
#endif
    PSTAMP(0);
    for (int tile = blockIdx.x; tile < NTOK / PR_TT; tile += gridDim.x) {
        const int tok0 = tile * PR_TT;
        __syncthreads();
        for (int e = tid; e < 42 * 168; e += blockDim.x) {
            const int r = e / 168, c = e % 168, tok = tok0 - 1 + r;
            uint4 v = make_uint4(0u, 0u, 0u, 0u);
            if (tok >= 0 && tok < NTOK) v = *(const uint4*)((const unsigned char*)UR + (size_t)tok * PR_ROWB + c * 16);
            *(uint4*)(lb + r * PR_ROWB + c * 16) = v;
        }
        __syncthreads();
        for (int e = tid; e < 48 * 192; e += blockDim.x) {
            const int tk = e / 192, j = e % 192, col = 1152 + j;
            float x = 0.f;
            if (tk < PR_TT) {
                int s, t, T, st; tok_info(tok0 + tk, s, t, T, st);
                const float xc = bf2f(urt[(tk + 1) * 1344 + col]);
                const float xp = t > 0 ? bf2f(urt[tk * 1344 + col]) : 0.f;
                const float xn = t < T - 1 ? bf2f(urt[(tk + 2) * 1344 + col]) : 0.f;
                x = xc + mu0[col] * (xp - xc) + mu1[col] * (xn - xc);
                if (j < 64) x = tanhf(x); else if (j >= 128) x = sigmoidf_(x);
            }
            linb[tk * PR_LS + j] = f2bf(x);
        }
        __syncthreads();
        PSTAMP(1);
        {
            const int n = lane & 15, kg = lane >> 4;
            const bf16_t* WLT = (const bf16_t*)(p.ws + WS_WLT) + (size_t)l * WLT_L;
#pragma unroll 3
            for (int combo = wv; combo < 120; combo += 8) {
                const int kind = combo / 24, nt = combo % 24, ch = nt * 16 + n, h = ch >> 6, cl = ch & 63;
                const int K = kind == 4 ? 64 : 32, loff = kind == 4 ? 128 : (kind >> 1) * 64 + (kind & 1) * 32;
                const bf16_t* wrow = WLT + kind * 12288 + (size_t)ch * K + 8 * kg;
                const bf16x8p b0 = *(const bf16x8p*)wrow;
                bf16x8p b1 = b0; if (kind == 4) b1 = *(const bf16x8p*)(wrow + 32);
                float bias = 0.f;
                if (kind < 4) bias = ((kind >> 1) ? p.iclr_a0 : p.decay_w0)[(size_t)(l * 2 + (kind & 1)) * 384 + ch];
#pragma unroll
                for (int mt = 0; mt < 3; ++mt) {
                    f32x4p acc = {bias, bias, bias, bias};
                    const bf16x8p a0 = *(const bf16x8p*)(linb + (mt * 16 + n) * PR_LS + loff + 8 * kg);
                    acc = __builtin_amdgcn_mfma_f32_16x16x32_bf16(a0, b0, acc, 0, 0, 0);
                    if (kind == 4) { const bf16x8p a1 = *(const bf16x8p*)(linb + (mt * 16 + n) * PR_LS + loff + 32 + 8 * kg); acc = __builtin_amdgcn_mfma_f32_16x16x32_bf16(a1, b1, acc, 0, 0, 0); }
#pragma unroll
                    for (int r = 0; r < 4; ++r) {
                        const int tk = mt * 16 + kg * 4 + r;
                        if (tk < PR_TT) {
                            unsigned char* rec = p.ws + WS_OPS + (size_t)(tok0 + tk) * OPS_TOK + (size_t)h * OPS_REC;
                            if (kind == 4) ((bf16_t*)(rec + 1280))[192 + cl] = f2bf(acc[r]);
                            else { const float sg = sigmoidf_(acc[r]); ((float*)rec)[64 + (kind >> 1) * 128 + (kind & 1) * 64 + cl] = (kind >> 1) ? sg : __expf(-0.60653065971263342f * sg); }
                        }
                    }
                }
            }
        }
#if PROBE_ID
        if (blockIdx.x == 0 && tid == 0 && l == 0) tsp[2] = __builtin_amdgcn_s_memrealtime();
#endif
        {
#pragma unroll 2
            for (int pr = wv; pr < PR_TT * NH; pr += 8) {
                const int tk = pr / NH, h = pr % NH, ch = h * 64 + lane, tok = tok0 + tk; int s, t, T, st; tok_info(tok, s, t, T, st);
                float rkv[3];
#pragma unroll
                for (int q = 0; q < 3; ++q) { const int col = q * 384 + ch;
                    const float xc = bf2f(urt[(tk + 1) * 1344 + col]);
                    const float xp = t > 0 ? bf2f(urt[tk * 1344 + col]) : 0.f;
                    const float xn = t < T - 1 ? bf2f(urt[(tk + 2) * 1344 + col]) : 0.f;
                    rkv[q] = xc + mu0[col] * (xp - xc) + mu1[col] * (xn - xc); }
                const float kkr = rkv[1] * p.k_k[(size_t)l * 384 + ch];
                const float nrm = sqrtf(wave_sum(kkr * kkr));
                const float kk = kkr / fmaxf(nrm, 1e-12f);
                unsigned char* rec = p.ws + WS_OPS + (size_t)tok * OPS_TOK + (size_t)h * OPS_REC;
                ((float*)rec)[lane] = -kk;
                bf16_t* rb = (bf16_t*)(rec + 1280);
                rb[lane] = f2bf(rkv[0]); rb[64 + lane] = f2bf(rkv[2]); rb[128 + lane] = f2bf(rkv[1]);
            }
        }
    }
    PSTAMP(3);
    bf16_t* UD = (bf16_t*)(p.ws + WS_UD);
    for (int e = blockIdx.x * blockDim.x + tid; e < 2048 * 384; e += gridDim.x * blockDim.x) {
        const int tk = e / 384, pi = e % 384;
        const int grp = pi >> 3, pr = pi & 7, col = grp * 16 + pr;
        const int axis = grp & 1;
        const int t = tk & 1023, pos = axis == 0 ? (t >> 6) : (t & 63);
        const float inv = __powf(10000.f, -(float)pr / 8.f);
        float sn, cs; __sincosf((float)pos * inv, &sn, &cs);
        bf16_t* ptr = UD + (size_t)(NPTOK + tk) * 1152 + col;
        const float x1 = bf2f(ptr[0]), x2 = bf2f(ptr[8]);
        ptr[0] = f2bf(x1 * cs - x2 * sn); ptr[8] = f2bf(x2 * cs + x1 * sn);
    }
    PSTAMP(4);
}

#define SC_TC 32
template <int CTRL> __device__ __forceinline__ float dpp_add(float x) {
    return x + __builtin_bit_cast(float, __builtin_amdgcn_update_dpp(0, __builtin_bit_cast(int, x), CTRL, 0xf, 0xf, false));
}
#define SJ_RT   0
#define SJ_AT   4608
#define SJ_ZT   9216
#define SJ_ZPT  18432
#define SJ_WT   27648
#define SJ_S    36864
#define SJ_LAB  54272
#define SJ_LAKB 58880
#define SJ_MRB  61440
#define SJ_HB   66048
#define SJ_PC   74752
#define SJ_BYTES 75008
typedef float f32x4s __attribute__((ext_vector_type(4)));
typedef short bf16x8s __attribute__((ext_vector_type(8)));
#define MFMAB(a, b, c) __builtin_amdgcn_mfma_f32_16x16x32_bf16((a), (b), (c), 0, 0, 0)
struct ScanStage { float nkk[8], w[8], a[8]; bf16_t r[8], v[8], k[8]; };
__device__ __forceinline__ void scan_load(const P& p, int h, int dir, int T, int start, int st_base, int ht, ScanStage& g) {
    const int k = 16 * (ht >> 6) + ((ht & 63) >> 2), seg = ht & 3;
#pragma unroll
    for (int j = 0; j < 8; ++j) {
        const int st = st_base + 8 * seg + j, t = dir == 0 ? st : T - 1 - st, tok = start + t;
        const unsigned char* rec = p.ws + WS_OPS + (size_t)tok * OPS_TOK + (size_t)h * OPS_REC;
        const float* rf = (const float*)rec; const bf16_t* rb = (const bf16_t*)(rec + 1280);
        g.nkk[j] = rf[k]; g.w[j] = rf[64 + dir * 64 + k]; g.a[j] = rf[192 + dir * 64 + k];
        g.r[j] = rb[k]; g.v[j] = rb[64 + k]; g.k[j] = rb[128 + k];
    }
}
__device__ __forceinline__ void scan_store(const ScanStage& g, float ka, float vmul, int ht, unsigned char* J) {
    const int k = 16 * (ht >> 6) + ((ht & 63) >> 2), seg = ht & 3;
    float cp[9]; cp[0] = 1.f;
#pragma unroll
    for (int j = 0; j < 8; ++j) cp[j + 1] = cp[j] * g.w[j];
    const int ci = __builtin_bit_cast(int, cp[8]);
    const float T0 = __builtin_bit_cast(float, __builtin_amdgcn_mov_dpp(ci, 0x00, 0xf, 0xf, true)), T1 = __builtin_bit_cast(float, __builtin_amdgcn_mov_dpp(ci, 0x55, 0xf, 0xf, true)),
                T2 = __builtin_bit_cast(float, __builtin_amdgcn_mov_dpp(ci, 0xAA, 0xf, 0xf, true)), T3 = __builtin_bit_cast(float, __builtin_amdgcn_mov_dpp(ci, 0xFF, 0xf, 0xf, true));
    const float pre = seg == 0 ? 1.f : (seg == 1 ? T0 : (seg == 2 ? T0 * T1 : T0 * T1 * T2));
    const float PCk = T0 * T1 * T2 * T3;
    bf16_t* RT = (bf16_t*)(J + SJ_RT); bf16_t* AT = (bf16_t*)(J + SJ_AT); bf16_t* ZT = (bf16_t*)(J + SJ_ZT); bf16_t* ZPT = (bf16_t*)(J + SJ_ZPT); bf16_t* WT = (bf16_t*)(J + SJ_WT);
#pragma unroll
    for (int j = 0; j < 8; ++j) {
        const int t = 8 * seg + j;
        const float Pm = pre * cp[j], Pt = pre * cp[j + 1], inv = __builtin_amdgcn_rcpf(Pt), kk = bf2f(g.k[j]);
        const float bt = -g.nkk[j] * g.a[j] * inv, kt = kk * (1.f + (g.a[j] - 1.f) * ka) * inv;
        RT[t * 72 + k] = f2bf(bf2f(g.r[j]) * Pt); AT[t * 72 + k] = f2bf(g.nkk[j] * Pm);
        ZT[t * 72 + k] = f2bf(bt); ZT[(32 + t) * 72 + k] = f2bf(kt);
        ZPT[k * 72 + t] = f2bf(bt * PCk); ZPT[k * 72 + 32 + t] = f2bf(kt * PCk);
        WT[k * 72 + 32 + t] = f2bf(bf2f(g.v[j]) * vmul);
    }
    if (seg == 0) ((float*)(J + SJ_PC))[k] = PCk;
}
__device__ __forceinline__ bf16x8s lds_b8(const unsigned char* p) { return *(const bf16x8s*)p; }
__device__ __forceinline__ void ph_scan_job(const P& p, int l, int s, int h, int mode, int pdir, int seg, int st0, int nsteps, float* sm) {
    const int tid = otid(), half = tid >> 8, ht = tid & 255, wq = ht >> 6, lane = ht & 63, l15 = lane & 15, l4 = lane >> 4;
    const int dir = mode == 0 ? half : pdir, kind = mode == 0 ? 0 : 1 + half;
    int start, T; seq_info(s, start, T);
    unsigned char* J = (unsigned char*)sm + half * SJ_BYTES;
    float* S = (float*)(J + SJ_S); float* LAB = (float*)(J + SJ_LAB); float* HB = (float*)(J + SJ_HB); const float* PC = (const float*)(J + SJ_PC);
    bf16_t* WT = (bf16_t*)(J + SJ_WT); bf16_t* LAKB = (bf16_t*)(J + SJ_LAKB); bf16_t* MRB = (bf16_t*)(J + SJ_MRB);
    const float vmul = kind == 1 ? 0.f : 1.f;
    float* ybase = kind == 1 ? (float*)(p.ws + WS_ZS) + ((ptrdiff_t)dir * 2048 - (ptrdiff_t)NPTOK) * 384 : (float*)(p.ws + WS_UR) + (size_t)dir * NTOK * 384;
    ybase += h * 64 + 16 * wq + l15;
    const float ka = p.k_a[(size_t)l * 384 + h * 64 + 16 * wq + (lane >> 2)];
    const int nc = nsteps / SC_TC;
    ScanStage g;
    __syncthreads();
    {
        const float* s0 = (kind == 0 && s >= 32) ? p.state_rwkv + ((((size_t)(s - 32) * 2 + l) * 2 + dir) * NH + h) * 4096 : nullptr;
        for (int e = ht; e < 4096; e += 256) { const int v = e >> 6, k = e & 63; S[v * 68 + k] = s0 ? s0[e] : (kind == 1 && v == k ? 1.f : 0.f); }
    }
    scan_load(p, h, dir, T, start, st0, ht, g);
    scan_store(g, ka, vmul, ht, J);
    __syncthreads();
    for (int c = 0; c < nc; ++c) {
        if (c + 1 < nc) scan_load(p, h, dir, T, start, st0 + (c + 1) * SC_TC, ht, g);
        f32x4s accG[2], accY[2];
#pragma unroll
        for (int tt = 0; tt < 2; ++tt) { accG[tt] = (f32x4s){0.f, 0.f, 0.f, 0.f}; accY[tt] = accG[tt]; }
#pragma unroll
        for (int ks = 0; ks < 2; ++ks) {
            const float4 s0 = *(const float4*)(S + (16 * wq + l15) * 68 + 32 * ks + 8 * l4), s1 = *(const float4*)(S + (16 * wq + l15) * 68 + 32 * ks + 8 * l4 + 4);
            const float sv[8] = {s0.x, s0.y, s0.z, s0.w, s1.x, s1.y, s1.z, s1.w};
            union { unsigned u[4]; bf16x8s v; } hi, lo;
#pragma unroll
            for (int e = 0; e < 4; ++e) {
                const float h0 = bf2f(f2bf(sv[2 * e])), h1 = bf2f(f2bf(sv[2 * e + 1]));
                hi.u[e] = pk_bf16(sv[2 * e], sv[2 * e + 1]); lo.u[e] = pk_bf16(sv[2 * e] - h0, sv[2 * e + 1] - h1);
            }
#pragma unroll
            for (int tt = 0; tt < 2; ++tt) {
                const bf16x8s a = lds_b8(J + SJ_AT + (16 * tt + l15) * 144 + 64 * ks + 16 * l4), r = lds_b8(J + SJ_RT + (16 * tt + l15) * 144 + 64 * ks + 16 * l4);
                accG[tt] = MFMAB(a, hi.v, accG[tt]); accG[tt] = MFMAB(a, lo.v, accG[tt]);
                accY[tt] = MFMAB(r, hi.v, accY[tt]); accY[tt] = MFMAB(r, lo.v, accY[tt]);
            }
        }
        {
            const int xoff = wq < 2 ? SJ_AT + (16 * wq + l15) * 144 : SJ_RT + (16 * (wq - 2) + l15) * 144;
            const bf16x8s xa0 = lds_b8(J + xoff + 16 * l4), xa1 = lds_b8(J + xoff + 64 + 16 * l4);
#pragma unroll
            for (int zt = 0; zt < 4; ++zt) {
                f32x4s m = {0.f, 0.f, 0.f, 0.f};
                m = MFMAB(xa0, lds_b8(J + SJ_ZT + (16 * zt + l15) * 144 + 16 * l4), m);
                m = MFMAB(xa1, lds_b8(J + SJ_ZT + (16 * zt + l15) * 144 + 64 + 16 * l4), m);
#pragma unroll
                for (int r = 0; r < 4; ++r) {
                    const int t = (16 * wq + 4 * l4 + r) & 31, i = (16 * zt + l15) & 31;
                    if (wq < 2) { const float val = i < t ? m[r] : 0.f; if (zt < 2) LAB[t * 36 + i] = val; else LAKB[t * 40 + i] = f2bf(val); }
                    else MRB[t * 72 + 16 * zt + l15] = f2bf(i <= t ? m[r] : 0.f);
                }
            }
        }
        __syncthreads();
        {
            const bf16x8s vb = lds_b8(J + SJ_WT + (16 * wq + l15) * 144 + 64 + 16 * l4);
#pragma unroll
            for (int tt = 0; tt < 2; ++tt) {
                accG[tt] = MFMAB(lds_b8(J + SJ_LAKB + (16 * tt + l15) * 80 + 16 * l4), vb, accG[tt]);
#pragma unroll
                for (int r = 0; r < 4; ++r) HB[(16 * tt + 4 * l4 + r) * 68 + 16 * wq + l15] = accG[tt][r];
            }
        }
        asm volatile("s_waitcnt lgkmcnt(0)" ::: "memory");
        {
            const int vloc = lane >> 2, part = lane & 3, v = 16 * wq + vloc;
            float um[8];
#pragma unroll
            for (int j = 0; j < 8; ++j) um[j] = 0.f;
#pragma unroll
            for (int tb = 0; tb < 4; ++tb) {
                float lab[8][8], hb[8];
#pragma unroll
                for (int q = 0; q < 8; ++q) { const int t = 8 * tb + q; hb[q] = HB[t * 68 + v];
#pragma unroll
                    for (int j = 0; j < 8; ++j) lab[q][j] = (4 * j < t) ? LAB[t * 36 + 4 * j + part] : 0.f; }
#pragma unroll
                for (int q = 0; q < 8; ++q) {
                    const int t = 8 * tb + q;
                    float sacc = 0.f;
#pragma unroll
                    for (int j = 0; j < 8; ++j) if (4 * j < t) sacc += lab[q][j] * um[j];
                    sacc = dpp_add<0xB1>(sacc); sacc = dpp_add<0x4E>(sacc);
                    const float u = hb[q] + sacc;
                    if ((t & 3) == part) um[t >> 2] = u;
                    WT[v * 72 + t] = f2bf(u);
                }
            }
        }
        asm volatile("s_waitcnt lgkmcnt(0)" ::: "memory");
        {
            const bf16x8s w0 = lds_b8(J + SJ_WT + (16 * wq + l15) * 144 + 16 * l4), w1 = lds_b8(J + SJ_WT + (16 * wq + l15) * 144 + 64 + 16 * l4);
#pragma unroll
            for (int tt = 0; tt < 2; ++tt) {
                accY[tt] = MFMAB(lds_b8(J + SJ_MRB + (16 * tt + l15) * 144 + 16 * l4), w0, accY[tt]);
                accY[tt] = MFMAB(lds_b8(J + SJ_MRB + (16 * tt + l15) * 144 + 64 + 16 * l4), w1, accY[tt]);
#pragma unroll
                for (int r = 0; r < 4; ++r) { const int st = st0 + c * SC_TC + 16 * tt + 4 * l4 + r, t = dir == 0 ? st : T - 1 - st; ybase[(size_t)(start + t) * 384] = accY[tt][r]; }
            }
#pragma unroll
            for (int kt = 0; kt < 4; ++kt) {
                const int k = 16 * kt + l15; const float pc = PC[k];
                f32x4s acc;
#pragma unroll
                for (int r = 0; r < 4; ++r) acc[r] = S[(16 * wq + 4 * l4 + r) * 68 + k] * pc;
                acc = MFMAB(w0, lds_b8(J + SJ_ZPT + k * 144 + 16 * l4), acc);
                acc = MFMAB(w1, lds_b8(J + SJ_ZPT + k * 144 + 64 + 16 * l4), acc);
#pragma unroll
                for (int r = 0; r < 4; ++r) S[(16 * wq + 4 * l4 + r) * 68 + k] = acc[r];
            }
        }
        __syncthreads();
        if (c + 1 < nc) { scan_store(g, ka, vmul, ht, J); __syncthreads(); }
    }
    float* so = nullptr;
    if (mode == 0) so = s < 32 ? p.out + OUT_ST + ((((size_t)s * 2 + l) * 2 + dir) * NH + h) * 4096
                              : (float*)(p.ws + WS_SS) + ((size_t)(((s - 32) * NH + h) * 2 + dir) * 3 + 0) * 4096;
    else if (seg == 1) so = (float*)(p.ws + WS_SS) + ((size_t)(((s - 32) * NH + h) * 2 + dir) * 3 + kind) * 4096;
    if (so) for (int e = ht; e < 4096; e += 256) so[e] = S[(e >> 6) * 68 + (e & 63)];
}

#define SEG0_LEN 352
#define SEG1_LEN 352
#define SEG2_LEN 320
#define CTL_SCANDONE 3720
__device__ __forceinline__ void fixup_item(const P& p, int l, int item4, float* sm) {
    const int tid = otid(), lane = tid & 63, wv = tid >> 6;
    {
        const int item = item4 >> 2, qtr = item4 & 3;
        const int b = item / 24, h = (item % 24) >> 2, dir = (item >> 1) & 1, seg = 1 + (item & 1);
        const float* E0 = (const float*)(p.ws + WS_SS) + (size_t)(((b * NH + h) * 2 + dir) * 3) * 4096; const float* P1 = E0 + 4096; const float* Q1 = E0 + 8192;
        if (tid == 0) {
            unsigned* cnt = (unsigned*)(p.ws + WS_CTL) + CTL_SCANDONE + 32 * l + (b * NH + h) * 2 + dir; unsigned sp = 0;
            while (__hip_atomic_load(cnt, __ATOMIC_RELAXED, __HIP_MEMORY_SCOPE_AGENT) < 3u && ++sp < (1u << 24)) __builtin_amdgcn_s_sleep(4);
            __builtin_amdgcn_fence(__ATOMIC_ACQUIRE, "agent");
            asm volatile("s_waitcnt vmcnt(0)" ::: "memory");
        }
        __syncthreads();
        { const int v = tid >> 3, kg = tid & 7;
          float acc[8];
          if (seg == 1) {
#pragma unroll
              for (int j = 0; j < 8; ++j) acc[j] = E0[v * 64 + kg * 8 + j];
          } else {
#pragma unroll
              for (int j = 0; j < 8; ++j) acc[j] = Q1[v * 64 + kg * 8 + j];
#pragma unroll 8
              for (int i = 0; i < 64; ++i) { const float e = E0[v * 64 + i]; const float4 pa = *(const float4*)(P1 + i * 64 + kg * 8), pb = *(const float4*)(P1 + i * 64 + kg * 8 + 4);
                  acc[0] += e * pa.x; acc[1] += e * pa.y; acc[2] += e * pa.z; acc[3] += e * pa.w; acc[4] += e * pb.x; acc[5] += e * pb.y; acc[6] += e * pb.z; acc[7] += e * pb.w; }
          }
#pragma unroll
          for (int j = 0; j < 8; ++j) sm[v * 65 + kg * 8 + j] = acc[j]; }
        __syncthreads();
        float Srow[64];
#pragma unroll
        for (int i = 0; i < 64; ++i) Srow[i] = sm[lane * 65 + i];
        const int qlen = (seg == 1 ? SEG1_LEN : SEG2_LEN) / 4;
        const int st0 = (seg == 1 ? SEG0_LEN : SEG0_LEN + SEG1_LEN) + qtr * qlen;
        const float* Zb = (const float*)(p.ws + WS_ZS) + (size_t)dir * 2048 * 384; float* Yb = (float*)(p.ws + WS_UR) + (size_t)dir * NTOK * 384;
#pragma unroll 1
        for (int q = wv * 4; q < qlen; q += 32) {
            int zi[4]; float yv[4]; float* yp[4]; bool ok[4];
#pragma unroll
            for (int u = 0; u < 4; ++u) {
                ok[u] = (q + u) < qlen;
                const int st = st0 + (ok[u] ? q + u : 0), t = dir ? 1023 - st : st, stok = b * 1024 + t;
                zi[u] = __builtin_bit_cast(int, Zb[(size_t)stok * 384 + h * 64 + lane]);
                yp[u] = Yb + (size_t)(NPTOK + stok) * 384 + h * 64 + lane; yv[u] = *yp[u];
            }
#pragma unroll
            for (int i = 0; i < 64; ++i)
#pragma unroll
                for (int u = 0; u < 4; ++u) yv[u] += Srow[i] * __builtin_bit_cast(float, __builtin_amdgcn_readlane(zi[u], i));
#pragma unroll
            for (int u = 0; u < 4; ++u) if (ok[u]) *yp[u] = yv[u];
        }
    }
}

__device__ __forceinline__ void ph_finalize(const P& p, int l) {
    const int tid_ = otid(); const int lane = tid_ & 63, wv = tid_ >> 6, nw = blockDim.x >> 6;
    const float* Yb = (const float*)(p.ws + WS_UR);
    bf16_t* MIX = (bf16_t*)(p.ws + WS_H);
    for (int it0 = (blockIdx.x * nw + wv) * 8; it0 < NTOK * NH; it0 += gridDim.x * nw * 8) {
        float y[8], a0[8], a1[8], r[8], vv[8], k[8], g[8];
        int tokv[8], chv[8];
#pragma unroll
        for (int u = 0; u < 8; ++u) {
            const int it = it0 + u, tok = it / NH, h = it % NH, ch = h * 64 + lane; tokv[u] = tok; chv[u] = ch;
            y[u] = Yb[(size_t)tok * 384 + ch] + Yb[((size_t)NTOK + tok) * 384 + ch];
            const unsigned char* rec = p.ws + WS_OPS + (size_t)tok * OPS_TOK + (size_t)h * OPS_REC;
            const float* rf = (const float*)rec; const bf16_t* rb = (const bf16_t*)(rec + 1280);
            a0[u] = rf[192 + lane]; a1[u] = rf[256 + lane];
            r[u] = bf2f(rb[lane]); vv[u] = bf2f(rb[64 + lane]); k[u] = bf2f(rb[128 + lane]); g[u] = bf2f(rb[192 + lane]);
        }
        float mu[8], var[8], bs[8];
#pragma unroll
        for (int u = 0; u < 8; ++u) mu[u] = y[u];
#pragma unroll
        for (int o = 1; o < 64; o <<= 1)
#pragma unroll
            for (int u = 0; u < 8; ++u) mu[u] += __shfl_xor(mu[u], o);
#pragma unroll
        for (int u = 0; u < 8; ++u) { mu[u] *= (1.f / 64.f); y[u] -= mu[u]; var[u] = y[u] * y[u];
            const float ka = p.k_a[(size_t)l * 384 + chv[u]];
            bs[u] = r[u] * (k[u] * (1.f + (a0[u] - 1.f) * ka) + k[u] * (1.f + (a1[u] - 1.f) * ka)) * p.r_k[(size_t)l * 384 + chv[u]]; }
#pragma unroll
        for (int o = 1; o < 64; o <<= 1)
#pragma unroll
            for (int u = 0; u < 8; ++u) { var[u] += __shfl_xor(var[u], o); bs[u] += __shfl_xor(bs[u], o); }
#pragma unroll
        for (int u = 0; u < 8; ++u) {
            const float yn = y[u] * rsqrtf(var[u] * (1.f / 64.f) + 64e-5f) * p.lnx_g[(size_t)l * 384 + chv[u]] + p.lnx_b[(size_t)l * 384 + chv[u]];
            MIX[(size_t)tokv[u] * 1024 + chv[u]] = f2bf((yn + bs[u] * vv[u]) * g[u]);
        }
    }
}

#define LAS __attribute__((address_space(3)))
namespace pg8 {
typedef short bf16x8 __attribute__((ext_vector_type(8)));
typedef float f32x4 __attribute__((ext_vector_type(4)));
constexpr int BM = 256, BK = 64, HALF = 128, HTB = HALF * BK * 2, STAGE_BYTES = 8 * HTB, NXCD = 8, WGM = 8;
__host__ __device__ __forceinline__ int lds_byte(int r, int c) { const int st = (r >> 4) * 2 + (c >> 5), rr = r & 15, cc = c & 31, ob = rr * 64 + cc * 2; return st * 1024 + (ob ^ (((ob >> 9) & 1) << 5)); }
__host__ __device__ __forceinline__ void stage_rc(int b, int& R, int& C) { const int st = b / 1024, sb = b % 1024, swz = sb ^ (((sb >> 9) & 1) << 5); R = (st >> 1) * 16 + swz / 64; C = (st & 1) * 32 + (swz % 64) / 2; }
struct Unit { int pm, pn; };
struct Gemm { const bf16_t* A; const bf16_t* Bt; int M, N, K; };
struct StaticOrder {
    int nM, nN, nwg, G, c;
    __device__ void init(int M, int N, int G_, int c_) { nM = M / BM; nN = N / BM; nwg = nM * nN; G = G_; c = c_; }
    __device__ bool next(int i, Unit& u) const {
        const long L = (long)i * G + c; if (L >= nwg) return false;
        int wgid = (int)L; { const int q = nwg / NXCD, r = nwg % NXCD, xcd = wgid % NXCD, off = wgid / NXCD; wgid = (xcd < r ? xcd * (q + 1) : r * (q + 1) + (xcd - r) * q) + off; }
        const int nig = WGM * nN, gid = wgid / nig, fm = gid * WGM, gsz = (nM - fm) < WGM ? (nM - fm) : WGM;
        u.pm = fm + ((wgid % nig) % gsz); u.pn = (wgid % nig) / gsz; return true;
    }
};
template <class Epi, class Sched>
__device__ __forceinline__ void gemm_phase(LAS unsigned char* lds, const Gemm g, const Sched& S, const Epi& E) {
    int tid_ = threadIdx.x; asm volatile("" : "+v"(tid_));
    const int tid = tid_, wid = __builtin_amdgcn_readfirstlane(tid >> 6), lane = tid & 63, wr = wid >> 2, wc = wid & 3, fr = lane & 15, fq = lane >> 4;
    const int K = g.K, nt = K / BK;
    unsigned voffA[2], voffB[2];
#pragma unroll
    for (int i = 0; i < 2; ++i) { int R, C; stage_rc(tid * 16 + i * 8192, R, C);
        const int rho = R & 31, Rb = Epi::PERM ? ((R & ~31) + 8 * ((rho & 15) >> 2) + 4 * (rho >> 4) + (rho & 3)) : R;
        voffA[i] = (unsigned)(R * K + C) * 2u; voffB[i] = (unsigned)(Rb * K + C) * 2u; }
    const size_t kstep = (size_t)(BK * 2);
    const size_t hstep = (size_t)HALF * K * 2;
    const size_t tstep = 2 * hstep;
    const unsigned ldsw = (unsigned)wid * 1024u;
    const int aoff = lds_byte(wr * 64 + fr, fq * 8), boff = lds_byte(wc * 32 + fr, fq * 8);
#define PG8_SA(b, h) (((b) * 2 + (h)) * HTB)
#define PG8_SB(b, h) ((4 + (b) * 2 + (h)) * HTB)
#define PG8_STAGE(bufoff, gbase, voff) do { _Pragma("unroll") for (int _i = 0; _i < 2; ++_i) \
        __builtin_amdgcn_global_load_lds((const unsigned*)((const char*)(gbase) + (voff)[_i]), (LAS unsigned*)(lds + (bufoff) + ldsw + _i * 8192), 16, 0, 0); } while (0)
#define PG8_LDA(dst, b, h) do { _Pragma("unroll") for (int m = 0; m < 4; ++m) _Pragma("unroll") for (int k = 0; k < 2; ++k) dst[m][k] = *(const LAS bf16x8*)(lds + PG8_SA(b, h) + aoff + m * 2048 + k * 1024); } while (0)
#define PG8_LDB(dst, b, h) do { _Pragma("unroll") for (int n = 0; n < 2; ++n) _Pragma("unroll") for (int k = 0; k < 2; ++k) dst[n][k] = *(const LAS bf16x8*)(lds + PG8_SB(b, h) + boff + n * 2048 + k * 1024); } while (0)
#define PG8_MMA(ai, bj, At, Bt) do { __builtin_amdgcn_s_setprio(1); _Pragma("unroll") for (int m = 0; m < 4; ++m) _Pragma("unroll") for (int n = 0; n < 2; ++n) _Pragma("unroll") for (int k = 0; k < 2; ++k) \
        acc[ai][bj][m][n] = __builtin_amdgcn_mfma_f32_16x16x32_bf16(Bt[n][k], At[m][k], acc[ai][bj][m][n], 0, 0, 0); __builtin_amdgcn_s_setprio(0); } while (0)
#define PG8_WAIT_V(n) asm volatile("s_waitcnt vmcnt(" #n ")" ::: "memory")
#define PG8_WAIT_L(n) asm volatile("s_waitcnt lgkmcnt(" #n ")" ::: "memory")
#define PG8_BAR __builtin_amdgcn_s_barrier()
#define PG8_SCHED __builtin_amdgcn_sched_barrier(0)
    Unit cur, nxt; int ui = 0;
    if (!S.next(0, cur)) return;
    f32x4 acc[2][2][4][2];
#pragma unroll
    for (int a = 0; a < 2; ++a)
#pragma unroll
        for (int b = 0; b < 2; ++b)
#pragma unroll
            for (int m = 0; m < 4; ++m)
#pragma unroll
                for (int n = 0; n < 2; ++n) acc[a][b][m][n] = (f32x4){0.f, 0.f, 0.f, 0.f};
    bf16x8 At[4][2], B0[2][2], B1[2][2];
    const char* cA = (const char*)g.A + (size_t)cur.pm * tstep; const char* cB = (const char*)g.Bt + (size_t)cur.pn * tstep;
    PG8_STAGE(PG8_SB(0, 0), cB, voffB); PG8_STAGE(PG8_SA(0, 0), cA, voffA); PG8_STAGE(PG8_SB(0, 1), cB + hstep, voffB); PG8_STAGE(PG8_SA(0, 1), cA + hstep, voffA);
    if (wr == 1) PG8_BAR;
    PG8_WAIT_V(4); PG8_BAR;
    PG8_STAGE(PG8_SB(1, 0), cB + kstep, voffB); PG8_STAGE(PG8_SA(1, 0), cA + kstep, voffA); PG8_STAGE(PG8_SB(1, 1), cB + hstep + kstep, voffB);
    PG8_WAIT_V(6); PG8_BAR;
    for (;;) {
        const bool has_next = S.next(ui + 1, nxt);
        const char* nA = has_next ? (const char*)g.A + (size_t)nxt.pm * tstep : cA; const char* nB = has_next ? (const char*)g.Bt + (size_t)nxt.pn * tstep : cB;
        for (int t = 0; t < nt; t += 2) {
            const bool last = (t == nt - 2);
            const char* a1 = cA + (size_t)(t + 1) * kstep;
            const char* a2 = last ? nA : cA + (size_t)(t + 2) * kstep; const char* b2 = last ? nB : cB + (size_t)(t + 2) * kstep;
            const char* a3 = a2 + kstep; const char* b3 = b2 + kstep;
            PG8_LDB(B0, 0, 0); PG8_SCHED; PG8_LDA(At, 0, 0); PG8_STAGE(PG8_SA(1, 1), a1 + hstep, voffA);
            PG8_WAIT_L(8); PG8_BAR; PG8_WAIT_L(0); PG8_MMA(0, 0, At, B0); PG8_BAR; PG8_SCHED;
            PG8_LDB(B1, 0, 1); PG8_STAGE(PG8_SB(0, 0), b2, voffB);
            PG8_BAR; PG8_WAIT_L(0); PG8_MMA(0, 1, At, B1); PG8_BAR;
            PG8_LDA(At, 0, 1); PG8_STAGE(PG8_SA(0, 0), a2, voffA);
            PG8_BAR; PG8_WAIT_L(0); PG8_MMA(1, 0, At, B0); PG8_BAR; PG8_SCHED;
            PG8_STAGE(PG8_SB(0, 1), b2 + hstep, voffB);
            PG8_WAIT_V(6); PG8_BAR; PG8_MMA(1, 1, At, B1); PG8_BAR;
            PG8_LDB(B0, 1, 0); PG8_SCHED; PG8_LDA(At, 1, 0); PG8_STAGE(PG8_SA(0, 1), a2 + hstep, voffA);
            PG8_WAIT_L(8); PG8_BAR; PG8_WAIT_L(0); PG8_MMA(0, 0, At, B0); PG8_BAR; PG8_SCHED;
            PG8_LDB(B1, 1, 1); PG8_STAGE(PG8_SB(1, 0), b3, voffB);
            PG8_BAR; PG8_WAIT_L(0); PG8_MMA(0, 1, At, B1); PG8_BAR;
            PG8_LDA(At, 1, 1); PG8_STAGE(PG8_SA(1, 0), a3, voffA);
            PG8_BAR; PG8_WAIT_L(0); PG8_MMA(1, 0, At, B0); PG8_BAR; PG8_SCHED;
            PG8_STAGE(PG8_SB(1, 1), b3 + hstep, voffB);
            PG8_WAIT_V(6); PG8_BAR; PG8_MMA(1, 1, At, B1); PG8_BAR;
        }
        E(acc, cur, wr, wc, fr, fq);
        if (!has_next) break;
#pragma unroll
        for (int a = 0; a < 2; ++a)
#pragma unroll
            for (int b = 0; b < 2; ++b)
#pragma unroll
                for (int m = 0; m < 4; ++m)
#pragma unroll
                    for (int n = 0; n < 2; ++n) acc[a][b][m][n] = (f32x4){0.f, 0.f, 0.f, 0.f};
        cur = nxt; cA = nA; cB = nB; ++ui;
    }
    PG8_WAIT_V(0);
    if (wr == 0) PG8_BAR;
    PG8_BAR;
#undef PG8_SA
#undef PG8_SB
#undef PG8_STAGE
#undef PG8_LDA
#undef PG8_LDB
#undef PG8_MMA
#undef PG8_WAIT_V
#undef PG8_WAIT_L
#undef PG8_BAR
#undef PG8_SCHED
}
template <class F> struct EpiWrap {
    static constexpr bool PERM = false;
    const P* p; F f;
    __device__ __forceinline__ void operator()(const f32x4 (&acc)[2][2][4][2], const Unit& u, int wr, int wc, int fr, int fq) const {
        const int row0 = u.pm * BM + wr * 64 + fr, col0 = u.pn * BM + wc * 32 + 4 * fq;
#pragma unroll
        for (int ai = 0; ai < 2; ++ai)
#pragma unroll
            for (int m = 0; m < 4; ++m)
#pragma unroll
                for (int bj = 0; bj < 2; ++bj)
#pragma unroll
                    for (int n = 0; n < 2; ++n) {
                        const f32x4 a = acc[ai][bj][m][n]; const float v[4] = {a[0], a[1], a[2], a[3]};
                        f(*p, row0 + ai * HALF + m * 16, col0 + bj * HALF + n * 16, v);
                    }
    }
};
struct EpiG1H {
    static constexpr bool PERM = true;
    const P* p; int l;
    __device__ __forceinline__ void operator()(const f32x4 (&acc)[2][2][4][2], const Unit& u, int wr, int wc, int fr, int fq) const {
        const int row0 = u.pm * BM + wr * 64 + fr, col0 = u.pn * BM + wc * 32 + 8 * fq;
        const float* rsq = (const float*)(p->ws + WS_RSQ) + (size_t)(2 * l) * NTOK;
        const float* bias = (const float*)(p->ws + WS_BIAS) + (size_t)(l * 3 + tok_cls(u.pm * BM)) * 3072 + col0;
        float rs[2][4]; float4 bb[2][2];
#pragma unroll
        for (int ai = 0; ai < 2; ++ai)
#pragma unroll
            for (int m = 0; m < 4; ++m) rs[ai][m] = rsq[row0 + ai * HALF + m * 16];
#pragma unroll
        for (int bj = 0; bj < 2; ++bj)
#pragma unroll
            for (int n = 0; n < 2; ++n) bb[bj][n] = *(const float4*)(bias + bj * HALF + n * 4);
#pragma unroll
        for (int ai = 0; ai < 2; ++ai)
#pragma unroll
            for (int m = 0; m < 4; ++m) rs[ai][m] = rsqrtf(rs[ai][m] * (1.f / 1024.f) + 1e-6f);
#pragma unroll
        for (int ai = 0; ai < 2; ++ai)
#pragma unroll
            for (int m = 0; m < 4; ++m)
#pragma unroll
                for (int bj = 0; bj < 2; ++bj) {
                    const int row = row0 + ai * HALF + m * 16, col = col0 + bj * HALF; const float r = rs[ai][m];
                    const f32x4 a0 = acc[ai][bj][m][0], a1 = acc[ai][bj][m][1]; const float4 b0 = bb[bj][0], b1 = bb[bj][1];
                    const float v[8] = {a0[0] * r + b0.x, a0[1] * r + b0.y, a0[2] * r + b0.z, a0[3] * r + b0.w, a1[0] * r + b1.x, a1[1] * r + b1.y, a1[2] * r + b1.z, a1[3] * r + b1.w};
                    if (col < C_FNET) {
                        uint4 w; w.x = pk_bf16(v[0], v[1]); w.y = pk_bf16(v[2], v[3]); w.z = pk_bf16(v[4], v[5]); w.w = pk_bf16(v[6], v[7]);
                        *(uint4*)((bf16_t*)(p->ws + WS_UD) + (size_t)row * 1152 + col) = w;
                        if (row < NPTOK && col >= 384) {
                            const int b = row >> 8, t = row & 255;
                            float* dst = p->out + (col < 768 ? OUT_CK : OUT_CV) + ((size_t)(b * 2 + l) * 256 + t) * 384 + (col < 768 ? col - 384 : col - 768);
                            *(float4*)dst = make_float4(v[0], v[1], v[2], v[3]); *(float4*)(dst + 4) = make_float4(v[4], v[5], v[6], v[7]);
                        }
                    } else if (col < C_RWKV) {
                        const int cc = col - C_FNET, g = cc >> 7, half = (cc >> 6) & 1, fc = cc & 63;
                        if (row < NPTOK) { const int sq = row >> 8, t = row & 255; bf16_t* o = (bf16_t*)(p->ws + WS_ZF) + ((size_t)(sq * 256 + g * 64 + fc) * 512 + half * 256 + t);
#pragma unroll
                            for (int e = 0; e < 8; ++e) o[e * 512] = f2bf(v[e]); }
                        else { const int rr = row - NPTOK, b = rr >> 10, t = rr & 1023; bf16_t* o = (bf16_t*)(p->ws + WS_ZF) + (size_t)8192 * 512 + ((size_t)(b * 256 + g * 64 + fc) * 2048 + half * 1024 + t);
#pragma unroll
                            for (int e = 0; e < 8; ++e) o[e * 2048] = f2bf(v[e]); }
                    } else if (col < C_END) {
                        uint4 w; w.x = pk_bf16(v[0], v[1]); w.y = pk_bf16(v[2], v[3]); w.z = pk_bf16(v[4], v[5]); w.w = pk_bf16(v[6], v[7]);
                        *(uint4*)((bf16_t*)(p->ws + WS_UR) + (size_t)row * N_RWKV + (col - C_RWKV)) = w;
                    }
                }
    }
};
struct EpiFfn1 {
    static constexpr bool PERM = true;
    const P* p; int l;
    __device__ __forceinline__ void operator()(const f32x4 (&acc)[2][2][4][2], const Unit& u, int wr, int wc, int fr, int fq) const {
        const int row0 = u.pm * BM + wr * 64 + fr, j0 = u.pn * 128 + wc * 32 + 8 * fq, c0 = u.pn * 256 + wc * 32 + 8 * fq;
        bf16_t* HA = (bf16_t*)(p->ws + WS_UR);
        const float* rsq = (const float*)(p->ws + WS_RSQ) + (size_t)(2 * l + 1) * NTOK;
        const float* bc = (const float*)(p->ws + WS_BIAS) + 2 * 3 * 3072 + (size_t)(l * 3 + tok_cls(u.pm * BM)) * 5632 + c0;
        float rs[2][4]; float4 bg[2], bu[2];
#pragma unroll
        for (int ai = 0; ai < 2; ++ai)
#pragma unroll
            for (int m = 0; m < 4; ++m) rs[ai][m] = rsq[row0 + ai * HALF + m * 16];
#pragma unroll
        for (int n = 0; n < 2; ++n) { bg[n] = *(const float4*)(bc + n * 4); bu[n] = *(const float4*)(bc + 128 + n * 4); }
#pragma unroll
        for (int ai = 0; ai < 2; ++ai)
#pragma unroll
            for (int m = 0; m < 4; ++m) rs[ai][m] = rsqrtf(rs[ai][m] * (1.f / 1024.f) + 1e-6f);
#pragma unroll
        for (int ai = 0; ai < 2; ++ai)
#pragma unroll
            for (int m = 0; m < 4; ++m) {
                const int row = row0 + ai * HALF + m * 16; const float r = rs[ai][m];
                float h[8];
#pragma unroll
                for (int n = 0; n < 2; ++n) {
                    const f32x4 g = acc[ai][0][m][n], up = acc[ai][1][m][n];
                    const float bgv[4] = {bg[n].x, bg[n].y, bg[n].z, bg[n].w}, buv[4] = {bu[n].x, bu[n].y, bu[n].z, bu[n].w};
#pragma unroll
                    for (int e = 0; e < 4; ++e) { const float gt = g[e] * r + bgv[e], uu = up[e] * r + buv[e]; h[4 * n + e] = gt * sigmoidf_(gt) * uu; }
                }
                uint4 w; w.x = pk_bf16(h[0], h[1]); w.y = pk_bf16(h[2], h[3]); w.z = pk_bf16(h[4], h[5]); w.w = pk_bf16(h[6], h[7]);
                *(uint4*)(HA + (size_t)row * D_FF + j0) = w;
            }
    }
};
struct EpiResN {
    static constexpr bool PERM = true;
    const P* p; int l, which;
    const float* ng; int nl, nsc;
    bf16_t* Hout; float* rsq;
    __device__ __forceinline__ void operator()(const f32x4 (&acc)[2][2][4][2], const Unit& u, int wr, int wc, int fr, int fq) const {
        const int row0 = u.pm * BM + wr * 64 + fr, col0 = u.pn * BM + wc * 32 + 8 * fq;
        const int cls = tok_cls(u.pm * BM);
        const float* g = mod_vec(*p, l, cls, which) + col0;
        float4 gg[2][2], gw[2][2];
#pragma unroll
        for (int bj = 0; bj < 2; ++bj)
#pragma unroll
            for (int n = 0; n < 2; ++n) {
                gg[bj][n] = *(const float4*)(g + bj * HALF + n * 4);
                if (ng) { const float4 gn = *(const float4*)(ng + col0 + bj * HALF + n * 4), sc = *(const float4*)(mod_vec(*p, nl, cls, nsc) + col0 + bj * HALF + n * 4);
                    gw[bj][n] = make_float4(gn.x * (1.f + sc.x), gn.y * (1.f + sc.y), gn.z * (1.f + sc.z), gn.w * (1.f + sc.w)); }
            }
#pragma unroll
        for (int ai = 0; ai < 2; ++ai)
#pragma unroll
            for (int mp = 0; mp < 4; mp += 2) {
                float4 x[2][2][2];
#pragma unroll
                for (int q = 0; q < 2; ++q) {
                    const int row = row0 + ai * HALF + (mp + q) * 16;
                    const float* xo = ((which == 2 && l == 0) ? xin_row(*p, row) : X_row(*p, row)) + col0;
#pragma unroll
                    for (int bj = 0; bj < 2; ++bj)
#pragma unroll
                        for (int n = 0; n < 2; ++n) x[q][bj][n] = *(const float4*)(xo + bj * HALF + n * 4);
                }
#pragma unroll
                for (int q = 0; q < 2; ++q) {
                    const int row = row0 + ai * HALF + (mp + q) * 16;
                    float ssq = 0.f;
#pragma unroll
                    for (int bj = 0; bj < 2; ++bj) {
                        float4 xn[2];
#pragma unroll
                        for (int n = 0; n < 2; ++n) {
                            const f32x4 a = acc[ai][bj][mp + q][n]; const float4 xv = x[q][bj][n], gv = gg[bj][n];
                            xn[n] = make_float4(xv.x + gv.x * a[0], xv.y + gv.y * a[1], xv.z + gv.z * a[2], xv.w + gv.w * a[3]);
                            *(float4*)(X_row(*p, row) + col0 + bj * HALF + n * 4) = xn[n];
                        }
                        if (ng) {
                            ssq += xn[0].x * xn[0].x + xn[0].y * xn[0].y + xn[0].z * xn[0].z + xn[0].w * xn[0].w + xn[1].x * xn[1].x + xn[1].y * xn[1].y + xn[1].z * xn[1].z + xn[1].w * xn[1].w;
                            const float4 w0 = gw[bj][0], w1 = gw[bj][1];
                            uint4 w; w.x = pk_bf16(xn[0].x * w0.x, xn[0].y * w0.y); w.y = pk_bf16(xn[0].z * w0.z, xn[0].w * w0.w); w.z = pk_bf16(xn[1].x * w1.x, xn[1].y * w1.y); w.w = pk_bf16(xn[1].z * w1.z, xn[1].w * w1.w);
                            *(uint4*)(Hout + (size_t)row * 1024 + col0 + bj * HALF) = w;
                        }
                    }
                    if (ng) { ssq += __shfl_xor(ssq, 16); ssq += __shfl_xor(ssq, 32); if (fq == 0) unsafeAtomicAdd(rsq + row, ssq); }
                }
            }
    }
};
}


typedef short bf16x8_t __attribute__((ext_vector_type(8)));
typedef short bf16x4_t __attribute__((ext_vector_type(4)));
typedef float f32x16_t __attribute__((ext_vector_type(16)));
#define AT_KS_BYTES (256 * 72 * 2)
__device__ __forceinline__ void attn_stage(const P& p, int l, int s, int h, int start, int nctx, int chunk, bool withV, bf16_t* Ks, bf16_t* Vt, int tid) {
    const int key = tid >> 1, half = tid & 1, j = chunk * 256 + key;
    if (j < nctx) {
        const size_t base = (((size_t)(s - 32) * 2 + l) * 512 + j) * 384 + h * 64 + half * 32;
        const float4* kp = (const float4*)(p.cache_k + base);
#pragma unroll
        for (int i = 0; i < 4; ++i) { const float4 a = kp[2 * i], b = kp[2 * i + 1]; uint4 o; o.x = pk_bf16(a.x, a.y); o.y = pk_bf16(a.z, a.w); o.z = pk_bf16(b.x, b.y); o.w = pk_bf16(b.z, b.w);
            *(uint4*)(Ks + key * 72 + half * 32 + i * 8) = o; }
        if (withV) { const float4* vp = (const float4*)(p.cache_v + base);
#pragma unroll
            for (int i = 0; i < 8; ++i) { const float4 a = vp[i]; bf16_t* d = Vt + (half * 32 + i * 4) * 260 + key; d[0] = f2bf(a.x); d[260] = f2bf(a.y); d[520] = f2bf(a.z); d[780] = f2bf(a.w); } }
    } else {
        const bf16_t* UD = (const bf16_t*)(p.ws + WS_UD);
        const size_t base = (size_t)(start + j - nctx) * 1152 + h * 64 + half * 32;
        const uint4* kp = (const uint4*)(UD + base + 384);
#pragma unroll
        for (int i = 0; i < 4; ++i) *(uint4*)(Ks + key * 72 + half * 32 + i * 8) = kp[i];
        if (withV) { const uint4* vp = (const uint4*)(UD + base + 768);
#pragma unroll
            for (int i = 0; i < 4; ++i) { const uint4 u = vp[i]; const unsigned w[4] = {u.x, u.y, u.z, u.w}; bf16_t* d = Vt + (half * 32 + i * 8) * 260 + key;
#pragma unroll
                for (int e = 0; e < 4; ++e) { d[(2 * e) * 260] = (bf16_t)(w[e] & 0xffff); d[(2 * e + 1) * 260] = (bf16_t)(w[e] >> 16); } } }
    }
}
__device__ __forceinline__ void attn_item(const P& p, int l, int item, unsigned char* lds, float lam, float lam_init) {
    const int tid = otid(), lane = tid & 63, wv = tid >> 6, n = lane & 31, hh = lane >> 5;
    int s, h, qb;
    if (item < 48) { s = 32 + item / 24; h = (item % 24) / 4; qb = item & 3; } else { const int r = item - 48; s = r / 6; h = r % 6; qb = 0; }
    int start, T; seq_info(s, start, T);
    const int nctx = s >= 32 ? 512 : 0, nchunks = (nctx + T) >> 8;
    bf16_t* Ks = (bf16_t*)lds; bf16_t* Vt = (bf16_t*)(lds + AT_KS_BYTES);
    const bf16_t* UD = (const bf16_t*)(p.ws + WS_UD);
    const int qtok = start + qb * 256 + wv * 32 + n;
    bf16x8_t Qf[2][2];
#pragma unroll
    for (int m = 0; m < 2; ++m)
#pragma unroll
        for (int si = 0; si < 2; ++si) Qf[m][si] = *(const bf16x8_t*)(UD + (size_t)qtok * 1152 + h * 64 + m * 32 + si * 16 + hh * 8);
    const float c = 0.17677669529663687f * 1.4426950408889634f;
    float m0 = -1e30f, m1 = -1e30f, l0 = 0.f, l1 = 0.f;
    for (int ch = 0; ch < nchunks; ++ch) {
        __syncthreads();
        attn_stage(p, l, s, h, start, nctx, ch, false, Ks, Vt, tid);
        __syncthreads();
#pragma unroll 1
        for (int kt = 0; kt < 8; ++kt) {
            f32x16_t S0 = {0,0,0,0,0,0,0,0,0,0,0,0,0,0,0,0}, S1 = S0;
#pragma unroll
            for (int si = 0; si < 2; ++si) {
                const bf16x8_t k0 = *(const bf16x8_t*)(Ks + (kt * 32 + n) * 72 + si * 16 + hh * 8);
                const bf16x8_t k1 = *(const bf16x8_t*)(Ks + (kt * 32 + n) * 72 + 32 + si * 16 + hh * 8);
                S0 = __builtin_amdgcn_mfma_f32_32x32x16_bf16(k0, Qf[0][si], S0, 0, 0, 0);
                S1 = __builtin_amdgcn_mfma_f32_32x32x16_bf16(k1, Qf[1][si], S1, 0, 0, 0);
            }
            float t0 = S0[0], t1 = S1[0];
#pragma unroll
            for (int r = 1; r < 16; ++r) { t0 = fmaxf(t0, S0[r]); t1 = fmaxf(t1, S1[r]); }
            const float n0 = fmaxf(m0, t0), n1 = fmaxf(m1, t1);
            float a0 = 0.f, a1 = 0.f;
#pragma unroll
            for (int r = 0; r < 16; ++r) { a0 += __builtin_amdgcn_exp2f((S0[r] - n0) * c); a1 += __builtin_amdgcn_exp2f((S1[r] - n1) * c); }
            l0 = l0 * __builtin_amdgcn_exp2f((m0 - n0) * c) + a0; l1 = l1 * __builtin_amdgcn_exp2f((m1 - n1) * c) + a1;
            m0 = n0; m1 = n1;
        }
    }
    {
        const float mo0 = __shfl_xor(m0, 32), lo0 = __shfl_xor(l0, 32), mo1 = __shfl_xor(m1, 32), lo1 = __shfl_xor(l1, 32);
        const float M0 = fmaxf(m0, mo0), M1 = fmaxf(m1, mo1);
        l0 = l0 * __builtin_amdgcn_exp2f((m0 - M0) * c) + lo0 * __builtin_amdgcn_exp2f((mo0 - M0) * c);
        l1 = l1 * __builtin_amdgcn_exp2f((m1 - M1) * c) + lo1 * __builtin_amdgcn_exp2f((mo1 - M1) * c);
        m0 = M0; m1 = M1;
    }
    const float i0 = 1.f / l0, i1 = lam / l1;
    f32x16_t O0 = {0,0,0,0,0,0,0,0,0,0,0,0,0,0,0,0}, O1 = O0;
    for (int ch = 0; ch < nchunks; ++ch) {
        __syncthreads();
        attn_stage(p, l, s, h, start, nctx, ch, true, Ks, Vt, tid);
        __syncthreads();
#pragma unroll 1
        for (int kt = 0; kt < 8; ++kt) {
            f32x16_t S0 = {0,0,0,0,0,0,0,0,0,0,0,0,0,0,0,0}, S1 = S0;
#pragma unroll
            for (int si = 0; si < 2; ++si) {
                const bf16x8_t k0 = *(const bf16x8_t*)(Ks + (kt * 32 + n) * 72 + si * 16 + hh * 8);
                const bf16x8_t k1 = *(const bf16x8_t*)(Ks + (kt * 32 + n) * 72 + 32 + si * 16 + hh * 8);
                S0 = __builtin_amdgcn_mfma_f32_32x32x16_bf16(k0, Qf[0][si], S0, 0, 0, 0);
                S1 = __builtin_amdgcn_mfma_f32_32x32x16_bf16(k1, Qf[1][si], S1, 0, 0, 0);
            }
            float pw[16];
#pragma unroll
            for (int r = 0; r < 16; ++r) pw[r] = __builtin_amdgcn_exp2f((S0[r] - m0) * c) * i0 - __builtin_amdgcn_exp2f((S1[r] - m1) * c) * i1;
#pragma unroll
            for (int si = 0; si < 2; ++si) {
                union { unsigned u[4]; bf16x8_t v; } pf;
#pragma unroll
                for (int e = 0; e < 4; ++e) pf.u[e] = pk_bf16(pw[8 * si + 2 * e], pw[8 * si + 2 * e + 1]);
                union { bf16x4_t h2[2]; bf16x8_t v; } va, vb;
                const bf16_t* v0 = Vt + n * 260 + kt * 32 + si * 16 + hh * 4;
                va.h2[0] = *(const bf16x4_t*)v0; va.h2[1] = *(const bf16x4_t*)(v0 + 8);
                vb.h2[0] = *(const bf16x4_t*)(v0 + 32 * 260); vb.h2[1] = *(const bf16x4_t*)(v0 + 32 * 260 + 8);
                O0 = __builtin_amdgcn_mfma_f32_32x32x16_bf16(va.v, pf.v, O0, 0, 0, 0);
                O1 = __builtin_amdgcn_mfma_f32_32x32x16_bf16(vb.v, pf.v, O1, 0, 0, 0);
            }
        }
    }
    float ss = 0.f;
#pragma unroll
    for (int r = 0; r < 16; ++r) ss += O0[r] * O0[r] + O1[r] * O1[r];
    ss += __shfl_xor(ss, 32);
    const float rs = rsqrtf(ss * (1.f / 64.f) + 1e-5f) * (1.f - lam_init);
    bf16_t* mo = (bf16_t*)(p.ws + WS_H) + (size_t)qtok * 1024 + 384 + h * 64;
    const float* sg = p.subln_g + (size_t)l * 64;
#pragma unroll
    for (int g = 0; g < 4; ++g) {
        const int vd = 8 * g + 4 * hh;
        uint2 w0, w1;
        w0.x = pk_bf16(O0[4 * g] * rs * sg[vd], O0[4 * g + 1] * rs * sg[vd + 1]); w0.y = pk_bf16(O0[4 * g + 2] * rs * sg[vd + 2], O0[4 * g + 3] * rs * sg[vd + 3]);
        w1.x = pk_bf16(O1[4 * g] * rs * sg[32 + vd], O1[4 * g + 1] * rs * sg[32 + vd + 1]); w1.y = pk_bf16(O1[4 * g + 2] * rs * sg[32 + vd + 2], O1[4 * g + 3] * rs * sg[32 + vd + 3]);
        *(uint2*)(mo + vd) = w0; *(uint2*)(mo + 32 + vd) = w1;
    }
}

struct EpiFnet {
    int samp;
    __device__ __forceinline__ void operator()(const P& p, int row, int col, const float* v) const {
        const int sq = col >> 8, ch = col & 255;
        const int tok = samp ? NPTOK + sq * 1024 + row : sq * 256 + row;
        uint2 w; w.x = pk_bf16(v[0], v[1]); w.y = pk_bf16(v[2], v[3]);
        *(uint2*)((bf16_t*)(p.ws + WS_H) + (size_t)tok * 1024 + 768 + ch) = w;
    }
};
struct OneUnit { int pm, pn; __device__ bool next(int i, pg8::Unit& u) const { if (i) return false; u.pm = pm; u.pn = pn; return true; } };

#define MX_ITEMS 724
template <class GemmFn>
__device__ __forceinline__ void ph_mixer(const P& p, int l, unsigned char* lds, volatile LAS unsigned* slot, GemmFn gemm_one) {
    const float lam_init = 0.8f - 0.6f * __expf(-0.3f * (float)l);
    float lam;
    { const float* lp = p.diff_lambda + (size_t)l * 128; float s01 = 0.f, s23 = 0.f;
      for (int d = 0; d < 32; ++d) { s01 += lp[d] * lp[32 + d]; s23 += lp[64 + d] * lp[96 + d]; }
      lam = __expf(s01) - __expf(s23) + lam_init; }
    unsigned* ctr = (unsigned*)(p.ws + WS_CTL) + CTL_QUEUE + 64 * l;
    for (;;) {
        __syncthreads();
        if (threadIdx.x == 0) *slot = atomicAdd(ctr, 1u);
        __syncthreads();
        const int item = (int)*slot;
        if (item >= MX_ITEMS) break;
#if PROBE_ID
        const unsigned long long it0 = __builtin_amdgcn_s_memrealtime();
#endif
        if (item < 48) attn_item(p, l, item, lds, lam, lam_init);
        else if (item < 60) ph_scan_job(p, l, 32 + (item - 48) / NH, (item - 48) % NH, 0, 0, 0, 0, SEG0_LEN, (float*)lds);
        else if (item < 108) { const int r = item - 60, sg = 1 + (r & 1), dr = (r >> 1) & 1, hh = (r >> 2) % NH, bb = r / 24;
            ph_scan_job(p, l, 32 + bb, hh, 1, dr, sg, sg == 1 ? SEG0_LEN : SEG0_LEN + SEG1_LEN, sg == 1 ? SEG1_LEN : SEG2_LEN, (float*)lds); }
        else if (item < 300) ph_scan_job(p, l, (item - 108) / NH, (item - 108) % NH, 0, 0, 0, 0, TP, (float*)lds);
        else if (item < 308) gemm_one(1, (item - 300) >> 1, (item - 300) & 1);
        else if (item < 500) attn_item(p, l, 48 + item - 308, lds, lam, lam_init);
        else if (item < 532) gemm_one(0, 0, item - 500);
        else fixup_item(p, l, item - 532, (float*)lds);
        if (item >= 48 && item < 108) {
            asm volatile("s_waitcnt vmcnt(0)" ::: "memory");
            __syncthreads();
            if (threadIdx.x == 0) {
                __builtin_amdgcn_fence(__ATOMIC_RELEASE, "agent");
                asm volatile("s_waitcnt vmcnt(0)" ::: "memory");
                unsigned* cnt = (unsigned*)(p.ws + WS_CTL) + CTL_SCANDONE + 32 * l;
                if (item < 60) { const int bh = item - 48; __hip_atomic_fetch_add(cnt + bh * 2, 1u, __ATOMIC_RELAXED, __HIP_MEMORY_SCOPE_AGENT); __hip_atomic_fetch_add(cnt + bh * 2 + 1, 1u, __ATOMIC_RELAXED, __HIP_MEMORY_SCOPE_AGENT); }
                else { const int r = item - 60, dr = (r >> 1) & 1, hh = (r >> 2) % NH, bb = r / 24; __hip_atomic_fetch_add(cnt + (bb * NH + hh) * 2 + dr, 1u, __ATOMIC_RELAXED, __HIP_MEMORY_SCOPE_AGENT); }
            }
        }
#if PROBE_ID
        __syncthreads();
        if (threadIdx.x == 0 && l == 0) { const int cls = item < 48 ? 3 : item < 60 ? 0 : item < 108 ? 6 : item < 300 ? 2 : item < 308 ? 1 : item < 500 ? 5 : 4;
            atomicMax((unsigned*)(p.ws + WS_CTL) + 3712 + cls, (unsigned)(__builtin_amdgcn_s_memrealtime() - it0)); }
#endif
    }
}

#define XB_TMO      128
#define XB_XCNT(j)  (256  + 64 * (j))
#define XB_XSUB(j)  (1280 + 64 * (j))
#define XB_XGEN(j)  (2304 + 64 * (j))
#define XB_TOP      3328
#define XB_TOPGEN   3392
#define XCD_BAR_WORDS 3456
#define XB_SPIN_CAP (1u << 22)
__device__ __forceinline__ unsigned xb_ld(unsigned* p)              { return __hip_atomic_load(p, __ATOMIC_RELAXED, __HIP_MEMORY_SCOPE_AGENT); }
__device__ __forceinline__ unsigned xb_add(unsigned* p, unsigned v) { return __hip_atomic_fetch_add(p, v, __ATOMIC_RELAXED, __HIP_MEMORY_SCOPE_AGENT); }
__device__ __forceinline__ unsigned xb_xcc_id() { return (unsigned)__builtin_amdgcn_s_getreg((3 << 11) | 20) & 0xFu; }
#define XB_SPIN(cond, bar) do { unsigned _sp = 0; while (cond) { __builtin_amdgcn_s_sleep(1); \
    if ((++_sp & 255u) == 0u) { if (xb_ld(&(bar)[XB_TMO])) break; if (_sp > XB_SPIN_CAP) { atomicAdd(&(bar)[XB_TMO], 1u); break; } } } } while (0)
struct XcdBarrier { unsigned* bar; unsigned x; volatile LAS unsigned* st; };
__device__ __forceinline__ XcdBarrier xcd_barrier_post(unsigned* bar, volatile LAS unsigned* st) {
    XcdBarrier b; b.bar = bar; b.x = xb_xcc_id(); b.st = st;
    if (threadIdx.x == 0) (void)xb_add(&bar[XB_XCNT(b.x)], 1u);
    return b;
}
__device__ __forceinline__ void xcd_barrier_complete(unsigned* bar, unsigned x, unsigned& nloc, unsigned& nx) {
    const unsigned G = gridDim.x * gridDim.y * gridDim.z;
    unsigned sum, cnt, mine, sp = 0u;
    for (;;) {
        sum = 0u; cnt = 0u; mine = 0u;
#pragma unroll
        for (unsigned j = 0; j < 16; ++j) { const unsigned c = xb_ld(&bar[XB_XCNT(j)]); sum += c; cnt += (c > 0u) ? 1u : 0u; mine = (j == x) ? c : mine; }
        if (sum == G) break;
        __builtin_amdgcn_s_sleep(1);
        if ((++sp & 255u) == 0u) { if (xb_ld(&bar[XB_TMO])) break; if (sp > XB_SPIN_CAP) { atomicAdd(&bar[XB_TMO], 1u); break; } }
    }
    nloc = mine > 0u ? mine : 1u; nx = cnt > 0u ? cnt : 1u;
}
__device__ __forceinline__ void xcd_barrier(const XcdBarrier& b) {
    asm volatile("s_waitcnt vmcnt(0)" ::: "memory");
    __syncthreads();
    if (threadIdx.x == 0) {
        unsigned* bar = b.bar;
        __builtin_amdgcn_s_waitcnt(0);
        unsigned nloc = b.st[0], nx = b.st[1];
        if (nloc == 0u) { xcd_barrier_complete(bar, b.x, nloc, nx); b.st[0] = nloc; b.st[1] = nx; }
        const unsigned old = xb_add(&bar[XB_XSUB(b.x)], 1u);
        const unsigned gen = old / nloc;
        if (old + 1u == (gen + 1u) * nloc) {
            __builtin_amdgcn_fence(__ATOMIC_RELEASE, "agent");
            asm volatile("s_waitcnt vmcnt(0)" ::: "memory");
            const unsigned og = xb_add(&bar[XB_TOP], 1u);
            const unsigned tg = og / nx;
            if (og + 1u == (tg + 1u) * nx) xb_add(&bar[XB_TOPGEN], 1u);
            else XB_SPIN(xb_ld(&bar[XB_TOPGEN]) == tg, bar);
            __builtin_amdgcn_fence(__ATOMIC_ACQUIRE, "agent");
            xb_add(&bar[XB_XGEN(b.x)], 1u);
            asm volatile("s_waitcnt vmcnt(0)" ::: "memory");
        } else {
            XB_SPIN(xb_ld(&bar[XB_XGEN(b.x)]) == gen, bar);
            __builtin_amdgcn_fence(__ATOMIC_ACQUIRE, "agent");
            asm volatile("s_waitcnt vmcnt(0)" ::: "memory");
        }
    }
    __syncthreads();
}

#define MISC_OFF 150528
#define LDS_BYTES (MISC_OFF + 1024)
#define N_PHASES 17
struct Args { P p; int ph_lo, ph_hi; };
__global__ __launch_bounds__(512, 2) void mega(Args a) {
    extern __shared__ __attribute__((aligned(16))) unsigned char lds[];
    const P& p = a.p;
    LAS unsigned char* l3 = (LAS unsigned char*)lds;
    volatile LAS unsigned* misc = (volatile LAS unsigned*)(l3 + MISC_OFF);
    if (threadIdx.x < 16) misc[threadIdx.x] = 0u;
    __syncthreads();
    XcdBarrier bar = xcd_barrier_post((unsigned*)(p.ws + WS_CTL), misc);
    float* sm = (float*)lds;
    const int lo = a.ph_lo, hi = a.ph_hi;
#define IN(k) (lo <= (k) && (k) < hi)
#if PROBE_ID
    unsigned long long* tsl = (unsigned long long*)(p.ws + WS_CTL + 15360);
    if (blockIdx.x == 0 && otid() == 0) tsl[0] = __builtin_amdgcn_s_memrealtime();
#define SEAM(k) do { if (IN(k) && IN((k) + 1)) xcd_barrier(bar); if (blockIdx.x == 0 && otid() == 0) tsl[1 + (k)] = __builtin_amdgcn_s_memrealtime(); } while (0)
#else
#define SEAM(k) do { if (IN(k) && IN((k) + 1)) xcd_barrier(bar); } while (0)
#endif
    if (IN(0)) ph_prep0(p, sm);
    SEAM(0);
    if (IN(1)) ph_prep0b(p);
    SEAM(1);
    for (int l = 0; l < 2; ++l) {
        const int b0 = 2 + 7 * l;
        if (IN(b0 + 0)) { pg8::Gemm g{(const bf16_t*)(p.ws + WS_H), (const bf16_t*)(p.ws + WS_WIN) + (size_t)l * N1 * 1024, NTOK, N1, 1024};
            pg8::StaticOrder S; S.init(NTOK, N1, gridDim.x, blockIdx.x); pg8::EpiG1H E{&p, l}; pg8::gemm_phase(l3, g, S, E); }
        SEAM(b0 + 0);
        if (IN(b0 + 1)) ph_prep(p, l, sm);
        SEAM(b0 + 1);
        if (IN(b0 + 2)) {
            auto gemm_one = [&](int samp, int pm, int pn) {
                pg8::Gemm g{samp ? (const bf16_t*)(p.ws + WS_L1024) : (const bf16_t*)(p.ws + WS_L256), samp ? (const bf16_t*)(p.ws + WS_ZF) + (size_t)8192 * 512 : (const bf16_t*)(p.ws + WS_ZF),
                            samp ? 1024 : 256, samp ? 512 : 8192, samp ? 2048 : 512};
                OneUnit S{pm, pn}; pg8::EpiWrap<EpiFnet> E{&p, EpiFnet{samp}}; pg8::gemm_phase(l3, g, S, E); };
            ph_mixer(p, l, lds, misc + 4, gemm_one);
        }
        SEAM(b0 + 2);
        if (IN(b0 + 3)) ph_finalize(p, l);
        SEAM(b0 + 3);
        if (IN(b0 + 4)) { pg8::Gemm g{(const bf16_t*)(p.ws + WS_H), (const bf16_t*)(p.ws + WS_WOUT) + (size_t)l * 1024 * 1024, NTOK, 1024, 1024};
            pg8::StaticOrder S; S.init(NTOK, 1024, gridDim.x, blockIdx.x);
            pg8::EpiResN E{&p, l, 2, p.norm2_g + (size_t)l * 1024, l, 4, (bf16_t*)(p.ws + WS_H2), (float*)(p.ws + WS_RSQ) + (size_t)(2 * l + 1) * NTOK}; pg8::gemm_phase(l3, g, S, E); }
        SEAM(b0 + 4);
        if (IN(b0 + 5)) { pg8::Gemm g{(const bf16_t*)(p.ws + WS_H2), (const bf16_t*)(p.ws + WS_WF1) + (size_t)l * 5632 * 1024, NTOK, 5632, 1024};
            pg8::StaticOrder S; S.init(NTOK, 5632, gridDim.x, blockIdx.x); pg8::EpiFfn1 E{&p, l}; pg8::gemm_phase(l3, g, S, E); }
        SEAM(b0 + 5);
        if (IN(b0 + 6)) { pg8::Gemm g{(const bf16_t*)(p.ws + WS_UR), (const bf16_t*)(p.ws + WS_WF2) + (size_t)l * 1024 * 2816, NTOK, 1024, 2816};
            pg8::StaticOrder S; S.init(NTOK, 1024, gridDim.x, blockIdx.x);
            pg8::EpiResN E{&p, l, 5, l == 0 ? p.norm1_g + 1024 : (const float*)nullptr, 1, 1, (bf16_t*)(p.ws + WS_H), (float*)(p.ws + WS_RSQ) + (size_t)2 * NTOK}; pg8::gemm_phase(l3, g, S, E); }
        SEAM(b0 + 6);
    }
    if (IN(16)) ph_norm(p, 0, 2);
#if PROBE_ID
    __syncthreads();
    if (blockIdx.x == 0 && otid() == 0) {
        tsl[17] = __builtin_amdgcn_s_memrealtime();
        __threadfence();
        unsigned long long acc = 0;
#pragma unroll 1
        for (int k = 0; k < 17; ++k) {
            const int st = k == 0 ? -1 : (k == 1 ? -3 : (k == 16 ? -2 : 20 + (k - 2) % 7));
            bool sel = false;
            if (PROBE_ID == 1) sel = (k == 0);
            if (PROBE_ID == 2) sel = (st == 10 || st == 15 || st == 16 || st == 17);
            if (PROBE_ID == 3) sel = (st == 12);
            if (PROBE_ID == 4) sel = (st == -2 || st == -3);
            if (PROBE_ID == 5) sel = (st == 11);
            if (PROBE_ID == 6) sel = (st == 13);
            if (PROBE_ID == 7) sel = (st == 14);
            if (PROBE_ID == 8) sel = (st == 10);
            if (PROBE_ID == 9) sel = (st == 15);
            if (PROBE_ID == 10) sel = (st == 16);
            if (PROBE_ID == 11) sel = (st == 17);
            if (sel) acc += __hip_atomic_load(tsl + 1 + k, __ATOMIC_RELAXED, __HIP_MEMORY_SCOPE_AGENT) - __hip_atomic_load(tsl + k, __ATOMIC_RELAXED, __HIP_MEMORY_SCOPE_AGENT);
        }
        if (PROBE_ID >= 30 && PROBE_ID < 34) { unsigned long long* tsp = (unsigned long long*)(p.ws + WS_CTL + 15360) + 32; acc = __hip_atomic_load(tsp + (PROBE_ID - 29), __ATOMIC_RELAXED, __HIP_MEMORY_SCOPE_AGENT) - __hip_atomic_load(tsp + (PROBE_ID - 30), __ATOMIC_RELAXED, __HIP_MEMORY_SCOPE_AGENT); }
        else if (PROBE_ID >= 20) acc = __hip_atomic_load((unsigned*)(p.ws + WS_CTL) + 3712 + (PROBE_ID - 20), __ATOMIC_RELAXED, __HIP_MEMORY_SCOPE_AGENT);
        const unsigned long long t_end = __builtin_amdgcn_s_memrealtime();
        while (__builtin_amdgcn_s_memrealtime() - t_end < 4ull * acc) __builtin_amdgcn_s_sleep(8);
    }
#endif
#undef IN
#undef SEAM
}

extern "C" void kernel_launch(void* const* d_in, const int* in_sizes, int n_in, void* d_out, int out_size, void* d_ws, size_t ws_size, hipStream_t stream) {
    static int grid = 0;
    if (grid == 0) {
        if (n_in != 29 || ws_size < WS_END) { fprintf(stderr, "kernel_launch: bad n_in %d or ws_size %zu (need %zu)\n", n_in, ws_size, (size_t)WS_END); grid = -1; return; }
        int dev = 0, cus = 0, per_cu = 0;
        hipGetDevice(&dev); hipDeviceGetAttribute(&cus, hipDeviceAttributeMultiprocessorCount, dev);
        if (hipFuncSetAttribute((const void*)mega, hipFuncAttributeMaxDynamicSharedMemorySize, LDS_BYTES) != hipSuccess) { fprintf(stderr, "kernel_launch: hipFuncSetAttribute failed\n"); grid = -1; return; }
        if (hipOccupancyMaxActiveBlocksPerMultiprocessor(&per_cu, (const void*)mega, 512, LDS_BYTES) != hipSuccess || per_cu < 1) { fprintf(stderr, "kernel_launch: occupancy query says %d\n", per_cu); per_cu = 1; }
        (void)hipGetLastError();
        grid = cus;
    }
    if (grid < 0) return;
    hipMemsetAsync((unsigned char*)d_ws + WS_CTL, 0, 16384 + 4 * NTOK * 4, stream);
    Args a{};
    const float** f = (const float**)&a.p;
    for (int i = 0; i < 29; ++i) f[i] = (const float*)d_in[i];
    a.p.out = (float*)d_out; a.p.ws = (unsigned char*)d_ws;
#if ONE_LAUNCH
    a.ph_lo = 0; a.ph_hi = N_PHASES;
    hipLaunchKernelGGL(mega, dim3(grid), dim3(512), LDS_BYTES, stream, a);
#else
    for (int ph = 0; ph < N_PHASES; ++ph) { a.ph_lo = ph; a.ph_hi = ph + 1; hipLaunchKernelGGL(mega, dim3(grid), dim3(512), LDS_BYTES, stream, a); }
#endif
}
```

```cpp
#include <hip/hip_runtime.h>
#include <stdint.h>
#include <stdio.h>
#ifndef ONE_LAUNCH
#define ONE_LAUNCH 1
#endif
#ifndef PROBE_ID
#define PROBE_ID 0
#endif

typedef unsigned short bf16_t;

#define D_MODEL 1024
#define NTOK 10240
#define NPTOK 8192
#define TP 256
#define TS 1024
#define NSEQ 34
#define NH 6
#define N1 3072
#define C_DIFF 0
#define C_FNET 1152
#define C_RWKV 1664
#define C_END 3008
#define N_RWKV 1344
#define D_FF 2816
#define D_IN 2752

#define OUT_YP 0
#define OUT_YS 8388608
#define OUT_ST 10485760
#define OUT_CK 13631488
#define OUT_CV 19922944

#define OPS_REC 1792
#define OPS_TOK (6 * OPS_REC)

#define WS_WIN   ((size_t)0)
#define WS_WOUT  (WS_WIN + (size_t)2 * N1 * 1024 * 2)
#define WS_WF1   (WS_WOUT + (size_t)2 * 1024 * 1024 * 2)
#define WS_WF2   (WS_WF1 + (size_t)2 * 5632 * 1024 * 2)
#define WS_H     (WS_WF2 + (size_t)2 * 1024 * 2816 * 2)
#define WS_UD    (WS_H + (size_t)NTOK * 1024 * 2)
#define WS_ZF    (WS_UD + (size_t)NTOK * 1152 * 2)
#define WS_UR    (WS_ZF + (size_t)NTOK * 512 * 2)
#define WS_OPS   (WS_UR + (size_t)2 * NTOK * 384 * 4)
#define WS_MOD   (WS_OPS + (size_t)NTOK * OPS_TOK)
#define WS_L256  (WS_MOD + (size_t)2 * 3 * 6144 * 4)
#define WS_L1024 (WS_L256 + (size_t)256 * 512 * 2)
#define WS_CTL   (WS_L1024 + (size_t)1024 * 2048 * 2)
#define WS_RSQ   (WS_CTL + (size_t)16384)
#define WS_CNT2  (WS_RSQ + (size_t)4 * NTOK * 4)
#define WS_ZS    (WS_CNT2 + (size_t)2048)
#define WS_SS    (WS_ZS + (size_t)2 * 2048 * 384 * 4)
#define WS_WLT   (WS_SS + (size_t)24 * 3 * 4096 * 4)
#define WLT_L    73728
#define WS_BIAS  (WS_WLT + (size_t)2 * WLT_L * 2)
#define WS_END   (WS_BIAS + (size_t)(2 * 3 * 3072 + 2 * 3 * 5632) * 4)
#define WS_H2    (WS_OPS + ((size_t)64 << 20))
#define CTL_QUEUE 3584
static_assert(WS_END <= ((size_t)256 << 20), "workspace exceeds 256 MiB");

struct P {
    const float *x_prompt, *x_sample, *c, *state_rwkv, *cache_k, *cache_v, *c_ctx, *norm1_g, *norm2_g, *final_g;
    const float *w_mod, *b_mod, *w_in, *w_out, *shift_mu, *decay_w0, *decay_up, *iclr_a0, *iclr_up, *gate_up;
    const float *k_k, *k_a, *r_k, *lnx_g, *lnx_b, *diff_lambda, *subln_g, *w_ffn_in, *w_ffn_out;
    float* out;
    unsigned char* ws;
};

typedef float f32x2c __attribute__((ext_vector_type(2)));
typedef __bf16 bf16x2c __attribute__((ext_vector_type(2)));
__device__ __forceinline__ bf16_t f2bf(float f) { return __builtin_bit_cast(unsigned short, (__bf16)f); }
__device__ __forceinline__ unsigned pk_bf16(float lo, float hi) { const f32x2c v = {lo, hi}; return __builtin_bit_cast(unsigned, __builtin_convertvector(v, bf16x2c)); }
__device__ __forceinline__ float bf2f(bf16_t b) { return __builtin_bit_cast(float, ((unsigned)b) << 16); }
__device__ __forceinline__ float sigmoidf_(float x) { return 1.f / (1.f + __expf(-x)); }
__device__ __forceinline__ float wave_sum(float v) {
#pragma unroll
    for (int o = 1; o < 64; o <<= 1) v += __shfl_xor(v, o);
    return v;
}
__device__ __forceinline__ int otid() { int t = threadIdx.x; asm volatile("" : "+v"(t)); return t; }
__device__ __forceinline__ int tok_cls(int tok) { return tok < NPTOK ? 0 : 1 + ((tok - NPTOK) >> 10); }
__device__ __forceinline__ const float* xin_row(const P& p, int tok) { return tok < NPTOK ? p.x_prompt + (size_t)tok * 1024 : p.x_sample + (size_t)(tok - NPTOK) * 1024; }
__device__ __forceinline__ float* X_row(const P& p, int tok) { return p.out + (size_t)tok * 1024; }
__device__ __forceinline__ const float* mod_vec(const P& p, int l, int cls, int which) { return (const float*)(p.ws + WS_MOD) + ((size_t)(l * 3 + cls) * 6144 + which * 1024); }
__device__ __forceinline__ void seq_info(int s, int& start, int& T) { if (s < 32) { start = s * TP; T = TP; } else { start = NPTOK + (s - 32) * TS; T = TS; } }
__device__ __forceinline__ void tok_info(int tok, int& s, int& t, int& T, int& start) {
    if (tok < NPTOK) { s = tok >> 8; t = tok & 255; T = TP; start = s * TP; } else { int r = tok - NPTOK; s = 32 + (r >> 10); t = r & 1023; T = TS; start = NPTOK + ((r >> 10) << 10); }
}

#define P0_MOD 192
#define P0_TILES_L 3136
struct P0Tile { const float* src; bf16_t* dst; int srcN, K, n0, k0, mode, scol; };
__device__ __forceinline__ P0Tile p0_decode(const P& p, int it) {
    P0Tile t; const int l = it / P0_TILES_L; it %= P0_TILES_L; int ntile, ktile; t.mode = 0; t.scol = 0;
    if (it < 768) { ntile = it / 16; ktile = it % 16; t.K = 1024; t.srcN = D_IN; t.src = p.w_in + (size_t)l * 1024 * D_IN; t.dst = (bf16_t*)(p.ws + WS_WIN) + (size_t)l * N1 * 1024;
        t.n0 = ntile * 64;
        if (t.n0 < C_FNET) { t.scol = 1344 + t.n0; } else if (t.n0 < C_RWKV) { t.mode = 1 + ((t.n0 - C_FNET) / 64) % 2; t.scol = 2496 + ((t.n0 - C_FNET) / 128) * 64; } else if (t.n0 < C_END) { t.scol = t.n0 - C_RWKV; } else t.mode = 3; }
    else if (it < 1024) { it -= 768; ntile = it / 16; ktile = it % 16; t.K = 1024; t.srcN = 1024; t.src = p.w_out + (size_t)l * 1024 * 1024; t.dst = (bf16_t*)(p.ws + WS_WOUT) + (size_t)l * 1024 * 1024; t.n0 = ntile * 64; t.scol = t.n0; }
    else if (it < 2432) { it -= 1024; ntile = it / 16; ktile = it % 16; t.K = 1024; t.srcN = 5632; t.src = p.w_ffn_in + (size_t)l * 1024 * 5632; t.dst = (bf16_t*)(p.ws + WS_WF1) + (size_t)l * 5632 * 1024; t.n0 = ntile * 64;
        const int pn = ntile >> 2, sub = ntile & 3; t.scol = (sub < 2) ? (128 * pn + 64 * sub) : (2816 + 128 * pn + 64 * (sub - 2)); }
    else { it -= 2432; ntile = it / 44; ktile = it % 44; t.K = 2816; t.srcN = 1024; t.src = p.w_ffn_out + (size_t)l * 2816 * 1024; t.dst = (bf16_t*)(p.ws + WS_WF2) + (size_t)l * 1024 * 2816; t.n0 = ntile * 64; t.scol = t.n0; }
    t.k0 = ktile * 64;
    return t;
}
#define P0_TGROUPS 1568
__device__ __forceinline__ void ph_prep0(const P& p, float* sm) {
    const int tid = otid();
    const int nitems = P0_MOD + P0_TGROUPS + 1280 + 10;
    for (int item = blockIdx.x; item < nitems; item += gridDim.x) {
        __syncthreads();
        if (item < P0_MOD) {
            const int l = item / 96, cg = item % 96, c4 = tid & 15, ks = tid >> 4;
            const float* W = p.w_mod + (size_t)l * 1024 * 6144 + cg * 64 + c4 * 4;
            float* sl = sm + 6144;
            for (int e = tid; e < 3072; e += blockDim.x) { const int cls = e >> 10, k = e & 1023; const float c = cls == 0 ? p.c_ctx[k] : p.c[(cls - 1) * 1024 + k]; sl[e] = c * sigmoidf_(c); }
            __syncthreads();
            float4 a0 = make_float4(0.f, 0.f, 0.f, 0.f), a1 = a0, a2 = a0;
#pragma unroll 8
            for (int k = ks * 32; k < ks * 32 + 32; ++k) {
                const float4 w = *(const float4*)(W + (size_t)k * 6144);
                const float s0 = sl[k], s1 = sl[1024 + k], s2 = sl[2048 + k];
                a0.x += s0 * w.x; a0.y += s0 * w.y; a0.z += s0 * w.z; a0.w += s0 * w.w;
                a1.x += s1 * w.x; a1.y += s1 * w.y; a1.z += s1 * w.z; a1.w += s1 * w.w;
                a2.x += s2 * w.x; a2.y += s2 * w.y; a2.z += s2 * w.z; a2.w += s2 * w.w;
            }
            *(float4*)(sm + (ks * 3 + 0) * 64 + c4 * 4) = a0; *(float4*)(sm + (ks * 3 + 1) * 64 + c4 * 4) = a1; *(float4*)(sm + (ks * 3 + 2) * 64 + c4 * 4) = a2;
            __syncthreads();
            if (tid < 192) {
                const int cls = tid >> 6, cc = tid & 63; float s = 0.f;
                for (int k = 0; k < 32; ++k) s += sm[(k * 3 + cls) * 64 + cc];
                const int colo = cg * 64 + cc;
                ((float*)(p.ws + WS_MOD))[(size_t)(l * 3 + cls) * 6144 + colo] = s + p.b_mod[(size_t)l * 6144 + colo];
            }
        } else if (item < P0_MOD + P0_TGROUPS) {
            int gi = item - P0_MOD; const int gl = gi / 784; gi %= 784;
            int base, nK; if (gi < 192) { base = 0; nK = 16; } else if (gi < 256) { gi -= 192; base = 768; nK = 16; } else if (gi < 608) { gi -= 256; base = 1024; nK = 16; } else { gi -= 608; base = 2432; nK = 44; }
            const int ng = gi / nK, kt = gi % nK;
#define P0_ITEM(u) (gl * P0_TILES_L + base + (ng * 4 + (u)) * nK + kt)
            float* cs = sm + 4 * 64 * 65;
            if (tid < 64) { cs[tid] = cospif((float)tid / 32.f); cs[64 + tid] = sinpif((float)tid / 32.f); }
#pragma unroll
            for (int u = 0; u < 4; ++u) {
                const P0Tile t = p0_decode(p, P0_ITEM(u)); float* tile = sm + u * 64 * 65;
                if (t.mode != 3) {
#pragma unroll
                    for (int i = 0; i < 2; ++i) { const int k = i * 32 + (tid >> 4), n4 = (tid & 15) * 4;
                        const float4 v = *(const float4*)(t.src + (size_t)(t.k0 + k) * t.srcN + t.scol + n4);
                        tile[k * 65 + n4] = v.x; tile[k * 65 + n4 + 1] = v.y; tile[k * 65 + n4 + 2] = v.z; tile[k * 65 + n4 + 3] = v.w; }
                }
            }
            __syncthreads();
#pragma unroll 1
            for (int u = 0; u < 4; ++u) {
                const P0Tile t = p0_decode(p, P0_ITEM(u)); const float* tile = sm + u * 64 * 65;
                const int n = tid >> 3, k8 = (tid & 7) * 8;
                float v[8];
                if (t.mode == 0) {
#pragma unroll
                    for (int j = 0; j < 8; ++j) v[j] = tile[(k8 + j) * 65 + n];
                } else if (t.mode == 3) {
#pragma unroll
                    for (int j = 0; j < 8; ++j) v[j] = 0.f;
                } else {
#pragma unroll
                    for (int j = 0; j < 8; ++j) v[j] = 0.f;
                    for (int cc = 0; cc < 64; ++cc) {
                        const int idx = (n * cc) & 63;
                        const float tr = (t.mode == 1) ? cs[idx] * 0.125f : -cs[64 + idx] * 0.125f;
#pragma unroll
                        for (int j = 0; j < 8; ++j) v[j] += tile[(k8 + j) * 65 + cc] * tr;
                    }
                }
                uint4 o;
                o.x = pk_bf16(v[0], v[1]); o.y = pk_bf16(v[2], v[3]);
                o.z = pk_bf16(v[4], v[5]); o.w = pk_bf16(v[6], v[7]);
                *(uint4*)(t.dst + (size_t)(t.n0 + n) * t.K + t.k0 + k8) = o;
            }
        } else if (item >= P0_MOD + P0_TGROUPS + 1280) {
            const int it = item - (P0_MOD + P0_TGROUPS + 1280), l = it / 5, kind = it % 5, K = kind == 4 ? 64 : 32;
            const float* src = kind == 4 ? p.gate_up + (size_t)l * 64 * 384 : ((kind >> 1) ? p.iclr_up : p.decay_up) + (size_t)((l * 2 + (kind & 1)) * 32) * 384;
            bf16_t* dst = (bf16_t*)(p.ws + WS_WLT) + (size_t)l * WLT_L + kind * 12288;
            for (int e = tid; e < 384 * K; e += blockDim.x) { const int n = e % 384, k = e / 384; dst[n * K + k] = f2bf(src[(size_t)k * 384 + n]); }
        } else {
            const int r = item - (P0_MOD + P0_TGROUPS);
            const int T = r < 256 ? 256 : 1024, ft = r < 256 ? r : r - 256;
            bf16_t* L = r < 256 ? (bf16_t*)(p.ws + WS_L256) + (size_t)ft * 512 : (bf16_t*)(p.ws + WS_L1024) + (size_t)ft * 2048;
            const float sc = r < 256 ? 0.0625f : 0.03125f;
            for (int k = tid; k < 2 * T; k += blockDim.x) {
                const int t = k & (T - 1), idx = (ft * t) & (T - 1);
                const float ang = (float)(2 * idx) / (float)T;
                L[k] = f2bf((k < T ? cospif(ang) : sinpif(ang)) * sc);
            }
        }
    }
}

__device__ __forceinline__ void ph_prep0b(const P& p) {
    const int tid_ = otid(); const int lane = tid_ & 63, wv = tid_ >> 6, nw = blockDim.x >> 6;
#pragma unroll 1
    for (int grp = 0; grp < 4; ++grp) {
        const int l = grp & 1, isf = grp >> 1, N = isf ? 5632 : 3072, which = isf ? 3 : 0;
        const bf16_t* Wb = isf ? (const bf16_t*)(p.ws + WS_WF1) + (size_t)l * 5632 * 1024 : (const bf16_t*)(p.ws + WS_WIN) + (size_t)l * N1 * 1024;
        float* outb = (float*)(p.ws + WS_BIAS) + (isf ? 2 * 3 * 3072 + (size_t)(l * 3) * 5632 : (size_t)(l * 3) * 3072);
        float sh[3][16];
#pragma unroll
        for (int c = 0; c < 3; ++c) { const float* sp = mod_vec(p, l, c, which) + lane * 16;
#pragma unroll
            for (int e = 0; e < 4; ++e) { const float4 v = *(const float4*)(sp + 4 * e); sh[c][4 * e] = v.x; sh[c][4 * e + 1] = v.y; sh[c][4 * e + 2] = v.z; sh[c][4 * e + 3] = v.w; } }
#pragma unroll 2
        for (int n = blockIdx.x * nw + wv; n < N; n += gridDim.x * nw) {
            const bf16_t* W = Wb + (size_t)n * 1024;
            const uint4 w0 = *(const uint4*)(W + lane * 16), w1 = *(const uint4*)(W + lane * 16 + 8);
            const unsigned ww[8] = {w0.x, w0.y, w0.z, w0.w, w1.x, w1.y, w1.z, w1.w};
            float acc[3] = {0.f, 0.f, 0.f};
#pragma unroll
            for (int c = 0; c < 3; ++c)
#pragma unroll
                for (int e = 0; e < 8; ++e) acc[c] += sh[c][2 * e] * bf2f((bf16_t)(ww[e] & 0xffff)) + sh[c][2 * e + 1] * bf2f((bf16_t)(ww[e] >> 16));
#pragma unroll
            for (int c = 0; c < 3; ++c) { const float t = wave_sum(acc[c]); if (lane == 0) outb[(size_t)c * N + n] = t; }
        }
    }
    float* rsq0 = (float*)(p.ws + WS_RSQ);
    for (int row = blockIdx.x * nw + wv; row < NTOK; row += gridDim.x * nw) {
        const float* xr = xin_row(p, row);
        float4 x[4]; float ss = 0.f;
#pragma unroll
        for (int i = 0; i < 4; ++i) { x[i] = *(const float4*)(xr + i * 256 + lane * 4); ss += x[i].x * x[i].x + x[i].y * x[i].y + x[i].z * x[i].z + x[i].w * x[i].w; }
        ss = wave_sum(ss);
        if (lane == 0) rsq0[row] = ss;
        const float* sc = mod_vec(p, 0, tok_cls(row), 1);
        bf16_t* h = (bf16_t*)(p.ws + WS_H) + (size_t)row * 1024;
#pragma unroll
        for (int i = 0; i < 4; ++i) { const int c = i * 256 + lane * 4;
            const float4 gg = *(const float4*)(p.norm1_g + c), s1 = *(const float4*)(sc + c);
            uint2 o; o.x = pk_bf16(x[i].x * gg.x * (1.f + s1.x), x[i].y * gg.y * (1.f + s1.y));
            o.y = pk_bf16(x[i].z * gg.z * (1.f + s1.z), x[i].w * gg.w * (1.f + s1.w));
            *(uint2*)(h + c) = o; }
    }
}

__device__ __forceinline__ void ph_norm(const P& p, int l, int which) {
    const int tid_ = otid(); const int lane = tid_ & 63, wv = tid_ >> 6, nw = blockDim.x >> 6;
    for (int row = blockIdx.x * nw + wv; row < NTOK; row += gridDim.x * nw) {
        const float* xr = (which == 0 && l == 0) ? xin_row(p, row) : X_row(p, row);
        float4 x[4]; float ss = 0.f;
#pragma unroll
        for (int i = 0; i < 4; ++i) { x[i] = *(const float4*)(xr + i * 256 + lane * 4); ss += x[i].x * x[i].x + x[i].y * x[i].y + x[i].z * x[i].z + x[i].w * x[i].w; }
        ss = wave_sum(ss);
        const float rstd = rsqrtf(ss * (1.f / 1024.f) + 1e-6f);
        if (which == 2) {
            float* o = p.out + (size_t)row * 1024;
#pragma unroll
            for (int i = 0; i < 4; ++i) { const float4 g = *(const float4*)(p.final_g + i * 256 + lane * 4);
                float4 y; y.x = x[i].x * rstd * g.x; y.y = x[i].y * rstd * g.y; y.z = x[i].z * rstd * g.z; y.w = x[i].w * rstd * g.w;
                *(float4*)(o + i * 256 + lane * 4) = y; }
        } else {
            const int cls = tok_cls(row);
            const float* g = (which == 0 ? p.norm1_g : p.norm2_g) + (size_t)l * 1024;
            const float* sh = mod_vec(p, l, cls, which == 0 ? 0 : 3);
            const float* sc = mod_vec(p, l, cls, which == 0 ? 1 : 4);
            bf16_t* h = (bf16_t*)(p.ws + WS_H) + (size_t)row * 1024;
#pragma unroll
            for (int i = 0; i < 4; ++i) { const int c = i * 256 + lane * 4;
                const float4 gg = *(const float4*)(g + c), s1 = *(const float4*)(sc + c), s0 = *(const float4*)(sh + c);
                const float y0 = x[i].x * rstd * gg.x * (1.f + s1.x) + s0.x, y1 = x[i].y * rstd * gg.y * (1.f + s1.y) + s0.y;
                const float y2 = x[i].z * rstd * gg.z * (1.f + s1.z) + s0.z, y3 = x[i].w * rstd * gg.w * (1.f + s1.w) + s0.w;
                uint2 o; o.x = pk_bf16(y0, y1); o.y = pk_bf16(y2, y3);
                *(uint2*)(h + c) = o; }
        }
    }
}

struct EpiG1 {
    int l;
    __device__ __forceinline__ void operator()(const P& p, int row, int col, const float* v) const {
        if (col < C_FNET) {
            bf16_t* o = (bf16_t*)(p.ws + WS_UD) + (size_t)row * 1152 + col;
            uint2 w; w.x = pk_bf16(v[0], v[1]); w.y = pk_bf16(v[2], v[3]);
            *(uint2*)o = w;
            if (row < NPTOK && col >= 384) {
                const int b = row >> 8, t = row & 255;
                float* dst = p.out + (col < 768 ? OUT_CK : OUT_CV) + ((size_t)(b * 2 + l) * 256 + t) * 384 + (col < 768 ? col - 384 : col - 768);
                *(float4*)dst = make_float4(v[0], v[1], v[2], v[3]);
            }
        } else if (col < C_RWKV) {
            const int cc = col - C_FNET, g = cc >> 7, half = (cc >> 6) & 1, fc = cc & 63;
            bf16_t* o;
            if (row < NPTOK) { const int sq = row >> 8, t = row & 255; o = (bf16_t*)(p.ws + WS_ZF) + ((size_t)(sq * 256 + g * 64 + fc) * 512 + half * 256 + t);
                o[0] = f2bf(v[0]); o[512] = f2bf(v[1]); o[1024] = f2bf(v[2]); o[1536] = f2bf(v[3]); }
            else { const int r = row - NPTOK, b = r >> 10, t = r & 1023; o = (bf16_t*)(p.ws + WS_ZF) + (size_t)8192 * 512 + ((size_t)(b * 256 + g * 64 + fc) * 2048 + half * 1024 + t);
                o[0] = f2bf(v[0]); o[2048] = f2bf(v[1]); o[4096] = f2bf(v[2]); o[6144] = f2bf(v[3]); }
        } else if (col < C_END) {
            bf16_t* o = (bf16_t*)(p.ws + WS_UR) + (size_t)row * N_RWKV + (col - C_RWKV);
            uint2 w; w.x = pk_bf16(v[0], v[1]); w.y = pk_bf16(v[2], v[3]);
            *(uint2*)o = w;
        }
    }
};
struct EpiRes {
    int l, which;
    __device__ __forceinline__ void operator()(const P& p, int row, int col, const float* v) const {
        const float* g = mod_vec(p, l, tok_cls(row), which) + col;
        const float* xo = (which == 2 && l == 0) ? xin_row(p, row) + col : X_row(p, row) + col;
        const float4 x = *(const float4*)xo; const float4 gg = *(const float4*)g;
        *(float4*)(X_row(p, row) + col) = make_float4(x.x + gg.x * v[0], x.y + gg.y * v[1], x.z + gg.z * v[2], x.w + gg.w * v[3]);
    }
};

#define PR_TT 40
#define PR_LS 200
typedef short bf16x8p __attribute__((ext_vector_type(8)));
typedef float f32x4p __attribute__((ext_vector_type(4)));
#define PR_ROWB 2688
__device__ __forceinline__ void ph_prep(const P& p, int l, float* sm) {
    const int tid = otid(), lane = tid & 63, wv = tid >> 6;
    const bf16_t* UR = (const bf16_t*)(p.ws + WS_UR);
    unsigned char* lb = (unsigned char*)sm;
    bf16_t* urt = (bf16_t*)lb;
    bf16_t* linb = (bf16_t*)(lb + 42 * PR_ROWB);
    const float* mu0 = p.shift_mu + (size_t)l * 2 * N_RWKV; const float* mu1 = mu0 + N_RWKV;
#if PROBE_ID
    unsigned long long* tsp = (unsigned long long*)(p.ws + WS_CTL + 15360) + 32;
#define PSTAMP(i) do { __syncthreads(); if (blockIdx.x == 0 && tid == 0 && l == 0) tsp[i] = __builtin_amdgcn_s_memrealtime(); } while (0)
#else
#define PSTAMP(i)
#endif
    PSTAMP(0);
    for (int tile = blockIdx.x; tile < NTOK / PR_TT; tile += gridDim.x) {
        const int tok0 = tile * PR_TT;
        __syncthreads();
        for (int e = tid; e < 42 * 168; e += blockDim.x) {
            const int r = e / 168, c = e % 168, tok = tok0 - 1 + r;
            uint4 v = make_uint4(0u, 0u, 0u, 0u);
            if (tok >= 0 && tok < NTOK) v = *(const uint4*)((const unsigned char*)UR + (size_t)tok * PR_ROWB + c * 16);
            *(uint4*)(lb + r * PR_ROWB + c * 16) = v;
        }
        __syncthreads();
        for (int e = tid; e < 48 * 192; e += blockDim.x) {
            const int tk = e / 192, j = e % 192, col = 1152 + j;
            float x = 0.f;
            if (tk < PR_TT) {
                int s, t, T, st; tok_info(tok0 + tk, s, t, T, st);
                const float xc = bf2f(urt[(tk + 1) * 1344 + col]);
                const float xp = t > 0 ? bf2f(urt[tk * 1344 + col]) : 0.f;
                const float xn = t < T - 1 ? bf2f(urt[(tk + 2) * 1344 + col]) : 0.f;
                x = xc + mu0[col] * (xp - xc) + mu1[col] * (xn - xc);
                if (j < 64) x = tanhf(x); else if (j >= 128) x = sigmoidf_(x);
            }
            linb[tk * PR_LS + j] = f2bf(x);
        }
        __syncthreads();
        PSTAMP(1);
        {
            const int n = lane & 15, kg = lane >> 4;
            const bf16_t* WLT = (const bf16_t*)(p.ws + WS_WLT) + (size_t)l * WLT_L;
#pragma unroll 3
            for (int combo = wv; combo < 120; combo += 8) {
                const int kind = combo / 24, nt = combo % 24, ch = nt * 16 + n, h = ch >> 6, cl = ch & 63;
                const int K = kind == 4 ? 64 : 32, loff = kind == 4 ? 128 : (kind >> 1) * 64 + (kind & 1) * 32;
                const bf16_t* wrow = WLT + kind * 12288 + (size_t)ch * K + 8 * kg;
                const bf16x8p b0 = *(const bf16x8p*)wrow;
                bf16x8p b1 = b0; if (kind == 4) b1 = *(const bf16x8p*)(wrow + 32);
                float bias = 0.f;
                if (kind < 4) bias = ((kind >> 1) ? p.iclr_a0 : p.decay_w0)[(size_t)(l * 2 + (kind & 1)) * 384 + ch];
#pragma unroll
                for (int mt = 0; mt < 3; ++mt) {
                    f32x4p acc = {bias, bias, bias, bias};
                    const bf16x8p a0 = *(const bf16x8p*)(linb + (mt * 16 + n) * PR_LS + loff + 8 * kg);
                    acc = __builtin_amdgcn_mfma_f32_16x16x32_bf16(a0, b0, acc, 0, 0, 0);
                    if (kind == 4) { const bf16x8p a1 = *(const bf16x8p*)(linb + (mt * 16 + n) * PR_LS + loff + 32 + 8 * kg); acc = __builtin_amdgcn_mfma_f32_16x16x32_bf16(a1, b1, acc, 0, 0, 0); }
#pragma unroll
                    for (int r = 0; r < 4; ++r) {
                        const int tk = mt * 16 + kg * 4 + r;
                        if (tk < PR_TT) {
                            unsigned char* rec = p.ws + WS_OPS + (size_t)(tok0 + tk) * OPS_TOK + (size_t)h * OPS_REC;
                            if (kind == 4) ((bf16_t*)(rec + 1280))[192 + cl] = f2bf(acc[r]);
                            else { const float sg = sigmoidf_(acc[r]); ((float*)rec)[64 + (kind >> 1) * 128 + (kind & 1) * 64 + cl] = (kind >> 1) ? sg : __expf(-0.60653065971263342f * sg); }
                        }
                    }
                }
            }
        }
#if PROBE_ID
        if (blockIdx.x == 0 && tid == 0 && l == 0) tsp[2] = __builtin_amdgcn_s_memrealtime();
#endif
        {
#pragma unroll 2
            for (int pr = wv; pr < PR_TT * NH; pr += 8) {
                const int tk = pr / NH, h = pr % NH, ch = h * 64 + lane, tok = tok0 + tk; int s, t, T, st; tok_info(tok, s, t, T, st);
                float rkv[3];
#pragma unroll
                for (int q = 0; q < 3; ++q) { const int col = q * 384 + ch;
                    const float xc = bf2f(urt[(tk + 1) * 1344 + col]);
                    const float xp = t > 0 ? bf2f(urt[tk * 1344 + col]) : 0.f;
                    const float xn = t < T - 1 ? bf2f(urt[(tk + 2) * 1344 + col]) : 0.f;
                    rkv[q] = xc + mu0[col] * (xp - xc) + mu1[col] * (xn - xc); }
                const float kkr = rkv[1] * p.k_k[(size_t)l * 384 + ch];
                const float nrm = sqrtf(wave_sum(kkr * kkr));
                const float kk = kkr / fmaxf(nrm, 1e-12f);
                unsigned char* rec = p.ws + WS_OPS + (size_t)tok * OPS_TOK + (size_t)h * OPS_REC;
                ((float*)rec)[lane] = -kk;
                bf16_t* rb = (bf16_t*)(rec + 1280);
                rb[lane] = f2bf(rkv[0]); rb[64 + lane] = f2bf(rkv[2]); rb[128 + lane] = f2bf(rkv[1]);
            }
        }
    }
    PSTAMP(3);
    bf16_t* UD = (bf16_t*)(p.ws + WS_UD);
    for (int e = blockIdx.x * blockDim.x + tid; e < 2048 * 384; e += gridDim.x * blockDim.x) {
        const int tk = e / 384, pi = e % 384;
        const int grp = pi >> 3, pr = pi & 7, col = grp * 16 + pr;
        const int axis = grp & 1;
        const int t = tk & 1023, pos = axis == 0 ? (t >> 6) : (t & 63);
        const float inv = __powf(10000.f, -(float)pr / 8.f);
        float sn, cs; __sincosf((float)pos * inv, &sn, &cs);
        bf16_t* ptr = UD + (size_t)(NPTOK + tk) * 1152 + col;
        const float x1 = bf2f(ptr[0]), x2 = bf2f(ptr[8]);
        ptr[0] = f2bf(x1 * cs - x2 * sn); ptr[8] = f2bf(x2 * cs + x1 * sn);
    }
    PSTAMP(4);
}

#define SC_TC 32
template <int CTRL> __device__ __forceinline__ float dpp_add(float x) {
    return x + __builtin_bit_cast(float, __builtin_amdgcn_update_dpp(0, __builtin_bit_cast(int, x), CTRL, 0xf, 0xf, false));
}
#define SJ_RT   0
#define SJ_AT   4608
#define SJ_ZT   9216
#define SJ_ZPT  18432
#define SJ_WT   27648
#define SJ_S    36864
#define SJ_LAB  54272
#define SJ_LAKB 58880
#define SJ_MRB  61440
#define SJ_HB   66048
#define SJ_PC   74752
#define SJ_TOT  78208
#define SJ_LABB 75008
#define SJ_BYTES 79232
typedef float f32x4s __attribute__((ext_vector_type(4)));
typedef short bf16x8s __attribute__((ext_vector_type(8)));
#define MFMAB(a, b, c) __builtin_amdgcn_mfma_f32_16x16x32_bf16((a), (b), (c), 0, 0, 0)
struct ScanStage { float nkk[8], w[8], a[8]; bf16_t r[8], v[8], k[8]; };
__device__ __forceinline__ void scan_load(const P& p, int h, int dir, int T, int start, int st_base, int ht, ScanStage& g) {
    const int k = ht & 63, seg = __builtin_amdgcn_readfirstlane(ht >> 6);
#pragma unroll
    for (int j = 0; j < 8; ++j) {
        const int st = st_base + 8 * seg + j, t = dir == 0 ? st : T - 1 - st, tok = start + t;
        const unsigned char* rec = p.ws + WS_OPS + (size_t)tok * OPS_TOK + (size_t)h * OPS_REC;
        const float* rf = (const float*)rec; const bf16_t* rb = (const bf16_t*)(rec + 1280);
        g.nkk[j] = rf[k]; g.w[j] = rf[64 + dir * 64 + k]; g.a[j] = rf[192 + dir * 64 + k];
        g.r[j] = rb[k]; g.v[j] = rb[64 + k]; g.k[j] = rb[128 + k];
    }
}
__device__ __forceinline__ void scan_totals(const ScanStage& g, int ht, unsigned char* J) {
    float c = g.w[0];
#pragma unroll
    for (int j = 1; j < 8; ++j) c *= g.w[j];
    ((float*)(J + SJ_TOT))[(ht >> 6) * 64 + (ht & 63)] = c;
}
__device__ __forceinline__ void scan_store(const ScanStage& g, float ka, float vmul, int ht, unsigned char* J) {
    const int k = ht & 63, seg = ht >> 6;
    float cp[9]; cp[0] = 1.f;
#pragma unroll
    for (int j = 0; j < 8; ++j) cp[j + 1] = cp[j] * g.w[j];
    const float* TOT = (const float*)(J + SJ_TOT);
    const float T0 = TOT[k], T1 = TOT[64 + k], T2 = TOT[128 + k], T3 = TOT[192 + k];
    const float pre = seg == 0 ? 1.f : (seg == 1 ? T0 : (seg == 2 ? T0 * T1 : T0 * T1 * T2));
    const float PCk = T0 * T1 * T2 * T3;
    bf16_t* RT = (bf16_t*)(J + SJ_RT); bf16_t* AT = (bf16_t*)(J + SJ_AT); bf16_t* ZT = (bf16_t*)(J + SJ_ZT); bf16_t* ZPT = (bf16_t*)(J + SJ_ZPT); bf16_t* WT = (bf16_t*)(J + SJ_WT);
    float zb[8], zk[8], vv[8];
#pragma unroll
    for (int j = 0; j < 8; ++j) {
        const int t = 8 * seg + j;
        const float Pm = pre * cp[j], Pt = pre * cp[j + 1], inv = __builtin_amdgcn_rcpf(Pt), kk = bf2f(g.k[j]);
        const float bt = -g.nkk[j] * g.a[j] * inv, kt = kk * (1.f + (g.a[j] - 1.f) * ka) * inv;
        RT[t * 72 + k] = f2bf(bf2f(g.r[j]) * Pt); AT[t * 72 + k] = f2bf(g.nkk[j] * Pm);
        ZT[t * 72 + k] = f2bf(bt); ZT[(32 + t) * 72 + k] = f2bf(kt);
        zb[j] = bt * PCk; zk[j] = kt * PCk; vv[j] = bf2f(g.v[j]) * vmul;
    }
    { uint4 o; o.x = pk_bf16(zb[0], zb[1]); o.y = pk_bf16(zb[2], zb[3]); o.z = pk_bf16(zb[4], zb[5]); o.w = pk_bf16(zb[6], zb[7]); *(uint4*)(ZPT + k * 72 + 8 * seg) = o; }
    { uint4 o; o.x = pk_bf16(zk[0], zk[1]); o.y = pk_bf16(zk[2], zk[3]); o.z = pk_bf16(zk[4], zk[5]); o.w = pk_bf16(zk[6], zk[7]); *(uint4*)(ZPT + k * 72 + 32 + 8 * seg) = o; }
    { uint4 o; o.x = pk_bf16(vv[0], vv[1]); o.y = pk_bf16(vv[2], vv[3]); o.z = pk_bf16(vv[4], vv[5]); o.w = pk_bf16(vv[6], vv[7]); *(uint4*)(WT + k * 72 + 32 + 8 * seg) = o; }
    if (seg == 0) ((float*)(J + SJ_PC))[k] = PCk;
}
__device__ __forceinline__ bf16x8s lds_b8(const unsigned char* p) { return *(const bf16x8s*)p; }
__device__ __forceinline__ void ph_scan_job(const P& p, int l, int s, int h, int mode, int pdir, int seg, int st0, int nsteps, float* sm) {
    const int tid = otid(), half = __builtin_amdgcn_readfirstlane(tid >> 8), ht = tid & 255, wq = __builtin_amdgcn_readfirstlane(ht >> 6), lane = ht & 63, l15 = lane & 15, l4 = lane >> 4;
    const int dir = mode == 0 ? half : pdir, kind = mode == 0 ? 0 : 1 + half;
    int start, T; seq_info(s, start, T);
    unsigned char* J = (unsigned char*)sm + half * SJ_BYTES;
    float* S = (float*)(J + SJ_S); float* LAB = (float*)(J + SJ_LAB); float* HB = (float*)(J + SJ_HB); const float* PC = (const float*)(J + SJ_PC);
    bf16_t* WT = (bf16_t*)(J + SJ_WT); bf16_t* LAKB = (bf16_t*)(J + SJ_LAKB); bf16_t* MRB = (bf16_t*)(J + SJ_MRB); bf16_t* LABB = (bf16_t*)(J + SJ_LABB);
    const float vmul = kind == 1 ? 0.f : 1.f;
    float* ybase = kind == 1 ? (float*)(p.ws + WS_ZS) + ((ptrdiff_t)dir * 2048 - (ptrdiff_t)NPTOK) * 384 : (float*)(p.ws + WS_UR) + (size_t)dir * NTOK * 384;
    ybase += h * 64 + 16 * wq + l15;
    const float ka = p.k_a[(size_t)l * 384 + h * 64 + lane];
    const int nc = nsteps / SC_TC;
    ScanStage g;
    __syncthreads();
    {
        const float* s0 = (kind == 0 && s >= 32) ? p.state_rwkv + ((((size_t)(s - 32) * 2 + l) * 2 + dir) * NH + h) * 4096 : nullptr;
        for (int e = ht; e < 4096; e += 256) { const int v = e >> 6, k = e & 63; S[v * 68 + k] = s0 ? s0[e] : (kind == 1 && v == k ? 1.f : 0.f); }
        for (int e = ht; e < 64 * 32; e += 256) WT[(e >> 5) * 72 + (e & 31)] = 0;
    }
    scan_load(p, h, dir, T, start, st0, ht, g);
    scan_totals(g, ht, J);
    __syncthreads();
    scan_store(g, ka, vmul, ht, J);
    __syncthreads();
    for (int c = 0; c < nc; ++c) {
        if (c + 1 < nc) scan_load(p, h, dir, T, start, st0 + (c + 1) * SC_TC, ht, g);
        f32x4s accG[2], accY[2];
#pragma unroll
        for (int tt = 0; tt < 2; ++tt) { accG[tt] = (f32x4s){0.f, 0.f, 0.f, 0.f}; accY[tt] = accG[tt]; }
#pragma unroll
        for (int ks = 0; ks < 2; ++ks) {
            const float4 s0 = *(const float4*)(S + (16 * wq + l15) * 68 + 32 * ks + 8 * l4), s1 = *(const float4*)(S + (16 * wq + l15) * 68 + 32 * ks + 8 * l4 + 4);
            const float sv[8] = {s0.x, s0.y, s0.z, s0.w, s1.x, s1.y, s1.z, s1.w};
            union { unsigned u[4]; bf16x8s v; } hi, lo;
#pragma unroll
            for (int e = 0; e < 4; ++e) {
                const float h0 = bf2f(f2bf(sv[2 * e])), h1 = bf2f(f2bf(sv[2 * e + 1]));
                hi.u[e] = pk_bf16(sv[2 * e], sv[2 * e + 1]); lo.u[e] = pk_bf16(sv[2 * e] - h0, sv[2 * e + 1] - h1);
            }
#pragma unroll
            for (int tt = 0; tt < 2; ++tt) {
                const bf16x8s a = lds_b8(J + SJ_AT + (16 * tt + l15) * 144 + 64 * ks + 16 * l4), r = lds_b8(J + SJ_RT + (16 * tt + l15) * 144 + 64 * ks + 16 * l4);
                accG[tt] = MFMAB(a, hi.v, accG[tt]); accG[tt] = MFMAB(a, lo.v, accG[tt]);
                accY[tt] = MFMAB(r, hi.v, accY[tt]); accY[tt] = MFMAB(r, lo.v, accY[tt]);
            }
        }
        {
            const int xoff = wq < 2 ? SJ_AT + (16 * wq + l15) * 144 : SJ_RT + (16 * (wq - 2) + l15) * 144;
            const bf16x8s xa0 = lds_b8(J + xoff + 16 * l4), xa1 = lds_b8(J + xoff + 64 + 16 * l4);
#pragma unroll
            for (int zt = 0; zt < 4; ++zt) {
                f32x4s m = {0.f, 0.f, 0.f, 0.f};
                m = MFMAB(xa0, lds_b8(J + SJ_ZT + (16 * zt + l15) * 144 + 16 * l4), m);
                m = MFMAB(xa1, lds_b8(J + SJ_ZT + (16 * zt + l15) * 144 + 64 + 16 * l4), m);
#pragma unroll
                for (int r = 0; r < 4; ++r) {
                    const int t = (16 * wq + 4 * l4 + r) & 31, i = (16 * zt + l15) & 31;
                    if (wq < 2) { const float val = i < t ? m[r] : 0.f; if (zt < 2) { LAB[t * 36 + i] = val; LABB[t * 40 + i] = f2bf(val); } else LAKB[t * 40 + i] = f2bf(val); }
                    else MRB[t * 72 + 16 * zt + l15] = f2bf(i <= t ? m[r] : 0.f);
                }
            }
        }
        __syncthreads();
        {
            const bf16x8s vb = lds_b8(J + SJ_WT + (16 * wq + l15) * 144 + 64 + 16 * l4);
#pragma unroll
            for (int tt = 0; tt < 2; ++tt) {
                accG[tt] = MFMAB(lds_b8(J + SJ_LAKB + (16 * tt + l15) * 80 + 16 * l4), vb, accG[tt]);
#pragma unroll
                for (int r = 0; r < 4; ++r) HB[(16 * tt + 4 * l4 + r) * 68 + 16 * wq + l15] = accG[tt][r];
            }
        }
        asm volatile("s_waitcnt lgkmcnt(0)" ::: "memory");
        {
            const int vloc = lane >> 2, part = lane & 3, v = 16 * wq + vloc;
            const bf16x8s zero8 = {0, 0, 0, 0, 0, 0, 0, 0};
#pragma unroll
            for (int tb = 0; tb < 4; ++tb) {
                if (tb > 0) {
                    bf16x8s a = lds_b8(J + SJ_LABB + (8 * tb + l15) * 80 + 16 * l4);
                    if (l4 >= tb) a = zero8;
                    const bf16x8s ub = lds_b8(J + SJ_WT + (16 * wq + l15) * 144 + 16 * l4);
                    f32x4s d = {0.f, 0.f, 0.f, 0.f};
                    d = MFMAB(a, ub, d);
                    if (l4 < 2) {
#pragma unroll
                        for (int r = 0; r < 4; ++r) HB[(8 * tb + 4 * l4 + r) * 68 + 16 * wq + l15] += d[r];
                    }
                    asm volatile("s_waitcnt lgkmcnt(0)" ::: "memory");
                }
                float lab[8][2], hb[8], ub2[2] = {0.f, 0.f};
#pragma unroll
                for (int q = 0; q < 8; ++q) { const int t = 8 * tb + q; hb[q] = HB[t * 68 + v];
#pragma unroll
                    for (int cc = 0; cc < 2; ++cc) lab[q][cc] = (4 * cc < q) ? LAB[t * 36 + 8 * tb + 4 * cc + part] : 0.f; }
#pragma unroll
                for (int q = 0; q < 8; ++q) {
                    const int t = 8 * tb + q;
                    float sacc = 0.f;
#pragma unroll
                    for (int cc = 0; cc < 2; ++cc) if (4 * cc < q) sacc = fmaf(lab[q][cc], ub2[cc], sacc);
                    sacc = dpp_add<0xB1>(sacc); sacc = dpp_add<0x4E>(sacc);
                    const float u = hb[q] + sacc;
                    if ((q & 3) == part) ub2[q >> 2] = u;
                    WT[v * 72 + t] = f2bf(u);
                }
                asm volatile("s_waitcnt lgkmcnt(0)" ::: "memory");
            }
        }
        asm volatile("s_waitcnt lgkmcnt(0)" ::: "memory");
        {
            const bf16x8s w0 = lds_b8(J + SJ_WT + (16 * wq + l15) * 144 + 16 * l4), w1 = lds_b8(J + SJ_WT + (16 * wq + l15) * 144 + 64 + 16 * l4);
#pragma unroll
            for (int tt = 0; tt < 2; ++tt) {
                accY[tt] = MFMAB(lds_b8(J + SJ_MRB + (16 * tt + l15) * 144 + 16 * l4), w0, accY[tt]);
                accY[tt] = MFMAB(lds_b8(J + SJ_MRB + (16 * tt + l15) * 144 + 64 + 16 * l4), w1, accY[tt]);
#pragma unroll
                for (int r = 0; r < 4; ++r) { const int st = st0 + c * SC_TC + 16 * tt + 4 * l4 + r, t = dir == 0 ? st : T - 1 - st; __hip_atomic_store(ybase + (size_t)(start + t) * 384, accY[tt][r], __ATOMIC_RELAXED, __HIP_MEMORY_SCOPE_AGENT); }
            }
#pragma unroll
            for (int kt = 0; kt < 4; ++kt) {
                const int k = 16 * kt + l15; const float pc = PC[k];
                f32x4s acc;
#pragma unroll
                for (int r = 0; r < 4; ++r) acc[r] = S[(16 * wq + 4 * l4 + r) * 68 + k] * pc;
                acc = MFMAB(w0, lds_b8(J + SJ_ZPT + k * 144 + 16 * l4), acc);
                acc = MFMAB(w1, lds_b8(J + SJ_ZPT + k * 144 + 64 + 16 * l4), acc);
#pragma unroll
                for (int r = 0; r < 4; ++r) S[(16 * wq + 4 * l4 + r) * 68 + k] = acc[r];
            }
        }
        if (c + 1 < nc) scan_totals(g, ht, J);
        __syncthreads();
        if (c + 1 < nc) { scan_store(g, ka, vmul, ht, J); __syncthreads(); }
    }
    float* so = nullptr;
    if (mode == 0) so = s < 32 ? p.out + OUT_ST + ((((size_t)s * 2 + l) * 2 + dir) * NH + h) * 4096
                              : (float*)(p.ws + WS_SS) + ((size_t)(((s - 32) * NH + h) * 2 + dir) * 3 + 0) * 4096;
    else if (seg == 1) so = (float*)(p.ws + WS_SS) + ((size_t)(((s - 32) * NH + h) * 2 + dir) * 3 + kind) * 4096;
    if (so) for (int e = ht; e < 4096; e += 256) so[e] = S[(e >> 6) * 68 + (e & 63)];
}

#define SEG0_LEN 352
#define SEG1_LEN 352
#define SEG2_LEN 320
#define CTL_SCANDONE 3720
__device__ __forceinline__ void fixup_item(const P& p, int l, int item4, float* sm) {
    const int tid = otid(), lane = tid & 63, wv = tid >> 6;
    {
        const int item = item4 >> 2, qtr = item4 & 3;
        const int b = item / 24, h = (item % 24) >> 2, dir = (item >> 1) & 1, seg = 1 + (item & 1);
        const float* E0 = (const float*)(p.ws + WS_SS) + (size_t)(((b * NH + h) * 2 + dir) * 3) * 4096; const float* P1 = E0 + 4096; const float* Q1 = E0 + 8192;
        if (tid == 0) {
            unsigned* cnt = (unsigned*)(p.ws + WS_CTL) + CTL_SCANDONE + 32 * l + (b * NH + h) * 2 + dir; unsigned sp = 0;
            while (__hip_atomic_load(cnt, __ATOMIC_RELAXED, __HIP_MEMORY_SCOPE_AGENT) < 3u && ++sp < (1u << 24)) __builtin_amdgcn_s_sleep(4);
            __builtin_amdgcn_fence(__ATOMIC_ACQUIRE, "agent");
            asm volatile("s_waitcnt vmcnt(0)" ::: "memory");
        }
        __syncthreads();
        { const int v = tid >> 3, kg = tid & 7;
          float acc[8];
          if (seg == 1) {
#pragma unroll
              for (int j = 0; j < 8; ++j) acc[j] = E0[v * 64 + kg * 8 + j];
          } else {
#pragma unroll
              for (int j = 0; j < 8; ++j) acc[j] = Q1[v * 64 + kg * 8 + j];
#pragma unroll 8
              for (int i = 0; i < 64; ++i) { const float e = E0[v * 64 + i]; const float4 pa = *(const float4*)(P1 + i * 64 + kg * 8), pb = *(const float4*)(P1 + i * 64 + kg * 8 + 4);
                  acc[0] += e * pa.x; acc[1] += e * pa.y; acc[2] += e * pa.z; acc[3] += e * pa.w; acc[4] += e * pb.x; acc[5] += e * pb.y; acc[6] += e * pb.z; acc[7] += e * pb.w; }
          }
#pragma unroll
          for (int j = 0; j < 8; ++j) sm[v * 65 + kg * 8 + j] = acc[j]; }
        __syncthreads();
        float Srow[64];
#pragma unroll
        for (int i = 0; i < 64; ++i) Srow[i] = sm[lane * 65 + i];
        const int qlen = (seg == 1 ? SEG1_LEN : SEG2_LEN) / 4;
        const int st0 = (seg == 1 ? SEG0_LEN : SEG0_LEN + SEG1_LEN) + qtr * qlen;
        const float* Zb = (const float*)(p.ws + WS_ZS) + (size_t)dir * 2048 * 384; float* Yb = (float*)(p.ws + WS_UR) + (size_t)dir * NTOK * 384;
#pragma unroll 1
        for (int q = wv * 4; q < qlen; q += 32) {
            int zi[4]; float yv[4]; float* yp[4]; bool ok[4];
#pragma unroll
            for (int u = 0; u < 4; ++u) {
                ok[u] = (q + u) < qlen;
                const int st = st0 + (ok[u] ? q + u : 0), t = dir ? 1023 - st : st, stok = b * 1024 + t;
                zi[u] = __builtin_bit_cast(int, Zb[(size_t)stok * 384 + h * 64 + lane]);
                yp[u] = Yb + (size_t)(NPTOK + stok) * 384 + h * 64 + lane; yv[u] = *yp[u];
            }
#pragma unroll
            for (int i = 0; i < 64; ++i)
#pragma unroll
                for (int u = 0; u < 4; ++u) yv[u] += Srow[i] * __builtin_bit_cast(float, __builtin_amdgcn_readlane(zi[u], i));
#pragma unroll
            for (int u = 0; u < 4; ++u) if (ok[u]) __hip_atomic_store(yp[u], yv[u], __ATOMIC_RELAXED, __HIP_MEMORY_SCOPE_AGENT);
        }
        asm volatile("s_waitcnt vmcnt(0)" ::: "memory");
        __syncthreads();
        if (tid == 0) __hip_atomic_fetch_add((unsigned*)(p.ws + WS_CNT2) + 256 * l + 192 + b * NH + h, 1u, __ATOMIC_RELAXED, __HIP_MEMORY_SCOPE_AGENT);
    }
}

template <class Map>
__device__ __forceinline__ void finalize_range(const P& p, int l, int n_items, int wave0, int wstride, const Map& map) {
    const int tid_ = otid(); const int lane = tid_ & 63;
    const float* Yb = (const float*)(p.ws + WS_UR);
    bf16_t* MIX = (bf16_t*)(p.ws + WS_H);
    for (int it0 = wave0 * 8; it0 < n_items; it0 += wstride * 8) {
        float y[8], a0[8], a1[8], r[8], vv[8], k[8], g[8];
        int tokv[8], chv[8];
#pragma unroll
        for (int u = 0; u < 8; ++u) {
            int tok, h; map(it0 + u, tok, h); const int ch = h * 64 + lane; tokv[u] = tok; chv[u] = ch;
            y[u] = Yb[(size_t)tok * 384 + ch] + Yb[((size_t)NTOK + tok) * 384 + ch];
            const unsigned char* rec = p.ws + WS_OPS + (size_t)tok * OPS_TOK + (size_t)h * OPS_REC;
            const float* rf = (const float*)rec; const bf16_t* rb = (const bf16_t*)(rec + 1280);
            a0[u] = rf[192 + lane]; a1[u] = rf[256 + lane];
            r[u] = bf2f(rb[lane]); vv[u] = bf2f(rb[64 + lane]); k[u] = bf2f(rb[128 + lane]); g[u] = bf2f(rb[192 + lane]);
        }
        float mu[8], var[8], bs[8];
#pragma unroll
        for (int u = 0; u < 8; ++u) mu[u] = y[u];
#pragma unroll
        for (int o = 1; o < 64; o <<= 1)
#pragma unroll
            for (int u = 0; u < 8; ++u) mu[u] += __shfl_xor(mu[u], o);
#pragma unroll
        for (int u = 0; u < 8; ++u) { mu[u] *= (1.f / 64.f); y[u] -= mu[u]; var[u] = y[u] * y[u];
            const float ka = p.k_a[(size_t)l * 384 + chv[u]];
            bs[u] = r[u] * (k[u] * (1.f + (a0[u] - 1.f) * ka) + k[u] * (1.f + (a1[u] - 1.f) * ka)) * p.r_k[(size_t)l * 384 + chv[u]]; }
#pragma unroll
        for (int o = 1; o < 64; o <<= 1)
#pragma unroll
            for (int u = 0; u < 8; ++u) { var[u] += __shfl_xor(var[u], o); bs[u] += __shfl_xor(bs[u], o); }
#pragma unroll
        for (int u = 0; u < 8; ++u) {
            const float yn = y[u] * rsqrtf(var[u] * (1.f / 64.f) + 64e-5f) * p.lnx_g[(size_t)l * 384 + chv[u]] + p.lnx_b[(size_t)l * 384 + chv[u]];
            MIX[(size_t)tokv[u] * 1024 + chv[u]] = f2bf((yn + bs[u] * vv[u]) * g[u]);
        }
    }
}

__device__ __forceinline__ void finalize_item(const P& p, int l, int item) {
    const int q4 = item < 192 ? 0 : (item - 192) & 3, bh = item < 192 ? item : 192 + ((item - 192) >> 2);
    unsigned* cnt = (unsigned*)(p.ws + WS_CNT2) + 256 * l + bh; const unsigned need = item < 192 ? 1u : 16u;
    if (threadIdx.x == 0) { unsigned sp = 0;
        while (__hip_atomic_load(cnt, __ATOMIC_RELAXED, __HIP_MEMORY_SCOPE_AGENT) < need && ++sp < (1u << 24)) __builtin_amdgcn_s_sleep(4);
        __builtin_amdgcn_fence(__ATOMIC_ACQUIRE, "agent");
        asm volatile("s_waitcnt vmcnt(0)" ::: "memory"); }
    __syncthreads();
    const int wv = otid() >> 6;
    if (item < 192) { const int ss = item / NH, hh = item % NH; finalize_range(p, l, TP, wv, 8, [=](int it, int& tok, int& h) { tok = ss * TP + it; h = hh; }); }
    else { const int bb = (bh - 192) / NH, hh = (bh - 192) % NH; finalize_range(p, l, 256, wv, 8, [=](int it, int& tok, int& h) { tok = NPTOK + bb * TS + q4 * 256 + it; h = hh; }); }
}

#define LAS __attribute__((address_space(3)))
namespace pg8 {
typedef short bf16x8 __attribute__((ext_vector_type(8)));
typedef float f32x4 __attribute__((ext_vector_type(4)));
constexpr int BM = 256, BK = 64, HALF = 128, HTB = HALF * BK * 2, STAGE_BYTES = 8 * HTB, NXCD = 8, WGM = 8;
__host__ __device__ __forceinline__ int lds_byte(int r, int c) { const int st = (r >> 4) * 2 + (c >> 5), rr = r & 15, cc = c & 31, ob = rr * 64 + cc * 2; return st * 1024 + (ob ^ (((ob >> 9) & 1) << 5)); }
__host__ __device__ __forceinline__ void stage_rc(int b, int& R, int& C) { const int st = b / 1024, sb = b % 1024, swz = sb ^ (((sb >> 9) & 1) << 5); R = (st >> 1) * 16 + swz / 64; C = (st & 1) * 32 + (swz % 64) / 2; }
struct Unit { int pm, pn; };
struct Gemm { const bf16_t* A; const bf16_t* Bt; int M, N, K; };
struct StaticOrder {
    int nM, nN, nwg, G, c;
    __device__ void init(int M, int N, int G_, int c_) { nM = M / BM; nN = N / BM; nwg = nM * nN; G = G_; c = c_; }
    __device__ bool next(int i, Unit& u) const {
        const long L = (long)i * G + c; if (L >= nwg) return false;
        int wgid = (int)L; { const int q = nwg / NXCD, r = nwg % NXCD, xcd = wgid % NXCD, off = wgid / NXCD; wgid = (xcd < r ? xcd * (q + 1) : r * (q + 1) + (xcd - r) * q) + off; }
        const int nig = WGM * nN, gid = wgid / nig, fm = gid * WGM, gsz = (nM - fm) < WGM ? (nM - fm) : WGM;
        u.pm = fm + ((wgid % nig) % gsz); u.pn = (wgid % nig) / gsz; return true;
    }
};
template <class Epi, class Sched>
__device__ __forceinline__ void gemm_phase(LAS unsigned char* lds, const Gemm g, const Sched& S, const Epi& E) {
    int tid_ = threadIdx.x; asm volatile("" : "+v"(tid_));
    const int tid = tid_, wid = __builtin_amdgcn_readfirstlane(tid >> 6), lane = tid & 63, wr = wid >> 2, wc = wid & 3, fr = lane & 15, fq = lane >> 4;
    const int K = g.K, nt = K / BK;
    unsigned voffA[2], voffB[2];
#pragma unroll
    for (int i = 0; i < 2; ++i) { int R, C; stage_rc(tid * 16 + i * 8192, R, C);
        const int rho = R & 31, Rb = Epi::PERM ? ((R & ~31) + 8 * ((rho & 15) >> 2) + 4 * (rho >> 4) + (rho & 3)) : R;
        voffA[i] = (unsigned)(R * K + C) * 2u; voffB[i] = (unsigned)(Rb * K + C) * 2u; }
    const size_t kstep = (size_t)(BK * 2);
    const size_t hstep = (size_t)HALF * K * 2;
    const size_t tstep = 2 * hstep;
    const unsigned ldsw = (unsigned)wid * 1024u;
    const int aoff = lds_byte(wr * 64 + fr, fq * 8), boff = lds_byte(wc * 32 + fr, fq * 8);
#define PG8_SA(b, h) (((b) * 2 + (h)) * HTB)
#define PG8_SB(b, h) ((4 + (b) * 2 + (h)) * HTB)
#define PG8_STAGE(bufoff, gbase, voff) do { _Pragma("unroll") for (int _i = 0; _i < 2; ++_i) \
        __builtin_amdgcn_global_load_lds((const unsigned*)((const char*)(gbase) + (voff)[_i]), (LAS unsigned*)(lds + (bufoff) + ldsw + _i * 8192), 16, 0, 0); } while (0)
#define PG8_LDA(dst, b, h) do { _Pragma("unroll") for (int m = 0; m < 4; ++m) _Pragma("unroll") for (int k = 0; k < 2; ++k) dst[m][k] = *(const LAS bf16x8*)(lds + PG8_SA(b, h) + aoff + m * 2048 + k * 1024); } while (0)
#define PG8_LDB(dst, b, h) do { _Pragma("unroll") for (int n = 0; n < 2; ++n) _Pragma("unroll") for (int k = 0; k < 2; ++k) dst[n][k] = *(const LAS bf16x8*)(lds + PG8_SB(b, h) + boff + n * 2048 + k * 1024); } while (0)
#define PG8_MMA(ai, bj, At, Bt) do { __builtin_amdgcn_s_setprio(1); _Pragma("unroll") for (int m = 0; m < 4; ++m) _Pragma("unroll") for (int n = 0; n < 2; ++n) _Pragma("unroll") for (int k = 0; k < 2; ++k) \
        acc[ai][bj][m][n] = __builtin_amdgcn_mfma_f32_16x16x32_bf16(Bt[n][k], At[m][k], acc[ai][bj][m][n], 0, 0, 0); __builtin_amdgcn_s_setprio(0); } while (0)
#define PG8_WAIT_V(n) asm volatile("s_waitcnt vmcnt(" #n ")" ::: "memory")
#define PG8_WAIT_L(n) asm volatile("s_waitcnt lgkmcnt(" #n ")" ::: "memory")
#define PG8_BAR __builtin_amdgcn_s_barrier()
#define PG8_SCHED __builtin_amdgcn_sched_barrier(0)
    Unit cur, nxt; int ui = 0;
    if (!S.next(0, cur)) return;
    f32x4 acc[2][2][4][2];
#pragma unroll
    for (int a = 0; a < 2; ++a)
#pragma unroll
        for (int b = 0; b < 2; ++b)
#pragma unroll
            for (int m = 0; m < 4; ++m)
#pragma unroll
                for (int n = 0; n < 2; ++n) acc[a][b][m][n] = (f32x4){0.f, 0.f, 0.f, 0.f};
    bf16x8 At[4][2], B0[2][2], B1[2][2];
    const char* cA = (const char*)g.A + (size_t)cur.pm * tstep; const char* cB = (const char*)g.Bt + (size_t)cur.pn * tstep;
    PG8_STAGE(PG8_SB(0, 0), cB, voffB); PG8_STAGE(PG8_SA(0, 0), cA, voffA); PG8_STAGE(PG8_SB(0, 1), cB + hstep, voffB); PG8_STAGE(PG8_SA(0, 1), cA + hstep, voffA);
    if (wr == 1) PG8_BAR;
    PG8_WAIT_V(4); PG8_BAR;
    PG8_STAGE(PG8_SB(1, 0), cB + kstep, voffB); PG8_STAGE(PG8_SA(1, 0), cA + kstep, voffA); PG8_STAGE(PG8_SB(1, 1), cB + hstep + kstep, voffB);
    PG8_WAIT_V(6); PG8_BAR;
    for (;;) {
        const bool has_next = S.next(ui + 1, nxt);
        const char* nA = has_next ? (const char*)g.A + (size_t)nxt.pm * tstep : cA; const char* nB = has_next ? (const char*)g.Bt + (size_t)nxt.pn * tstep : cB;
        for (int t = 0; t < nt; t += 2) {
            const bool last = (t == nt - 2);
            const char* a1 = cA + (size_t)(t + 1) * kstep;
            const char* a2 = last ? nA : cA + (size_t)(t + 2) * kstep; const char* b2 = last ? nB : cB + (size_t)(t + 2) * kstep;
            const char* a3 = a2 + kstep; const char* b3 = b2 + kstep;
            PG8_LDB(B0, 0, 0); PG8_SCHED; PG8_LDA(At, 0, 0); PG8_STAGE(PG8_SA(1, 1), a1 + hstep, voffA);
            PG8_WAIT_L(8); PG8_BAR; PG8_WAIT_L(0); PG8_MMA(0, 0, At, B0); PG8_BAR; PG8_SCHED;
            PG8_LDB(B1, 0, 1); PG8_STAGE(PG8_SB(0, 0), b2, voffB);
            PG8_BAR; PG8_WAIT_L(0); PG8_MMA(0, 1, At, B1); PG8_BAR;
            PG8_LDA(At, 0, 1); PG8_STAGE(PG8_SA(0, 0), a2, voffA);
            PG8_BAR; PG8_WAIT_L(0); PG8_MMA(1, 0, At, B0); PG8_BAR; PG8_SCHED;
            PG8_STAGE(PG8_SB(0, 1), b2 + hstep, voffB);
            PG8_WAIT_V(6); PG8_BAR; PG8_MMA(1, 1, At, B1); PG8_BAR;
            PG8_LDB(B0, 1, 0); PG8_SCHED; PG8_LDA(At, 1, 0); PG8_STAGE(PG8_SA(0, 1), a2 + hstep, voffA);
            PG8_WAIT_L(8); PG8_BAR; PG8_WAIT_L(0); PG8_MMA(0, 0, At, B0); PG8_BAR; PG8_SCHED;
            PG8_LDB(B1, 1, 1); PG8_STAGE(PG8_SB(1, 0), b3, voffB);
            PG8_BAR; PG8_WAIT_L(0); PG8_MMA(0, 1, At, B1); PG8_BAR;
            PG8_LDA(At, 1, 1); PG8_STAGE(PG8_SA(1, 0), a3, voffA);
            PG8_BAR; PG8_WAIT_L(0); PG8_MMA(1, 0, At, B0); PG8_BAR; PG8_SCHED;
            PG8_STAGE(PG8_SB(1, 1), b3 + hstep, voffB);
            PG8_WAIT_V(6); PG8_BAR; PG8_MMA(1, 1, At, B1); PG8_BAR;
        }
        E(acc, cur, wr, wc, fr, fq);
        if (!has_next) break;
#pragma unroll
        for (int a = 0; a < 2; ++a)
#pragma unroll
            for (int b = 0; b < 2; ++b)
#pragma unroll
                for (int m = 0; m < 4; ++m)
#pragma unroll
                    for (int n = 0; n < 2; ++n) acc[a][b][m][n] = (f32x4){0.f, 0.f, 0.f, 0.f};
        cur = nxt; cA = nA; cB = nB; ++ui;
    }
    PG8_WAIT_V(0);
    if (wr == 0) PG8_BAR;
    PG8_BAR;
#undef PG8_SA
#undef PG8_SB
#undef PG8_STAGE
#undef PG8_LDA
#undef PG8_LDB
#undef PG8_MMA
#undef PG8_WAIT_V
#undef PG8_WAIT_L
#undef PG8_BAR
#undef PG8_SCHED
}
template <class F> struct EpiWrap {
    static constexpr bool PERM = false;
    const P* p; F f;
    __device__ __forceinline__ void operator()(const f32x4 (&acc)[2][2][4][2], const Unit& u, int wr, int wc, int fr, int fq) const {
        const int row0 = u.pm * BM + wr * 64 + fr, col0 = u.pn * BM + wc * 32 + 4 * fq;
#pragma unroll
        for (int ai = 0; ai < 2; ++ai)
#pragma unroll
            for (int m = 0; m < 4; ++m)
#pragma unroll
                for (int bj = 0; bj < 2; ++bj)
#pragma unroll
                    for (int n = 0; n < 2; ++n) {
                        const f32x4 a = acc[ai][bj][m][n]; const float v[4] = {a[0], a[1], a[2], a[3]};
                        f(*p, row0 + ai * HALF + m * 16, col0 + bj * HALF + n * 16, v);
                    }
    }
};
struct EpiG1H {
    static constexpr bool PERM = true;
    const P* p; int l;
    __device__ __forceinline__ void operator()(const f32x4 (&acc)[2][2][4][2], const Unit& u, int wr, int wc, int fr, int fq) const {
        const int row0 = u.pm * BM + wr * 64 + fr, col0 = u.pn * BM + wc * 32 + 8 * fq;
        const float* rsq = (const float*)(p->ws + WS_RSQ) + (size_t)(2 * l) * NTOK;
        const float* bias = (const float*)(p->ws + WS_BIAS) + (size_t)(l * 3 + tok_cls(u.pm * BM)) * 3072 + col0;
        float rs[2][4]; float4 bb[2][2];
#pragma unroll
        for (int ai = 0; ai < 2; ++ai)
#pragma unroll
            for (int m = 0; m < 4; ++m) rs[ai][m] = rsq[row0 + ai * HALF + m * 16];
#pragma unroll
        for (int bj = 0; bj < 2; ++bj)
#pragma unroll
            for (int n = 0; n < 2; ++n) bb[bj][n] = *(const float4*)(bias + bj * HALF + n * 4);
#pragma unroll
        for (int ai = 0; ai < 2; ++ai)
#pragma unroll
            for (int m = 0; m < 4; ++m) rs[ai][m] = rsqrtf(rs[ai][m] * (1.f / 1024.f) + 1e-6f);
#pragma unroll
        for (int ai = 0; ai < 2; ++ai)
#pragma unroll
            for (int m = 0; m < 4; ++m)
#pragma unroll
                for (int bj = 0; bj < 2; ++bj) {
                    const int row = row0 + ai * HALF + m * 16, col = col0 + bj * HALF; const float r = rs[ai][m];
                    const f32x4 a0 = acc[ai][bj][m][0], a1 = acc[ai][bj][m][1]; const float4 b0 = bb[bj][0], b1 = bb[bj][1];
                    const float v[8] = {a0[0] * r + b0.x, a0[1] * r + b0.y, a0[2] * r + b0.z, a0[3] * r + b0.w, a1[0] * r + b1.x, a1[1] * r + b1.y, a1[2] * r + b1.z, a1[3] * r + b1.w};
                    if (col < C_FNET) {
                        uint4 w; w.x = pk_bf16(v[0], v[1]); w.y = pk_bf16(v[2], v[3]); w.z = pk_bf16(v[4], v[5]); w.w = pk_bf16(v[6], v[7]);
                        *(uint4*)((bf16_t*)(p->ws + WS_UD) + (size_t)row * 1152 + col) = w;
                        if (row < NPTOK && col >= 384) {
                            const int b = row >> 8, t = row & 255;
                            float* dst = p->out + (col < 768 ? OUT_CK : OUT_CV) + ((size_t)(b * 2 + l) * 256 + t) * 384 + (col < 768 ? col - 384 : col - 768);
                            *(float4*)dst = make_float4(v[0], v[1], v[2], v[3]); *(float4*)(dst + 4) = make_float4(v[4], v[5], v[6], v[7]);
                        }
                    } else if (col < C_RWKV) {
                        const int cc = col - C_FNET, g = cc >> 7, half = (cc >> 6) & 1, fc = cc & 63;
                        if (row < NPTOK) { const int sq = row >> 8, t = row & 255; bf16_t* o = (bf16_t*)(p->ws + WS_ZF) + ((size_t)(sq * 256 + g * 64 + fc) * 512 + half * 256 + t);
#pragma unroll
                            for (int e = 0; e < 8; ++e) o[e * 512] = f2bf(v[e]); }
                        else { const int rr = row - NPTOK, b = rr >> 10, t = rr & 1023; bf16_t* o = (bf16_t*)(p->ws + WS_ZF) + (size_t)8192 * 512 + ((size_t)(b * 256 + g * 64 + fc) * 2048 + half * 1024 + t);
#pragma unroll
                            for (int e = 0; e < 8; ++e) o[e * 2048] = f2bf(v[e]); }
                    } else if (col < C_END) {
                        uint4 w; w.x = pk_bf16(v[0], v[1]); w.y = pk_bf16(v[2], v[3]); w.z = pk_bf16(v[4], v[5]); w.w = pk_bf16(v[6], v[7]);
                        *(uint4*)((bf16_t*)(p->ws + WS_UR) + (size_t)row * N_RWKV + (col - C_RWKV)) = w;
                    }
                }
    }
};
struct EpiFfn1 {
    static constexpr bool PERM = true;
    const P* p; int l;
    __device__ __forceinline__ void operator()(const f32x4 (&acc)[2][2][4][2], const Unit& u, int wr, int wc, int fr, int fq) const {
        const int row0 = u.pm * BM + wr * 64 + fr, j0 = u.pn * 128 + wc * 32 + 8 * fq, c0 = u.pn * 256 + wc * 32 + 8 * fq;
        bf16_t* HA = (bf16_t*)(p->ws + WS_UR);
        const float* rsq = (const float*)(p->ws + WS_RSQ) + (size_t)(2 * l + 1) * NTOK;
        const float* bc = (const float*)(p->ws + WS_BIAS) + 2 * 3 * 3072 + (size_t)(l * 3 + tok_cls(u.pm * BM)) * 5632 + c0;
        float rs[2][4]; float4 bg[2], bu[2];
#pragma unroll
        for (int ai = 0; ai < 2; ++ai)
#pragma unroll
            for (int m = 0; m < 4; ++m) rs[ai][m] = rsq[row0 + ai * HALF + m * 16];
#pragma unroll
        for (int n = 0; n < 2; ++n) { bg[n] = *(const float4*)(bc + n * 4); bu[n] = *(const float4*)(bc + 128 + n * 4); }
#pragma unroll
        for (int ai = 0; ai < 2; ++ai)
#pragma unroll
            for (int m = 0; m < 4; ++m) rs[ai][m] = rsqrtf(rs[ai][m] * (1.f / 1024.f) + 1e-6f);
#pragma unroll
        for (int ai = 0; ai < 2; ++ai)
#pragma unroll
            for (int m = 0; m < 4; ++m) {
                const int row = row0 + ai * HALF + m * 16; const float r = rs[ai][m];
                float h[8];
#pragma unroll
                for (int n = 0; n < 2; ++n) {
                    const f32x4 g = acc[ai][0][m][n], up = acc[ai][1][m][n];
                    const float bgv[4] = {bg[n].x, bg[n].y, bg[n].z, bg[n].w}, buv[4] = {bu[n].x, bu[n].y, bu[n].z, bu[n].w};
#pragma unroll
                    for (int e = 0; e < 4; ++e) { const float gt = g[e] * r + bgv[e], uu = up[e] * r + buv[e]; h[4 * n + e] = gt * sigmoidf_(gt) * uu; }
                }
                uint4 w; w.x = pk_bf16(h[0], h[1]); w.y = pk_bf16(h[2], h[3]); w.z = pk_bf16(h[4], h[5]); w.w = pk_bf16(h[6], h[7]);
                *(uint4*)(HA + (size_t)row * D_FF + j0) = w;
            }
    }
};
struct EpiResN {
    static constexpr bool PERM = true;
    const P* p; int l, which;
    const float* ng; int nl, nsc;
    bf16_t* Hout; float* rsq;
    __device__ __forceinline__ void operator()(const f32x4 (&acc)[2][2][4][2], const Unit& u, int wr, int wc, int fr, int fq) const {
        const int row0 = u.pm * BM + wr * 64 + fr, col0 = u.pn * BM + wc * 32 + 8 * fq;
        const int cls = tok_cls(u.pm * BM);
        const float* g = mod_vec(*p, l, cls, which) + col0;
        float4 gg[2][2], gw[2][2];
#pragma unroll
        for (int bj = 0; bj < 2; ++bj)
#pragma unroll
            for (int n = 0; n < 2; ++n) {
                gg[bj][n] = *(const float4*)(g + bj * HALF + n * 4);
                if (ng) { const float4 gn = *(const float4*)(ng + col0 + bj * HALF + n * 4), sc = *(const float4*)(mod_vec(*p, nl, cls, nsc) + col0 + bj * HALF + n * 4);
                    gw[bj][n] = make_float4(gn.x * (1.f + sc.x), gn.y * (1.f + sc.y), gn.z * (1.f + sc.z), gn.w * (1.f + sc.w)); }
            }
#pragma unroll
        for (int ai = 0; ai < 2; ++ai)
#pragma unroll
            for (int mp = 0; mp < 4; mp += 2) {
                float4 x[2][2][2];
#pragma unroll
                for (int q = 0; q < 2; ++q) {
                    const int row = row0 + ai * HALF + (mp + q) * 16;
                    const float* xo = ((which == 2 && l == 0) ? xin_row(*p, row) : X_row(*p, row)) + col0;
#pragma unroll
                    for (int bj = 0; bj < 2; ++bj)
#pragma unroll
                        for (int n = 0; n < 2; ++n) x[q][bj][n] = *(const float4*)(xo + bj * HALF + n * 4);
                }
#pragma unroll
                for (int q = 0; q < 2; ++q) {
                    const int row = row0 + ai * HALF + (mp + q) * 16;
                    float ssq = 0.f;
#pragma unroll
                    for (int bj = 0; bj < 2; ++bj) {
                        float4 xn[2];
#pragma unroll
                        for (int n = 0; n < 2; ++n) {
                            const f32x4 a = acc[ai][bj][mp + q][n]; const float4 xv = x[q][bj][n], gv = gg[bj][n];
                            xn[n] = make_float4(xv.x + gv.x * a[0], xv.y + gv.y * a[1], xv.z + gv.z * a[2], xv.w + gv.w * a[3]);
                            *(float4*)(X_row(*p, row) + col0 + bj * HALF + n * 4) = xn[n];
                        }
                        if (ng) {
                            ssq += xn[0].x * xn[0].x + xn[0].y * xn[0].y + xn[0].z * xn[0].z + xn[0].w * xn[0].w + xn[1].x * xn[1].x + xn[1].y * xn[1].y + xn[1].z * xn[1].z + xn[1].w * xn[1].w;
                            const float4 w0 = gw[bj][0], w1 = gw[bj][1];
                            uint4 w; w.x = pk_bf16(xn[0].x * w0.x, xn[0].y * w0.y); w.y = pk_bf16(xn[0].z * w0.z, xn[0].w * w0.w); w.z = pk_bf16(xn[1].x * w1.x, xn[1].y * w1.y); w.w = pk_bf16(xn[1].z * w1.z, xn[1].w * w1.w);
                            *(uint4*)(Hout + (size_t)row * 1024 + col0 + bj * HALF) = w;
                        }
                    }
                    if (ng) { ssq += __shfl_xor(ssq, 16); ssq += __shfl_xor(ssq, 32); if (fq == 0) unsafeAtomicAdd(rsq + row, ssq); }
                }
            }
    }
};
}


typedef short bf16x8_t __attribute__((ext_vector_type(8)));
typedef short bf16x4_t __attribute__((ext_vector_type(4)));
typedef float f32x16_t __attribute__((ext_vector_type(16)));
#define AT_KS_BYTES (256 * 72 * 2)
__device__ __forceinline__ void attn_stage(const P& p, int l, int s, int h, int start, int nctx, int chunk, bool withV, bf16_t* Ks, bf16_t* Vt, int tid) {
    const int key = tid >> 1, half = tid & 1, j = chunk * 256 + key;
    if (j < nctx) {
        const size_t base = (((size_t)(s - 32) * 2 + l) * 512 + j) * 384 + h * 64 + half * 32;
        const float4* kp = (const float4*)(p.cache_k + base);
#pragma unroll
        for (int i = 0; i < 4; ++i) { const float4 a = kp[2 * i], b = kp[2 * i + 1]; uint4 o; o.x = pk_bf16(a.x, a.y); o.y = pk_bf16(a.z, a.w); o.z = pk_bf16(b.x, b.y); o.w = pk_bf16(b.z, b.w);
            *(uint4*)(Ks + key * 72 + half * 32 + i * 8) = o; }
        if (withV) { const float4* vp = (const float4*)(p.cache_v + base);
#pragma unroll
            for (int i = 0; i < 8; ++i) { const float4 a = vp[i]; bf16_t* d = Vt + (half * 32 + i * 4) * 260 + key; d[0] = f2bf(a.x); d[260] = f2bf(a.y); d[520] = f2bf(a.z); d[780] = f2bf(a.w); } }
    } else {
        const bf16_t* UD = (const bf16_t*)(p.ws + WS_UD);
        const size_t base = (size_t)(start + j - nctx) * 1152 + h * 64 + half * 32;
        const uint4* kp = (const uint4*)(UD + base + 384);
#pragma unroll
        for (int i = 0; i < 4; ++i) *(uint4*)(Ks + key * 72 + half * 32 + i * 8) = kp[i];
        if (withV) { const uint4* vp = (const uint4*)(UD + base + 768);
#pragma unroll
            for (int i = 0; i < 4; ++i) { const uint4 u = vp[i]; const unsigned w[4] = {u.x, u.y, u.z, u.w}; bf16_t* d = Vt + (half * 32 + i * 8) * 260 + key;
#pragma unroll
                for (int e = 0; e < 4; ++e) { d[(2 * e) * 260] = (bf16_t)(w[e] & 0xffff); d[(2 * e + 1) * 260] = (bf16_t)(w[e] >> 16); } } }
    }
}
__device__ __forceinline__ void attn_item(const P& p, int l, int item, unsigned char* lds, float lam, float lam_init) {
    const int tid = otid(), lane = tid & 63, wv = tid >> 6, n = lane & 31, hh = lane >> 5;
    int s, h, qb;
    if (item < 48) { s = 32 + item / 24; h = (item % 24) / 4; qb = item & 3; } else { const int r = item - 48; s = r / 6; h = r % 6; qb = 0; }
    int start, T; seq_info(s, start, T);
    const int nctx = s >= 32 ? 512 : 0, nchunks = (nctx + T) >> 8;
    bf16_t* Ks = (bf16_t*)lds; bf16_t* Vt = (bf16_t*)(lds + AT_KS_BYTES);
    const bf16_t* UD = (const bf16_t*)(p.ws + WS_UD);
    const int qtok = start + qb * 256 + wv * 32 + n;
    bf16x8_t Qf[2][2];
#pragma unroll
    for (int m = 0; m < 2; ++m)
#pragma unroll
        for (int si = 0; si < 2; ++si) Qf[m][si] = *(const bf16x8_t*)(UD + (size_t)qtok * 1152 + h * 64 + m * 32 + si * 16 + hh * 8);
    const float c = 0.17677669529663687f * 1.4426950408889634f;
    float m0 = -1e30f, m1 = -1e30f, l0 = 0.f, l1 = 0.f;
    for (int ch = 0; ch < nchunks; ++ch) {
        __syncthreads();
        attn_stage(p, l, s, h, start, nctx, ch, nchunks == 1, Ks, Vt, tid);
        __syncthreads();
#pragma unroll 1
        for (int kt = 0; kt < 8; ++kt) {
            f32x16_t S0 = {0,0,0,0,0,0,0,0,0,0,0,0,0,0,0,0}, S1 = S0;
#pragma unroll
            for (int si = 0; si < 2; ++si) {
                const bf16x8_t k0 = *(const bf16x8_t*)(Ks + (kt * 32 + n) * 72 + si * 16 + hh * 8);
                const bf16x8_t k1 = *(const bf16x8_t*)(Ks + (kt * 32 + n) * 72 + 32 + si * 16 + hh * 8);
                S0 = __builtin_amdgcn_mfma_f32_32x32x16_bf16(k0, Qf[0][si], S0, 0, 0, 0);
                S1 = __builtin_amdgcn_mfma_f32_32x32x16_bf16(k1, Qf[1][si], S1, 0, 0, 0);
            }
            float t0 = S0[0], t1 = S1[0];
#pragma unroll
            for (int r = 1; r < 16; ++r) { t0 = fmaxf(t0, S0[r]); t1 = fmaxf(t1, S1[r]); }
            const float n0 = fmaxf(m0, t0), n1 = fmaxf(m1, t1);
            float a0 = 0.f, a1 = 0.f;
#pragma unroll
            for (int r = 0; r < 16; ++r) { a0 += __builtin_amdgcn_exp2f((S0[r] - n0) * c); a1 += __builtin_amdgcn_exp2f((S1[r] - n1) * c); }
            l0 = l0 * __builtin_amdgcn_exp2f((m0 - n0) * c) + a0; l1 = l1 * __builtin_amdgcn_exp2f((m1 - n1) * c) + a1;
            m0 = n0; m1 = n1;
        }
    }
    {
        const float mo0 = __shfl_xor(m0, 32), lo0 = __shfl_xor(l0, 32), mo1 = __shfl_xor(m1, 32), lo1 = __shfl_xor(l1, 32);
        const float M0 = fmaxf(m0, mo0), M1 = fmaxf(m1, mo1);
        l0 = l0 * __builtin_amdgcn_exp2f((m0 - M0) * c) + lo0 * __builtin_amdgcn_exp2f((mo0 - M0) * c);
        l1 = l1 * __builtin_amdgcn_exp2f((m1 - M1) * c) + lo1 * __builtin_amdgcn_exp2f((mo1 - M1) * c);
        m0 = M0; m1 = M1;
    }
    const float i0 = 1.f / l0, i1 = lam / l1;
    f32x16_t O0 = {0,0,0,0,0,0,0,0,0,0,0,0,0,0,0,0}, O1 = O0;
    for (int ch = 0; ch < nchunks; ++ch) {
        if (nchunks > 1) {
            __syncthreads();
            attn_stage(p, l, s, h, start, nctx, ch, true, Ks, Vt, tid);
            __syncthreads();
        }
#pragma unroll 1
        for (int kt = 0; kt < 8; ++kt) {
            f32x16_t S0 = {0,0,0,0,0,0,0,0,0,0,0,0,0,0,0,0}, S1 = S0;
#pragma unroll
            for (int si = 0; si < 2; ++si) {
                const bf16x8_t k0 = *(const bf16x8_t*)(Ks + (kt * 32 + n) * 72 + si * 16 + hh * 8);
                const bf16x8_t k1 = *(const bf16x8_t*)(Ks + (kt * 32 + n) * 72 + 32 + si * 16 + hh * 8);
                S0 = __builtin_amdgcn_mfma_f32_32x32x16_bf16(k0, Qf[0][si], S0, 0, 0, 0);
                S1 = __builtin_amdgcn_mfma_f32_32x32x16_bf16(k1, Qf[1][si], S1, 0, 0, 0);
            }
            float pw[16];
#pragma unroll
            for (int r = 0; r < 16; ++r) pw[r] = __builtin_amdgcn_exp2f((S0[r] - m0) * c) * i0 - __builtin_amdgcn_exp2f((S1[r] - m1) * c) * i1;
#pragma unroll
            for (int si = 0; si < 2; ++si) {
                union { unsigned u[4]; bf16x8_t v; } pf;
#pragma unroll
                for (int e = 0; e < 4; ++e) pf.u[e] = pk_bf16(pw[8 * si + 2 * e], pw[8 * si + 2 * e + 1]);
                union { bf16x4_t h2[2]; bf16x8_t v; } va, vb;
                const bf16_t* v0 = Vt + n * 260 + kt * 32 + si * 16 + hh * 4;
                va.h2[0] = *(const bf16x4_t*)v0; va.h2[1] = *(const bf16x4_t*)(v0 + 8);
                vb.h2[0] = *(const bf16x4_t*)(v0 + 32 * 260); vb.h2[1] = *(const bf16x4_t*)(v0 + 32 * 260 + 8);
                O0 = __builtin_amdgcn_mfma_f32_32x32x16_bf16(va.v, pf.v, O0, 0, 0, 0);
                O1 = __builtin_amdgcn_mfma_f32_32x32x16_bf16(vb.v, pf.v, O1, 0, 0, 0);
            }
        }
    }
    float ss = 0.f;
#pragma unroll
    for (int r = 0; r < 16; ++r) ss += O0[r] * O0[r] + O1[r] * O1[r];
    ss += __shfl_xor(ss, 32);
    const float rs = rsqrtf(ss * (1.f / 64.f) + 1e-5f) * (1.f - lam_init);
    bf16_t* mo = (bf16_t*)(p.ws + WS_H) + (size_t)qtok * 1024 + 384 + h * 64;
    const float* sg = p.subln_g + (size_t)l * 64;
#pragma unroll
    for (int g = 0; g < 4; ++g) {
        const int vd = 8 * g + 4 * hh;
        uint2 w0, w1;
        w0.x = pk_bf16(O0[4 * g] * rs * sg[vd], O0[4 * g + 1] * rs * sg[vd + 1]); w0.y = pk_bf16(O0[4 * g + 2] * rs * sg[vd + 2], O0[4 * g + 3] * rs * sg[vd + 3]);
        w1.x = pk_bf16(O1[4 * g] * rs * sg[32 + vd], O1[4 * g + 1] * rs * sg[32 + vd + 1]); w1.y = pk_bf16(O1[4 * g + 2] * rs * sg[32 + vd + 2], O1[4 * g + 3] * rs * sg[32 + vd + 3]);
        *(uint2*)(mo + vd) = w0; *(uint2*)(mo + 32 + vd) = w1;
    }
}

struct EpiFnet {
    int samp;
    __device__ __forceinline__ void operator()(const P& p, int row, int col, const float* v) const {
        const int sq = col >> 8, ch = col & 255;
        const int tok = samp ? NPTOK + sq * 1024 + row : sq * 256 + row;
        uint2 w; w.x = pk_bf16(v[0], v[1]); w.y = pk_bf16(v[2], v[3]);
        *(uint2*)((bf16_t*)(p.ws + WS_H) + (size_t)tok * 1024 + 768 + ch) = w;
    }
};
struct OneUnit { int pm, pn; __device__ bool next(int i, pg8::Unit& u) const { if (i) return false; u.pm = pm; u.pn = pn; return true; } };

#define MX_ITEMS 964
template <class GemmFn>
__device__ __forceinline__ void ph_mixer(const P& p, int l, unsigned char* lds, volatile LAS unsigned* slot, GemmFn gemm_one) {
    const float lam_init = 0.8f - 0.6f * __expf(-0.3f * (float)l);
    float lam;
    { const float* lp = p.diff_lambda + (size_t)l * 128; float s01 = 0.f, s23 = 0.f;
      for (int d = 0; d < 32; ++d) { s01 += lp[d] * lp[32 + d]; s23 += lp[64 + d] * lp[96 + d]; }
      lam = __expf(s01) - __expf(s23) + lam_init; }
    unsigned* ctr = (unsigned*)(p.ws + WS_CTL) + CTL_QUEUE + 64 * l;
    for (;;) {
        __syncthreads();
        if (threadIdx.x == 0) *slot = atomicAdd(ctr, 1u);
        __syncthreads();
        const int item = (int)*slot;
        if (item >= MX_ITEMS) break;
#if PROBE_ID
        const unsigned long long it0 = __builtin_amdgcn_s_memrealtime();
#endif
        if (item < 48) attn_item(p, l, item, lds, lam, lam_init);
        else if (item < 60) ph_scan_job(p, l, 32 + (item - 48) / NH, (item - 48) % NH, 0, 0, 0, 0, SEG0_LEN, (float*)lds);
        else if (item < 108) { const int r = item - 60, sg = 1 + (r & 1), dr = (r >> 1) & 1, hh = (r >> 2) % NH, bb = r / 24;
            ph_scan_job(p, l, 32 + bb, hh, 1, dr, sg, sg == 1 ? SEG0_LEN : SEG0_LEN + SEG1_LEN, sg == 1 ? SEG1_LEN : SEG2_LEN, (float*)lds); }
        else if (item < 300) ph_scan_job(p, l, (item - 108) / NH, (item - 108) % NH, 0, 0, 0, 0, TP, (float*)lds);
        else if (item < 308) gemm_one(1, (item - 300) >> 1, (item - 300) & 1);
        else if (item < 500) attn_item(p, l, 48 + item - 308, lds, lam, lam_init);
        else if (item < 532) gemm_one(0, 0, item - 500);
        else if (item < 724) fixup_item(p, l, item - 532, (float*)lds);
        else finalize_item(p, l, item - 724);
        if (item >= 108 && item < 300) {
            asm volatile("s_waitcnt vmcnt(0)" ::: "memory");
            __syncthreads();
            if (threadIdx.x == 0) __hip_atomic_fetch_add((unsigned*)(p.ws + WS_CNT2) + 256 * l + (item - 108), 1u, __ATOMIC_RELAXED, __HIP_MEMORY_SCOPE_AGENT);
        }
        if (item >= 48 && item < 108) {
            asm volatile("s_waitcnt vmcnt(0)" ::: "memory");
            __syncthreads();
            if (threadIdx.x == 0) {
                __builtin_amdgcn_fence(__ATOMIC_RELEASE, "agent");
                asm volatile("s_waitcnt vmcnt(0)" ::: "memory");
                unsigned* cnt = (unsigned*)(p.ws + WS_CTL) + CTL_SCANDONE + 32 * l;
                if (item < 60) { const int bh = item - 48; __hip_atomic_fetch_add(cnt + bh * 2, 1u, __ATOMIC_RELAXED, __HIP_MEMORY_SCOPE_AGENT); __hip_atomic_fetch_add(cnt + bh * 2 + 1, 1u, __ATOMIC_RELAXED, __HIP_MEMORY_SCOPE_AGENT); }
                else { const int r = item - 60, dr = (r >> 1) & 1, hh = (r >> 2) % NH, bb = r / 24; __hip_atomic_fetch_add(cnt + (bb * NH + hh) * 2 + dr, 1u, __ATOMIC_RELAXED, __HIP_MEMORY_SCOPE_AGENT); }
            }
        }
#if PROBE_ID
        __syncthreads();
        if (threadIdx.x == 0 && l == 0) { const int cls = item < 48 ? 3 : item < 60 ? 0 : item < 108 ? 6 : item < 300 ? 2 : item < 308 ? 1 : item < 500 ? 5 : 4;
            atomicMax((unsigned*)(p.ws + WS_CTL) + 3712 + cls, (unsigned)(__builtin_amdgcn_s_memrealtime() - it0)); }
#endif
    }
}

#define XB_TMO      128
#define XB_XCNT(j)  (256  + 64 * (j))
#define XB_XSUB(j)  (1280 + 64 * (j))
#define XB_XGEN(j)  (2304 + 64 * (j))
#define XB_TOP      3328
#define XB_TOPGEN   3392
#define XCD_BAR_WORDS 3456
#define XB_SPIN_CAP (1u << 22)
__device__ __forceinline__ unsigned xb_ld(unsigned* p)              { return __hip_atomic_load(p, __ATOMIC_RELAXED, __HIP_MEMORY_SCOPE_AGENT); }
__device__ __forceinline__ unsigned xb_add(unsigned* p, unsigned v) { return __hip_atomic_fetch_add(p, v, __ATOMIC_RELAXED, __HIP_MEMORY_SCOPE_AGENT); }
__device__ __forceinline__ unsigned xb_xcc_id() { return (unsigned)__builtin_amdgcn_s_getreg((3 << 11) | 20) & 0xFu; }
#define XB_SPIN(cond, bar) do { unsigned _sp = 0; while (cond) { __builtin_amdgcn_s_sleep(1); \
    if ((++_sp & 255u) == 0u) { if (xb_ld(&(bar)[XB_TMO])) break; if (_sp > XB_SPIN_CAP) { atomicAdd(&(bar)[XB_TMO], 1u); break; } } } } while (0)
struct XcdBarrier { unsigned* bar; unsigned x; volatile LAS unsigned* st; };
__device__ __forceinline__ XcdBarrier xcd_barrier_post(unsigned* bar, volatile LAS unsigned* st) {
    XcdBarrier b; b.bar = bar; b.x = xb_xcc_id(); b.st = st;
    if (threadIdx.x == 0) (void)xb_add(&bar[XB_XCNT(b.x)], 1u);
    return b;
}
__device__ __forceinline__ void xcd_barrier_complete(unsigned* bar, unsigned x, unsigned& nloc, unsigned& nx) {
    const unsigned G = gridDim.x * gridDim.y * gridDim.z;
    unsigned sum, cnt, mine, sp = 0u;
    for (;;) {
        sum = 0u; cnt = 0u; mine = 0u;
#pragma unroll
        for (unsigned j = 0; j < 16; ++j) { const unsigned c = xb_ld(&bar[XB_XCNT(j)]); sum += c; cnt += (c > 0u) ? 1u : 0u; mine = (j == x) ? c : mine; }
        if (sum == G) break;
        __builtin_amdgcn_s_sleep(1);
        if ((++sp & 255u) == 0u) { if (xb_ld(&bar[XB_TMO])) break; if (sp > XB_SPIN_CAP) { atomicAdd(&bar[XB_TMO], 1u); break; } }
    }
    nloc = mine > 0u ? mine : 1u; nx = cnt > 0u ? cnt : 1u;
}
__device__ __forceinline__ void xcd_barrier(const XcdBarrier& b) {
    asm volatile("s_waitcnt vmcnt(0)" ::: "memory");
    __syncthreads();
    if (threadIdx.x == 0) {
        unsigned* bar = b.bar;
        __builtin_amdgcn_s_waitcnt(0);
        unsigned nloc = b.st[0], nx = b.st[1];
        if (nloc == 0u) { xcd_barrier_complete(bar, b.x, nloc, nx); b.st[0] = nloc; b.st[1] = nx; }
        const unsigned old = xb_add(&bar[XB_XSUB(b.x)], 1u);
        const unsigned gen = old / nloc;
        if (old + 1u == (gen + 1u) * nloc) {
            __builtin_amdgcn_fence(__ATOMIC_RELEASE, "agent");
            asm volatile("s_waitcnt vmcnt(0)" ::: "memory");
            const unsigned og = xb_add(&bar[XB_TOP], 1u);
            const unsigned tg = og / nx;
            if (og + 1u == (tg + 1u) * nx) xb_add(&bar[XB_TOPGEN], 1u);
            else XB_SPIN(xb_ld(&bar[XB_TOPGEN]) == tg, bar);
            __builtin_amdgcn_fence(__ATOMIC_ACQUIRE, "agent");
            xb_add(&bar[XB_XGEN(b.x)], 1u);
            asm volatile("s_waitcnt vmcnt(0)" ::: "memory");
        } else {
            XB_SPIN(xb_ld(&bar[XB_XGEN(b.x)]) == gen, bar);
            __builtin_amdgcn_fence(__ATOMIC_ACQUIRE, "agent");
            asm volatile("s_waitcnt vmcnt(0)" ::: "memory");
        }
    }
    __syncthreads();
}

#define MISC_OFF 158720
#define LDS_BYTES (MISC_OFF + 1024)
#define N_PHASES 15
struct Args { P p; int ph_lo, ph_hi; };
__global__ __launch_bounds__(512, 2) void mega(Args a) {
    extern __shared__ __attribute__((aligned(16))) unsigned char lds[];
    const P& p = a.p;
    LAS unsigned char* l3 = (LAS unsigned char*)lds;
    volatile LAS unsigned* misc = (volatile LAS unsigned*)(l3 + MISC_OFF);
    if (threadIdx.x < 16) misc[threadIdx.x] = 0u;
    __syncthreads();
    XcdBarrier bar = xcd_barrier_post((unsigned*)(p.ws + WS_CTL), misc);
    float* sm = (float*)lds;
    const int lo = a.ph_lo, hi = a.ph_hi;
#define IN(k) (lo <= (k) && (k) < hi)
#if PROBE_ID
    unsigned long long* tsl = (unsigned long long*)(p.ws + WS_CTL + 15360);
    if (blockIdx.x == 0 && otid() == 0) tsl[0] = __builtin_amdgcn_s_memrealtime();
#define SEAM(k) do { if (IN(k) && IN((k) + 1)) xcd_barrier(bar); if (blockIdx.x == 0 && otid() == 0) tsl[1 + (k)] = __builtin_amdgcn_s_memrealtime(); } while (0)
#else
#define SEAM(k) do { if (IN(k) && IN((k) + 1)) xcd_barrier(bar); } while (0)
#endif
    if (IN(0)) ph_prep0(p, sm);
    SEAM(0);
    if (IN(1)) ph_prep0b(p);
    SEAM(1);
    for (int l = 0; l < 2; ++l) {
        const int b0 = 2 + 6 * l;
        if (IN(b0 + 0)) { pg8::Gemm g{(const bf16_t*)(p.ws + WS_H), (const bf16_t*)(p.ws + WS_WIN) + (size_t)l * N1 * 1024, NTOK, N1, 1024};
            pg8::StaticOrder S; S.init(NTOK, N1, gridDim.x, blockIdx.x); pg8::EpiG1H E{&p, l}; pg8::gemm_phase(l3, g, S, E); }
        SEAM(b0 + 0);
        if (IN(b0 + 1)) ph_prep(p, l, sm);
        SEAM(b0 + 1);
        if (IN(b0 + 2)) {
            auto gemm_one = [&](int samp, int pm, int pn) {
                pg8::Gemm g{samp ? (const bf16_t*)(p.ws + WS_L1024) : (const bf16_t*)(p.ws + WS_L256), samp ? (const bf16_t*)(p.ws + WS_ZF) + (size_t)8192 * 512 : (const bf16_t*)(p.ws + WS_ZF),
                            samp ? 1024 : 256, samp ? 512 : 8192, samp ? 2048 : 512};
                OneUnit S{pm, pn}; pg8::EpiWrap<EpiFnet> E{&p, EpiFnet{samp}}; pg8::gemm_phase(l3, g, S, E); };
            ph_mixer(p, l, lds, misc + 4, gemm_one);
        }
        SEAM(b0 + 2);
        if (IN(b0 + 3)) { pg8::Gemm g{(const bf16_t*)(p.ws + WS_H), (const bf16_t*)(p.ws + WS_WOUT) + (size_t)l * 1024 * 1024, NTOK, 1024, 1024};
            pg8::StaticOrder S; S.init(NTOK, 1024, gridDim.x, blockIdx.x);
            pg8::EpiResN E{&p, l, 2, p.norm2_g + (size_t)l * 1024, l, 4, (bf16_t*)(p.ws + WS_H2), (float*)(p.ws + WS_RSQ) + (size_t)(2 * l + 1) * NTOK}; pg8::gemm_phase(l3, g, S, E); }
        SEAM(b0 + 3);
        if (IN(b0 + 4)) { pg8::Gemm g{(const bf16_t*)(p.ws + WS_H2), (const bf16_t*)(p.ws + WS_WF1) + (size_t)l * 5632 * 1024, NTOK, 5632, 1024};
            pg8::StaticOrder S; S.init(NTOK, 5632, gridDim.x, blockIdx.x); pg8::EpiFfn1 E{&p, l}; pg8::gemm_phase(l3, g, S, E); }
        SEAM(b0 + 4);
        if (IN(b0 + 5)) { pg8::Gemm g{(const bf16_t*)(p.ws + WS_UR), (const bf16_t*)(p.ws + WS_WF2) + (size_t)l * 1024 * 2816, NTOK, 1024, 2816};
            pg8::StaticOrder S; S.init(NTOK, 1024, gridDim.x, blockIdx.x);
            pg8::EpiResN E{&p, l, 5, l == 0 ? p.norm1_g + 1024 : (const float*)nullptr, 1, 1, (bf16_t*)(p.ws + WS_H), (float*)(p.ws + WS_RSQ) + (size_t)2 * NTOK}; pg8::gemm_phase(l3, g, S, E); }
        SEAM(b0 + 5);
    }
    if (IN(14)) ph_norm(p, 0, 2);
#if PROBE_ID
    __syncthreads();
    if (blockIdx.x == 0 && otid() == 0) {
        tsl[15] = __builtin_amdgcn_s_memrealtime();
        __threadfence();
        unsigned long long acc = 0;
#pragma unroll 1
        for (int k = 0; k < 15; ++k) {
            const int st = k == 0 ? -1 : (k == 1 ? -3 : (k == 14 ? -2 : 30 + (k - 2) % 6));
            bool sel = false;
            if (PROBE_ID == 1) sel = (k == 0);
            if (PROBE_ID == 2) sel = (st == 10 || st == 15 || st == 16 || st == 17);
            if (PROBE_ID == 3) sel = (st == 12);
            if (PROBE_ID == 4) sel = (st == -2 || st == -3);
            if (PROBE_ID == 5) sel = (st == 11);
            if (PROBE_ID == 6) sel = (st == 13);
            if (PROBE_ID == 7) sel = (st == 14);
            if (PROBE_ID == 8) sel = (st == 10);
            if (PROBE_ID == 9) sel = (st == 15);
            if (PROBE_ID == 10) sel = (st == 16);
            if (PROBE_ID == 11) sel = (st == 17);
            if (sel) acc += __hip_atomic_load(tsl + 1 + k, __ATOMIC_RELAXED, __HIP_MEMORY_SCOPE_AGENT) - __hip_atomic_load(tsl + k, __ATOMIC_RELAXED, __HIP_MEMORY_SCOPE_AGENT);
        }
        if (PROBE_ID >= 30 && PROBE_ID < 34) { unsigned long long* tsp = (unsigned long long*)(p.ws + WS_CTL + 15360) + 32; acc = __hip_atomic_load(tsp + (PROBE_ID - 29), __ATOMIC_RELAXED, __HIP_MEMORY_SCOPE_AGENT) - __hip_atomic_load(tsp + (PROBE_ID - 30), __ATOMIC_RELAXED, __HIP_MEMORY_SCOPE_AGENT); }
        else if (PROBE_ID >= 20) acc = __hip_atomic_load((unsigned*)(p.ws + WS_CTL) + 3712 + (PROBE_ID - 20), __ATOMIC_RELAXED, __HIP_MEMORY_SCOPE_AGENT);
        const unsigned long long t_end = __builtin_amdgcn_s_memrealtime();
        while (__builtin_amdgcn_s_memrealtime() - t_end < 4ull * acc) __builtin_amdgcn_s_sleep(8);
    }
#endif
#undef IN
#undef SEAM
}

extern "C" void kernel_launch(void* const* d_in, const int* in_sizes, int n_in, void* d_out, int out_size, void* d_ws, size_t ws_size, hipStream_t stream) {
    static int grid = 0;
    if (grid == 0) {
        if (n_in != 29 || ws_size < WS_END) { fprintf(stderr, "kernel_launch: bad n_in %d or ws_size %zu (need %zu)\n", n_in, ws_size, (size_t)WS_END); grid = -1; return; }
        int dev = 0, cus = 0, per_cu = 0;
        hipGetDevice(&dev); hipDeviceGetAttribute(&cus, hipDeviceAttributeMultiprocessorCount, dev);
        if (hipFuncSetAttribute((const void*)mega, hipFuncAttributeMaxDynamicSharedMemorySize, LDS_BYTES) != hipSuccess) { fprintf(stderr, "kernel_launch: hipFuncSetAttribute failed\n"); grid = -1; return; }
        if (hipOccupancyMaxActiveBlocksPerMultiprocessor(&per_cu, (const void*)mega, 512, LDS_BYTES) != hipSuccess || per_cu < 1) { fprintf(stderr, "kernel_launch: occupancy query says %d\n", per_cu); per_cu = 1; }
        (void)hipGetLastError();
        grid = cus;
    }
    if (grid < 0) return;
    hipMemsetAsync((unsigned char*)d_ws + WS_CTL, 0, 16384 + 4 * NTOK * 4 + 2048, stream);
    Args a{};
    const float** f = (const float**)&a.p;
    for (int i = 0; i < 29; ++i) f[i] = (const float*)d_in[i];
    a.p.out = (float*)d_out; a.p.ws = (unsigned char*)d_ws;
#if ONE_LAUNCH
    a.ph_lo = 0; a.ph_hi = N_PHASES;
    hipLaunchKernelGGL(mega, dim3(grid), dim3(512), LDS_BYTES, stream, a);
#else
    for (int ph = 0; ph < N_PHASES; ++ph) { a.ph_lo = ph; a.ph_hi = ph + 1; hipLaunchKernelGGL(mega, dim3(grid), dim3(512), LDS_BYTES, stream, a); }
#endif
}
```

```cpp
#include <hip/hip_runtime.h>
#include <stdint.h>
#include <stdio.h>
#ifndef ONE_LAUNCH
#define ONE_LAUNCH 1
#endif
#ifndef PROBE_ID
#define PROBE_ID 0
#endif

typedef unsigned short bf16_t;

#define D_MODEL 1024
#define NTOK 10240
#define NPTOK 8192
#define TP 256
#define TS 1024
#define NSEQ 34
#define NH 6
#define N1 3072
#define C_DIFF 0
#define C_FNET 1152
#define C_RWKV 1664
#define C_END 3008
#define N_RWKV 1344
#define D_FF 2816
#define D_IN 2752

#define OUT_YP 0
#define OUT_YS 8388608
#define OUT_ST 10485760
#define OUT_CK 13631488
#define OUT_CV 19922944

#define OPS_REC 1408
#define OPS_TOK (6 * OPS_REC)

#define WS_WIN   ((size_t)0)
#define WS_WOUT  (WS_WIN + (size_t)2 * N1 * 1024 * 2)
#define WS_WF1   (WS_WOUT + (size_t)2 * 1024 * 1024 * 2)
#define WS_WF2   (WS_WF1 + (size_t)2 * 5632 * 1024 * 2)
#define WS_H     (WS_WF2 + (size_t)2 * 1024 * 2816 * 2)
#define WS_UD    (WS_H + (size_t)NTOK * 1024 * 2)
#define WS_ZF    (WS_UD + (size_t)NTOK * 1152 * 2)
#define WS_UR    (WS_ZF + (size_t)NTOK * 512 * 2)
#define WS_OPS   (WS_UR + (size_t)2 * NTOK * 384 * 4)
#define WS_L256  (WS_OPS + (size_t)NTOK * OPS_TOK)
#define WS_L1024 (WS_L256 + (size_t)256 * 512 * 2)
#define WS_CTL   (WS_L1024 + (size_t)1024 * 2048 * 2)
#define WS_RSQ   (WS_CTL + (size_t)16384)
#define WS_CNT2  (WS_RSQ + (size_t)4 * NTOK * 4)
#define WS_MOD   (WS_CNT2 + (size_t)2048)
#define WS_ZS    (WS_MOD + (size_t)2 * 3 * 6144 * 4)
#define WS_SS    (WS_ZS + (size_t)2 * 2048 * 384 * 4)
#define WS_WLT   (WS_SS + (size_t)24 * 3 * 4096 * 4)
#define WLT_L    73728
#define WS_BIAS  (WS_WLT + (size_t)2 * WLT_L * 2)
#define WS_END   (WS_BIAS + (size_t)(2 * 3 * 3072 + 2 * 3 * 5632) * 4)
#define WS_H2    (WS_OPS + ((size_t)60 << 20))
#define CTL_QUEUE 3584
static_assert(WS_END <= ((size_t)256 << 20), "workspace exceeds 256 MiB");
static_assert(WS_H2 + (size_t)NTOK * 1024 * 2 <= WS_OPS + (size_t)NTOK * OPS_TOK, "H2 must stay inside the OPS region");

struct P {
    const float *x_prompt, *x_sample, *c, *state_rwkv, *cache_k, *cache_v, *c_ctx, *norm1_g, *norm2_g, *final_g;
    const float *w_mod, *b_mod, *w_in, *w_out, *shift_mu, *decay_w0, *decay_up, *iclr_a0, *iclr_up, *gate_up;
    const float *k_k, *k_a, *r_k, *lnx_g, *lnx_b, *diff_lambda, *subln_g, *w_ffn_in, *w_ffn_out;
    float* out;
    unsigned char* ws;
};

typedef float f32x2c __attribute__((ext_vector_type(2)));
typedef float f32x4nt __attribute__((ext_vector_type(4)));
__device__ __forceinline__ float4 ld_stream4(const float* ptr) { const f32x4nt v = __builtin_nontemporal_load((const f32x4nt*)ptr); return make_float4(v[0], v[1], v[2], v[3]); }
typedef __bf16 bf16x2c __attribute__((ext_vector_type(2)));
__device__ __forceinline__ bf16_t f2bf(float f) { return __builtin_bit_cast(unsigned short, (__bf16)f); }
__device__ __forceinline__ unsigned pk_bf16(float lo, float hi) { const f32x2c v = {lo, hi}; return __builtin_bit_cast(unsigned, __builtin_convertvector(v, bf16x2c)); }
__device__ __forceinline__ float bf2f(bf16_t b) { return __builtin_bit_cast(float, ((unsigned)b) << 16); }
__device__ __forceinline__ float sigmoidf_(float x) { return __builtin_amdgcn_rcpf(1.f + __expf(-x)); }
__device__ __forceinline__ float tanhf_(float x) { return 1.f - 2.f * __builtin_amdgcn_rcpf(1.f + __expf(2.f * x)); }
template <int CTRL> __device__ __forceinline__ float dpp_add(float x) {
    return x + __builtin_bit_cast(float, __builtin_amdgcn_update_dpp(0, __builtin_bit_cast(int, x), CTRL, 0xf, 0xf, false));
}
__device__ __forceinline__ float row16_sum(float x) { x = dpp_add<0xB1>(x); x = dpp_add<0x4E>(x); x = dpp_add<0x141>(x); return dpp_add<0x140>(x); }
__device__ __forceinline__ float wave_sum(float v) {
    v = row16_sum(v);
    const int vi = __builtin_bit_cast(int, v);
    return (__builtin_bit_cast(float, __builtin_amdgcn_readlane(vi, 0)) + __builtin_bit_cast(float, __builtin_amdgcn_readlane(vi, 16)))
         + (__builtin_bit_cast(float, __builtin_amdgcn_readlane(vi, 32)) + __builtin_bit_cast(float, __builtin_amdgcn_readlane(vi, 48)));
}
__device__ __forceinline__ int otid() { int t = threadIdx.x; asm volatile("" : "+v"(t)); return t; }
__device__ __forceinline__ int tok_cls(int tok) { return tok < NPTOK ? 0 : 1 + ((tok - NPTOK) >> 10); }
__device__ __forceinline__ const float* xin_row(const P& p, int tok) { return tok < NPTOK ? p.x_prompt + (size_t)tok * 1024 : p.x_sample + (size_t)(tok - NPTOK) * 1024; }
__device__ __forceinline__ float* X_row(const P& p, int tok) { return p.out + (size_t)tok * 1024; }
__device__ __forceinline__ const float* mod_vec(const P& p, int l, int cls, int which) { return (const float*)(p.ws + WS_MOD) + ((size_t)(l * 3 + cls) * 6144 + which * 1024); }
__device__ __forceinline__ void seq_info(int s, int& start, int& T) { if (s < 32) { start = s * TP; T = TP; } else { start = NPTOK + (s - 32) * TS; T = TS; } }
__device__ __forceinline__ void tok_info(int tok, int& s, int& t, int& T, int& start) {
    if (tok < NPTOK) { s = tok >> 8; t = tok & 255; T = TP; start = s * TP; } else { int r = tok - NPTOK; s = 32 + (r >> 10); t = r & 1023; T = TS; start = NPTOK + ((r >> 10) << 10); }
}

#define P0_MOD 192
#define P0_TILES_L 3136
struct P0Tile { const float* src; bf16_t* dst; int srcN, K, n0, k0, mode, scol; };
__device__ __forceinline__ P0Tile p0_decode(const P& p, int it) {
    P0Tile t; const int l = it / P0_TILES_L; it %= P0_TILES_L; int ntile, ktile; t.mode = 0; t.scol = 0;
    if (it < 768) { ntile = it / 16; ktile = it % 16; t.K = 1024; t.srcN = D_IN; t.src = p.w_in + (size_t)l * 1024 * D_IN; t.dst = (bf16_t*)(p.ws + WS_WIN) + (size_t)l * N1 * 1024;
        t.n0 = ntile * 64;
        if (t.n0 < C_FNET) { t.scol = 1344 + t.n0; } else if (t.n0 < C_RWKV) { t.mode = 1 + ((t.n0 - C_FNET) / 64) % 2; t.scol = 2496 + ((t.n0 - C_FNET) / 128) * 64; } else if (t.n0 < C_END) { t.scol = t.n0 - C_RWKV; } else t.mode = 3; }
    else if (it < 1024) { it -= 768; ntile = it / 16; ktile = it % 16; t.K = 1024; t.srcN = 1024; t.src = p.w_out + (size_t)l * 1024 * 1024; t.dst = (bf16_t*)(p.ws + WS_WOUT) + (size_t)l * 1024 * 1024; t.n0 = ntile * 64; t.scol = t.n0; }
    else if (it < 2432) { it -= 1024; ntile = it / 16; ktile = it % 16; t.K = 1024; t.srcN = 5632; t.src = p.w_ffn_in + (size_t)l * 1024 * 5632; t.dst = (bf16_t*)(p.ws + WS_WF1) + (size_t)l * 5632 * 1024; t.n0 = ntile * 64;
        const int pn = ntile >> 2, sub = ntile & 3; t.scol = (sub < 2) ? (128 * pn + 64 * sub) : (2816 + 128 * pn + 64 * (sub - 2)); }
    else { it -= 2432; ntile = it / 44; ktile = it % 44; t.K = 2816; t.srcN = 1024; t.src = p.w_ffn_out + (size_t)l * 2816 * 1024; t.dst = (bf16_t*)(p.ws + WS_WF2) + (size_t)l * 1024 * 2816; t.n0 = ntile * 64; t.scol = t.n0; }
    t.k0 = ktile * 64;
    return t;
}
#define P0_TGROUPS 1568
__device__ __forceinline__ void p0_group_decode(int item, int& gl, int& base, int& nK, int& ng, int& kt) {
    int gi = item - P0_MOD; gl = gi / 784; gi %= 784;
    if (gi < 192) { base = 0; nK = 16; } else if (gi < 256) { gi -= 192; base = 768; nK = 16; } else if (gi < 608) { gi -= 256; base = 1024; nK = 16; } else { gi -= 608; base = 2432; nK = 44; }
    ng = gi / nK; kt = gi % nK;
}
#define P0_ITEM(u) (gl * P0_TILES_L + base + (ng * 4 + (u)) * nK + kt)
__device__ __forceinline__ void p0_group_load(const P& p, int item, int tid, float4 (&pf)[8]) {
    int gl, base, nK, ng, kt; p0_group_decode(item, gl, base, nK, ng, kt);
#pragma unroll
    for (int u = 0; u < 4; ++u) {
        const P0Tile t = p0_decode(p, P0_ITEM(u));
#pragma unroll
        for (int i = 0; i < 2; ++i) { const int k = i * 32 + (tid >> 4), n4 = (tid & 15) * 4;
            pf[u * 2 + i] = make_float4(0.f, 0.f, 0.f, 0.f);
            if (t.mode != 3) pf[u * 2 + i] = ld_stream4(t.src + (size_t)(t.k0 + k) * t.srcN + t.scol + n4); }
    }
}
__device__ __forceinline__ void mod_item(const P& p, float* sm, int item) {
    asm volatile("" : "+s"(item));
    const int tid = otid();
    __syncthreads();
    {
        const int l = item / 96, cb = (item % 96) >> 2, kq = item & 3, c4 = tid & 63, ks = tid >> 6;
        const float* W = p.w_mod + (size_t)l * 1024 * 6144 + (size_t)(kq * 256 + ks * 32) * 6144 + cb * 256 + c4 * 4;
        float* sl = sm + 6144;
        for (int e = tid; e < 768; e += 512) { const int cls = e >> 8, k = kq * 256 + (e & 255); const float c = cls == 0 ? p.c_ctx[k] : p.c[(cls - 1) * 1024 + k]; sl[e] = c * sigmoidf_(c); }
        __syncthreads();
        float4 a0 = make_float4(0.f, 0.f, 0.f, 0.f), a1 = a0, a2 = a0;
#pragma unroll 16
        for (int i = 0; i < 32; ++i) {
            const float4 w = ld_stream4(W + (size_t)i * 6144);
            const float s0 = sl[ks * 32 + i], s1 = sl[256 + ks * 32 + i], s2 = sl[512 + ks * 32 + i];
            a0.x += s0 * w.x; a0.y += s0 * w.y; a0.z += s0 * w.z; a0.w += s0 * w.w;
            a1.x += s1 * w.x; a1.y += s1 * w.y; a1.z += s1 * w.z; a1.w += s1 * w.w;
            a2.x += s2 * w.x; a2.y += s2 * w.y; a2.z += s2 * w.z; a2.w += s2 * w.w;
        }
        *(float4*)(sm + (ks * 3 + 0) * 256 + c4 * 4) = a0; *(float4*)(sm + (ks * 3 + 1) * 256 + c4 * 4) = a1; *(float4*)(sm + (ks * 3 + 2) * 256 + c4 * 4) = a2;
        __syncthreads();
        for (int o = tid; o < 768; o += 512) {
            const int cls = o >> 8, cc = o & 255; float s = 0.f;
#pragma unroll
            for (int k = 0; k < 8; ++k) s += sm[(k * 3 + cls) * 256 + cc];
            const int colo = cb * 256 + cc;
            if (kq == 0) s += p.b_mod[(size_t)l * 6144 + colo];
            unsafeAtomicAdd((float*)(p.ws + WS_MOD) + (size_t)(l * 3 + cls) * 6144 + colo, s);
        }
    }
}
struct NoPre { __device__ __forceinline__ void operator()() const {} };
template <class Pre>
__device__ __forceinline__ void p0_convert(const P& p, float* sm, int gl, int g_lo, int g_hi, int w, int nwk, const Pre& pre) {
    asm volatile("" : "+s"(w), "+s"(gl));
    const int tid = otid();
    int item = P0_MOD + gl * 784 + g_lo + w; const int item_hi = P0_MOD + gl * 784 + g_hi;
    float4 pf[8];
    if (item < item_hi) p0_group_load(p, item, tid, pf);
    pre();
    if (item < item_hi) {
        float* cs = sm + 4 * 64 * 65;
        __syncthreads();
        if (tid < 64) { cs[tid] = cospif((float)tid / 32.f); cs[64 + tid] = sinpif((float)tid / 32.f); }
#pragma unroll 1
        for (; item < item_hi; item += nwk) {
            int gl, base, nK, ng, kt; p0_group_decode(item, gl, base, nK, ng, kt);
            __syncthreads();
#pragma unroll
            for (int u = 0; u < 4; ++u) {
                float* tile = sm + u * 64 * 65;
#pragma unroll
                for (int i = 0; i < 2; ++i) { const int k = i * 32 + (tid >> 4), n4 = (tid & 15) * 4; const float4 v = pf[u * 2 + i];
                    tile[k * 65 + n4] = v.x; tile[k * 65 + n4 + 1] = v.y; tile[k * 65 + n4 + 2] = v.z; tile[k * 65 + n4 + 3] = v.w; }
            }
            __syncthreads();
            if (item + nwk < item_hi) p0_group_load(p, item + nwk, tid, pf);
#pragma unroll 1
            for (int u = 0; u < 4; ++u) {
                const P0Tile t = p0_decode(p, P0_ITEM(u)); const float* tile = sm + u * 64 * 65;
                const int n = tid >> 3, k8 = (tid & 7) * 8;
                float v[8];
                if (t.mode == 0) {
#pragma unroll
                    for (int j = 0; j < 8; ++j) v[j] = tile[(k8 + j) * 65 + n];
                } else if (t.mode == 3) {
#pragma unroll
                    for (int j = 0; j < 8; ++j) v[j] = 0.f;
                } else {
#pragma unroll
                    for (int j = 0; j < 8; ++j) v[j] = 0.f;
                    for (int cc = 0; cc < 64; ++cc) {
                        const int idx = (n * cc) & 63;
                        const float tr = (t.mode == 1) ? cs[idx] * 0.125f : -cs[64 + idx] * 0.125f;
#pragma unroll
                        for (int j = 0; j < 8; ++j) v[j] += tile[(k8 + j) * 65 + cc] * tr;
                    }
                }
                uint4 o;
                o.x = pk_bf16(v[0], v[1]); o.y = pk_bf16(v[2], v[3]);
                o.z = pk_bf16(v[4], v[5]); o.w = pk_bf16(v[6], v[7]);
                *(uint4*)(t.dst + (size_t)(t.n0 + n) * t.K + t.k0 + k8) = o;
            }
        }
    }
}
__device__ __forceinline__ void ph_prep0(const P& p, float* sm) {
    const int tid = otid();
    auto mod_items = [&]() { if (blockIdx.x < 96) mod_item(p, sm, blockIdx.x); };
    p0_convert(p, sm, 0, 0, 256, blockIdx.x, gridDim.x, mod_items);
    if (blockIdx.x >= 96) { __syncthreads(); p0_convert(p, sm, 0, 256, 608, blockIdx.x - 96, gridDim.x - 96, NoPre{}); }
    for (int item = blockIdx.x; item < 170; item += gridDim.x) {
        if (item >= 160) {
            const int it = item - 160, l = it / 5, kind = it % 5, K = kind == 4 ? 64 : 32;
            const float* src = kind == 4 ? p.gate_up + (size_t)l * 64 * 384 : ((kind >> 1) ? p.iclr_up : p.decay_up) + (size_t)((l * 2 + (kind & 1)) * 32) * 384;
            bf16_t* dst = (bf16_t*)(p.ws + WS_WLT) + (size_t)l * WLT_L + kind * 12288;
#pragma unroll 16
            for (int e = tid; e < 384 * K; e += 512) { const int n = e % 384, k = e / 384; dst[n * K + k] = f2bf(src[(size_t)k * 384 + n]); }
        } else {
            const int r = item * 8 + (tid >> 6);
            const int T = r < 256 ? 256 : 1024, ft = r < 256 ? r : r - 256;
            bf16_t* L = r < 256 ? (bf16_t*)(p.ws + WS_L256) + (size_t)ft * 512 : (bf16_t*)(p.ws + WS_L1024) + (size_t)ft * 2048;
            const float sc = r < 256 ? 0.0625f : 0.03125f;
            for (int kp = (tid & 63); kp < T; kp += 64) {
                float v[2];
#pragma unroll
                for (int e = 0; e < 2; ++e) { const int k = 2 * kp + e, t = k & (T - 1), idx = (ft * t) & (T - 1);
                    const float rev = (float)idx * (r < 256 ? (1.f / 256.f) : (1.f / 1024.f));
                    v[e] = (k < T ? __builtin_amdgcn_cosf(rev) : __builtin_amdgcn_sinf(rev)) * sc; }
                *(unsigned*)(L + 2 * kp) = pk_bf16(v[0], v[1]);
            }
        }
    }
}

__device__ __forceinline__ void bias_gemv(const P& p, int grp, int w, int nwk) {
    asm volatile("" : "+s"(w), "+s"(grp));
    const int tid_ = otid(); const int lane = tid_ & 63, wv = tid_ >> 6, nw = 8;
    {
        const int l = grp & 1, isf = grp >> 1, N = isf ? 5632 : 3072, which = isf ? 3 : 0;
        const bf16_t* Wb = isf ? (const bf16_t*)(p.ws + WS_WF1) + (size_t)l * 5632 * 1024 : (const bf16_t*)(p.ws + WS_WIN) + (size_t)l * N1 * 1024;
        float* outb = (float*)(p.ws + WS_BIAS) + (isf ? 2 * 3 * 3072 + (size_t)(l * 3) * 5632 : (size_t)(l * 3) * 3072);
        float sh[3][16];
#pragma unroll
        for (int c = 0; c < 3; ++c) { const float* sp = mod_vec(p, l, c, which) + lane * 16;
#pragma unroll
            for (int e = 0; e < 4; ++e) { const float4 v = *(const float4*)(sp + 4 * e); sh[c][4 * e] = v.x; sh[c][4 * e + 1] = v.y; sh[c][4 * e + 2] = v.z; sh[c][4 * e + 3] = v.w; } }
#pragma unroll 2
        for (int n = w * nw + wv; n < N; n += nwk * nw) {
            const bf16_t* W = Wb + (size_t)n * 1024;
            const uint4 w0 = *(const uint4*)(W + lane * 16), w1 = *(const uint4*)(W + lane * 16 + 8);
            const unsigned ww[8] = {w0.x, w0.y, w0.z, w0.w, w1.x, w1.y, w1.z, w1.w};
            float acc[3] = {0.f, 0.f, 0.f};
#pragma unroll
            for (int c = 0; c < 3; ++c)
#pragma unroll
                for (int e = 0; e < 8; ++e) acc[c] += sh[c][2 * e] * bf2f((bf16_t)(ww[e] & 0xffff)) + sh[c][2 * e + 1] * bf2f((bf16_t)(ww[e] >> 16));
#pragma unroll
            for (int c = 0; c < 3; ++c) { const float t = wave_sum(acc[c]); if (lane == 0) outb[(size_t)c * N + n] = t; }
        }
    }
}
__device__ __forceinline__ void ph_prep0b(const P& p) {
    const int tid_ = otid(); const int lane = tid_ & 63, wv = tid_ >> 6, nw = blockDim.x >> 6;
    bias_gemv(p, 0, blockIdx.x, gridDim.x); bias_gemv(p, 2, blockIdx.x, gridDim.x);
    float* rsq0 = (float*)(p.ws + WS_RSQ);
    for (int row = blockIdx.x * nw + wv; row < NTOK; row += gridDim.x * nw) {
        const float* xr = xin_row(p, row);
        float4 x[4]; float ss = 0.f;
#pragma unroll
        for (int i = 0; i < 4; ++i) { x[i] = ld_stream4(xr + i * 256 + lane * 4); ss += x[i].x * x[i].x + x[i].y * x[i].y + x[i].z * x[i].z + x[i].w * x[i].w; }
        ss = wave_sum(ss);
        if (lane == 0) rsq0[row] = ss;
        const float* sc = mod_vec(p, 0, tok_cls(row), 1);
        bf16_t* h = (bf16_t*)(p.ws + WS_H) + (size_t)row * 1024;
#pragma unroll
        for (int i = 0; i < 4; ++i) { const int c = i * 256 + lane * 4;
            const float4 gg = *(const float4*)(p.norm1_g + c), s1 = *(const float4*)(sc + c);
            uint2 o; o.x = pk_bf16(x[i].x * gg.x * (1.f + s1.x), x[i].y * gg.y * (1.f + s1.y));
            o.y = pk_bf16(x[i].z * gg.z * (1.f + s1.z), x[i].w * gg.w * (1.f + s1.w));
            *(uint2*)(h + c) = o; }
    }
}

__device__ __forceinline__ void ph_norm(const P& p, int l, int which) {
    const int tid_ = otid(); const int lane = tid_ & 63, wv = tid_ >> 6, nw = blockDim.x >> 6;
    for (int row = blockIdx.x * nw + wv; row < NTOK; row += gridDim.x * nw) {
        const float* xr = (which == 0 && l == 0) ? xin_row(p, row) : X_row(p, row);
        float4 x[4]; float ss = 0.f;
#pragma unroll
        for (int i = 0; i < 4; ++i) { x[i] = *(const float4*)(xr + i * 256 + lane * 4); ss += x[i].x * x[i].x + x[i].y * x[i].y + x[i].z * x[i].z + x[i].w * x[i].w; }
        ss = wave_sum(ss);
        const float rstd = rsqrtf(ss * (1.f / 1024.f) + 1e-6f);
        if (which == 2) {
            float* o = p.out + (size_t)row * 1024;
#pragma unroll
            for (int i = 0; i < 4; ++i) { const float4 g = *(const float4*)(p.final_g + i * 256 + lane * 4);
                float4 y; y.x = x[i].x * rstd * g.x; y.y = x[i].y * rstd * g.y; y.z = x[i].z * rstd * g.z; y.w = x[i].w * rstd * g.w;
                *(float4*)(o + i * 256 + lane * 4) = y; }
        } else {
            const int cls = tok_cls(row);
            const float* g = (which == 0 ? p.norm1_g : p.norm2_g) + (size_t)l * 1024;
            const float* sh = mod_vec(p, l, cls, which == 0 ? 0 : 3);
            const float* sc = mod_vec(p, l, cls, which == 0 ? 1 : 4);
            bf16_t* h = (bf16_t*)(p.ws + WS_H) + (size_t)row * 1024;
#pragma unroll
            for (int i = 0; i < 4; ++i) { const int c = i * 256 + lane * 4;
                const float4 gg = *(const float4*)(g + c), s1 = *(const float4*)(sc + c), s0 = *(const float4*)(sh + c);
                const float y0 = x[i].x * rstd * gg.x * (1.f + s1.x) + s0.x, y1 = x[i].y * rstd * gg.y * (1.f + s1.y) + s0.y;
                const float y2 = x[i].z * rstd * gg.z * (1.f + s1.z) + s0.z, y3 = x[i].w * rstd * gg.w * (1.f + s1.w) + s0.w;
                uint2 o; o.x = pk_bf16(y0, y1); o.y = pk_bf16(y2, y3);
                *(uint2*)(h + c) = o; }
        }
    }
}

struct EpiG1 {
    int l;
    __device__ __forceinline__ void operator()(const P& p, int row, int col, const float* v) const {
        if (col < C_FNET) {
            bf16_t* o = (bf16_t*)(p.ws + WS_UD) + (size_t)row * 1152 + col;
            uint2 w; w.x = pk_bf16(v[0], v[1]); w.y = pk_bf16(v[2], v[3]);
            *(uint2*)o = w;
            if (row < NPTOK && col >= 384) {
                const int b = row >> 8, t = row & 255;
                float* dst = p.out + (col < 768 ? OUT_CK : OUT_CV) + ((size_t)(b * 2 + l) * 256 + t) * 384 + (col < 768 ? col - 384 : col - 768);
                *(float4*)dst = make_float4(v[0], v[1], v[2], v[3]);
            }
        } else if (col < C_RWKV) {
            const int cc = col - C_FNET, g = cc >> 7, half = (cc >> 6) & 1, fc = cc & 63;
            bf16_t* o;
            if (row < NPTOK) { const int sq = row >> 8, t = row & 255; o = (bf16_t*)(p.ws + WS_ZF) + ((size_t)(sq * 256 + g * 64 + fc) * 512 + half * 256 + t);
                o[0] = f2bf(v[0]); o[512] = f2bf(v[1]); o[1024] = f2bf(v[2]); o[1536] = f2bf(v[3]); }
            else { const int r = row - NPTOK, b = r >> 10, t = r & 1023; o = (bf16_t*)(p.ws + WS_ZF) + (size_t)8192 * 512 + ((size_t)(b * 256 + g * 64 + fc) * 2048 + half * 1024 + t);
                o[0] = f2bf(v[0]); o[2048] = f2bf(v[1]); o[4096] = f2bf(v[2]); o[6144] = f2bf(v[3]); }
        } else if (col < C_END) {
            bf16_t* o = (bf16_t*)(p.ws + WS_UR) + (size_t)row * N_RWKV + (col - C_RWKV);
            uint2 w; w.x = pk_bf16(v[0], v[1]); w.y = pk_bf16(v[2], v[3]);
            *(uint2*)o = w;
        }
    }
};
struct EpiRes {
    int l, which;
    __device__ __forceinline__ void operator()(const P& p, int row, int col, const float* v) const {
        const float* g = mod_vec(p, l, tok_cls(row), which) + col;
        const float* xo = (which == 2 && l == 0) ? xin_row(p, row) + col : X_row(p, row) + col;
        const float4 x = *(const float4*)xo; const float4 gg = *(const float4*)g;
        *(float4*)(X_row(p, row) + col) = make_float4(x.x + gg.x * v[0], x.y + gg.y * v[1], x.z + gg.z * v[2], x.w + gg.w * v[3]);
    }
};

#define PR_TT 40
#define PR_LS 200
typedef short bf16x8p __attribute__((ext_vector_type(8)));
typedef float f32x4p __attribute__((ext_vector_type(4)));
#define PR_ROWB 2688
__device__ __forceinline__ void ph_prep(const P& p, int l, float* sm) {
    const int tid = otid(), lane = tid & 63, wv = tid >> 6;
    const bf16_t* UR = (const bf16_t*)(p.ws + WS_UR);
    unsigned char* lb = (unsigned char*)sm;
    bf16_t* urt = (bf16_t*)lb;
    bf16_t* linb = (bf16_t*)(lb + 42 * PR_ROWB);
    const float* mu0 = p.shift_mu + (size_t)l * 2 * N_RWKV; const float* mu1 = mu0 + N_RWKV;
#if PROBE_ID
    unsigned long long* tsp = (unsigned long long*)(p.ws + WS_CTL + 15360) + 32;
#define PSTAMP(i) do { __syncthreads(); if (blockIdx.x == 0 && tid == 0 && l == 0) tsp[i] = __builtin_amdgcn_s_memrealtime(); } while (0)
#else
#define PSTAMP(i)
#endif
    PSTAMP(0);
    for (int tile = blockIdx.x; tile < NTOK / PR_TT; tile += gridDim.x) {
        const int tok0 = tile * PR_TT;
        __syncthreads();
        {
            uint4 sv[14];
#pragma unroll
            for (int i = 0; i < 14; ++i) {
                const int e = tid + i * 512, r = e / 168, c = e % 168, tok = tok0 - 1 + r;
                sv[i] = make_uint4(0u, 0u, 0u, 0u);
                if (e < 42 * 168 && tok >= 0 && tok < NTOK) sv[i] = *(const uint4*)((const unsigned char*)UR + (size_t)tok * PR_ROWB + c * 16);
            }
#pragma unroll
            for (int i = 0; i < 14; ++i) { const int e = tid + i * 512, r = e / 168, c = e % 168; if (e < 42 * 168) *(uint4*)(lb + r * PR_ROWB + c * 16) = sv[i]; }
        }
        __syncthreads();
        if (tid < 384) {
            const int j = tid % 192, col = 1152 + j; const float c0 = mu0[col], c1 = mu1[col];
#pragma unroll 4
            for (int tk = tid / 192; tk < 48; tk += 2) {
                float x = 0.f;
                if (tk < PR_TT) {
                    int s, t, T, st; tok_info(tok0 + tk, s, t, T, st);
                    const float xc = bf2f(urt[(tk + 1) * 1344 + col]);
                    const float xp = t > 0 ? bf2f(urt[tk * 1344 + col]) : 0.f;
                    const float xn = t < T - 1 ? bf2f(urt[(tk + 2) * 1344 + col]) : 0.f;
                    x = xc + c0 * (xp - xc) + c1 * (xn - xc);
                    if (j < 64) x = tanhf_(x); else if (j >= 128) x = sigmoidf_(x);
                }
                linb[tk * PR_LS + j] = f2bf(x);
            }
        }
        __syncthreads();
        PSTAMP(1);
        {
            const int n = lane & 15, kg = lane >> 4;
            const bf16_t* WLT = (const bf16_t*)(p.ws + WS_WLT) + (size_t)l * WLT_L;
#pragma unroll 5
            for (int combo = wv; combo < 120; combo += 8) {
                const int kind = combo / 24, nt = combo % 24, ch = nt * 16 + n, h = ch >> 6, cl = ch & 63;
                const int K = kind == 4 ? 64 : 32, loff = kind == 4 ? 128 : (kind >> 1) * 64 + (kind & 1) * 32;
                const bf16_t* wrow = WLT + kind * 12288 + (size_t)ch * K + 8 * kg;
                const bf16x8p b0 = *(const bf16x8p*)wrow;
                bf16x8p b1 = b0; if (kind == 4) b1 = *(const bf16x8p*)(wrow + 32);
                float bias = 0.f;
                if (kind < 4) bias = ((kind >> 1) ? p.iclr_a0 : p.decay_w0)[(size_t)(l * 2 + (kind & 1)) * 384 + ch];
#pragma unroll
                for (int mt = 0; mt < 3; ++mt) {
                    f32x4p acc = {bias, bias, bias, bias};
                    const bf16x8p a0 = *(const bf16x8p*)(linb + (mt * 16 + n) * PR_LS + loff + 8 * kg);
                    acc = __builtin_amdgcn_mfma_f32_16x16x32_bf16(a0, b0, acc, 0, 0, 0);
                    if (kind == 4) { const bf16x8p a1 = *(const bf16x8p*)(linb + (mt * 16 + n) * PR_LS + loff + 32 + 8 * kg); acc = __builtin_amdgcn_mfma_f32_16x16x32_bf16(a1, b1, acc, 0, 0, 0); }
#pragma unroll
                    for (int r = 0; r < 4; ++r) {
                        const int tk = mt * 16 + kg * 4 + r;
                        if (tk < PR_TT) {
                            unsigned char* rec = p.ws + WS_OPS + (size_t)(tok0 + tk) * OPS_TOK + (size_t)h * OPS_REC;
                            if (kind == 4) ((bf16_t*)(rec + 1280))[cl] = f2bf(acc[r]);
                            else { const float sg = sigmoidf_(acc[r]);
                                if (kind >> 1) ((bf16_t*)(rec + 640))[(kind & 1) * 64 + cl] = f2bf(sg);
                                else ((float*)rec)[(kind & 1) * 64 + cl] = __expf(-0.60653065971263342f * sg); }
                        }
                    }
                }
            }
        }
#if PROBE_ID
        if (blockIdx.x == 0 && tid == 0 && l == 0) tsp[2] = __builtin_amdgcn_s_memrealtime();
#endif
        {
            float c0[NH][3], c1[NH][3], ckk[NH];
#pragma unroll
            for (int h = 0; h < NH; ++h) { ckk[h] = p.k_k[(size_t)l * 384 + h * 64 + lane];
#pragma unroll
                for (int q = 0; q < 3; ++q) { c0[h][q] = mu0[q * 384 + h * 64 + lane]; c1[h][q] = mu1[q * 384 + h * 64 + lane]; } }
#pragma unroll 1
            for (int tk = wv; tk < PR_TT; tk += 8) {
                const int tok = tok0 + tk; int s, t, T, st; tok_info(tok, s, t, T, st);
#pragma unroll
                for (int h = 0; h < NH; ++h) {
                    const int ch = h * 64 + lane;
                    float rkv[3];
#pragma unroll
                    for (int q = 0; q < 3; ++q) { const int col = q * 384 + ch;
                        const float xc = bf2f(urt[(tk + 1) * 1344 + col]);
                        const float xp = t > 0 ? bf2f(urt[tk * 1344 + col]) : 0.f;
                        const float xn = t < T - 1 ? bf2f(urt[(tk + 2) * 1344 + col]) : 0.f;
                        rkv[q] = xc + c0[h][q] * (xp - xc) + c1[h][q] * (xn - xc); }
                    const float kkr = rkv[1] * ckk[h];
                    const float nrm = __builtin_amdgcn_sqrtf(wave_sum(kkr * kkr));
                    const float kk = kkr * __builtin_amdgcn_rcpf(fmaxf(nrm, 1e-12f));
                    unsigned char* rec = p.ws + WS_OPS + (size_t)tok * OPS_TOK + (size_t)h * OPS_REC;
                    ((bf16_t*)(rec + 512))[lane] = f2bf(-kk);
                    bf16_t* rb = (bf16_t*)(rec + 896);
                    rb[lane] = f2bf(rkv[0]); rb[64 + lane] = f2bf(rkv[2]); rb[128 + lane] = f2bf(rkv[1]);
                }
            }
        }
    }
    PSTAMP(3);
    bf16_t* UD = (bf16_t*)(p.ws + WS_UD);
    for (int e = blockIdx.x * blockDim.x + tid; e < 2048 * 48; e += gridDim.x * blockDim.x) {
        const int tk = e / 48, grp = e % 48;
        const int axis = grp & 1;
        const int t = tk & 1023, pos = axis == 0 ? (t >> 6) : (t & 63);
        uint4* ptr = (uint4*)(UD + (size_t)(NPTOK + tk) * 1152 + grp * 16);
        const uint4 lo = ptr[0], hi = ptr[1];
        const unsigned lw[4] = {lo.x, lo.y, lo.z, lo.w}, hw[4] = {hi.x, hi.y, hi.z, hi.w};
        float o1[8], o2[8];
#pragma unroll
        for (int pr = 0; pr < 8; ++pr) {
            const float inv = __powf(10000.f, -(float)pr / 8.f);
            float sn, cs; __sincosf((float)pos * inv, &sn, &cs);
            const float x1 = __builtin_bit_cast(float, (pr & 1) ? (lw[pr >> 1] & 0xffff0000u) : (lw[pr >> 1] << 16));
            const float x2 = __builtin_bit_cast(float, (pr & 1) ? (hw[pr >> 1] & 0xffff0000u) : (hw[pr >> 1] << 16));
            o1[pr] = x1 * cs - x2 * sn; o2[pr] = x2 * cs + x1 * sn;
        }
        uint4 w1, w2;
        w1.x = pk_bf16(o1[0], o1[1]); w1.y = pk_bf16(o1[2], o1[3]); w1.z = pk_bf16(o1[4], o1[5]); w1.w = pk_bf16(o1[6], o1[7]);
        w2.x = pk_bf16(o2[0], o2[1]); w2.y = pk_bf16(o2[2], o2[3]); w2.z = pk_bf16(o2[4], o2[5]); w2.w = pk_bf16(o2[6], o2[7]);
        ptr[0] = w1; ptr[1] = w2;
    }
    PSTAMP(4);
}

#define SC_TC 32
#define SJ_RT   0
#define SJ_AT   4608
#define SJ_ZT   9216
#define SJ_ZPT  18432
#define SJ_WT   27648
#define SJ_S    36864
#define SJ_LAB  54272
#define SJ_LAKB 58880
#define SJ_MRB  61440
#define SJ_HB   66048
#define SJ_PC   74752
#define SJ_TOT  78208
#define SJ_LABB 75008
#define SJ_BYTES 79232
typedef float f32x4s __attribute__((ext_vector_type(4)));
typedef short bf16x8s __attribute__((ext_vector_type(8)));
#define MFMAB(a, b, c) __builtin_amdgcn_mfma_f32_16x16x32_bf16((a), (b), (c), 0, 0, 0)
struct ScanStage { float nkk[8], w[8], a[8]; bf16_t r[8], v[8], k[8]; };
__device__ __forceinline__ void scan_load(const P& p, int h, int dir, int T, int start, int st_base, int ht, ScanStage& g) {
    const int k = ht & 63, seg = __builtin_amdgcn_readfirstlane(ht >> 6);
#pragma unroll
    for (int j = 0; j < 8; ++j) {
        const int st = st_base + 8 * seg + j, t = dir == 0 ? st : T - 1 - st, tok = start + t;
        const unsigned char* rec = p.ws + WS_OPS + (size_t)tok * OPS_TOK + (size_t)h * OPS_REC;
        const float* rf = (const float*)rec; const bf16_t* rb = (const bf16_t*)(rec + 512);
        g.w[j] = rf[dir * 64 + k]; g.nkk[j] = bf2f(rb[k]); g.a[j] = bf2f(rb[64 + dir * 64 + k]);
        g.r[j] = rb[192 + k]; g.v[j] = rb[256 + k]; g.k[j] = rb[320 + k];
    }
}
__device__ __forceinline__ void scan_totals(const ScanStage& g, int ht, unsigned char* J) {
    float c = g.w[0];
#pragma unroll
    for (int j = 1; j < 8; ++j) c *= g.w[j];
    ((float*)(J + SJ_TOT))[(ht >> 6) * 64 + (ht & 63)] = c;
}
__device__ __forceinline__ void scan_store(const ScanStage& g, float ka, float vmul, int ht, unsigned char* J) {
    const int k = ht & 63, seg = ht >> 6;
    float cp[9]; cp[0] = 1.f;
#pragma unroll
    for (int j = 0; j < 8; ++j) cp[j + 1] = cp[j] * g.w[j];
    const float* TOT = (const float*)(J + SJ_TOT);
    const float T0 = TOT[k], T1 = TOT[64 + k], T2 = TOT[128 + k], T3 = TOT[192 + k];
    const float pre = seg == 0 ? 1.f : (seg == 1 ? T0 : (seg == 2 ? T0 * T1 : T0 * T1 * T2));
    const float PCk = T0 * T1 * T2 * T3;
    bf16_t* RT = (bf16_t*)(J + SJ_RT); bf16_t* AT = (bf16_t*)(J + SJ_AT); bf16_t* ZT = (bf16_t*)(J + SJ_ZT); bf16_t* ZPT = (bf16_t*)(J + SJ_ZPT); bf16_t* WT = (bf16_t*)(J + SJ_WT);
    float zb[8], zk[8], vv[8];
#pragma unroll
    for (int j = 0; j < 8; ++j) {
        const int t = 8 * seg + j;
        const float Pm = pre * cp[j], Pt = pre * cp[j + 1], inv = __builtin_amdgcn_rcpf(Pt), kk = bf2f(g.k[j]);
        const float bt = -g.nkk[j] * g.a[j] * inv, kt = kk * (1.f + (g.a[j] - 1.f) * ka) * inv;
        RT[t * 72 + k] = f2bf(bf2f(g.r[j]) * Pt); AT[t * 72 + k] = f2bf(g.nkk[j] * Pm);
        ZT[t * 72 + k] = f2bf(bt); ZT[(32 + t) * 72 + k] = f2bf(kt);
        zb[j] = bt * PCk; zk[j] = kt * PCk; vv[j] = bf2f(g.v[j]) * vmul;
    }
    { uint4 o; o.x = pk_bf16(zb[0], zb[1]); o.y = pk_bf16(zb[2], zb[3]); o.z = pk_bf16(zb[4], zb[5]); o.w = pk_bf16(zb[6], zb[7]); *(uint4*)(ZPT + k * 72 + 8 * seg) = o; }
    { uint4 o; o.x = pk_bf16(zk[0], zk[1]); o.y = pk_bf16(zk[2], zk[3]); o.z = pk_bf16(zk[4], zk[5]); o.w = pk_bf16(zk[6], zk[7]); *(uint4*)(ZPT + k * 72 + 32 + 8 * seg) = o; }
    { uint4 o; o.x = pk_bf16(vv[0], vv[1]); o.y = pk_bf16(vv[2], vv[3]); o.z = pk_bf16(vv[4], vv[5]); o.w = pk_bf16(vv[6], vv[7]); *(uint4*)(WT + k * 72 + 32 + 8 * seg) = o; }
    if (seg == 0) ((float*)(J + SJ_PC))[k] = PCk;
}
__device__ __forceinline__ bf16x8s lds_b8(const unsigned char* p) { return *(const bf16x8s*)p; }
__device__ __forceinline__ void ph_scan_job(const P& p, int l, int s, int h, int mode, int pdir, int seg, int st0, int nsteps, float* sm) {
    const int tid = otid(), half = __builtin_amdgcn_readfirstlane(tid >> 8), ht = tid & 255, wq = __builtin_amdgcn_readfirstlane(ht >> 6), lane = ht & 63, l15 = lane & 15, l4 = lane >> 4;
    const int dir = mode == 0 ? half : pdir, kind = mode == 0 ? 0 : 1 + half;
    int start, T; seq_info(s, start, T);
    unsigned char* J = (unsigned char*)sm + half * SJ_BYTES;
    float* S = (float*)(J + SJ_S); float* LAB = (float*)(J + SJ_LAB); float* HB = (float*)(J + SJ_HB); const float* PC = (const float*)(J + SJ_PC);
    bf16_t* WT = (bf16_t*)(J + SJ_WT); bf16_t* LAKB = (bf16_t*)(J + SJ_LAKB); bf16_t* MRB = (bf16_t*)(J + SJ_MRB); bf16_t* LABB = (bf16_t*)(J + SJ_LABB);
    const float vmul = kind == 1 ? 0.f : 1.f;
    float* ybase = kind == 1 ? (float*)(p.ws + WS_ZS) + ((ptrdiff_t)dir * 2048 - (ptrdiff_t)NPTOK) * 384 : (float*)(p.ws + WS_UR) + (size_t)dir * NTOK * 384;
    ybase += h * 64 + 16 * wq + l15;
    const float ka = p.k_a[(size_t)l * 384 + h * 64 + lane];
    const int nc = nsteps / SC_TC;
    ScanStage g;
    scan_load(p, h, dir, T, start, st0, ht, g);
    __syncthreads();
    {
        const float* s0 = (kind == 0 && s >= 32) ? p.state_rwkv + ((((size_t)(s - 32) * 2 + l) * 2 + dir) * NH + h) * 4096 : nullptr;
        for (int e = ht; e < 4096; e += 256) { const int v = e >> 6, k = e & 63; S[v * 68 + k] = s0 ? s0[e] : (kind == 1 && v == k ? 1.f : 0.f); }
        for (int e = ht; e < 64 * 32; e += 256) WT[(e >> 5) * 72 + (e & 31)] = 0;
    }
    scan_totals(g, ht, J);
    __syncthreads();
    scan_store(g, ka, vmul, ht, J);
    __syncthreads();
    for (int c = 0; c < nc; ++c) {
        if (c + 1 < nc) scan_load(p, h, dir, T, start, st0 + (c + 1) * SC_TC, ht, g);
        f32x4s accG[2], accY[2];
#pragma unroll
        for (int tt = 0; tt < 2; ++tt) { accG[tt] = (f32x4s){0.f, 0.f, 0.f, 0.f}; accY[tt] = accG[tt]; }
#pragma unroll
        for (int ks = 0; ks < 2; ++ks) {
            const float4 s0 = *(const float4*)(S + (16 * wq + l15) * 68 + 32 * ks + 8 * l4), s1 = *(const float4*)(S + (16 * wq + l15) * 68 + 32 * ks + 8 * l4 + 4);
            const float sv[8] = {s0.x, s0.y, s0.z, s0.w, s1.x, s1.y, s1.z, s1.w};
            union { unsigned u[4]; bf16x8s v; } hi, lo;
#pragma unroll
            for (int e = 0; e < 4; ++e) {
                const float h0 = bf2f(f2bf(sv[2 * e])), h1 = bf2f(f2bf(sv[2 * e + 1]));
                hi.u[e] = pk_bf16(sv[2 * e], sv[2 * e + 1]); lo.u[e] = pk_bf16(sv[2 * e] - h0, sv[2 * e + 1] - h1);
            }
#pragma unroll
            for (int tt = 0; tt < 2; ++tt) {
                const bf16x8s a = lds_b8(J + SJ_AT + (16 * tt + l15) * 144 + 64 * ks + 16 * l4), r = lds_b8(J + SJ_RT + (16 * tt + l15) * 144 + 64 * ks + 16 * l4);
                accG[tt] = MFMAB(a, hi.v, accG[tt]); accG[tt] = MFMAB(a, lo.v, accG[tt]);
                accY[tt] = MFMAB(r, hi.v, accY[tt]); accY[tt] = MFMAB(r, lo.v, accY[tt]);
            }
        }
        {
            const int xoff = wq < 2 ? SJ_AT + (16 * wq + l15) * 144 : SJ_RT + (16 * (wq - 2) + l15) * 144;
            const bf16x8s xa0 = lds_b8(J + xoff + 16 * l4), xa1 = lds_b8(J + xoff + 64 + 16 * l4);
#pragma unroll
            for (int zt = 0; zt < 4; ++zt) {
                f32x4s m = {0.f, 0.f, 0.f, 0.f};
                m = MFMAB(xa0, lds_b8(J + SJ_ZT + (16 * zt + l15) * 144 + 16 * l4), m);
                m = MFMAB(xa1, lds_b8(J + SJ_ZT + (16 * zt + l15) * 144 + 64 + 16 * l4), m);
#pragma unroll
                for (int r = 0; r < 4; ++r) {
                    const int t = (16 * wq + 4 * l4 + r) & 31, i = (16 * zt + l15) & 31;
                    if (wq < 2) { const float val = i < t ? m[r] : 0.f; if (zt < 2) { LAB[t * 36 + i] = val; LABB[t * 40 + i] = f2bf(val); } else LAKB[t * 40 + i] = f2bf(val); }
                    else MRB[t * 72 + 16 * zt + l15] = f2bf(i <= t ? m[r] : 0.f);
                }
            }
        }
        __syncthreads();
        {
            const bf16x8s vb = lds_b8(J + SJ_WT + (16 * wq + l15) * 144 + 64 + 16 * l4);
#pragma unroll
            for (int tt = 0; tt < 2; ++tt) {
                accG[tt] = MFMAB(lds_b8(J + SJ_LAKB + (16 * tt + l15) * 80 + 16 * l4), vb, accG[tt]);
#pragma unroll
                for (int r = 0; r < 4; ++r) HB[(16 * tt + 4 * l4 + r) * 68 + 16 * wq + l15] = accG[tt][r];
            }
        }
        asm volatile("s_waitcnt lgkmcnt(0)" ::: "memory");
        {
            const int vloc = lane >> 2, part = lane & 3, v = 16 * wq + vloc;
            const bf16x8s zero8 = {0, 0, 0, 0, 0, 0, 0, 0};
#pragma unroll
            for (int tb = 0; tb < 4; ++tb) {
                if (tb > 0) {
                    bf16x8s a = lds_b8(J + SJ_LABB + (8 * tb + l15) * 80 + 16 * l4);
                    if (l4 >= tb) a = zero8;
                    const bf16x8s ub = lds_b8(J + SJ_WT + (16 * wq + l15) * 144 + 16 * l4);
                    f32x4s d = {0.f, 0.f, 0.f, 0.f};
                    d = MFMAB(a, ub, d);
                    if (l4 < 2) {
#pragma unroll
                        for (int r = 0; r < 4; ++r) HB[(8 * tb + 4 * l4 + r) * 68 + 16 * wq + l15] += d[r];
                    }
                    asm volatile("s_waitcnt lgkmcnt(0)" ::: "memory");
                }
                float lab[8][2], hb[8], ub2[2] = {0.f, 0.f};
#pragma unroll
                for (int q = 0; q < 8; ++q) { const int t = 8 * tb + q; hb[q] = HB[t * 68 + v];
#pragma unroll
                    for (int cc = 0; cc < 2; ++cc) lab[q][cc] = (4 * cc < q) ? LAB[t * 36 + 8 * tb + 4 * cc + part] : 0.f; }
#pragma unroll
                for (int q = 0; q < 8; ++q) {
                    const int t = 8 * tb + q;
                    float sacc = 0.f;
#pragma unroll
                    for (int cc = 0; cc < 2; ++cc) if (4 * cc < q) sacc = fmaf(lab[q][cc], ub2[cc], sacc);
                    sacc = dpp_add<0xB1>(sacc); sacc = dpp_add<0x4E>(sacc);
                    const float u = hb[q] + sacc;
                    if ((q & 3) == part) ub2[q >> 2] = u;
                    WT[v * 72 + t] = f2bf(u);
                }
                asm volatile("s_waitcnt lgkmcnt(0)" ::: "memory");
            }
        }
        asm volatile("s_waitcnt lgkmcnt(0)" ::: "memory");
        {
            const bf16x8s w0 = lds_b8(J + SJ_WT + (16 * wq + l15) * 144 + 16 * l4), w1 = lds_b8(J + SJ_WT + (16 * wq + l15) * 144 + 64 + 16 * l4);
#pragma unroll
            for (int tt = 0; tt < 2; ++tt) {
                accY[tt] = MFMAB(lds_b8(J + SJ_MRB + (16 * tt + l15) * 144 + 16 * l4), w0, accY[tt]);
                accY[tt] = MFMAB(lds_b8(J + SJ_MRB + (16 * tt + l15) * 144 + 64 + 16 * l4), w1, accY[tt]);
#pragma unroll
                for (int r = 0; r < 4; ++r) { const int st = st0 + c * SC_TC + 16 * tt + 4 * l4 + r, t = dir == 0 ? st : T - 1 - st; __hip_atomic_store(ybase + (size_t)(start + t) * 384, accY[tt][r], __ATOMIC_RELAXED, __HIP_MEMORY_SCOPE_AGENT); }
            }
#pragma unroll
            for (int kt = 0; kt < 4; ++kt) {
                const int k = 16 * kt + l15; const float pc = PC[k];
                f32x4s acc;
#pragma unroll
                for (int r = 0; r < 4; ++r) acc[r] = S[(16 * wq + 4 * l4 + r) * 68 + k] * pc;
                acc = MFMAB(w0, lds_b8(J + SJ_ZPT + k * 144 + 16 * l4), acc);
                acc = MFMAB(w1, lds_b8(J + SJ_ZPT + k * 144 + 64 + 16 * l4), acc);
#pragma unroll
                for (int r = 0; r < 4; ++r) S[(16 * wq + 4 * l4 + r) * 68 + k] = acc[r];
            }
        }
        if (c + 1 < nc) scan_totals(g, ht, J);
        __syncthreads();
        if (c + 1 < nc) { scan_store(g, ka, vmul, ht, J); __syncthreads(); }
    }
    float* so = nullptr;
    if (mode == 0) so = s < 32 ? p.out + OUT_ST + ((((size_t)s * 2 + l) * 2 + dir) * NH + h) * 4096
                              : (float*)(p.ws + WS_SS) + ((size_t)(((s - 32) * NH + h) * 2 + dir) * 3 + 0) * 4096;
    else if (seg == 1) so = (float*)(p.ws + WS_SS) + ((size_t)(((s - 32) * NH + h) * 2 + dir) * 3 + kind) * 4096;
    if (so) for (int e = ht; e < 4096; e += 256) so[e] = S[(e >> 6) * 68 + (e & 63)];
}

#define SEG0_LEN 352
#define SEG1_LEN 352
#define SEG2_LEN 320
#define CTL_SCANDONE 3720
__device__ __forceinline__ void fixup_item(const P& p, int l, int item4, float* sm) {
    const int tid = otid(), lane = tid & 63, wv = tid >> 6;
    {
        const int item = item4 >> 2, qtr = item4 & 3;
        const int b = item / 24, h = (item % 24) >> 2, dir = (item >> 1) & 1, seg = 1 + (item & 1);
        const float* E0 = (const float*)(p.ws + WS_SS) + (size_t)(((b * NH + h) * 2 + dir) * 3) * 4096; const float* P1 = E0 + 4096; const float* Q1 = E0 + 8192;
        if (tid == 0) {
            unsigned* cnt = (unsigned*)(p.ws + WS_CTL) + CTL_SCANDONE + 32 * l + (b * NH + h) * 2 + dir; unsigned sp = 0;
            while (__hip_atomic_load(cnt, __ATOMIC_RELAXED, __HIP_MEMORY_SCOPE_AGENT) < 3u && ++sp < (1u << 24)) __builtin_amdgcn_s_sleep(20);
            __builtin_amdgcn_fence(__ATOMIC_ACQUIRE, "agent");
            asm volatile("s_waitcnt vmcnt(0)" ::: "memory");
        }
        __syncthreads();
        float* sE = sm; float* sP = sm + 64 * 68; float* sS = sm + 2 * 64 * 68;
        const int qlen = (seg == 1 ? SEG1_LEN : SEG2_LEN) / 4;
        const int st0 = (seg == 1 ? SEG0_LEN : SEG0_LEN + SEG1_LEN) + qtr * qlen;
        const float* Zb = (const float*)(p.ws + WS_ZS) + (size_t)dir * 2048 * 384; float* Yb = (float*)(p.ws + WS_UR) + (size_t)dir * NTOK * 384;
        int zi[12]; float yv[12];
#pragma unroll
        for (int e = 0; e < 12; ++e) {
            const int q = wv * 4 + (e >> 2) * 32 + (e & 3);
            const int st = st0 + (q < qlen ? q : 0), t = dir ? 1023 - st : st, stok = b * 1024 + t;
            zi[e] = __builtin_bit_cast(int, Zb[(size_t)stok * 384 + h * 64 + lane]);
            yv[e] = Yb[(size_t)(NPTOK + stok) * 384 + h * 64 + lane];
        }
        if (seg == 1) {
#pragma unroll
            for (int i = 0; i < 2; ++i) { const int e = tid * 2 + i, row = e >> 4, c4 = (e & 15) * 4; const float4 v = *(const float4*)(E0 + row * 64 + c4);
                sS[row * 65 + c4] = v.x; sS[row * 65 + c4 + 1] = v.y; sS[row * 65 + c4 + 2] = v.z; sS[row * 65 + c4 + 3] = v.w; }
        } else {
            const int r = lane & 15, q = lane >> 4, tv = wv >> 1, tn0 = (wv & 1) * 2;
            f32x4s c0, c1;
#pragma unroll
            for (int g = 0; g < 4; ++g) { c0[g] = Q1[(16 * tv + 4 * q + g) * 64 + 16 * tn0 + r]; c1[g] = Q1[(16 * tv + 4 * q + g) * 64 + 16 * tn0 + 16 + r]; }
#pragma unroll
            for (int i = 0; i < 2; ++i) { const int e = tid * 2 + i, row = e >> 4, c4 = (e & 15) * 4;
                *(float4*)(sE + row * 68 + c4) = *(const float4*)(E0 + row * 64 + c4); *(float4*)(sP + row * 68 + c4) = *(const float4*)(P1 + row * 64 + c4); }
            __syncthreads();
#pragma unroll
            for (int ks = 0; ks < 16; ++ks) {
                const float av = sE[(16 * tv + r) * 68 + 4 * ks + q];
                c0 = __builtin_amdgcn_mfma_f32_16x16x4f32(av, sP[(4 * ks + q) * 68 + 16 * tn0 + r], c0, 0, 0, 0);
                c1 = __builtin_amdgcn_mfma_f32_16x16x4f32(av, sP[(4 * ks + q) * 68 + 16 * tn0 + 16 + r], c1, 0, 0, 0);
            }
#pragma unroll
            for (int g = 0; g < 4; ++g) { sS[(16 * tv + 4 * q + g) * 65 + 16 * tn0 + r] = c0[g]; sS[(16 * tv + 4 * q + g) * 65 + 16 * tn0 + 16 + r] = c1[g]; }
        }
        __syncthreads();
        float Srow[64];
#pragma unroll
        for (int i = 0; i < 64; ++i) Srow[i] = sS[lane * 65 + i];
#pragma unroll
        for (int trip = 0; trip < 3; ++trip) {
#pragma unroll
            for (int i = 0; i < 64; ++i)
#pragma unroll
                for (int u = 0; u < 4; ++u) yv[trip * 4 + u] += Srow[i] * __builtin_bit_cast(float, __builtin_amdgcn_readlane(zi[trip * 4 + u], i));
#pragma unroll
            for (int u = 0; u < 4; ++u) {
                const int q = wv * 4 + trip * 32 + u;
                if (q < qlen) { const int st = st0 + q, t = dir ? 1023 - st : st, stok = b * 1024 + t;
                    __hip_atomic_store(Yb + (size_t)(NPTOK + stok) * 384 + h * 64 + lane, yv[trip * 4 + u], __ATOMIC_RELAXED, __HIP_MEMORY_SCOPE_AGENT); }
            }
        }
        asm volatile("s_waitcnt vmcnt(0)" ::: "memory");
        __syncthreads();
        if (tid == 0) __hip_atomic_fetch_add((unsigned*)(p.ws + WS_CNT2) + 256 * l + 192 + b * NH + h, 1u, __ATOMIC_RELAXED, __HIP_MEMORY_SCOPE_AGENT);
    }
}

template <class Wait>
__device__ __forceinline__ void finalize_256(const P& p, int l, int tok0, int h, const Wait& wait_deps) {
    const int tid_ = otid(); const int lane = tid_ & 63, wv = tid_ >> 6, row4 = lane >> 4, c4 = lane & 15, ch = h * 64 + c4 * 4;
    const float* Yb = (const float*)(p.ws + WS_UR);
    bf16_t* MIX = (bf16_t*)(p.ws + WS_H);
    const float4 ka = *(const float4*)(p.k_a + (size_t)l * 384 + ch), rk = *(const float4*)(p.r_k + (size_t)l * 384 + ch);
    const float4 lg = *(const float4*)(p.lnx_g + (size_t)l * 384 + ch), lb = *(const float4*)(p.lnx_b + (size_t)l * 384 + ch);
    {
        float4 yf[8], yb[8]; uint2 a0[8], a1[8], rr[8], vv[8], kk[8], gg[8];
#pragma unroll
        for (int u = 0; u < 8; ++u) {
            const int tok = tok0 + wv * 32 + u * 4 + row4;
            const unsigned char* rec = p.ws + WS_OPS + (size_t)tok * OPS_TOK + (size_t)h * OPS_REC;
            a0[u] = *(const uint2*)(rec + 640 + c4 * 8); a1[u] = *(const uint2*)(rec + 768 + c4 * 8);
            rr[u] = *(const uint2*)(rec + 896 + c4 * 8); vv[u] = *(const uint2*)(rec + 1024 + c4 * 8);
            kk[u] = *(const uint2*)(rec + 1152 + c4 * 8); gg[u] = *(const uint2*)(rec + 1280 + c4 * 8);
        }
        wait_deps();
#pragma unroll
        for (int u = 0; u < 8; ++u) {
            const int tok = tok0 + wv * 32 + u * 4 + row4;
            yf[u] = *(const float4*)(Yb + (size_t)tok * 384 + ch); yb[u] = *(const float4*)(Yb + ((size_t)NTOK + tok) * 384 + ch);
        }
#pragma unroll
        for (int u = 0; u < 8; ++u) {
            const int tok = tok0 + wv * 32 + u * 4 + row4;
            float y[4] = {yf[u].x + yb[u].x, yf[u].y + yb[u].y, yf[u].z + yb[u].z, yf[u].w + yb[u].w};
            const float A0[4] = {__builtin_bit_cast(float, a0[u].x << 16), __builtin_bit_cast(float, a0[u].x & 0xffff0000u), __builtin_bit_cast(float, a0[u].y << 16), __builtin_bit_cast(float, a0[u].y & 0xffff0000u)};
            const float A1[4] = {__builtin_bit_cast(float, a1[u].x << 16), __builtin_bit_cast(float, a1[u].x & 0xffff0000u), __builtin_bit_cast(float, a1[u].y << 16), __builtin_bit_cast(float, a1[u].y & 0xffff0000u)};
            const float KA[4] = {ka.x, ka.y, ka.z, ka.w}, RK[4] = {rk.x, rk.y, rk.z, rk.w}, LG[4] = {lg.x, lg.y, lg.z, lg.w}, LB[4] = {lb.x, lb.y, lb.z, lb.w};
            const unsigned rw[2] = {rr[u].x, rr[u].y}, vw[2] = {vv[u].x, vv[u].y}, kw[2] = {kk[u].x, kk[u].y}, gw[2] = {gg[u].x, gg[u].y};
            const float mu = row16_sum(y[0] + y[1] + y[2] + y[3]) * (1.f / 64.f);
            float var = 0.f, bs = 0.f, vj[4], gj[4];
#pragma unroll
            for (int j = 0; j < 4; ++j) {
                const float r = __builtin_bit_cast(float, (j & 1) ? (rw[j >> 1] & 0xffff0000u) : (rw[j >> 1] << 16));
                const float k = __builtin_bit_cast(float, (j & 1) ? (kw[j >> 1] & 0xffff0000u) : (kw[j >> 1] << 16));
                vj[j] = __builtin_bit_cast(float, (j & 1) ? (vw[j >> 1] & 0xffff0000u) : (vw[j >> 1] << 16));
                gj[j] = __builtin_bit_cast(float, (j & 1) ? (gw[j >> 1] & 0xffff0000u) : (gw[j >> 1] << 16));
                y[j] -= mu; var += y[j] * y[j];
                bs += r * (k * (1.f + (A0[j] - 1.f) * KA[j]) + k * (1.f + (A1[j] - 1.f) * KA[j])) * RK[j];
            }
            var = row16_sum(var); bs = row16_sum(bs);
            const float rstd = rsqrtf(var * (1.f / 64.f) + 64e-5f);
            float o[4];
#pragma unroll
            for (int j = 0; j < 4; ++j) o[j] = ((y[j] * rstd * LG[j] + LB[j]) + bs * vj[j]) * gj[j];
            uint2 w; w.x = pk_bf16(o[0], o[1]); w.y = pk_bf16(o[2], o[3]);
            *(uint2*)(MIX + (size_t)tok * 1024 + ch) = w;
        }
    }
}

__device__ __forceinline__ void finalize_item(const P& p, int l, int item) {
    const int q4 = item < 192 ? 0 : (item - 192) & 3, bh = item < 192 ? item : 192 + ((item - 192) >> 2);
    unsigned* cnt = (unsigned*)(p.ws + WS_CNT2) + 256 * l + bh; const unsigned need = item < 192 ? 1u : 16u;
    auto wait_deps = [&]() {
        if (threadIdx.x == 0) { unsigned sp = 0;
            while (__hip_atomic_load(cnt, __ATOMIC_RELAXED, __HIP_MEMORY_SCOPE_AGENT) < need && ++sp < (1u << 24)) __builtin_amdgcn_s_sleep(20);
            __builtin_amdgcn_fence(__ATOMIC_ACQUIRE, "agent");
            asm volatile("s_waitcnt vmcnt(0)" ::: "memory"); }
        __syncthreads();
    };
    if (item < 192) finalize_256(p, l, (item / NH) * TP, item % NH, wait_deps);
    else finalize_256(p, l, NPTOK + ((bh - 192) / NH) * TS + q4 * 256, (bh - 192) % NH, wait_deps);
}

#define LAS __attribute__((address_space(3)))
namespace pg8 {
typedef short bf16x8 __attribute__((ext_vector_type(8)));
typedef float f32x4 __attribute__((ext_vector_type(4)));
constexpr int BM = 256, BK = 64, HALF = 128, HTB = HALF * BK * 2, STAGE_BYTES = 8 * HTB, NXCD = 8, WGM = 8;
__host__ __device__ __forceinline__ int lds_byte(int r, int c) { const int st = (r >> 4) * 2 + (c >> 5), rr = r & 15, cc = c & 31, ob = rr * 64 + cc * 2; return st * 1024 + (ob ^ (((ob >> 9) & 1) << 5)); }
__host__ __device__ __forceinline__ void stage_rc(int b, int& R, int& C) { const int st = b / 1024, sb = b % 1024, swz = sb ^ (((sb >> 9) & 1) << 5); R = (st >> 1) * 16 + swz / 64; C = (st & 1) * 32 + (swz % 64) / 2; }
struct Unit { int pm, pn; };
struct Gemm { const bf16_t* A; const bf16_t* Bt; int M, N, K; };
struct StaticOrder {
    int nM, nN, nwg, G, c;
    __device__ void init(int M, int N, int G_, int c_) { nM = M / BM; nN = N / BM; nwg = nM * nN; G = G_; c = c_; }
    __device__ bool next(int i, Unit& u) const {
        const long L = (long)i * G + c; if (L >= nwg) return false;
        int wgid = (int)L; { const int q = nwg / NXCD, r = nwg % NXCD, xcd = wgid % NXCD, off = wgid / NXCD; wgid = (xcd < r ? xcd * (q + 1) : r * (q + 1) + (xcd - r) * q) + off; }
        const int nig = WGM * nN, gid = wgid / nig, fm = gid * WGM, gsz = (nM - fm) < WGM ? (nM - fm) : WGM;
        u.pm = fm + ((wgid % nig) % gsz); u.pn = (wgid % nig) / gsz; return true;
    }
};
template <class Epi, class Sched>
__device__ __forceinline__ void gemm_phase(LAS unsigned char* lds, const Gemm g, const Sched& S, const Epi& E) {
    int tid_ = threadIdx.x; asm volatile("" : "+v"(tid_));
    const int tid = tid_, wid = __builtin_amdgcn_readfirstlane(tid >> 6), lane = tid & 63, wr = wid >> 2, wc = wid & 3, fr = lane & 15, fq = lane >> 4;
    const int K = g.K, nt = K / BK;
    unsigned voffA[2], voffB[2];
#pragma unroll
    for (int i = 0; i < 2; ++i) { int R, C; stage_rc(tid * 16 + i * 8192, R, C);
        const int rho = R & 31, Rb = Epi::PERM ? ((R & ~31) + 8 * ((rho & 15) >> 2) + 4 * (rho >> 4) + (rho & 3)) : R;
        voffA[i] = (unsigned)(R * K + C) * 2u; voffB[i] = (unsigned)(Rb * K + C) * 2u; }
    const size_t kstep = (size_t)(BK * 2);
    const size_t hstep = (size_t)HALF * K * 2;
    const size_t tstep = 2 * hstep;
    const unsigned ldsw = (unsigned)wid * 1024u;
    const int aoff = lds_byte(wr * 64 + fr, fq * 8), boff = lds_byte(wc * 32 + fr, fq * 8);
#define PG8_SA(b, h) (((b) * 2 + (h)) * HTB)
#define PG8_SB(b, h) ((4 + (b) * 2 + (h)) * HTB)
#define PG8_STAGE(bufoff, gbase, voff) do { _Pragma("unroll") for (int _i = 0; _i < 2; ++_i) \
        __builtin_amdgcn_global_load_lds((const unsigned*)((const char*)(gbase) + (voff)[_i]), (LAS unsigned*)(lds + (bufoff) + ldsw + _i * 8192), 16, 0, 0); } while (0)
#define PG8_LDA(dst, b, h) do { _Pragma("unroll") for (int m = 0; m < 4; ++m) _Pragma("unroll") for (int k = 0; k < 2; ++k) dst[m][k] = *(const LAS bf16x8*)(lds + PG8_SA(b, h) + aoff + m * 2048 + k * 1024); } while (0)
#define PG8_LDB(dst, b, h) do { _Pragma("unroll") for (int n = 0; n < 2; ++n) _Pragma("unroll") for (int k = 0; k < 2; ++k) dst[n][k] = *(const LAS bf16x8*)(lds + PG8_SB(b, h) + boff + n * 2048 + k * 1024); } while (0)
#define PG8_MMA(ai, bj, At, Bt) do { __builtin_amdgcn_s_setprio(1); _Pragma("unroll") for (int m = 0; m < 4; ++m) _Pragma("unroll") for (int n = 0; n < 2; ++n) _Pragma("unroll") for (int k = 0; k < 2; ++k) \
        acc[ai][bj][m][n] = __builtin_amdgcn_mfma_f32_16x16x32_bf16(Bt[n][k], At[m][k], acc[ai][bj][m][n], 0, 0, 0); __builtin_amdgcn_s_setprio(0); } while (0)
#define PG8_WAIT_V(n) asm volatile("s_waitcnt vmcnt(" #n ")" ::: "memory")
#define PG8_WAIT_L(n) asm volatile("s_waitcnt lgkmcnt(" #n ")" ::: "memory")
#define PG8_BAR __builtin_amdgcn_s_barrier()
#define PG8_SCHED __builtin_amdgcn_sched_barrier(0)
    Unit cur, nxt; int ui = 0;
    if (!S.next(0, cur)) return;
    f32x4 acc[2][2][4][2];
#pragma unroll
    for (int a = 0; a < 2; ++a)
#pragma unroll
        for (int b = 0; b < 2; ++b)
#pragma unroll
            for (int m = 0; m < 4; ++m)
#pragma unroll
                for (int n = 0; n < 2; ++n) acc[a][b][m][n] = (f32x4){0.f, 0.f, 0.f, 0.f};
    bf16x8 At[4][2], B0[2][2], B1[2][2];
    const char* cA = (const char*)g.A + (size_t)cur.pm * tstep; const char* cB = (const char*)g.Bt + (size_t)cur.pn * tstep;
    PG8_STAGE(PG8_SB(0, 0), cB, voffB); PG8_STAGE(PG8_SA(0, 0), cA, voffA); PG8_STAGE(PG8_SB(0, 1), cB + hstep, voffB); PG8_STAGE(PG8_SA(0, 1), cA + hstep, voffA);
    if (wr == 1) PG8_BAR;
    PG8_WAIT_V(4); PG8_BAR;
    PG8_STAGE(PG8_SB(1, 0), cB + kstep, voffB); PG8_STAGE(PG8_SA(1, 0), cA + kstep, voffA); PG8_STAGE(PG8_SB(1, 1), cB + hstep + kstep, voffB);
    PG8_WAIT_V(6); PG8_BAR;
    for (;;) {
        const bool has_next = S.next(ui + 1, nxt);
        const char* nA = has_next ? (const char*)g.A + (size_t)nxt.pm * tstep : cA; const char* nB = has_next ? (const char*)g.Bt + (size_t)nxt.pn * tstep : cB;
        for (int t = 0; t < nt; t += 2) {
            const bool last = (t == nt - 2);
            const char* a1 = cA + (size_t)(t + 1) * kstep;
            const char* a2 = last ? nA : cA + (size_t)(t + 2) * kstep; const char* b2 = last ? nB : cB + (size_t)(t + 2) * kstep;
            const char* a3 = a2 + kstep; const char* b3 = b2 + kstep;
            PG8_LDB(B0, 0, 0); PG8_SCHED; PG8_LDA(At, 0, 0); PG8_STAGE(PG8_SA(1, 1), a1 + hstep, voffA);
            PG8_WAIT_L(8); PG8_BAR; PG8_WAIT_L(0); PG8_MMA(0, 0, At, B0); PG8_BAR; PG8_SCHED;
            PG8_LDB(B1, 0, 1); PG8_STAGE(PG8_SB(0, 0), b2, voffB);
            PG8_BAR; PG8_WAIT_L(0); PG8_MMA(0, 1, At, B1); PG8_BAR;
            PG8_LDA(At, 0, 1); PG8_STAGE(PG8_SA(0, 0), a2, voffA);
            PG8_BAR; PG8_WAIT_L(0); PG8_MMA(1, 0, At, B0); PG8_BAR; PG8_SCHED;
            PG8_STAGE(PG8_SB(0, 1), b2 + hstep, voffB);
            PG8_WAIT_V(6); PG8_BAR; PG8_MMA(1, 1, At, B1); PG8_BAR;
            PG8_LDB(B0, 1, 0); PG8_SCHED; PG8_LDA(At, 1, 0); PG8_STAGE(PG8_SA(0, 1), a2 + hstep, voffA);
            PG8_WAIT_L(8); PG8_BAR; PG8_WAIT_L(0); PG8_MMA(0, 0, At, B0); PG8_BAR; PG8_SCHED;
            PG8_LDB(B1, 1, 1); PG8_STAGE(PG8_SB(1, 0), b3, voffB);
            PG8_BAR; PG8_WAIT_L(0); PG8_MMA(0, 1, At, B1); PG8_BAR;
            PG8_LDA(At, 1, 1); PG8_STAGE(PG8_SA(1, 0), a3, voffA);
            PG8_BAR; PG8_WAIT_L(0); PG8_MMA(1, 0, At, B0); PG8_BAR; PG8_SCHED;
            PG8_STAGE(PG8_SB(1, 1), b3 + hstep, voffB);
            PG8_WAIT_V(6); PG8_BAR; PG8_MMA(1, 1, At, B1); PG8_BAR;
        }
        E(acc, cur, wr, wc, fr, fq);
        if (!has_next) break;
#pragma unroll
        for (int a = 0; a < 2; ++a)
#pragma unroll
            for (int b = 0; b < 2; ++b)
#pragma unroll
                for (int m = 0; m < 4; ++m)
#pragma unroll
                    for (int n = 0; n < 2; ++n) acc[a][b][m][n] = (f32x4){0.f, 0.f, 0.f, 0.f};
        cur = nxt; cA = nA; cB = nB; ++ui;
    }
    PG8_WAIT_V(0);
    if (wr == 0) PG8_BAR;
    PG8_BAR;
#undef PG8_SA
#undef PG8_SB
#undef PG8_STAGE
#undef PG8_LDA
#undef PG8_LDB
#undef PG8_MMA
#undef PG8_WAIT_V
#undef PG8_WAIT_L
#undef PG8_BAR
#undef PG8_SCHED
}
template <class F> struct EpiWrap {
    static constexpr bool PERM = false;
    const P* p; F f;
    __device__ __forceinline__ void operator()(const f32x4 (&acc)[2][2][4][2], const Unit& u, int wr, int wc, int fr, int fq) const {
        const int row0 = u.pm * BM + wr * 64 + fr, col0 = u.pn * BM + wc * 32 + 4 * fq;
#pragma unroll
        for (int ai = 0; ai < 2; ++ai)
#pragma unroll
            for (int m = 0; m < 4; ++m)
#pragma unroll
                for (int bj = 0; bj < 2; ++bj)
#pragma unroll
                    for (int n = 0; n < 2; ++n) {
                        const f32x4 a = acc[ai][bj][m][n]; const float v[4] = {a[0], a[1], a[2], a[3]};
                        f(*p, row0 + ai * HALF + m * 16, col0 + bj * HALF + n * 16, v);
                    }
    }
};
template <int CTRL> __device__ __forceinline__ float dpp_movf(float x) { return __builtin_bit_cast(float, __builtin_amdgcn_update_dpp(0, __builtin_bit_cast(int, x), CTRL, 0xf, 0xf, false)); }
__device__ __forceinline__ void quad_transpose4(float (&a)[4], bool j0, bool j1) {
    const float d0 = dpp_movf<0xB1>(a[0]), d1 = dpp_movf<0xB1>(a[1]), d2 = dpp_movf<0xB1>(a[2]), d3 = dpp_movf<0xB1>(a[3]);
    const float b0 = j0 ? d1 : a[0], b1 = j0 ? a[1] : d0, b2 = j0 ? d3 : a[2], b3 = j0 ? a[3] : d2;
    const float e0 = dpp_movf<0x4E>(b0), e1 = dpp_movf<0x4E>(b1), e2 = dpp_movf<0x4E>(b2), e3 = dpp_movf<0x4E>(b3);
    a[0] = j1 ? e2 : b0; a[1] = j1 ? e3 : b1; a[2] = j1 ? b2 : e0; a[3] = j1 ? b3 : e1;
}
struct EpiG1H {
    static constexpr bool PERM = true;
    const P* p; int l;
    __device__ __forceinline__ void operator()(const f32x4 (&acc)[2][2][4][2], const Unit& u, int wr, int wc, int fr, int fq) const {
        const int row0 = u.pm * BM + wr * 64 + fr, col0 = u.pn * BM + wc * 32 + 8 * fq;
        const float* rsq = (const float*)(p->ws + WS_RSQ) + (size_t)(2 * l) * NTOK;
        const float* bias = (const float*)(p->ws + WS_BIAS) + (size_t)(l * 3 + tok_cls(u.pm * BM)) * 3072 + col0;
        float rs[2][4]; float4 bb[2][2];
#pragma unroll
        for (int ai = 0; ai < 2; ++ai)
#pragma unroll
            for (int m = 0; m < 4; ++m) rs[ai][m] = rsq[row0 + ai * HALF + m * 16];
#pragma unroll
        for (int bj = 0; bj < 2; ++bj)
#pragma unroll
            for (int n = 0; n < 2; ++n) bb[bj][n] = *(const float4*)(bias + bj * HALF + n * 4);
#pragma unroll
        for (int ai = 0; ai < 2; ++ai)
#pragma unroll
            for (int m = 0; m < 4; ++m) rs[ai][m] = rsqrtf(rs[ai][m] * (1.f / 1024.f) + 1e-6f);
#pragma unroll
        for (int ai = 0; ai < 2; ++ai)
#pragma unroll
            for (int m = 0; m < 4; ++m)
#pragma unroll
                for (int bj = 0; bj < 2; ++bj) {
                    const int row = row0 + ai * HALF + m * 16, col = col0 + bj * HALF; const float r = rs[ai][m];
                    const f32x4 a0 = acc[ai][bj][m][0], a1 = acc[ai][bj][m][1]; const float4 b0 = bb[bj][0], b1 = bb[bj][1];
                    const float v[8] = {a0[0] * r + b0.x, a0[1] * r + b0.y, a0[2] * r + b0.z, a0[3] * r + b0.w, a1[0] * r + b1.x, a1[1] * r + b1.y, a1[2] * r + b1.z, a1[3] * r + b1.w};
                    if (col < C_FNET) {
                        uint4 w; w.x = pk_bf16(v[0], v[1]); w.y = pk_bf16(v[2], v[3]); w.z = pk_bf16(v[4], v[5]); w.w = pk_bf16(v[6], v[7]);
                        *(uint4*)((bf16_t*)(p->ws + WS_UD) + (size_t)row * 1152 + col) = w;
                        if (row < NPTOK && col >= 384) {
                            const int b = row >> 8, t = row & 255;
                            float* dst = p->out + (col < 768 ? OUT_CK : OUT_CV) + ((size_t)(b * 2 + l) * 256 + t) * 384 + (col < 768 ? col - 384 : col - 768);
                            *(float4*)dst = make_float4(v[0], v[1], v[2], v[3]); *(float4*)(dst + 4) = make_float4(v[4], v[5], v[6], v[7]);
                        }
                    } else if (col < C_RWKV) {
                        const int cc = col - C_FNET, g = cc >> 7, half = (cc >> 6) & 1, j = fr & 3, fc = (cc & 63) + j, rb = row - j;
                        float lo[4] = {v[0], v[1], v[2], v[3]}, hi[4] = {v[4], v[5], v[6], v[7]};
                        quad_transpose4(lo, (fr & 1) != 0, (fr & 2) != 0); quad_transpose4(hi, (fr & 1) != 0, (fr & 2) != 0);
                        uint2 wl, wh; wl.x = pk_bf16(lo[0], lo[1]); wl.y = pk_bf16(lo[2], lo[3]); wh.x = pk_bf16(hi[0], hi[1]); wh.y = pk_bf16(hi[2], hi[3]);
                        if (rb < NPTOK) { const int sq = rb >> 8, t = rb & 255; bf16_t* o = (bf16_t*)(p->ws + WS_ZF) + ((size_t)(sq * 256 + g * 64 + fc) * 512 + half * 256 + t);
                            *(uint2*)o = wl; *(uint2*)(o + 4 * 512) = wh; }
                        else { const int rr = rb - NPTOK, b = rr >> 10, t = rr & 1023; bf16_t* o = (bf16_t*)(p->ws + WS_ZF) + (size_t)8192 * 512 + ((size_t)(b * 256 + g * 64 + fc) * 2048 + half * 1024 + t);
                            *(uint2*)o = wl; *(uint2*)(o + 4 * 2048) = wh; }
                    } else if (col < C_END) {
                        uint4 w; w.x = pk_bf16(v[0], v[1]); w.y = pk_bf16(v[2], v[3]); w.z = pk_bf16(v[4], v[5]); w.w = pk_bf16(v[6], v[7]);
                        *(uint4*)((bf16_t*)(p->ws + WS_UR) + (size_t)row * N_RWKV + (col - C_RWKV)) = w;
                    }
                }
    }
};
struct EpiFfn1 {
    static constexpr bool PERM = true;
    const P* p; int l;
    __device__ __forceinline__ void operator()(const f32x4 (&acc)[2][2][4][2], const Unit& u, int wr, int wc, int fr, int fq) const {
        const int row0 = u.pm * BM + wr * 64 + fr, j0 = u.pn * 128 + wc * 32 + 8 * fq, c0 = u.pn * 256 + wc * 32 + 8 * fq;
        bf16_t* HA = (bf16_t*)(p->ws + WS_UR);
        const float* rsq = (const float*)(p->ws + WS_RSQ) + (size_t)(2 * l + 1) * NTOK;
        const float* bc = (const float*)(p->ws + WS_BIAS) + 2 * 3 * 3072 + (size_t)(l * 3 + tok_cls(u.pm * BM)) * 5632 + c0;
        float rs[2][4]; float4 bg[2], bu[2];
#pragma unroll
        for (int ai = 0; ai < 2; ++ai)
#pragma unroll
            for (int m = 0; m < 4; ++m) rs[ai][m] = rsq[row0 + ai * HALF + m * 16];
#pragma unroll
        for (int n = 0; n < 2; ++n) { bg[n] = *(const float4*)(bc + n * 4); bu[n] = *(const float4*)(bc + 128 + n * 4); }
#pragma unroll
        for (int ai = 0; ai < 2; ++ai)
#pragma unroll
            for (int m = 0; m < 4; ++m) rs[ai][m] = rsqrtf(rs[ai][m] * (1.f / 1024.f) + 1e-6f);
#pragma unroll
        for (int ai = 0; ai < 2; ++ai)
#pragma unroll
            for (int m = 0; m < 4; ++m) {
                const int row = row0 + ai * HALF + m * 16; const float r = rs[ai][m];
                float h[8];
#pragma unroll
                for (int n = 0; n < 2; ++n) {
                    const f32x4 g = acc[ai][0][m][n], up = acc[ai][1][m][n];
                    const float bgv[4] = {bg[n].x, bg[n].y, bg[n].z, bg[n].w}, buv[4] = {bu[n].x, bu[n].y, bu[n].z, bu[n].w};
#pragma unroll
                    for (int e = 0; e < 4; ++e) { const float gt = g[e] * r + bgv[e], uu = up[e] * r + buv[e]; h[4 * n + e] = gt * sigmoidf_(gt) * uu; }
                }
                uint4 w; w.x = pk_bf16(h[0], h[1]); w.y = pk_bf16(h[2], h[3]); w.z = pk_bf16(h[4], h[5]); w.w = pk_bf16(h[6], h[7]);
                *(uint4*)(HA + (size_t)row * D_FF + j0) = w;
            }
    }
};
struct EpiResN {
    static constexpr bool PERM = true;
    const P* p; int l, which;
    const float* ng; int nl, nsc;
    bf16_t* Hout; float* rsq;
    __device__ __forceinline__ void operator()(const f32x4 (&acc)[2][2][4][2], const Unit& u, int wr, int wc, int fr, int fq) const {
        const int row0 = u.pm * BM + wr * 64 + fr, col0 = u.pn * BM + wc * 32 + 8 * fq;
        const int cls = tok_cls(u.pm * BM);
        const float* g = mod_vec(*p, l, cls, which) + col0;
        float4 gg[2][2], gw[2][2];
#pragma unroll
        for (int bj = 0; bj < 2; ++bj)
#pragma unroll
            for (int n = 0; n < 2; ++n) {
                gg[bj][n] = *(const float4*)(g + bj * HALF + n * 4);
                if (ng) { const float4 gn = *(const float4*)(ng + col0 + bj * HALF + n * 4), sc = *(const float4*)(mod_vec(*p, nl, cls, nsc) + col0 + bj * HALF + n * 4);
                    gw[bj][n] = make_float4(gn.x * (1.f + sc.x), gn.y * (1.f + sc.y), gn.z * (1.f + sc.z), gn.w * (1.f + sc.w)); }
            }
#pragma unroll
        for (int ai = 0; ai < 2; ++ai)
#pragma unroll
            for (int mp = 0; mp < 4; mp += 2) {
                float4 x[2][2][2];
#pragma unroll
                for (int q = 0; q < 2; ++q) {
                    const int row = row0 + ai * HALF + (mp + q) * 16;
                    const float* xo = ((which == 2 && l == 0) ? xin_row(*p, row) : X_row(*p, row)) + col0;
#pragma unroll
                    for (int bj = 0; bj < 2; ++bj)
#pragma unroll
                        for (int n = 0; n < 2; ++n) x[q][bj][n] = *(const float4*)(xo + bj * HALF + n * 4);
                }
#pragma unroll
                for (int q = 0; q < 2; ++q) {
                    const int row = row0 + ai * HALF + (mp + q) * 16;
                    float ssq = 0.f;
#pragma unroll
                    for (int bj = 0; bj < 2; ++bj) {
                        float4 xn[2];
#pragma unroll
                        for (int n = 0; n < 2; ++n) {
                            const f32x4 a = acc[ai][bj][mp + q][n]; const float4 xv = x[q][bj][n], gv = gg[bj][n];
                            xn[n] = make_float4(xv.x + gv.x * a[0], xv.y + gv.y * a[1], xv.z + gv.z * a[2], xv.w + gv.w * a[3]);
                            *(float4*)(X_row(*p, row) + col0 + bj * HALF + n * 4) = xn[n];
                        }
                        if (ng) {
                            ssq += xn[0].x * xn[0].x + xn[0].y * xn[0].y + xn[0].z * xn[0].z + xn[0].w * xn[0].w + xn[1].x * xn[1].x + xn[1].y * xn[1].y + xn[1].z * xn[1].z + xn[1].w * xn[1].w;
                            const float4 w0 = gw[bj][0], w1 = gw[bj][1];
                            uint4 w; w.x = pk_bf16(xn[0].x * w0.x, xn[0].y * w0.y); w.y = pk_bf16(xn[0].z * w0.z, xn[0].w * w0.w); w.z = pk_bf16(xn[1].x * w1.x, xn[1].y * w1.y); w.w = pk_bf16(xn[1].z * w1.z, xn[1].w * w1.w);
                            *(uint4*)(Hout + (size_t)row * 1024 + col0 + bj * HALF) = w;
                        }
                    }
                    if (ng) { ssq += __shfl_xor(ssq, 16); ssq += __shfl_xor(ssq, 32); if (fq == 0) unsafeAtomicAdd(rsq + row, ssq); }
                }
            }
    }
};
}


typedef short bf16x8_t __attribute__((ext_vector_type(8)));
typedef short bf16x4_t __attribute__((ext_vector_type(4)));
typedef float f32x16_t __attribute__((ext_vector_type(16)));
#define AT_KS_BYTES (256 * 72 * 2)
__device__ __forceinline__ void attn_stage(const P& p, int l, int s, int h, int start, int nctx, int chunk, bool withV, bf16_t* Ks, bf16_t* Vt, int tid) {
    const int key = tid >> 1, half = tid & 1, j = chunk * 256 + key;
    if (j < nctx) {
        const size_t base = (((size_t)(s - 32) * 2 + l) * 512 + j) * 384 + h * 64 + half * 32;
        const float4* kp = (const float4*)(p.cache_k + base);
#pragma unroll
        for (int i = 0; i < 4; ++i) { const float4 a = kp[2 * i], b = kp[2 * i + 1]; uint4 o; o.x = pk_bf16(a.x, a.y); o.y = pk_bf16(a.z, a.w); o.z = pk_bf16(b.x, b.y); o.w = pk_bf16(b.z, b.w);
            *(uint4*)(Ks + key * 72 + half * 32 + i * 8) = o; }
        if (withV) { const float4* vp = (const float4*)(p.cache_v + base);
#pragma unroll
            for (int i = 0; i < 8; ++i) { const float4 a = vp[i]; bf16_t* d = Vt + (half * 32 + i * 4) * 260 + key; d[0] = f2bf(a.x); d[260] = f2bf(a.y); d[520] = f2bf(a.z); d[780] = f2bf(a.w); } }
    } else {
        const bf16_t* UD = (const bf16_t*)(p.ws + WS_UD);
        const size_t base = (size_t)(start + j - nctx) * 1152 + h * 64 + half * 32;
        const uint4* kp = (const uint4*)(UD + base + 384);
#pragma unroll
        for (int i = 0; i < 4; ++i) *(uint4*)(Ks + key * 72 + half * 32 + i * 8) = kp[i];
        if (withV) { const uint4* vp = (const uint4*)(UD + base + 768);
#pragma unroll
            for (int i = 0; i < 4; ++i) { const uint4 u = vp[i]; const unsigned w[4] = {u.x, u.y, u.z, u.w}; bf16_t* d = Vt + (half * 32 + i * 8) * 260 + key;
#pragma unroll
                for (int e = 0; e < 4; ++e) { d[(2 * e) * 260] = (bf16_t)(w[e] & 0xffff); d[(2 * e + 1) * 260] = (bf16_t)(w[e] >> 16); } } }
    }
}
__device__ __forceinline__ void attn_item(const P& p, int l, int item, unsigned char* lds, float lam, float lam_init) {
    const int tid = otid(), lane = tid & 63, wv = tid >> 6, n = lane & 31, hh = lane >> 5;
    int s, h, qb;
    if (item < 48) { s = 32 + item / 24; h = (item % 24) / 4; qb = item & 3; } else { const int r = item - 48; s = r / 6; h = r % 6; qb = 0; }
    int start, T; seq_info(s, start, T);
    const int nctx = s >= 32 ? 512 : 0, nchunks = (nctx + T) >> 8;
    bf16_t* Ks = (bf16_t*)lds; bf16_t* Vt = (bf16_t*)(lds + AT_KS_BYTES);
    const bf16_t* UD = (const bf16_t*)(p.ws + WS_UD);
    const int qtok = start + qb * 256 + wv * 32 + n;
    bf16x8_t Qf[2][2];
#pragma unroll
    for (int m = 0; m < 2; ++m)
#pragma unroll
        for (int si = 0; si < 2; ++si) Qf[m][si] = *(const bf16x8_t*)(UD + (size_t)qtok * 1152 + h * 64 + m * 32 + si * 16 + hh * 8);
    const float c = 0.17677669529663687f * 1.4426950408889634f;
    float m0 = -1e30f, m1 = -1e30f;
    for (int ch = 0; ch < nchunks; ++ch) {
        __syncthreads();
        attn_stage(p, l, s, h, start, nctx, ch, nchunks == 1, Ks, Vt, tid);
        __syncthreads();
#pragma unroll 2
        for (int kt = 0; kt < 8; ++kt) {
            f32x16_t S0 = {0,0,0,0,0,0,0,0,0,0,0,0,0,0,0,0}, S1 = S0;
#pragma unroll
            for (int si = 0; si < 2; ++si) {
                const bf16x8_t k0 = *(const bf16x8_t*)(Ks + (kt * 32 + n) * 72 + si * 16 + hh * 8);
                const bf16x8_t k1 = *(const bf16x8_t*)(Ks + (kt * 32 + n) * 72 + 32 + si * 16 + hh * 8);
                S0 = __builtin_amdgcn_mfma_f32_32x32x16_bf16(k0, Qf[0][si], S0, 0, 0, 0);
                S1 = __builtin_amdgcn_mfma_f32_32x32x16_bf16(k1, Qf[1][si], S1, 0, 0, 0);
            }
#pragma unroll
            for (int r = 0; r < 16; ++r) { m0 = fmaxf(m0, S0[r]); m1 = fmaxf(m1, S1[r]); }
        }
    }
    m0 = fmaxf(m0, __shfl_xor(m0, 32)); m1 = fmaxf(m1, __shfl_xor(m1, 32));
    const float mc0 = m0 * c, mc1 = m1 * c;
    float l0 = 0.f, l1 = 0.f;
    f32x16_t O0 = {0,0,0,0,0,0,0,0,0,0,0,0,0,0,0,0}, O1 = O0, B0 = O0, B1 = O0;
    for (int ch = 0; ch < nchunks; ++ch) {
        if (nchunks > 1) {
            __syncthreads();
            attn_stage(p, l, s, h, start, nctx, ch, true, Ks, Vt, tid);
            __syncthreads();
        }
#pragma unroll 1
        for (int kt = 0; kt < 8; ++kt) {
            f32x16_t S0 = {0,0,0,0,0,0,0,0,0,0,0,0,0,0,0,0}, S1 = S0;
#pragma unroll
            for (int si = 0; si < 2; ++si) {
                const bf16x8_t k0 = *(const bf16x8_t*)(Ks + (kt * 32 + n) * 72 + si * 16 + hh * 8);
                const bf16x8_t k1 = *(const bf16x8_t*)(Ks + (kt * 32 + n) * 72 + 32 + si * 16 + hh * 8);
                S0 = __builtin_amdgcn_mfma_f32_32x32x16_bf16(k0, Qf[0][si], S0, 0, 0, 0);
                S1 = __builtin_amdgcn_mfma_f32_32x32x16_bf16(k1, Qf[1][si], S1, 0, 0, 0);
            }
            float pa[16], pb[16];
#pragma unroll
            for (int r = 0; r < 16; ++r) { pa[r] = __builtin_amdgcn_exp2f(__builtin_fmaf(S0[r], c, -mc0)); pb[r] = __builtin_amdgcn_exp2f(__builtin_fmaf(S1[r], c, -mc1)); l0 += pa[r]; l1 += pb[r]; }
#pragma unroll
            for (int si = 0; si < 2; ++si) {
                union { unsigned u[4]; bf16x8_t v; } pf, pg;
#pragma unroll
                for (int e = 0; e < 4; ++e) { pf.u[e] = pk_bf16(pa[8 * si + 2 * e], pa[8 * si + 2 * e + 1]); pg.u[e] = pk_bf16(pb[8 * si + 2 * e], pb[8 * si + 2 * e + 1]); }
                union { bf16x4_t h2[2]; bf16x8_t v; } va, vb;
                const bf16_t* v0 = Vt + n * 260 + kt * 32 + si * 16 + hh * 4;
                va.h2[0] = *(const bf16x4_t*)v0; va.h2[1] = *(const bf16x4_t*)(v0 + 8);
                vb.h2[0] = *(const bf16x4_t*)(v0 + 32 * 260); vb.h2[1] = *(const bf16x4_t*)(v0 + 32 * 260 + 8);
                O0 = __builtin_amdgcn_mfma_f32_32x32x16_bf16(va.v, pf.v, O0, 0, 0, 0);
                O1 = __builtin_amdgcn_mfma_f32_32x32x16_bf16(vb.v, pf.v, O1, 0, 0, 0);
                B0 = __builtin_amdgcn_mfma_f32_32x32x16_bf16(va.v, pg.v, B0, 0, 0, 0);
                B1 = __builtin_amdgcn_mfma_f32_32x32x16_bf16(vb.v, pg.v, B1, 0, 0, 0);
            }
        }
    }
    l0 += __shfl_xor(l0, 32); l1 += __shfl_xor(l1, 32);
    {
        const float i0 = 1.f / l0, i1 = lam / l1;
#pragma unroll
        for (int r = 0; r < 16; ++r) { O0[r] = O0[r] * i0 - B0[r] * i1; O1[r] = O1[r] * i0 - B1[r] * i1; }
    }
    float ss = 0.f;
#pragma unroll
    for (int r = 0; r < 16; ++r) ss += O0[r] * O0[r] + O1[r] * O1[r];
    ss += __shfl_xor(ss, 32);
    const float rs = rsqrtf(ss * (1.f / 64.f) + 1e-5f) * (1.f - lam_init);
    bf16_t* mo = (bf16_t*)(p.ws + WS_H) + (size_t)qtok * 1024 + 384 + h * 64;
    const float* sg = p.subln_g + (size_t)l * 64;
#pragma unroll
    for (int g = 0; g < 4; ++g) {
        const int vd = 8 * g + 4 * hh;
        uint2 w0, w1;
        w0.x = pk_bf16(O0[4 * g] * rs * sg[vd], O0[4 * g + 1] * rs * sg[vd + 1]); w0.y = pk_bf16(O0[4 * g + 2] * rs * sg[vd + 2], O0[4 * g + 3] * rs * sg[vd + 3]);
        w1.x = pk_bf16(O1[4 * g] * rs * sg[32 + vd], O1[4 * g + 1] * rs * sg[32 + vd + 1]); w1.y = pk_bf16(O1[4 * g + 2] * rs * sg[32 + vd + 2], O1[4 * g + 3] * rs * sg[32 + vd + 3]);
        *(uint2*)(mo + vd) = w0; *(uint2*)(mo + 32 + vd) = w1;
    }
}

struct EpiFnet {
    int samp;
    __device__ __forceinline__ void operator()(const P& p, int row, int col, const float* v) const {
        const int sq = col >> 8, ch = col & 255;
        const int tok = samp ? NPTOK + sq * 1024 + row : sq * 256 + row;
        uint2 w; w.x = pk_bf16(v[0], v[1]); w.y = pk_bf16(v[2], v[3]);
        *(uint2*)((bf16_t*)(p.ws + WS_H) + (size_t)tok * 1024 + 768 + ch) = w;
    }
};
struct OneUnit { int pm, pn; __device__ bool next(int i, pg8::Unit& u) const { if (i) return false; u.pm = pm; u.pn = pn; return true; } };

#define MX_ITEMS 964
template <class GemmFn>
__device__ __forceinline__ void ph_mixer(const P& p, int l, unsigned char* lds, volatile LAS unsigned* slot, GemmFn gemm_one) {
    const float lam_init = 0.8f - 0.6f * __expf(-0.3f * (float)l);
    float lam;
    { const float* lp = p.diff_lambda + (size_t)l * 128; float s01 = 0.f, s23 = 0.f;
      for (int d = 0; d < 32; ++d) { s01 += lp[d] * lp[32 + d]; s23 += lp[64 + d] * lp[96 + d]; }
      lam = __expf(s01) - __expf(s23) + lam_init; }
    unsigned* ctr = (unsigned*)(p.ws + WS_CTL) + CTL_QUEUE + 64 * l;
    for (;;) {
        __syncthreads();
        if (threadIdx.x == 0) *slot = atomicAdd(ctr, 1u);
        __syncthreads();
        int item = (int)*slot;
        if (item >= MX_ITEMS) break;
        if (item >= 108 && item < 308) item = item < 116 ? item + 192 : item - 8;
        else if (item >= 308 && item < 532) item = item < 340 ? item + 192 : item - 32;
#if PROBE_ID
        const unsigned long long it0 = __builtin_amdgcn_s_memrealtime();
#endif
        if (item < 48) attn_item(p, l, item, lds, lam, lam_init);
        else if (item < 60) ph_scan_job(p, l, 32 + (item - 48) / NH, (item - 48) % NH, 0, 0, 0, 0, SEG0_LEN, (float*)lds);
        else if (item < 108) { const int r = item - 60, sg = 1 + (r & 1), dr = (r >> 1) & 1, hh = (r >> 2) % NH, bb = r / 24;
            ph_scan_job(p, l, 32 + bb, hh, 1, dr, sg, sg == 1 ? SEG0_LEN : SEG0_LEN + SEG1_LEN, sg == 1 ? SEG1_LEN : SEG2_LEN, (float*)lds); }
        else if (item < 300) ph_scan_job(p, l, (item - 108) / NH, (item - 108) % NH, 0, 0, 0, 0, TP, (float*)lds);
        else if (item < 308) gemm_one(1, (item - 300) >> 1, (item - 300) & 1);
        else if (item < 500) attn_item(p, l, 48 + item - 308, lds, lam, lam_init);
        else if (item < 532) gemm_one(0, 0, item - 500);
        else if (item < 724) fixup_item(p, l, item - 532, (float*)lds);
        else finalize_item(p, l, item - 724);
        if (item >= 108 && item < 300) {
            asm volatile("s_waitcnt vmcnt(0)" ::: "memory");
            __syncthreads();
            if (threadIdx.x == 0) __hip_atomic_fetch_add((unsigned*)(p.ws + WS_CNT2) + 256 * l + (item - 108), 1u, __ATOMIC_RELAXED, __HIP_MEMORY_SCOPE_AGENT);
        }
        if (item >= 48 && item < 108) {
            asm volatile("s_waitcnt vmcnt(0)" ::: "memory");
            __syncthreads();
            if (threadIdx.x == 0) {
                __builtin_amdgcn_fence(__ATOMIC_RELEASE, "agent");
                asm volatile("s_waitcnt vmcnt(0)" ::: "memory");
                unsigned* cnt = (unsigned*)(p.ws + WS_CTL) + CTL_SCANDONE + 32 * l;
                if (item < 60) { const int bh = item - 48; __hip_atomic_fetch_add(cnt + bh * 2, 1u, __ATOMIC_RELAXED, __HIP_MEMORY_SCOPE_AGENT); __hip_atomic_fetch_add(cnt + bh * 2 + 1, 1u, __ATOMIC_RELAXED, __HIP_MEMORY_SCOPE_AGENT); }
                else { const int r = item - 60, dr = (r >> 1) & 1, hh = (r >> 2) % NH, bb = r / 24; __hip_atomic_fetch_add(cnt + (bb * NH + hh) * 2 + dr, 1u, __ATOMIC_RELAXED, __HIP_MEMORY_SCOPE_AGENT); }
            }
        }
#if PROBE_ID
        __syncthreads();
        if (threadIdx.x == 0 && l == 0) { const int cls = item < 48 ? 3 : item < 60 ? 0 : item < 108 ? 6 : item < 300 ? 2 : item < 308 ? 1 : item < 500 ? 5 : 4;
            atomicMax((unsigned*)(p.ws + WS_CTL) + 3712 + cls, (unsigned)(__builtin_amdgcn_s_memrealtime() - it0)); }
#endif
    }
}

#define XB_TMO      128
#define XB_XCNT(j)  (256  + 64 * (j))
#define XB_XSUB(j)  (1280 + 64 * (j))
#define XB_XGEN(j)  (2304 + 64 * (j))
#define XB_TOP      3328
#define XB_TOPGEN   3392
#define XCD_BAR_WORDS 3456
#define XB_SPIN_CAP (1u << 22)
__device__ __forceinline__ unsigned xb_ld(unsigned* p)              { return __hip_atomic_load(p, __ATOMIC_RELAXED, __HIP_MEMORY_SCOPE_AGENT); }
__device__ __forceinline__ unsigned xb_add(unsigned* p, unsigned v) { return __hip_atomic_fetch_add(p, v, __ATOMIC_RELAXED, __HIP_MEMORY_SCOPE_AGENT); }
__device__ __forceinline__ unsigned xb_xcc_id() { return (unsigned)__builtin_amdgcn_s_getreg((3 << 11) | 20) & 0xFu; }
#define XB_SPIN(cond, bar) do { unsigned _sp = 0; while (cond) { __builtin_amdgcn_s_sleep(1); \
    if ((++_sp & 255u) == 0u) { if (xb_ld(&(bar)[XB_TMO])) break; if (_sp > XB_SPIN_CAP) { atomicAdd(&(bar)[XB_TMO], 1u); break; } } } } while (0)
struct XcdBarrier { unsigned* bar; unsigned x; volatile LAS unsigned* st; };
__device__ __forceinline__ XcdBarrier xcd_barrier_post(unsigned* bar, volatile LAS unsigned* st) {
    XcdBarrier b; b.bar = bar; b.x = xb_xcc_id(); b.st = st;
    if (threadIdx.x == 0) (void)xb_add(&bar[XB_XCNT(b.x)], 1u);
    return b;
}
__device__ __forceinline__ void xcd_barrier_complete(unsigned* bar, unsigned x, unsigned& nloc, unsigned& nx) {
    const unsigned G = gridDim.x * gridDim.y * gridDim.z;
    unsigned sum, cnt, mine, sp = 0u;
    for (;;) {
        sum = 0u; cnt = 0u; mine = 0u;
#pragma unroll
        for (unsigned j = 0; j < 16; ++j) { const unsigned c = xb_ld(&bar[XB_XCNT(j)]); sum += c; cnt += (c > 0u) ? 1u : 0u; mine = (j == x) ? c : mine; }
        if (sum == G) break;
        __builtin_amdgcn_s_sleep(1);
        if ((++sp & 255u) == 0u) { if (xb_ld(&bar[XB_TMO])) break; if (sp > XB_SPIN_CAP) { atomicAdd(&bar[XB_TMO], 1u); break; } }
    }
    nloc = mine > 0u ? mine : 1u; nx = cnt > 0u ? cnt : 1u;
}
__device__ __forceinline__ void xcd_barrier(const XcdBarrier& b) {
    asm volatile("s_waitcnt vmcnt(0)" ::: "memory");
    __syncthreads();
    if (threadIdx.x == 0) {
        unsigned* bar = b.bar;
        __builtin_amdgcn_s_waitcnt(0);
        unsigned nloc = b.st[0], nx = b.st[1];
        if (nloc == 0u) { xcd_barrier_complete(bar, b.x, nloc, nx); b.st[0] = nloc; b.st[1] = nx; }
        const unsigned old = xb_add(&bar[XB_XSUB(b.x)], 1u);
        const unsigned gen = old / nloc;
        if (old + 1u == (gen + 1u) * nloc) {
            __builtin_amdgcn_fence(__ATOMIC_RELEASE, "agent");
            asm volatile("s_waitcnt vmcnt(0)" ::: "memory");
            const unsigned og = xb_add(&bar[XB_TOP], 1u);
            const unsigned tg = og / nx;
            if (og + 1u == (tg + 1u) * nx) xb_add(&bar[XB_TOPGEN], 1u);
            else XB_SPIN(xb_ld(&bar[XB_TOPGEN]) == tg, bar);
            __builtin_amdgcn_fence(__ATOMIC_ACQUIRE, "agent");
            xb_add(&bar[XB_XGEN(b.x)], 1u);
            asm volatile("s_waitcnt vmcnt(0)" ::: "memory");
        } else {
            XB_SPIN(xb_ld(&bar[XB_XGEN(b.x)]) == gen, bar);
            __builtin_amdgcn_fence(__ATOMIC_ACQUIRE, "agent");
            asm volatile("s_waitcnt vmcnt(0)" ::: "memory");
        }
    }
    __syncthreads();
}

#define MISC_OFF 158720
#define LDS_BYTES (MISC_OFF + 1024)
#define N_PHASES 15
struct Args { P p; int ph_lo, ph_hi; };
__global__ __launch_bounds__(512, 2) void mega(Args a) {
    extern __shared__ __attribute__((aligned(16))) unsigned char lds[];
    const P& p = a.p;
    LAS unsigned char* l3 = (LAS unsigned char*)lds;
    volatile LAS unsigned* misc = (volatile LAS unsigned*)(l3 + MISC_OFF);
    if (threadIdx.x < 16) misc[threadIdx.x] = 0u;
    __syncthreads();
    XcdBarrier bar = xcd_barrier_post((unsigned*)(p.ws + WS_CTL), misc);
    float* sm = (float*)lds;
    const int lo = a.ph_lo, hi = a.ph_hi;
#define IN(k) (lo <= (k) && (k) < hi)
#if PROBE_ID
    unsigned long long* tsl = (unsigned long long*)(p.ws + WS_CTL + 15360);
    if (blockIdx.x == 0 && otid() == 0) tsl[0] = __builtin_amdgcn_s_memrealtime();
#define SEAM(k) do { if (IN(k) && IN((k) + 1)) xcd_barrier(bar); if (blockIdx.x == 0 && otid() == 0) tsl[1 + (k)] = __builtin_amdgcn_s_memrealtime(); } while (0)
#else
#define SEAM(k) do { if (IN(k) && IN((k) + 1)) xcd_barrier(bar); } while (0)
#endif
    if (IN(0)) ph_prep0(p, sm);
    SEAM(0);
    if (IN(1)) ph_prep0b(p);
    SEAM(1);
    for (int l = 0; l < 2; ++l) {
        const int b0 = 2 + 6 * l;
        if (IN(b0 + 0)) { pg8::Gemm g{(const bf16_t*)(p.ws + WS_H), (const bf16_t*)(p.ws + WS_WIN) + (size_t)l * N1 * 1024, NTOK, N1, 1024};
            pg8::StaticOrder S; S.init(NTOK, N1, gridDim.x, blockIdx.x); pg8::EpiG1H E{&p, l}; pg8::gemm_phase(l3, g, S, E);
            if (l == 0 && blockIdx.x >= 224) mod_item(p, sm, 96 + (blockIdx.x - 224)); }
        SEAM(b0 + 0);
        if (IN(b0 + 1)) ph_prep(p, l, sm);
        SEAM(b0 + 1);
        if (IN(b0 + 2)) {
            auto gemm_one = [&](int samp, int pm, int pn) {
                pg8::Gemm g{samp ? (const bf16_t*)(p.ws + WS_L1024) : (const bf16_t*)(p.ws + WS_L256), samp ? (const bf16_t*)(p.ws + WS_ZF) + (size_t)8192 * 512 : (const bf16_t*)(p.ws + WS_ZF),
                            samp ? 1024 : 256, samp ? 512 : 8192, samp ? 2048 : 512};
                OneUnit S{pm, pn}; pg8::EpiWrap<EpiFnet> E{&p, EpiFnet{samp}}; pg8::gemm_phase(l3, g, S, E); };
            ph_mixer(p, l, lds, misc + 4, gemm_one);
        }
        SEAM(b0 + 2);
        if (IN(b0 + 3)) { pg8::Gemm g{(const bf16_t*)(p.ws + WS_H), (const bf16_t*)(p.ws + WS_WOUT) + (size_t)l * 1024 * 1024, NTOK, 1024, 1024};
            pg8::StaticOrder S; S.init(NTOK, 1024, gridDim.x, blockIdx.x);
            pg8::EpiResN E{&p, l, 2, p.norm2_g + (size_t)l * 1024, l, 4, (bf16_t*)(p.ws + WS_H2), (float*)(p.ws + WS_RSQ) + (size_t)(2 * l + 1) * NTOK}; pg8::gemm_phase(l3, g, S, E);
            if (blockIdx.x >= 160) { if (l == 0) { p0_convert(p, sm, 0, 608, 784, blockIdx.x - 160, gridDim.x - 160, NoPre{}); __syncthreads(); p0_convert(p, sm, 1, 0, 256, blockIdx.x - 160, gridDim.x - 160, NoPre{}); } else bias_gemv(p, 3, blockIdx.x - 160, gridDim.x - 160); } }
        SEAM(b0 + 3);
        if (IN(b0 + 4)) { pg8::Gemm g{(const bf16_t*)(p.ws + WS_H2), (const bf16_t*)(p.ws + WS_WF1) + (size_t)l * 5632 * 1024, NTOK, 5632, 1024};
            pg8::StaticOrder S; S.init(NTOK, 5632, gridDim.x, blockIdx.x); pg8::EpiFfn1 E{&p, l}; pg8::gemm_phase(l3, g, S, E);
            if (l == 0 && blockIdx.x >= 112 && blockIdx.x < 176) { __syncthreads(); mod_item(p, sm, 128 + (blockIdx.x - 112)); } }
        SEAM(b0 + 4);
        if (IN(b0 + 5)) { pg8::Gemm g{(const bf16_t*)(p.ws + WS_UR), (const bf16_t*)(p.ws + WS_WF2) + (size_t)l * 1024 * 2816, NTOK, 1024, 2816};
            pg8::StaticOrder S; S.init(NTOK, 1024, gridDim.x, blockIdx.x);
            pg8::EpiResN E{&p, l, 5, l == 0 ? p.norm1_g + 1024 : (const float*)nullptr, 1, 1, (bf16_t*)(p.ws + WS_H), (float*)(p.ws + WS_RSQ) + (size_t)2 * NTOK}; pg8::gemm_phase(l3, g, S, E);
            if (l == 0 && blockIdx.x >= 160) { p0_convert(p, sm, 1, 256, 784, blockIdx.x - 160, gridDim.x - 160, NoPre{}); bias_gemv(p, 1, blockIdx.x - 160, gridDim.x - 160); } }
        SEAM(b0 + 5);
    }
    if (IN(14)) ph_norm(p, 0, 2);
#if PROBE_ID
    __syncthreads();
    if (blockIdx.x == 0 && otid() == 0) {
        tsl[15] = __builtin_amdgcn_s_memrealtime();
        __threadfence();
        unsigned long long acc = 0;
#pragma unroll 1
        for (int k = 0; k < 15; ++k) {
            const int st = k == 0 ? -1 : (k == 1 ? -3 : (k == 14 ? -2 : 30 + (k - 2) % 6));
            bool sel = false;
            if (PROBE_ID == 1) sel = (k == 0);
            if (PROBE_ID == 2) sel = (st == 10 || st == 15 || st == 16 || st == 17);
            if (PROBE_ID == 3) sel = (st == 12);
            if (PROBE_ID == 4) sel = (st == -2 || st == -3);
            if (PROBE_ID == 5) sel = (st == 11);
            if (PROBE_ID == 6) sel = (st == 13);
            if (PROBE_ID == 7) sel = (st == 14);
            if (PROBE_ID == 8) sel = (st == 10);
            if (PROBE_ID == 9) sel = (st == 15);
            if (PROBE_ID == 10) sel = (st == 16);
            if (PROBE_ID == 11) sel = (st == 17);
            if (sel) acc += __hip_atomic_load(tsl + 1 + k, __ATOMIC_RELAXED, __HIP_MEMORY_SCOPE_AGENT) - __hip_atomic_load(tsl + k, __ATOMIC_RELAXED, __HIP_MEMORY_SCOPE_AGENT);
        }
        if (PROBE_ID >= 30 && PROBE_ID < 34) { unsigned long long* tsp = (unsigned long long*)(p.ws + WS_CTL + 15360) + 32; acc = __hip_atomic_load(tsp + (PROBE_ID - 29), __ATOMIC_RELAXED, __HIP_MEMORY_SCOPE_AGENT) - __hip_atomic_load(tsp + (PROBE_ID - 30), __ATOMIC_RELAXED, __HIP_MEMORY_SCOPE_AGENT); }
        else if (PROBE_ID >= 20) acc = __hip_atomic_load((unsigned*)(p.ws + WS_CTL) + 3712 + (PROBE_ID - 20), __ATOMIC_RELAXED, __HIP_MEMORY_SCOPE_AGENT);
        const unsigned long long t_end = __builtin_amdgcn_s_memrealtime();
        while (__builtin_amdgcn_s_memrealtime() - t_end < 4ull * acc) __builtin_amdgcn_s_sleep(8);
    }
#endif
#undef IN
#undef SEAM
}

extern "C" void kernel_launch(void* const* d_in, const int* in_sizes, int n_in, void* d_out, int out_size, void* d_ws, size_t ws_size, hipStream_t stream) {
    static int grid = 0;
    if (grid == 0) {
        if (n_in != 29 || ws_size < WS_END) { fprintf(stderr, "kernel_launch: bad n_in %d or ws_size %zu (need %zu)\n", n_in, ws_size, (size_t)WS_END); grid = -1; return; }
        int dev = 0, cus = 0, per_cu = 0;
        hipGetDevice(&dev); hipDeviceGetAttribute(&cus, hipDeviceAttributeMultiprocessorCount, dev);
        if (hipFuncSetAttribute((const void*)mega, hipFuncAttributeMaxDynamicSharedMemorySize, LDS_BYTES) != hipSuccess) { fprintf(stderr, "kernel_launch: hipFuncSetAttribute failed\n"); grid = -1; return; }
        if (hipOccupancyMaxActiveBlocksPerMultiprocessor(&per_cu, (const void*)mega, 512, LDS_BYTES) != hipSuccess || per_cu < 1) { fprintf(stderr, "kernel_launch: occupancy query says %d\n", per_cu); per_cu = 1; }
        (void)hipGetLastError();
        if (cus < 256) { fprintf(stderr, "kernel_launch: %d CUs, the phase schedules are written for 256 resident workgroups\n", cus); grid = -1; return; }
        grid = 256;
    }
    if (grid < 0) return;
    hipMemsetAsync((unsigned char*)d_ws + WS_CTL, 0, 16384 + 4 * NTOK * 4 + 2048 + 2 * 3 * 6144 * 4, stream);
    Args a{};
    const float** f = (const float**)&a.p;
    for (int i = 0; i < 29; ++i) f[i] = (const float*)d_in[i];
    a.p.out = (float*)d_out; a.p.ws = (unsigned char*)d_ws;
#if ONE_LAUNCH
    a.ph_lo = 0; a.ph_hi = N_PHASES;
    hipLaunchKernelGGL(mega, dim3(grid), dim3(512), LDS_BYTES, stream, a);
#else
    for (int ph = 0; ph < N_PHASES; ++ph) { a.ph_lo = ph; a.ph_hi = ph + 1; hipLaunchKernelGGL(mega, dim3(grid), dim3(512), LDS_BYTES, stream, a); }
#endif
}
```
